# Optimizing an MI355X kernel written in HIP

```python
import jax, jax.numpy as jnp
from jax import lax
import numpy as np

D_MODEL = 2048
BATCH = 2
SEQ = 16384
DEPTH = 2

GRID_W = 64
CTX_LEN = 256
HEAD_DIM = 128
A_HEADS = 8
A_KV_HEADS = 2
A_WINDOW = 128
A_BLOCK = 128
B_HEADS = 8
NA_ROWS = 8
NA_COLS = 16
ROPE_THETA = 10000.0
A_Q_COLS = A_HEADS * HEAD_DIM
A_KV_COLS = A_KV_HEADS * HEAD_DIM
B_COLS = B_HEADS * HEAD_DIM
QKV_COLS = A_Q_COLS + 2 * A_KV_COLS + 3 * B_COLS
QKV_SPLITS = (A_Q_COLS, A_Q_COLS + A_KV_COLS, A_Q_COLS + 2 * A_KV_COLS, A_Q_COLS + 2 * A_KV_COLS + B_COLS, A_Q_COLS + 2 * A_KV_COLS + 2 * B_COLS)
MIX_WIDTH = A_Q_COLS + B_COLS
RW_HEAD = 64
RW_HEADS = D_MODEL // RW_HEAD
RW_DECAY_LORA = 96
RW_AAA_LORA = 96
RW_GATE_LORA = 256
RW_LNX_EPS = 64e-5
N_GROUPS = 4
EXPERTS_PER_GROUP = 8
N_EXPERTS = N_GROUPS * EXPERTS_PER_GROUP
TOP_K = 2
EXPERT_FF = 512
MOE_BLOCK = 128
NORM_EPS = 1e-6
NEG_INF = -1e30

kernel_name = 'hybrid_diffusion_backbone'


def rmsnorm(x, g):
    xf = x.astype(jnp.float32)
    y = xf * lax.rsqrt(jnp.mean(xf * xf, axis=-1, keepdims=True) + NORM_EPS)
    return (y * g.astype(jnp.float32)).astype(x.dtype)


def ada_split(silu_cond, w, b):
    mod = (silu_cond @ w + b)[..., None, :]
    return jnp.split(mod, 6, axis=-1)


def axial_rope(x, row_pos, col_pos):
    half = x.shape[-1] // 2
    quarter = half // 2
    inv_freq = ROPE_THETA ** (-jnp.arange(quarter, dtype=jnp.float32) / quarter)

    def rotate(xp, pos):
        ang = pos.astype(jnp.float32)[:, None] * inv_freq[None, :]
        cos, sin = jnp.cos(ang)[None, :, None, :], jnp.sin(ang)[None, :, None, :]
        x1, x2 = xp[..., :quarter], xp[..., quarter:]
        return jnp.concatenate([x1 * cos - x2 * sin, x1 * sin + x2 * cos], axis=-1)

    xf = x.astype(jnp.float32)
    return jnp.concatenate([rotate(xf[..., :half], row_pos), rotate(xf[..., half:], col_pos)], axis=-1).astype(x.dtype)


def softmax_with_sink(logits, sink):
    m = jnp.maximum(jnp.max(logits, axis=-1, keepdims=True), sink)
    p = jnp.exp(logits - m)
    return p / (jnp.sum(p, axis=-1, keepdims=True) + jnp.exp(sink - m))


def split_heads(p):
    B, L, _ = p.shape
    parts = jnp.split(p, QKV_SPLITS, axis=-1)
    return tuple(t.reshape(B, L, -1, HEAD_DIM) for t in parts)


def window_attention(q, k, v, kc, vc, sink):
    B, L, _, dh = q.shape
    G = A_HEADS // A_KV_HEADS
    nb = L // A_BLOCK
    scale = dh ** -0.5
    qb = q.reshape(B, nb, A_BLOCK, A_KV_HEADS, G, dh)
    pad = ((0, 0), (A_BLOCK, A_BLOCK), (0, 0), (0, 0))
    kp = jnp.pad(k, pad).reshape(B, nb + 2, A_BLOCK, A_KV_HEADS, dh)
    vp = jnp.pad(v, pad).reshape(B, nb + 2, A_BLOCK, A_KV_HEADS, dh)
    kw = jnp.concatenate([kp[:, :-2], kp[:, 1:-1], kp[:, 2:]], axis=2)
    vw = jnp.concatenate([vp[:, :-2], vp[:, 1:-1], vp[:, 2:]], axis=2)
    blk = jnp.arange(nb)[:, None]
    qpos = blk * A_BLOCK + jnp.arange(A_BLOCK)[None, :]
    kpos = (blk - 1) * A_BLOCK + jnp.arange(3 * A_BLOCK)[None, :]
    valid = (jnp.abs(qpos[:, :, None] - kpos[:, None, :]) <= A_WINDOW) & (kpos[:, None, :] >= 0) & (kpos[:, None, :] < L)
    s_win = jnp.einsum('bnqkgd,bnskd->bnkgqs', qb, kw).astype(jnp.float32) * scale
    s_win = jnp.where(valid[None, :, None, None], s_win, NEG_INF)
    s_ctx = jnp.einsum('bnqkgd,bckd->bnkgqc', qb, kc).astype(jnp.float32) * scale
    sink_b = sink.astype(jnp.float32).reshape(A_KV_HEADS, G)[None, None, :, :, None, None]
    p = softmax_with_sink(jnp.concatenate([s_win, s_ctx], axis=-1), sink_b).astype(v.dtype)
    nw = 3 * A_BLOCK
    o = jnp.einsum('bnkgqs,bnskd->bnqkgd', p[..., :nw], vw) + jnp.einsum('bnkgqc,bckd->bnqkgd', p[..., nw:], vc)
    return o.reshape(B, L, A_HEADS * dh)


def neighbourhood_attention(q, k, v, kc, vc, rpb):
    B, L, H, dh = q.shape
    rows = L // GRID_W
    kr = min(NA_ROWS, rows)
    scale = dh ** -0.5
    r = jnp.arange(rows)
    col = jnp.arange(GRID_W)
    r0 = jnp.clip(r - kr // 2, 0, rows - kr)
    c0 = jnp.clip(col - NA_COLS // 2, 0, GRID_W - NA_COLS)
    band = r0[:, None] + jnp.arange(kr)[None, :]
    qg = q.reshape(B, rows, GRID_W, H, dh)
    kg = k.reshape(B, rows, GRID_W, H, dh)[:, band]
    vg = v.reshape(B, rows, GRID_W, H, dh)[:, band]
    col_ok = (col[None, :] >= c0[:, None]) & (col[None, :] < c0[:, None] + NA_COLS)
    dr = band - r[:, None] + (NA_ROWS - 1)
    dc = jnp.clip(col[None, :] - col[:, None] + (NA_COLS - 1), 0, 2 * NA_COLS - 2)
    bias = rpb.astype(jnp.float32)[:, dr[:, None, :, None], dc[None, :, None, :]]
    s_nb = jnp.einsum('brqhd,brjwhd->bhrqjw', qg, kg).astype(jnp.float32) * scale + bias
    s_nb = jnp.where(col_ok[:, None, :], s_nb, NEG_INF).reshape(B, H, rows, GRID_W, kr * GRID_W)
    s_ctx = jnp.einsum('brqhd,bchd->bhrqc', qg, kc).astype(jnp.float32) * scale
    p = jax.nn.softmax(jnp.concatenate([s_nb, s_ctx], axis=-1), axis=-1).astype(v.dtype)
    nk = kr * GRID_W
    p_nb = p[..., :nk].reshape(B, H, rows, GRID_W, kr, GRID_W)
    o = jnp.einsum('bhrqjw,brjwhd->brqhd', p_nb, vg) + jnp.einsum('bhrqc,bchd->brqhd', p[..., nk:], vc)
    return o.reshape(B, L, H * dh)


def context_attention(qc, kc, vc, sink):
    B, C, Hq, dh = qc.shape
    Hk = kc.shape[2]
    G = Hq // Hk
    qg = qc.reshape(B, C, Hk, G, dh)
    s = jnp.einsum('bqkgd,bckd->bkgqc', qg, kc).astype(jnp.float32) * dh ** -0.5
    if sink is None:
        p = jax.nn.softmax(s, axis=-1)
    else:
        p = softmax_with_sink(s, sink.astype(jnp.float32).reshape(Hk, G)[None, :, :, None, None])
    o = jnp.einsum('bkgqc,bckd->bqkgd', p.astype(vc.dtype), vc)
    return o.reshape(B, C, Hq * dh)


def attention_layer(h, hc, w_in, w_out, a_q_gain, a_k_gain, a_sink, b_q_gain, b_k_gain, b_rpb, row_pos, col_pos, need_ctx_out):
    qa, ka, va, qb, kb, vb = split_heads(h @ w_in)
    qa_c, ka_c, va_c, qb_c, kb_c, vb_c = split_heads(hc @ w_in)
    qa = axial_rope(rmsnorm(qa, a_q_gain), row_pos, col_pos)
    ka = axial_rope(rmsnorm(ka, a_k_gain), row_pos, col_pos)
    qb, kb = rmsnorm(qb, b_q_gain), rmsnorm(kb, b_k_gain)
    ka_c, kb_c = rmsnorm(ka_c, a_k_gain), rmsnorm(kb_c, b_k_gain)
    ya = window_attention(qa, ka, va, ka_c, va_c, a_sink)
    yb = neighbourhood_attention(qb, kb, vb, kb_c, vb_c, b_rpb)
    y = jnp.concatenate([ya, yb], axis=-1) @ w_out
    if not need_ctx_out:
        return y, None
    yac = context_attention(rmsnorm(qa_c, a_q_gain), ka_c, va_c, a_sink)
    ybc = context_attention(rmsnorm(qb_c, b_q_gain), kb_c, vb_c, None)
    return y, jnp.concatenate([yac, ybc], axis=-1) @ w_out


def centred_shift(x):
    xp = jnp.pad(x, ((0, 0), (1, 1), (0, 0)))
    return 0.5 * (xp[:, :-2] + xp[:, 2:]) - x


def l2_normalize(x):
    xf = x.astype(jnp.float32)
    return (xf * lax.rsqrt(jnp.sum(xf * xf, axis=-1, keepdims=True) + 1e-12)).astype(x.dtype)


def rwkv_prepare(x, mu, wr, wk, wv, w0, w1, w2, a0, a1, a2, g1, g2, k_k, k_a):
    B, L, D = x.shape
    heads = lambda t: t.reshape(B, L, RW_HEADS, RW_HEAD)
    xx = centred_shift(x)
    xr, xw, xk, xv, xa, xg = (x + xx * mu[m] for m in range(6))
    r = heads(xr @ wr)
    k = xk @ wk
    v = heads(xv @ wv)
    g = jax.nn.sigmoid(xg @ g1) @ g2
    kk = l2_normalize(heads(k * k_k))
    dirs = []
    for d in range(2):
        w_log = -jax.nn.softplus(-(w0[d] + jnp.tanh(xw @ w1[d]) @ w2[d]).astype(jnp.float32)) - 0.5
        decay = heads(jnp.exp(-jnp.exp(w_log)))
        a = jax.nn.sigmoid(a0[d] + (xa @ a1[d]) @ a2[d])
        kd = heads(k * (1 + (a - 1) * k_a))
        dirs.append((decay, kd, kk * heads(a)))
    return r, v, g, kk, dirs


def wkv_scan(state0, r, decay, k, v, a, b, reverse):
    xs = tuple(jnp.moveaxis(t.astype(jnp.float32), 1, 0) for t in (r, decay, k, v, a, b))

    def step(S, inp):
        rt, wt, kt, vt, at, bt = inp
        sa = jnp.einsum('bhvk,bhk->bhv', S, at)
        S = S * wt[:, :, None, :] + sa[..., None] * bt[:, :, None, :] + vt[..., None] * kt[:, :, None, :]
        return S, jnp.einsum('bhvk,bhk->bhv', S, rt)

    state, ys = lax.scan(step, state0, xs, reverse=reverse)
    return jnp.moveaxis(ys, 0, 1), state


def rwkv_output(y, r, v, g, k_sum, r_k, lnx_w, lnx_b, wo):
    B, L, H, N = y.shape
    mu = jnp.mean(y, axis=-1, keepdims=True)
    var = jnp.mean(jnp.square(y - mu), axis=-1, keepdims=True)
    yn = ((y - mu) * lax.rsqrt(var + RW_LNX_EPS)).reshape(B, L, H * N) * lnx_w + lnx_b
    bonus = jnp.sum((r * k_sum * r_k).astype(jnp.float32), axis=-1, keepdims=True) * v.astype(jnp.float32)
    return ((yn + bonus.reshape(B, L, H * N)).astype(g.dtype) * g) @ wo


def rwkv_layer(h, hc, mu, wr, wk, wv, wo, w0, w1, w2, a0, a1, a2, g1, g2, k_k, k_a, r_k, lnx_w, lnx_b, need_ctx_out):
    prep = lambda t: rwkv_prepare(t, mu, wr, wk, wv, w0, w1, w2, a0, a1, a2, g1, g2, k_k, k_a)
    r, v, g, kk, dirs = prep(h)
    rc, vc, gc, kkc, dirs_c = prep(hc)
    zero = jnp.zeros((h.shape[0], RW_HEADS, RW_HEAD, RW_HEAD), jnp.float32)
    y_parts, yc_parts = [], []
    for d, reverse in enumerate((False, True)):
        decay_c, k_c, b_c = dirs_c[d]
        yc_d, state_c = wkv_scan(zero, rc, decay_c, k_c, vc, -kkc, b_c, reverse)
        decay, kd, bd = dirs[d]
        y_d, _ = wkv_scan(state_c, r, decay, kd, v, -kk, bd, reverse)
        y_parts.append(y_d)
        yc_parts.append(yc_d)
    out = rwkv_output(y_parts[0] + y_parts[1], r, v, g, dirs[0][1] + dirs[1][1], r_k, lnx_w, lnx_b, wo)
    if not need_ctx_out:
        return out, None
    out_c = rwkv_output(yc_parts[0] + yc_parts[1], rc, vc, gc, dirs_c[0][1] + dirs_c[1][1], r_k, lnx_w, lnx_b, wo)
    return out, out_c


def hierarchical_moe(xt, w_grp, w_exp, w1, w3, w2):
    n, D = xt.shape
    xf = xt.astype(jnp.float32)
    p_grp = jax.nn.softmax(xf @ w_grp.astype(jnp.float32), axis=-1)
    g_sel = jnp.argmax(p_grp, axis=-1)
    p_sel = jnp.take_along_axis(p_grp, g_sel[:, None], axis=-1)
    logits = (xf @ w_exp.astype(jnp.float32)).reshape(n, N_GROUPS, EXPERTS_PER_GROUP)
    logits_g = jnp.take_along_axis(logits, g_sel[:, None, None], axis=1)[:, 0]
    top_val, top_idx = lax.top_k(logits_g, TOP_K)
    gate = p_sel * jax.nn.softmax(top_val, axis=-1)
    expert = g_sel[:, None] * EXPERTS_PER_GROUP + top_idx
    flat_e = expert.reshape(-1)
    flat_w = gate.reshape(-1)
    flat_tok = jnp.repeat(jnp.arange(n, dtype=jnp.int32), TOP_K)
    order = jnp.argsort(flat_e)
    se, stok, sw = flat_e[order], flat_tok[order], flat_w[order]
    counts = jnp.bincount(flat_e, length=N_EXPERTS)
    padded = (counts + MOE_BLOCK - 1) // MOE_BLOCK * MOE_BLOCK
    pad_end = jnp.cumsum(padded)
    start = jnp.cumsum(counts) - counts
    dest = pad_end[se] - padded[se] + jnp.arange(n * TOP_K) - start[se]
    n_blk = (n * TOP_K + N_EXPERTS * (MOE_BLOCK - 1) + MOE_BLOCK - 1) // MOE_BLOCK
    slots = n_blk * MOE_BLOCK
    slot_tok = jnp.full((slots,), n, jnp.int32).at[dest].set(stok)
    slot_w = jnp.zeros((slots,), jnp.float32).at[dest].set(sw)
    blk_expert = jnp.minimum(jnp.searchsorted(pad_end, jnp.arange(n_blk) * MOE_BLOCK, side='right'), N_EXPERTS - 1)
    x_rows = jnp.concatenate([xt, jnp.zeros((1, D), xt.dtype)], axis=0)[slot_tok].reshape(n_blk, MOE_BLOCK, D)

    def expert_block(args):
        xb, e = args
        return (jax.nn.silu(xb @ w1[e]) * (xb @ w3[e])) @ w2[e]

    y = lax.map(expert_block, (x_rows, blk_expert)).reshape(slots, D)
    out = jnp.zeros((n + 1, D), xt.dtype).at[slot_tok].add(y * slot_w[:, None].astype(xt.dtype))
    return out[:n]


def setup_inputs(seed: int = 0) -> dict:
    key = jax.random.key(seed)
    keys = iter(jax.random.split(key, 64))

    def normal(shape, scale):
        return jax.random.normal(next(keys), shape, jnp.float32) * scale

    def uniform(shape, lo, hi):
        return jax.random.uniform(next(keys), shape, jnp.float32, lo, hi)

    D = D_MODEL
    n_att = (DEPTH + 1) // 2
    n_rw = DEPTH // 2
    return {
        'x': normal((BATCH, SEQ, D), 1.0),
        'c': normal((BATCH, D), 1.0),
        'ctx': normal((BATCH, CTX_LEN, D), 1.0),
        'c_ctx': normal((D,), 1.0),
        'ada_w': normal((DEPTH, D, 6 * D), 0.5 * D ** -0.5),
        'ada_b': normal((DEPTH, 6 * D), 0.02),
        'norm_mix_g': 1.0 + normal((DEPTH, D), 0.02),
        'norm_ffn_g': 1.0 + normal((DEPTH, D), 0.02),
        'attn_w_in': normal((n_att, D, QKV_COLS), D ** -0.5),
        'attn_w_out': normal((n_att, MIX_WIDTH, D), MIX_WIDTH ** -0.5),
        'a_q_gain': 1.0 + normal((n_att, HEAD_DIM), 0.02),
        'a_k_gain': 1.0 + normal((n_att, HEAD_DIM), 0.02),
        'a_sink': normal((n_att, A_HEADS), 1.0),
        'b_q_gain': 1.0 + normal((n_att, HEAD_DIM), 0.02),
        'b_k_gain': 1.0 + normal((n_att, HEAD_DIM), 0.02),
        'b_rpb': normal((n_att, B_HEADS, 2 * NA_ROWS - 1, 2 * NA_COLS - 1), 0.5),
        'rw_mu': uniform((n_rw, 6, D), 0.0, 1.0),
        'rw_wr': normal((n_rw, D, D), D ** -0.5),
        'rw_wk': normal((n_rw, D, D), D ** -0.5),
        'rw_wv': normal((n_rw, D, D), D ** -0.5),
        'rw_wo': normal((n_rw, D, D), D ** -0.5),
        'rw_w0': uniform((n_rw, 2, D), -6.0, -1.0),
        'rw_w1': normal((n_rw, 2, D, RW_DECAY_LORA), D ** -0.5),
        'rw_w2': normal((n_rw, 2, RW_DECAY_LORA, D), 0.3 * RW_DECAY_LORA ** -0.5),
        'rw_a0': normal((n_rw, 2, D), 0.5),
        'rw_a1': normal((n_rw, 2, D, RW_AAA_LORA), D ** -0.5),
        'rw_a2': normal((n_rw, 2, RW_AAA_LORA, D), 0.5 * RW_AAA_LORA ** -0.5),
        'rw_g1': normal((n_rw, D, RW_GATE_LORA), D ** -0.5),
        'rw_g2': normal((n_rw, RW_GATE_LORA, D), RW_GATE_LORA ** -0.5),
        'rw_k_k': 1.0 + normal((n_rw, D), 0.1),
        'rw_k_a': 1.0 + normal((n_rw, D), 0.1),
        'rw_r_k': normal((n_rw, RW_HEADS, RW_HEAD), 0.1),
        'rw_lnx_w': 1.0 + normal((n_rw, D), 0.02),
        'rw_lnx_b': normal((n_rw, D), 0.02),
        'moe_w_grp': normal((DEPTH, D, N_GROUPS), D ** -0.5),
        'moe_w_exp': normal((DEPTH, D, N_EXPERTS), D ** -0.5),
        'moe_w1': normal((DEPTH, N_EXPERTS, D, EXPERT_FF), D ** -0.5),
        'moe_w3': normal((DEPTH, N_EXPERTS, D, EXPERT_FF), D ** -0.5),
        'moe_w2': normal((DEPTH, N_EXPERTS, EXPERT_FF, D), EXPERT_FF ** -0.5),
    }


def reference(x, c, ctx, c_ctx, ada_w, ada_b, norm_mix_g, norm_ffn_g, attn_w_in, attn_w_out, a_q_gain, a_k_gain, a_sink, b_q_gain, b_k_gain, b_rpb, rw_mu, rw_wr, rw_wk, rw_wv, rw_wo, rw_w0, rw_w1, rw_w2, rw_a0, rw_a1, rw_a2, rw_g1, rw_g2, rw_k_k, rw_k_a, rw_r_k, rw_lnx_w, rw_lnx_b, moe_w_grp, moe_w_exp, moe_w1, moe_w3, moe_w2):
    B, L, D = x.shape
    t = jnp.arange(L)
    row_pos, col_pos = t // GRID_W, t % GRID_W
    cond = jax.nn.silu(c)
    cond_ctx = jax.nn.silu(c_ctx)
    xc = ctx
    for i in range(DEPTH):
        last = i == DEPTH - 1
        j = i // 2
        sh1, sc1, gt1, sh2, sc2, gt2 = ada_split(cond, ada_w[i], ada_b[i])
        csh1, csc1, cgt1, csh2, csc2, cgt2 = ada_split(cond_ctx, ada_w[i], ada_b[i])
        h = rmsnorm(x, norm_mix_g[i]) * (1 + sc1) + sh1
        hc = rmsnorm(xc, norm_mix_g[i]) * (1 + csc1) + csh1
        if i % 2 == 0:
            y, yc = attention_layer(h, hc, attn_w_in[j], attn_w_out[j], a_q_gain[j], a_k_gain[j], a_sink[j], b_q_gain[j], b_k_gain[j], b_rpb[j], row_pos, col_pos, not last)
        else:
            y, yc = rwkv_layer(h, hc, rw_mu[j], rw_wr[j], rw_wk[j], rw_wv[j], rw_wo[j], rw_w0[j], rw_w1[j], rw_w2[j], rw_a0[j], rw_a1[j], rw_a2[j], rw_g1[j], rw_g2[j], rw_k_k[j], rw_k_a[j], rw_r_k[j], rw_lnx_w[j], rw_lnx_b[j], not last)
        x = x + gt1 * y
        h = rmsnorm(x, norm_ffn_g[i]) * (1 + sc2) + sh2
        experts = (moe_w_grp[i], moe_w_exp[i], moe_w1[i], moe_w3[i], moe_w2[i])
        if last:
            x = x + gt2 * hierarchical_moe(h.reshape(B * L, D), *experts).reshape(B, L, D)
        else:
            xc = xc + cgt1 * yc
            hc = rmsnorm(xc, norm_ffn_g[i]) * (1 + csc2) + csh2
            f = hierarchical_moe(jnp.concatenate([h.reshape(B * L, D), hc.reshape(-1, D)], axis=0), *experts)
            x = x + gt2 * f[:B * L].reshape(B, L, D)
            xc = xc + cgt2 * f[B * L:].reshape(hc.shape)
    return x
```

```cpp
#include <hip/hip_runtime.h>
#include <stdint.h>
#include <stdio.h>

#ifndef ONE_LAUNCH
#define ONE_LAUNCH 0
#endif

#define LAS __attribute__((address_space(3)))
typedef unsigned short bf16_t;
typedef short bf16x8 __attribute__((ext_vector_type(8)));
typedef float f32x4 __attribute__((ext_vector_type(4)));
typedef float f32x2 __attribute__((ext_vector_type(2)));
typedef unsigned u32x4 __attribute__((ext_vector_type(4)));
typedef unsigned u32x2 __attribute__((ext_vector_type(2)));

constexpr int D = 2048, NB = 2, SEQ = 16384, ML = NB * SEQ, CTXL = 256, MC = NB * CTXL, MT = ML + MC;
constexpr int QKVC = 4608, QA0 = 0, KA0 = 1024, VA0 = 1280, QB0 = 1536, KB0 = 2560, VB0 = 3584;
constexpr int NEXP = 32, FF = 512, MAXSLOT = 2 * MT + NEXP * 256;
constexpr int MODW = 6 * D;
constexpr int NTHR = 512;

constexpr size_t MiB = 1ull << 20;
constexpr size_t WS_CTL = 0;
constexpr size_t CTL_BYTES = 64 * 1024;
constexpr size_t CTL_CNT = 16384;
constexpr size_t WS_MOD = 1 * MiB;
constexpr size_t WS_XC = 2 * MiB;
constexpr size_t WS_TOKL = 6 * MiB;
constexpr size_t WS_TOKSEL = 11 * MiB;
constexpr size_t WS_TOKGATE = 11 * MiB + 512 * 1024;
constexpr size_t WS_CB = 12 * MiB;
constexpr size_t WS_WT = 20 * MiB;
constexpr size_t WT_IN = WS_WT, WT_OUT = WS_WT + 18 * MiB, WT_R = WS_WT + 26 * MiB, WT_K = WS_WT + 34 * MiB, WT_V = WS_WT + 42 * MiB, WT_O = WS_WT + 50 * MiB;
constexpr size_t WT_W1 = WS_WT + 58 * MiB, WT_A1 = WS_WT + 59 * MiB, WT_G1 = WS_WT + 60 * MiB, WT_W2 = WS_WT + 61 * MiB, WT_A2 = WS_WT + 63 * MiB, WT_G2 = WS_WT + 65 * MiB;
constexpr size_t WS_TW = 86 * MiB, WS_TA = 103 * MiB, WS_TG = 120 * MiB;
constexpr size_t WS_SLOT0 = 140 * MiB, SLOT = 130 * MiB;
constexpr size_t WS_END = WS_SLOT0 + 9 * SLOT;
#define SLOTP(k) (WS_SLOT0 + (size_t)(k) * SLOT)

__device__ __forceinline__ unsigned cvt_pk_bf16(float lo, float hi) { unsigned r; asm volatile("v_cvt_pk_bf16_f32 %0, %1, %2" : "=v"(r) : "v"(lo), "v"(hi)); return r; }
__device__ __forceinline__ float bf_lo(unsigned u) { return __uint_as_float(u << 16); }
__device__ __forceinline__ float bf_hi(unsigned u) { return __uint_as_float(u & 0xffff0000u); }
__device__ __forceinline__ float bf2f(bf16_t v) { return __uint_as_float(((unsigned)v) << 16); }
__device__ __forceinline__ float wave_sum(float v) { for (int o = 32; o; o >>= 1) v += __shfl_xor(v, o); return v; }
__device__ __forceinline__ float wave_max(float v) { for (int o = 32; o; o >>= 1) v = fmaxf(v, __shfl_xor(v, o)); return v; }
__device__ __forceinline__ float sigmoidf_(float x) { return 1.f / (1.f + __expf(-x)); }
__device__ __forceinline__ void lds_fence() { asm volatile("s_waitcnt lgkmcnt(0)" ::: "memory"); }

struct Args { const float* in[39]; float* out; unsigned char* ws; int ph_lo, ph_hi; };
struct Frame {
    const Args& A; float* out; unsigned char* ws; LAS unsigned char* lds;
    int tid, lane, wave, G, bid;
    __device__ __forceinline__ Frame(const Args& a) : A(a) {}
};
enum { I_X = 0, I_C, I_CTX, I_CCTX, I_ADAW, I_ADAB, I_NMIX, I_NFFN, I_WIN, I_WOUT, I_AQG, I_AKG, I_ASINK, I_BQG, I_BKG, I_RPB, I_MU, I_WR, I_WK, I_WV, I_WO, I_W0, I_W1, I_W2,
       I_A0, I_A1, I_A2, I_G1, I_G2, I_KK, I_KA, I_RK, I_LNW, I_LNB, I_MGRP, I_MEXP, I_MW1, I_MW3, I_MW2 };

#define XB_TMO      128
#define XB_XCNT(j)  (256  + 64 * (j))
#define XB_XSUB(j)  (1280 + 64 * (j))
#define XB_XGEN(j)  (2304 + 64 * (j))
#define XB_TOP      3328
#define XB_TOPGEN   3392
#define XCD_BAR_WORDS 3456
#define XB_SPIN_CAP (1u << 18)
__device__ __forceinline__ unsigned xb_ld(unsigned* p)              { return __hip_atomic_load(p, __ATOMIC_RELAXED, __HIP_MEMORY_SCOPE_AGENT); }
__device__ __forceinline__ unsigned xb_add(unsigned* p, unsigned v) { return __hip_atomic_fetch_add(p, v, __ATOMIC_RELAXED, __HIP_MEMORY_SCOPE_AGENT); }
__device__ __forceinline__ unsigned xb_xcc_id() { return (unsigned)__builtin_amdgcn_s_getreg((3 << 11) | 20) & 0xFu; }
#define XB_SPIN(cond, bar) do { unsigned _sp = 0; while (cond) { __builtin_amdgcn_s_sleep(1); \
    if ((++_sp & 255u) == 0u) { if (xb_ld(&(bar)[XB_TMO])) break; if (_sp > XB_SPIN_CAP) { atomicAdd(&(bar)[XB_TMO], 1u); break; } } } } while (0)
struct XcdBarrier { unsigned* bar; unsigned x; volatile LAS unsigned* st; };
__device__ __forceinline__ XcdBarrier xcd_barrier_post(unsigned* bar, volatile LAS unsigned* st) {
    XcdBarrier b; b.bar = bar; b.x = xb_xcc_id(); b.st = st;
    if (threadIdx.x == 0) (void)xb_add(&bar[XB_XCNT(b.x)], 1u);
    return b;
}
__device__ __forceinline__ void xcd_barrier_complete(unsigned* bar, unsigned x, unsigned& nloc, unsigned& nx) {
    const unsigned G = gridDim.x * gridDim.y * gridDim.z;
    unsigned sum, cnt, mine, sp = 0u;
    for (;;) {
        sum = 0u; cnt = 0u; mine = 0u;
#pragma unroll
        for (unsigned j = 0; j < 16; ++j) { const unsigned c = xb_ld(&bar[XB_XCNT(j)]); sum += c; cnt += (c > 0u) ? 1u : 0u; mine = (j == x) ? c : mine; }
        if (sum == G) break;
        __builtin_amdgcn_s_sleep(1);
        if ((++sp & 255u) == 0u) { if (xb_ld(&bar[XB_TMO])) break; if (sp > XB_SPIN_CAP) { atomicAdd(&bar[XB_TMO], 1u); break; } }
    }
    nloc = mine > 0u ? mine : 1u; nx = cnt > 0u ? cnt : 1u;
}
__device__ __forceinline__ void xcd_barrier(const XcdBarrier& b) {
    asm volatile("s_waitcnt vmcnt(0)" ::: "memory");
    __syncthreads();
    if (threadIdx.x == 0) {
        unsigned* bar = b.bar;
        __builtin_amdgcn_s_waitcnt(0);
        unsigned nloc = b.st[0], nx = b.st[1];
        if (nloc == 0u) { xcd_barrier_complete(bar, b.x, nloc, nx); b.st[0] = nloc; b.st[1] = nx; }
        const unsigned old = xb_add(&bar[XB_XSUB(b.x)], 1u);
        const unsigned gen = old / nloc;
        if (old + 1u == (gen + 1u) * nloc) {
            __builtin_amdgcn_fence(__ATOMIC_RELEASE, "agent");
            asm volatile("s_waitcnt vmcnt(0)" ::: "memory");
            const unsigned og = xb_add(&bar[XB_TOP], 1u);
            const unsigned tg = og / nx;
            if (og + 1u == (tg + 1u) * nx) xb_add(&bar[XB_TOPGEN], 1u);
            else XB_SPIN(xb_ld(&bar[XB_TOPGEN]) == tg, bar);
            __builtin_amdgcn_fence(__ATOMIC_ACQUIRE, "agent");
            xb_add(&bar[XB_XGEN(b.x)], 1u);
            asm volatile("s_waitcnt vmcnt(0)" ::: "memory");
        } else {
            XB_SPIN(xb_ld(&bar[XB_XGEN(b.x)]) == gen, bar);
            __builtin_amdgcn_fence(__ATOMIC_ACQUIRE, "agent");
            asm volatile("s_waitcnt vmcnt(0)" ::: "memory");
        }
    }
    __syncthreads();
}

namespace pg8 {
constexpr int BM = 256, BK = 64, HALF = 128, HTB = HALF * BK * 2, STAGE_BYTES = 8 * HTB, NXCD = 8, WGM = 8;
__host__ __device__ __forceinline__ int lds_byte(int r, int c) { const int st = (r >> 4) * 2 + (c >> 5), rr = r & 15, cc = c & 31, ob = rr * 64 + cc * 2; return st * 1024 + (ob ^ (((ob >> 9) & 1) << 5)); }
__host__ __device__ __forceinline__ void stage_rc(int b, int& R, int& C) { const int st = b / 1024, sb = b % 1024, swz = sb ^ (((sb >> 9) & 1) << 5); R = (st >> 1) * 16 + swz / 64; C = (st & 1) * 32 + (swz % 64) / 2; }
__host__ __device__ __forceinline__ int perm32(int rho) { const int n = rho >> 4, i = rho & 15; return 8 * (i >> 2) + 4 * n + (i & 3); }

struct Unit { int arow0, brow0, col0, e, pbase, cnt; };

struct DenseSched {
    int nM, nN, nwg, G, c, K;
    __device__ void init(int M, int N, int K_, int G_, int c_) { nM = M / BM; nN = N / BM; nwg = nM * nN; G = G_; c = c_; K = K_; }
    __device__ bool next(int i, Unit& u) const {
        const long L = (long)i * G + c; if (L >= nwg) return false;
        int wgid = (int)L; { const int q = nwg / NXCD, r = nwg % NXCD, xcd = wgid % NXCD, off = wgid / NXCD; wgid = (xcd < r ? xcd * (q + 1) : r * (q + 1) + (xcd - r) * q) + off; }
        const int nig = WGM * nN, gid = wgid / nig, fm = gid * WGM, gsz = (nM - fm) < WGM ? (nM - fm) : WGM;
        const int pm = fm + ((wgid % nig) % gsz), pn = (wgid % nig) / gsz;
        u.arow0 = pm * BM; u.brow0 = pn * BM; u.col0 = pn * BM; u.e = 0; u.pbase = 0; u.cnt = 0; return true;
    }
    __device__ __forceinline__ unsigned a_off(const Unit& u, int r, int C) const { return (unsigned)((u.arow0 + r) * K + C) * 2u; }
};

template <class Epi, class Sched>
__device__ __forceinline__ void gemm_phase(LAS unsigned char* lds, const bf16_t* A, const bf16_t* Bt, const int K, const Sched& S, const Epi& E) {
    const int tid = threadIdx.x, wid = __builtin_amdgcn_readfirstlane(tid >> 6), lane = tid & 63, wr = wid >> 2, wc = wid & 3, fr = lane & 15, fq = lane >> 4;
    const int nt = K / BK;
    int Rr[2], Cc[2]; unsigned voffB[2];
#pragma unroll
    for (int i = 0; i < 2; ++i) { int R, C; stage_rc(tid * 16 + i * 8192, R, C); const int Rb = Epi::PERM ? ((R & ~31) + perm32(R & 31)) : R;
        Rr[i] = R; Cc[i] = C; voffB[i] = (unsigned)(Rb * K + C) * 2u; }
    const size_t kstep = (size_t)(BK * 2);
    const size_t hstepB = (size_t)HALF * K * 2;
    const unsigned ldsw = (unsigned)wid * 1024u;
    const int aoff = lds_byte(wr * 64 + fr, fq * 8), boff = lds_byte(wc * 32 + fr, fq * 8);
#define PG8_SA(b, h) (((b) * 2 + (h)) * HTB)
#define PG8_SB(b, h) ((4 + (b) * 2 + (h)) * HTB)
#define PG8_STAGE(bufoff, gbase, voff) do { _Pragma("unroll") for (int _i = 0; _i < 2; ++_i) \
        __builtin_amdgcn_global_load_lds((const unsigned*)((const char*)(gbase) + (voff)[_i]), (LAS unsigned*)(lds + (bufoff) + ldsw + _i * 8192), 16, 0, 0); } while (0)
#define PG8_LDA(dst, b, h) do { _Pragma("unroll") for (int m = 0; m < 4; ++m) _Pragma("unroll") for (int k = 0; k < 2; ++k) dst[m][k] = *(const LAS bf16x8*)(lds + PG8_SA(b, h) + aoff + m * 2048 + k * 1024); } while (0)
#define PG8_LDB(dst, b, h) do { _Pragma("unroll") for (int n = 0; n < 2; ++n) _Pragma("unroll") for (int k = 0; k < 2; ++k) dst[n][k] = *(const LAS bf16x8*)(lds + PG8_SB(b, h) + boff + n * 2048 + k * 1024); } while (0)
#define PG8_MMA(ai, bj, At, Bt_) do { __builtin_amdgcn_s_setprio(1); _Pragma("unroll") for (int m = 0; m < 4; ++m) _Pragma("unroll") for (int n = 0; n < 2; ++n) _Pragma("unroll") for (int k = 0; k < 2; ++k) \
        acc[ai][bj][m][n] = __builtin_amdgcn_mfma_f32_16x16x32_bf16(Bt_[n][k], At[m][k], acc[ai][bj][m][n], 0, 0, 0); __builtin_amdgcn_s_setprio(0); } while (0)
#define PG8_WAIT_V(n) asm volatile("s_waitcnt vmcnt(" #n ")" ::: "memory")
#define PG8_WAIT_L(n) asm volatile("s_waitcnt lgkmcnt(" #n ")" ::: "memory")
#define PG8_BAR __builtin_amdgcn_s_barrier()
#define PG8_SCHED __builtin_amdgcn_sched_barrier(0)
    Unit cur, nxt; int ui = 0;
    if (!S.next(0, cur)) return;
    f32x4 acc[2][2][4][2];
#pragma unroll
    for (int a = 0; a < 2; ++a)
#pragma unroll
        for (int b = 0; b < 2; ++b)
#pragma unroll
            for (int m = 0; m < 4; ++m)
#pragma unroll
                for (int n = 0; n < 2; ++n) acc[a][b][m][n] = (f32x4){0.f, 0.f, 0.f, 0.f};
    bf16x8 At[4][2], B0[2][2], B1[2][2];
    unsigned oC0[2], oC1[2], oN0[2], oN1[2];
#pragma unroll
    for (int i = 0; i < 2; ++i) { oC0[i] = S.a_off(cur, Rr[i], Cc[i]); oC1[i] = S.a_off(cur, HALF + Rr[i], Cc[i]); }
    const char* gA = (const char*)A;
    const char* cB = (const char*)Bt + (size_t)cur.brow0 * K * 2;
    PG8_STAGE(PG8_SB(0, 0), cB, voffB); PG8_STAGE(PG8_SA(0, 0), gA, oC0); PG8_STAGE(PG8_SB(0, 1), cB + hstepB, voffB); PG8_STAGE(PG8_SA(0, 1), gA, oC1);
    if (wr == 1) PG8_BAR;
    PG8_WAIT_V(4); PG8_BAR;
    PG8_STAGE(PG8_SB(1, 0), cB + kstep, voffB); PG8_STAGE(PG8_SA(1, 0), gA + kstep, oC0); PG8_STAGE(PG8_SB(1, 1), cB + hstepB + kstep, voffB);
    PG8_WAIT_V(6); PG8_BAR;
    for (;;) {
        const bool has_next = S.next(ui + 1, nxt);
        if (has_next) {
#pragma unroll
            for (int i = 0; i < 2; ++i) { oN0[i] = S.a_off(nxt, Rr[i], Cc[i]); oN1[i] = S.a_off(nxt, HALF + Rr[i], Cc[i]); }
        } else {
#pragma unroll
            for (int i = 0; i < 2; ++i) { oN0[i] = oC0[i]; oN1[i] = oC1[i]; }
        }
        const char* nB = has_next ? (const char*)Bt + (size_t)nxt.brow0 * K * 2 : cB;
        for (int t = 0; t < nt; t += 2) {
            const bool last = (t == nt - 2);
            const char* a1 = gA + (size_t)(t + 1) * kstep;
            const char* a2 = last ? gA : gA + (size_t)(t + 2) * kstep; const char* b2 = last ? nB : cB + (size_t)(t + 2) * kstep;
            const char* a3 = a2 + kstep; const char* b3 = b2 + kstep;
            unsigned o20[2], o21[2];
#pragma unroll
            for (int i = 0; i < 2; ++i) { o20[i] = last ? oN0[i] : oC0[i]; o21[i] = last ? oN1[i] : oC1[i]; }
            PG8_LDB(B0, 0, 0); PG8_SCHED; PG8_LDA(At, 0, 0); PG8_STAGE(PG8_SA(1, 1), a1, oC1);
            PG8_WAIT_L(8); PG8_BAR; PG8_WAIT_L(0); PG8_MMA(0, 0, At, B0); PG8_BAR; PG8_SCHED;
            PG8_LDB(B1, 0, 1); PG8_STAGE(PG8_SB(0, 0), b2, voffB);
            PG8_BAR; PG8_WAIT_L(0); PG8_MMA(0, 1, At, B1); PG8_BAR;
            PG8_LDA(At, 0, 1); PG8_STAGE(PG8_SA(0, 0), a2, o20);
            PG8_BAR; PG8_WAIT_L(0); PG8_MMA(1, 0, At, B0); PG8_BAR; PG8_SCHED;
            PG8_STAGE(PG8_SB(0, 1), b2 + hstepB, voffB);
            PG8_WAIT_V(6); PG8_BAR; PG8_MMA(1, 1, At, B1); PG8_BAR;
            PG8_LDB(B0, 1, 0); PG8_SCHED; PG8_LDA(At, 1, 0); PG8_STAGE(PG8_SA(0, 1), a2, o21);
            PG8_WAIT_L(8); PG8_BAR; PG8_WAIT_L(0); PG8_MMA(0, 0, At, B0); PG8_BAR; PG8_SCHED;
            PG8_LDB(B1, 1, 1); PG8_STAGE(PG8_SB(1, 0), b3, voffB);
            PG8_BAR; PG8_WAIT_L(0); PG8_MMA(0, 1, At, B1); PG8_BAR;
            PG8_LDA(At, 1, 1); PG8_STAGE(PG8_SA(1, 0), a3, o20);
            PG8_BAR; PG8_WAIT_L(0); PG8_MMA(1, 0, At, B0); PG8_BAR; PG8_SCHED;
            PG8_STAGE(PG8_SB(1, 1), b3 + hstepB, voffB);
            PG8_WAIT_V(6); PG8_BAR; PG8_MMA(1, 1, At, B1); PG8_BAR;
        }
        E(acc, cur, wr, wc, fr, fq);
        if (!has_next) break;
#pragma unroll
        for (int a = 0; a < 2; ++a)
#pragma unroll
            for (int b = 0; b < 2; ++b)
#pragma unroll
                for (int m = 0; m < 4; ++m)
#pragma unroll
                    for (int n = 0; n < 2; ++n) acc[a][b][m][n] = (f32x4){0.f, 0.f, 0.f, 0.f};
        cur = nxt; cB = nB; ++ui;
#pragma unroll
        for (int i = 0; i < 2; ++i) { oC0[i] = oN0[i]; oC1[i] = oN1[i]; }
    }
    PG8_WAIT_V(0);
    if (wr == 0) PG8_BAR;
    PG8_BAR;
#undef PG8_SA
#undef PG8_SB
#undef PG8_STAGE
#undef PG8_LDA
#undef PG8_LDB
#undef PG8_MMA
#undef PG8_WAIT_V
#undef PG8_WAIT_L
#undef PG8_BAR
#undef PG8_SCHED
}

template <int ACT> struct EpiStoreBf16 {
    static constexpr bool PERM = true;
    bf16_t* O; int ldc; const float* vec; int split_cols; size_t split_stride;
    __device__ __forceinline__ float act(float v, float b) const {
        if (ACT == 1) return 2.f * sigmoidf_(2.f * v) - 1.f;
        if (ACT == 2) return sigmoidf_(v);
        if (ACT == 3) return 0.60653065971f * sigmoidf_(v + b);
        if (ACT == 4) return sigmoidf_(v + b);
        return v;
    }
    __device__ __forceinline__ void operator()(const f32x4 (&acc)[2][2][4][2], const Unit& u, int wr, int wc, int fr, int fq) const {
        const int row0 = u.arow0 + wr * 64 + fr; int colt = u.col0; bf16_t* base = O;
        if (split_cols) { const int t = colt / split_cols; base += (size_t)t * split_stride; colt -= t * split_cols; }
        const int col0 = colt + wc * 32 + 8 * fq, bcol0 = u.col0 + wc * 32 + 8 * fq;
#pragma unroll
        for (int bj = 0; bj < 2; ++bj) {
            const f32x4 b0 = (ACT >= 3) ? *(const f32x4*)(vec + bcol0 + bj * HALF) : (f32x4){0.f, 0.f, 0.f, 0.f}, b1 = (ACT >= 3) ? *(const f32x4*)(vec + bcol0 + bj * HALF + 4) : (f32x4){0.f, 0.f, 0.f, 0.f};
#pragma unroll
            for (int ai = 0; ai < 2; ++ai)
#pragma unroll
                for (int m = 0; m < 4; ++m) { bf16_t* rowp = base + (size_t)(row0 + ai * HALF + m * 16) * ldc + col0; const f32x4 v0 = acc[ai][bj][m][0], v1 = acc[ai][bj][m][1];
                {
                    u32x4 o; o[0] = cvt_pk_bf16(act(v0[0], b0[0]), act(v0[1], b0[1])); o[1] = cvt_pk_bf16(act(v0[2], b0[2]), act(v0[3], b0[3]));
                    o[2] = cvt_pk_bf16(act(v1[0], b1[0]), act(v1[1], b1[1])); o[3] = cvt_pk_bf16(act(v1[2], b1[2]), act(v1[3], b1[3]));
                    *(u32x4*)(rowp + bj * HALF) = o; } }
        }
    }
};
struct EpiRes {
    static constexpr bool PERM = false;
    const float* xin_l; float* out_l; const float* xin_c; float* out_c; const float* gate;
    __device__ __forceinline__ void operator()(const f32x4 (&acc)[2][2][4][2], const Unit& u, int wr, int wc, int fr, int fq) const {
        const int row0 = u.arow0 + wr * 64 + fr, col0 = u.col0 + wc * 32 + 4 * fq;
        const bool isc = u.arow0 >= ML;
        const int gb = isc ? 2 : (u.arow0 / SEQ);
        const float* gp = gate + (size_t)gb * MODW + col0;
        f32x4 gv[2][2];
#pragma unroll
        for (int bj = 0; bj < 2; ++bj)
#pragma unroll
            for (int n = 0; n < 2; ++n) gv[bj][n] = *(const f32x4*)(gp + bj * HALF + n * 16);
        const float* xi = isc ? xin_c - (size_t)ML * D : xin_l; float* xo = isc ? out_c - (size_t)ML * D : out_l;
#pragma unroll
        for (int ai = 0; ai < 2; ++ai)
#pragma unroll
            for (int m = 0; m < 4; ++m) { const size_t ro = (size_t)(row0 + ai * HALF + m * 16) * D + col0;
#pragma unroll
                for (int bj = 0; bj < 2; ++bj)
#pragma unroll
                    for (int n = 0; n < 2; ++n) { const f32x4 xv = *(const f32x4*)(xi + ro + bj * HALF + n * 16);
                        *(f32x4*)(xo + ro + bj * HALF + n * 16) = xv + gv[bj][n] * acc[ai][bj][m][n]; } }
    }
};
struct EpiMoeUp {
    static constexpr bool PERM = false;
    bf16_t* H;
    __device__ __forceinline__ void operator()(const f32x4 (&acc)[2][2][4][2], const Unit& u, int wr, int wc, int fr, int fq) const {
        const int row0 = u.arow0 + wr * 64 + fr;
#pragma unroll
        for (int ai = 0; ai < 2; ++ai)
#pragma unroll
            for (int m = 0; m < 4; ++m) { bf16_t* rowp = H + (size_t)(row0 + ai * HALF + m * 16) * FF;
#pragma unroll
                for (int bj = 0; bj < 2; ++bj) { const int j = (u.col0 + bj * HALF + wc * 32) / 2 + 4 * fq; const f32x4 a = acc[ai][bj][m][0], b = acc[ai][bj][m][1];
                    float h[4];
#pragma unroll
                    for (int i = 0; i < 4; ++i) h[i] = a[i] * sigmoidf_(a[i]) * b[i];
                    u32x2 o; o[0] = cvt_pk_bf16(h[0], h[1]); o[1] = cvt_pk_bf16(h[2], h[3]);
                    *(u32x2*)(rowp + j) = o; } }
    }
};
}

struct MoeSched {
    const LAS int* pref; const LAS int* cnt; const int* tokl; int nN, G, c, K, rowsB; bool gather;
    __device__ bool next(int i, pg8::Unit& u) const {
        const long L = (long)i * G + c; const int T = __builtin_amdgcn_readfirstlane(pref[NEXP]);
        if (L >= (long)T * nN) return false;
        const int tl = (int)(L / nN), pn = (int)(L % nN);
        int e = 0;
        for (int k = 1; k < NEXP; ++k) e = (pref[k] <= tl) ? k : e;
        e = __builtin_amdgcn_readfirstlane(e);
        u.e = e; u.pbase = __builtin_amdgcn_readfirstlane((tl - pref[e]) * 256); u.cnt = __builtin_amdgcn_readfirstlane(cnt[e]); u.arow0 = tl * 256; u.brow0 = e * rowsB + pn * 256; u.col0 = pn * 256; return true;
    }
    __device__ __forceinline__ unsigned a_off(const pg8::Unit& u, int r, int C) const {
        if (gather) { const int p = u.pbase + r; const int tok = (p < u.cnt) ? tokl[(size_t)u.e * MT + p] : 0; return (unsigned)(tok * K + C) * 2u; }
        return (unsigned)((u.arow0 + r) * K + C) * 2u;
    }
};

#define WSP(T, off) ((T*)(F.ws + (off)))
__device__ __forceinline__ const float* mod_row(const Frame& F, int layer, int row3) { return (const float*)(F.ws + WS_MOD) + ((size_t)layer * 3 + row3) * MODW; }

struct CvtJob { const float* src; const float* src2; bf16_t* dst; int Ksrc, Nsrc, ld_src, Kdst, Ndst, koff, grp_rows; size_t grp_stride; int mode; };
struct CvtRegs { f32x4 v[4]; };
__device__ __forceinline__ void cvt_load(const CvtJob& J, int tile, int tid, CvtRegs& R) {
    const int ktiles = J.Kdst / 64, nt = tile / ktiles, kt = tile % ktiles, n0 = nt * 128, k0 = kt * 64;
    const int e = n0 / J.grp_rows, nl0 = n0 % J.grp_rows;
    const int kr = tid >> 3, c8 = tid & 7;
    const int ks = k0 + kr - J.koff;
    const bool kok = (ks >= 0) && (ks < J.Ksrc);
#pragma unroll
    for (int cc = 0; cc < 2; ++cc) {
        const int nl = nl0 + (c8 + cc * 8) * 8;
        const float* sp = J.src + (size_t)e * J.grp_stride; int ncol = nl;
        if (J.mode == 1) { const int g = nl >> 5, w = nl & 31; sp = (w < 16 ? J.src : J.src2) + (size_t)e * J.grp_stride; ncol = g * 16 + (w & 15); }
        if (kok && ncol + 8 <= J.Nsrc) { const float* p = sp + (size_t)ks * J.ld_src + ncol; R.v[cc * 2] = *(const f32x4*)p; R.v[cc * 2 + 1] = *(const f32x4*)(p + 4); }
        else { R.v[cc * 2] = (f32x4){0.f, 0.f, 0.f, 0.f}; R.v[cc * 2 + 1] = (f32x4){0.f, 0.f, 0.f, 0.f}; }
    }
}
__device__ __forceinline__ void cvt_job(const Frame& F, const CvtJob& J, int& base) {
    const int ntiles = (J.Ndst / 128) * (J.Kdst / 64), tid = F.tid;
    LAS float* tl = (LAS float*)F.lds;
    int t = ((F.bid - base) % F.G + F.G) % F.G;
    base = (base + ntiles) % F.G;
    if (t >= ntiles) return;
    CvtRegs cur, nxt; cvt_load(J, t, tid, cur);
    const int ktiles = J.Kdst / 64;
    for (; t < ntiles; t += F.G) {
        const bool hn = (t + F.G) < ntiles;
        if (hn) cvt_load(J, t + F.G, tid, nxt);
        const int kr = tid >> 3, c8 = tid & 7;
#pragma unroll
        for (int cc = 0; cc < 2; ++cc)
#pragma unroll
            for (int j = 0; j < 8; ++j) tl[kr * 129 + (c8 + cc * 8) * 8 + j] = cur.v[cc * 2 + (j >> 2)][j & 3];
        __syncthreads();
        const int nrow = tid >> 2, kq = tid & 3, nt = t / ktiles, kt = t % ktiles;
        float x[16];
#pragma unroll
        for (int j = 0; j < 16; ++j) x[j] = tl[(kq * 16 + j) * 129 + nrow];
        u32x4 o0, o1;
#pragma unroll
        for (int j = 0; j < 4; ++j) { o0[j] = cvt_pk_bf16(x[2 * j], x[2 * j + 1]); o1[j] = cvt_pk_bf16(x[8 + 2 * j], x[8 + 2 * j + 1]); }
        bf16_t* dp = J.dst + (size_t)(nt * 128 + nrow) * J.Kdst + kt * 64 + kq * 16;
        *(u32x4*)dp = o0; *(u32x4*)(dp + 8) = o1;
        __syncthreads();
        if (hn) cur = nxt;
    }
}
__device__ __forceinline__ void cvt_simple(const Frame& F, const float* src, bf16_t* dst, int Ksrc, int Nsrc, int& base) {
    CvtJob J{src, src, dst, Ksrc, Nsrc, Nsrc, Ksrc, Nsrc, 0, Nsrc, 0, 0}; cvt_job(F, J, base);
}
__device__ __forceinline__ void cvt_moe(const Frame& F, int layer, bf16_t* w13, bf16_t* w2t, int& base) {
    const size_t lo = (size_t)layer * NEXP * D * FF;
    CvtJob J1{F.A.in[I_MW1] + lo, F.A.in[I_MW3] + lo, w13, D, FF, FF, D, NEXP * 2 * FF, 0, 2 * FF, (size_t)D * FF, 1}; cvt_job(F, J1, base);
    CvtJob J2{F.A.in[I_MW2] + lo, F.A.in[I_MW2] + lo, w2t, FF, D, D, FF, NEXP * D, 0, D, (size_t)FF * D, 0}; cvt_job(F, J2, base);
}

__device__ __forceinline__ void ph_prologue(const Frame& F) {
    const int tid = F.tid;
    {
        LAS float* cv = (LAS float*)F.lds;
        LAS float* red = (LAS float*)(F.lds + 32768);
        for (int k = tid; k < D; k += NTHR) {
            const float c0 = F.A.in[I_C][k], c1 = F.A.in[I_C][D + k], c2 = F.A.in[I_CCTX][k];
            cv[k] = c0 * sigmoidf_(c0); cv[D + k] = c1 * sigmoidf_(c1); cv[2 * D + k] = c2 * sigmoidf_(c2);
        }
        __syncthreads();
        for (int item = F.bid; item < 2 * 96; item += F.G) {
            const int l = item / 96, n0 = (item % 96) * 128, c4 = tid & 31, kg = tid >> 5;
            float a[3][4];
#pragma unroll
            for (int r = 0; r < 3; ++r)
#pragma unroll
                for (int j = 0; j < 4; ++j) a[r][j] = 0.f;
            const float* wp = F.A.in[I_ADAW] + (size_t)l * D * MODW + n0 + c4 * 4;
#pragma unroll 4
            for (int k = kg; k < D; k += 16) {
                const f32x4 w = *(const f32x4*)(wp + (size_t)k * MODW);
                const float s0 = cv[k], s1 = cv[D + k], s2 = cv[2 * D + k];
#pragma unroll
                for (int j = 0; j < 4; ++j) { a[0][j] += s0 * w[j]; a[1][j] += s1 * w[j]; a[2][j] += s2 * w[j]; }
            }
#pragma unroll
            for (int r = 0; r < 3; ++r)
#pragma unroll
                for (int j = 0; j < 4; ++j) red[(kg * 3 + r) * 128 + c4 * 4 + j] = a[r][j];
            __syncthreads();
            if (tid < 384) { const int r = tid >> 7, n = tid & 127; float s = F.A.in[I_ADAB][(size_t)l * MODW + n0 + n];
                for (int g = 0; g < 16; ++g) s += red[(g * 3 + r) * 128 + n];
                WSP(float, WS_MOD)[((size_t)l * 3 + r) * MODW + n0 + n] = s; }
            __syncthreads();
        }
        __syncthreads();
    }
    int base = 0;
    cvt_simple(F, F.A.in[I_WIN], WSP(bf16_t, WT_IN), D, QKVC, base);
    cvt_simple(F, F.A.in[I_WOUT], WSP(bf16_t, WT_OUT), D, D, base);
    cvt_simple(F, F.A.in[I_WR], WSP(bf16_t, WT_R), D, D, base);
    cvt_simple(F, F.A.in[I_WK], WSP(bf16_t, WT_K), D, D, base);
    cvt_simple(F, F.A.in[I_WV], WSP(bf16_t, WT_V), D, D, base);
    cvt_simple(F, F.A.in[I_WO], WSP(bf16_t, WT_O), D, D, base);
    for (int d = 0; d < 2; ++d) {
        { CvtJob J{F.A.in[I_W1] + (size_t)d * D * 96, nullptr, WSP(bf16_t, WT_W1) + (size_t)d * 128 * D, D, 96, 96, D, 128, 0, 128, 0, 0}; cvt_job(F, J, base); }
        { CvtJob J{F.A.in[I_A1] + (size_t)d * D * 96, nullptr, WSP(bf16_t, WT_A1) + (size_t)d * 128 * D, D, 96, 96, D, 128, 0, 128, 0, 0}; cvt_job(F, J, base); }
        { CvtJob J{F.A.in[I_W2] + (size_t)d * 96 * D, nullptr, WSP(bf16_t, WT_W2) + (size_t)d * D * 256, 96, D, D, 256, D, 128 * d, D, 0, 0}; cvt_job(F, J, base); }
        { CvtJob J{F.A.in[I_A2] + (size_t)d * 96 * D, nullptr, WSP(bf16_t, WT_A2) + (size_t)d * D * 256, 96, D, D, 256, D, 128 * d, D, 0, 0}; cvt_job(F, J, base); }
    }
    cvt_simple(F, F.A.in[I_G1], WSP(bf16_t, WT_G1), D, 256, base);
    cvt_simple(F, F.A.in[I_G2], WSP(bf16_t, WT_G2), 256, D, base);
    cvt_moe(F, 0, WSP(bf16_t, SLOTP(6)), WSP(bf16_t, SLOTP(6)) + (size_t)NEXP * 2 * FF * D, base);
}

struct RowOpts {
    const float* src_l; const float* src_c;
    int nrows;
    bool combine; int comb_layer; const bf16_t* yslot; float* dst_l; float* dst_c;
    bool norm; int layer; int which;
    bf16_t* H;
    bool router;
};
__device__ __forceinline__ void ph_rows(const Frame& F, const RowOpts& O) {
    LAS int* pref = (LAS int*)(F.lds + 131072 + 1024);
    if (O.combine) {
        if (F.tid == 0) { const int* cnt = WSP(int, WS_CTL + CTL_CNT) + O.comb_layer * NEXP; int s = 0; for (int e = 0; e < NEXP; ++e) { pref[e] = s; s += (cnt[e] + 255) >> 8; } pref[NEXP] = s; }
        __syncthreads();
    }
    const int lane = F.lane;
    for (int r = F.bid * 8 + F.wave; r < O.nrows; r += F.G * 8) {
        const bool isc = r >= ML;
        const int mrow = isc ? 2 : r / SEQ;
        const float* sp = isc ? O.src_c + (size_t)(r - ML) * D : O.src_l + (size_t)r * D;
        f32x4 v[8];
#pragma unroll
        for (int i = 0; i < 8; ++i) v[i] = *(const f32x4*)(sp + i * 256 + lane * 4);
        if (O.combine) {
            const int s0 = WSP(int, WS_TOKSEL)[r * 2], s1 = WSP(int, WS_TOKSEL)[r * 2 + 1];
            const float g0 = WSP(float, WS_TOKGATE)[r * 2], g1 = WSP(float, WS_TOKGATE)[r * 2 + 1];
            const size_t y0 = ((size_t)pref[s0 >> 20] * 256 + (s0 & 0xfffff)) * D, y1 = ((size_t)pref[s1 >> 20] * 256 + (s1 & 0xfffff)) * D;
            const float* gt = mod_row(F, O.comb_layer, mrow) + 5 * D;
            float* dp = isc ? O.dst_c + (size_t)(r - ML) * D : O.dst_l + (size_t)r * D;
#pragma unroll
            for (int i = 0; i < 8; ++i) {
                const int col = i * 256 + lane * 4;
                const u32x2 a = *(const u32x2*)(O.yslot + y0 + col), b = *(const u32x2*)(O.yslot + y1 + col);
                const f32x4 g = *(const f32x4*)(gt + col);
                v[i][0] += g[0] * (g0 * bf_lo(a[0]) + g1 * bf_lo(b[0])); v[i][1] += g[1] * (g0 * bf_hi(a[0]) + g1 * bf_hi(b[0]));
                v[i][2] += g[2] * (g0 * bf_lo(a[1]) + g1 * bf_lo(b[1])); v[i][3] += g[3] * (g0 * bf_hi(a[1]) + g1 * bf_hi(b[1]));
                *(f32x4*)(dp + col) = v[i];
            }
        }
        if (!O.norm) continue;
        float ss = 0.f;
#pragma unroll
        for (int i = 0; i < 8; ++i) ss += v[i][0] * v[i][0] + v[i][1] * v[i][1] + v[i][2] * v[i][2] + v[i][3] * v[i][3];
        ss = wave_sum(ss);
        const float rstd = rsqrtf(ss * (1.f / D) + 1e-6f);
        const float* gn = (O.which ? F.A.in[I_NFFN] : F.A.in[I_NMIX]) + (size_t)O.layer * D;
        const float* mr = mod_row(F, O.layer, mrow);
        const float* shp = mr + (O.which ? 3 * D : 0); const float* scp = mr + (O.which ? 4 * D : D);
        bf16_t* hp = O.H + (size_t)r * D;
#pragma unroll
        for (int i = 0; i < 8; ++i) {
            const int col = i * 256 + lane * 4;
            const f32x4 g = *(const f32x4*)(gn + col), sc = *(const f32x4*)(scp + col), sh = *(const f32x4*)(shp + col);
#pragma unroll
            for (int j = 0; j < 4; ++j) v[i][j] = v[i][j] * rstd * g[j] * (1.f + sc[j]) + sh[j];
            u32x2 o; o[0] = cvt_pk_bf16(v[i][0], v[i][1]); o[1] = cvt_pk_bf16(v[i][2], v[i][3]);
            *(u32x2*)(hp + col) = o;
        }
        if (!O.router) continue;
        const float* wg = F.A.in[I_MGRP] + (size_t)O.layer * D * 4;
        const float* we = F.A.in[I_MEXP] + (size_t)O.layer * D * NEXP;
        LAS float* hs = (LAS float*)(F.lds + F.wave * 8192);
#pragma unroll
        for (int i = 0; i < 8; ++i) *(LAS f32x4*)(hs + i * 256 + lane * 4) = v[i];
        lds_fence();
        float gl[4] = {0.f, 0.f, 0.f, 0.f};
#pragma unroll 4
        for (int k = lane; k < D; k += 64) { const float h = hs[k]; const f32x4 w = *(const f32x4*)(wg + (size_t)k * 4);
            gl[0] += h * w[0]; gl[1] += h * w[1]; gl[2] += h * w[2]; gl[3] += h * w[3]; }
#pragma unroll
        for (int q = 0; q < 4; ++q) gl[q] = wave_sum(gl[q]);
        int gs = 0; float gm = gl[0];
#pragma unroll
        for (int q = 1; q < 4; ++q) if (gl[q] > gm) { gm = gl[q]; gs = q; }
        float den = 0.f;
#pragma unroll
        for (int q = 0; q < 4; ++q) den += __expf(gl[q] - gm);
        const float psel = 1.f / den;
        float el[8] = {0.f, 0.f, 0.f, 0.f, 0.f, 0.f, 0.f, 0.f};
#pragma unroll 4
        for (int k = lane; k < D; k += 64) { const float h = hs[k]; const float* wp = we + (size_t)k * NEXP + gs * 8; const f32x4 w0 = *(const f32x4*)wp, w1 = *(const f32x4*)(wp + 4);
            el[0] += h * w0[0]; el[1] += h * w0[1]; el[2] += h * w0[2]; el[3] += h * w0[3]; el[4] += h * w1[0]; el[5] += h * w1[1]; el[6] += h * w1[2]; el[7] += h * w1[3]; }
#pragma unroll
        for (int q = 0; q < 8; ++q) el[q] = wave_sum(el[q]);
        lds_fence();
        int i1 = 0; float v1 = el[0];
#pragma unroll
        for (int q = 1; q < 8; ++q) if (el[q] > v1) { v1 = el[q]; i1 = q; }
        int i2 = -1; float v2 = -3.0e38f;
#pragma unroll
        for (int q = 0; q < 8; ++q) if (q != i1 && el[q] > v2) { v2 = el[q]; i2 = q; }
        const float e2 = __expf(v2 - v1), w1g = psel / (1.f + e2), w2g = psel * e2 / (1.f + e2);
        if (lane == 0) {
            int* cnt = WSP(int, WS_CTL + CTL_CNT) + O.layer * NEXP;
            const int ea = gs * 8 + i1, eb = gs * 8 + i2;
            const int pa = atomicAdd(cnt + ea, 1), pb = atomicAdd(cnt + eb, 1);
            WSP(int, WS_TOKL)[(size_t)ea * MT + pa] = r; WSP(int, WS_TOKL)[(size_t)eb * MT + pb] = r;
            WSP(int, WS_TOKSEL)[r * 2] = (ea << 20) | pa; WSP(int, WS_TOKSEL)[r * 2 + 1] = (eb << 20) | pb;
            WSP(float, WS_TOKGATE)[r * 2] = w1g; WSP(float, WS_TOKGATE)[r * 2 + 1] = w2g;
        }
    }
}

__device__ __forceinline__ void ph_qknorm(const Frame& F, bf16_t* QKV) {
    const int lane = F.lane;
    const int il = lane & 15;
    const float f0 = exp2f(-(float)(2 * il) * (13.287712379549449f / 32.f)), f1 = exp2f(-(float)(2 * il + 1) * (13.287712379549449f / 32.f));
    for (int r = F.bid * 8 + F.wave; r < MT; r += F.G * 8) {
        const bool lat = r < ML; const int t = r % SEQ;
        const float pos = (lane < 32) ? (float)(t / 64) : (float)(t % 64);
        float c0 = 1.f, s0 = 0.f, c1 = 1.f, s1 = 0.f;
        if (lat) { const float r0_ = __builtin_amdgcn_fractf(pos * f0 * 0.15915494309189535f), r1_ = __builtin_amdgcn_fractf(pos * f1 * 0.15915494309189535f);
            s0 = __builtin_amdgcn_sinf(r0_); c0 = __builtin_amdgcn_cosf(r0_); s1 = __builtin_amdgcn_sinf(r1_); c1 = __builtin_amdgcn_cosf(r1_); }
        bf16_t* row = QKV + (size_t)r * QKVC;
        for (int hd = 0; hd < 26; ++hd) {
            int col; const float* gain; bool rope;
            if (hd < 8) { col = QA0 + hd * 128; gain = F.A.in[I_AQG]; rope = lat; }
            else if (hd < 10) { col = KA0 + (hd - 8) * 128; gain = F.A.in[I_AKG]; rope = lat; }
            else if (hd < 18) { col = QB0 + (hd - 10) * 128; gain = F.A.in[I_BQG]; rope = false; }
            else { col = KB0 + (hd - 18) * 128; gain = F.A.in[I_BKG]; rope = false; }
            unsigned* p = (unsigned*)(row + col + 2 * lane);
            const unsigned u = *p;
            float x0 = bf_lo(u), x1 = bf_hi(u);
            const float ss = wave_sum(x0 * x0 + x1 * x1);
            const float rstd = rsqrtf(ss * (1.f / 128.f) + 1e-6f);
            x0 = x0 * rstd * gain[2 * lane]; x1 = x1 * rstd * gain[2 * lane + 1];
            if (rope) {
                const float p0 = __shfl_xor(x0, 16), p1 = __shfl_xor(x1, 16);
                if ((lane & 16) == 0) { x0 = x0 * c0 - p0 * s0; x1 = x1 * c1 - p1 * s1; }
                else { x0 = p0 * s0 + x0 * c0; x1 = p1 * s1 + x1 * c1; }
            }
            *p = cvt_pk_bf16(x0, x1);
        }
    }
}

__device__ __forceinline__ void ph_attn_simple(const Frame& F, const bf16_t* QKV, bf16_t* YC) {
    const int lane = F.lane;
    LAS float* qs = (LAS float*)(F.lds + F.wave * 4096);
    LAS float* ps = qs + 128;
    const float scale = 0.08838834764831845f;
    for (int it = F.bid * 8 + F.wave; it < MT * 16; it += F.G * 8) {
        const int r = it >> 4, hh = it & 15; const bool tA = hh < 8; const int h = hh & 7;
        const int qcol = tA ? QA0 + h * 128 : QB0 + h * 128, kcol = tA ? KA0 + (h >> 2) * 128 : KB0 + h * 128, vcol = tA ? VA0 + (h >> 2) * 128 : VB0 + h * 128;
        { const unsigned u = *(const unsigned*)(QKV + (size_t)r * QKVC + qcol + 2 * lane); qs[2 * lane] = bf_lo(u); qs[2 * lane + 1] = bf_hi(u); }
        lds_fence();
        const bool lat = r < ML;
        const int b = lat ? r / SEQ : (r - ML) / CTXL, t = r % SEQ;
        int nloc, lo = 0, r0 = 0, c0 = 0, rr = 0, cq = 0;
        if (!lat) nloc = 0;
        else if (tA) { lo = max(0, t - 128); const int hi = min(SEQ - 1, t + 128); nloc = hi - lo + 1; }
        else { rr = t >> 6; cq = t & 63; r0 = min(max(rr - 4, 0), 248); c0 = min(max(cq - 8, 0), 48); nloc = 128; }
        const int nkeys = nloc + CTXL;
        const float* rpb = F.A.in[I_RPB] + (size_t)h * 15 * 31;
        float mloc = -3.0e38f;
        for (int j = lane; j < nkeys; j += 64) {
            int krow; float bias = 0.f;
            if (j >= nloc) krow = ML + b * CTXL + (j - nloc);
            else if (tA) krow = b * SEQ + lo + j;
            else { const int jr = j >> 4, jc = j & 15; krow = b * SEQ + (r0 + jr) * 64 + c0 + jc; bias = rpb[(r0 + jr - rr + 7) * 31 + (c0 + jc - cq + 15)]; }
            const bf16_t* kp = QKV + (size_t)krow * QKVC + kcol;
            float dot = 0.f;
#pragma unroll 4
            for (int d8 = 0; d8 < 16; ++d8) { const u32x4 kv = *(const u32x4*)(kp + d8 * 8);
#pragma unroll
                for (int q = 0; q < 4; ++q) dot += qs[d8 * 8 + 2 * q] * bf_lo(kv[q]) + qs[d8 * 8 + 2 * q + 1] * bf_hi(kv[q]); }
            const float s = dot * scale + bias;
            ps[j] = s; mloc = fmaxf(mloc, s);
        }
        float m = wave_max(mloc);
        const float sink = tA ? F.A.in[I_ASINK][h] : -3.0e38f;
        if (tA) m = fmaxf(m, sink);
        float sloc = 0.f;
        for (int j = lane; j < nkeys; j += 64) { const float p = __expf(ps[j] - m); ps[j] = p; sloc += p; }
        float l = wave_sum(sloc);
        if (tA) l += __expf(sink - m);
        lds_fence();
        float o0 = 0.f, o1 = 0.f;
        for (int j = 0; j < nkeys; ++j) {
            int krow;
            if (j >= nloc) krow = ML + b * CTXL + (j - nloc);
            else if (tA) krow = b * SEQ + lo + j;
            else krow = b * SEQ + (r0 + (j >> 4)) * 64 + c0 + (j & 15);
            const unsigned u = *(const unsigned*)(QKV + (size_t)krow * QKVC + vcol + 2 * lane);
            const float p = ps[j];
            o0 += p * bf_lo(u); o1 += p * bf_hi(u);
        }
        const float inv = 1.f / l;
        *(unsigned*)(YC + (size_t)r * D + hh * 128 + 2 * lane) = cvt_pk_bf16(o0 * inv, o1 * inv);
        lds_fence();
    }
}

__device__ __forceinline__ void ph_mix(const Frame& F, const bf16_t* H, bf16_t* XM, int m) {
    const int lane = F.lane;
    const float* mu = F.A.in[I_MU] + (size_t)m * D;
    for (int r = F.bid * 8 + F.wave; r < MT; r += F.G * 8) {
        const int sl = (r < ML) ? SEQ : CTXL, t = (r < ML) ? (r % SEQ) : ((r - ML) % CTXL);
        const bool hp = t > 0, hn = t < sl - 1;
#pragma unroll
        for (int i = 0; i < 4; ++i) {
            const int col = i * 512 + lane * 8;
            const u32x4 c = *(const u32x4*)(H + (size_t)r * D + col);
            u32x4 p = (u32x4){0u, 0u, 0u, 0u}, n = (u32x4){0u, 0u, 0u, 0u};
            if (hp) p = *(const u32x4*)(H + (size_t)(r - 1) * D + col);
            if (hn) n = *(const u32x4*)(H + (size_t)(r + 1) * D + col);
            const f32x4 m0 = *(const f32x4*)(mu + col), m1 = *(const f32x4*)(mu + col + 4);
            u32x4 o;
#pragma unroll
            for (int q = 0; q < 4; ++q) {
                const float cl = bf_lo(c[q]), ch = bf_hi(c[q]);
                const float xl = 0.5f * (bf_lo(p[q]) + bf_lo(n[q])) - cl, xh = 0.5f * (bf_hi(p[q]) + bf_hi(n[q])) - ch;
                const float ml = (q < 2) ? m0[2 * q] : m1[2 * q - 4], mh = (q < 2) ? m0[2 * q + 1] : m1[2 * q - 3];
                o[q] = cvt_pk_bf16(cl + xl * ml, ch + xh * mh);
            }
            *(u32x4*)(XM + (size_t)r * D + col) = o;
        }
    }
}

constexpr int SC_T = 32, SC_NCH = (CTXL + SEQ) / SC_T;
constexpr int SC_BUF = 5 * SC_T * 64 * 4 + SC_T * 32 * 4;
struct ScanRaw { u32x4 r, k, e, a; u32x2 v; };
__device__ __forceinline__ int scan_row(int dir, int b, int s) {
    if (s < CTXL) return ML + b * CTXL + (dir ? CTXL - 1 - s : s);
    const int t = s - CTXL; return b * SEQ + (dir ? SEQ - 1 - t : t);
}
__device__ __forceinline__ void ph_scan(const Frame& F, const bf16_t* Rb, const bf16_t* Kb, const bf16_t* Vb, const bf16_t* DEC0, const bf16_t* DEC1, const bf16_t* AS0, const bf16_t* AS1,
                                        bf16_t* Y0, bf16_t* Y1, float* CB) {
    const int tid = F.tid, lane = F.lane, wave = F.wave;
    LAS float* ybuf = (LAS float*)(F.lds + 2 * SC_BUF);
    for (int item = F.bid; item < 256; item += F.G) {
        const int dir = item >> 7, b = (item >> 6) & 1, head = (item >> 1) & 31, half = item & 1;
        const bf16_t* DEC = dir ? DEC1 : DEC0; const bf16_t* AS = dir ? AS1 : AS0; bf16_t* Y = dir ? Y1 : Y0;
        const int hc = head * 64;
        if (wave >= 4) {
            const int lt = tid - 256, st = lt >> 3, sg = lt & 7;
            f32x4 kk0 = *(const f32x4*)(F.A.in[I_KK] + hc + sg * 8), kk1 = *(const f32x4*)(F.A.in[I_KK] + hc + sg * 8 + 4);
            f32x4 ka0 = *(const f32x4*)(F.A.in[I_KA] + hc + sg * 8), ka1 = *(const f32x4*)(F.A.in[I_KA] + hc + sg * 8 + 4);
            f32x4 rk0 = *(const f32x4*)(F.A.in[I_RK] + hc + sg * 8), rk1 = *(const f32x4*)(F.A.in[I_RK] + hc + sg * 8 + 4);
            ScanRaw cur, nxt;
            auto ld = [&](int ch, ScanRaw& R) {
                const int row = scan_row(dir, b, ch * SC_T + st); const size_t o = (size_t)row * D + hc + sg * 8;
                R.r = *(const u32x4*)(Rb + o); R.k = *(const u32x4*)(Kb + o); R.e = *(const u32x4*)(DEC + o); R.a = *(const u32x4*)(AS + o);
                R.v = *(const u32x2*)(Vb + (size_t)row * D + hc + half * 32 + sg * 4);
            };
            auto put = [&](int ch, const ScanRaw& R) {
                LAS float* bw = (LAS float*)(F.lds + (ch & 1) * SC_BUF);
                float r_[8], k_[8], e_[8], a_[8], kkv[8], kav[8], rkv[8];
#pragma unroll
                for (int q = 0; q < 4; ++q) { r_[2 * q] = bf_lo(R.r[q]); r_[2 * q + 1] = bf_hi(R.r[q]); k_[2 * q] = bf_lo(R.k[q]); k_[2 * q + 1] = bf_hi(R.k[q]);
                    e_[2 * q] = bf_lo(R.e[q]); e_[2 * q + 1] = bf_hi(R.e[q]); a_[2 * q] = bf_lo(R.a[q]); a_[2 * q + 1] = bf_hi(R.a[q]);
                    kkv[q] = kk0[q]; kkv[4 + q] = kk1[q]; kav[q] = ka0[q]; kav[4 + q] = ka1[q]; rkv[q] = rk0[q]; rkv[4 + q] = rk1[q]; }
                float ss = 0.f, cb = 0.f, kkr[8], kd[8];
#pragma unroll
                for (int q = 0; q < 8; ++q) { kkr[q] = k_[q] * kkv[q]; ss += kkr[q] * kkr[q]; kd[q] = k_[q] * (1.f + (a_[q] - 1.f) * kav[q]); cb += r_[q] * kd[q] * rkv[q]; }
                ss += __shfl_xor(ss, 1); ss += __shfl_xor(ss, 2); ss += __shfl_xor(ss, 4);
                cb += __shfl_xor(cb, 1); cb += __shfl_xor(cb, 2); cb += __shfl_xor(cb, 4);
                const float rn = rsqrtf(ss + 1e-12f);
                LAS float* p = bw + st * 64 + sg * 8;
#pragma unroll
                for (int q = 0; q < 8; ++q) { const float kkn = kkr[q] * rn;
                    p[0 * SC_T * 64 + q] = __expf(-e_[q]);
                    p[1 * SC_T * 64 + q] = -kkn;
                    p[2 * SC_T * 64 + q] = kkn * a_[q];
                    p[3 * SC_T * 64 + q] = kd[q];
                    p[4 * SC_T * 64 + q] = r_[q]; }
                LAS float* pv = bw + 5 * SC_T * 64 + st * 32 + sg * 4;
                pv[0] = bf_lo(R.v[0]); pv[1] = bf_hi(R.v[0]); pv[2] = bf_lo(R.v[1]); pv[3] = bf_hi(R.v[1]);
                const int s = ch * SC_T + st;
                if (half == 0 && sg == 0 && s >= CTXL) CB[((size_t)dir * ML + scan_row(dir, b, s)) * 32 + head] = cb;
            };
            auto flush = [&](int ch) {
                if (ch * SC_T < CTXL) return;
                const LAS float* yb = ybuf + (ch & 1) * (SC_T * 32) + st * 32 + sg * 4;
                const int row = scan_row(dir, b, ch * SC_T + st);
                u32x2 o; o[0] = cvt_pk_bf16(yb[0], yb[1]); o[1] = cvt_pk_bf16(yb[2], yb[3]);
                *(u32x2*)(Y + (size_t)row * D + hc + half * 32 + sg * 4) = o;
            };
            ld(0, cur); put(0, cur); ld(1, cur);
            __syncthreads();
            for (int ch = 0; ch < SC_NCH; ++ch) {
                if (ch + 2 < SC_NCH) ld(ch + 2, nxt);
                if (ch + 1 < SC_NCH) put(ch + 1, cur);
                if (ch >= 1) flush(ch - 1);
                cur = nxt;
                __syncthreads();
            }
            flush(SC_NCH - 1);
        } else {
            const int rw = wave * 8 + (lane >> 3), sg = lane & 7;
            float S[8];
#pragma unroll
            for (int q = 0; q < 8; ++q) S[q] = 0.f;
            __syncthreads();
            for (int ch = 0; ch < SC_NCH; ++ch) {
                const LAS float* bw = (const LAS float*)(F.lds + (ch & 1) * SC_BUF);
                LAS float* yb = ybuf + (ch & 1) * (SC_T * 32);
#pragma unroll 2
                for (int st = 0; st < SC_T; ++st) {
                    const LAS float* p = bw + st * 64 + sg * 8;
                    const f32x4 w0 = *(const LAS f32x4*)(p), w1 = *(const LAS f32x4*)(p + 4);
                    const f32x4 a0 = *(const LAS f32x4*)(p + SC_T * 64), a1 = *(const LAS f32x4*)(p + SC_T * 64 + 4);
                    const f32x4 b0 = *(const LAS f32x4*)(p + 2 * SC_T * 64), b1 = *(const LAS f32x4*)(p + 2 * SC_T * 64 + 4);
                    const f32x4 k0 = *(const LAS f32x4*)(p + 3 * SC_T * 64), k1 = *(const LAS f32x4*)(p + 3 * SC_T * 64 + 4);
                    const f32x4 r0 = *(const LAS f32x4*)(p + 4 * SC_T * 64), r1 = *(const LAS f32x4*)(p + 4 * SC_T * 64 + 4);
                    const float vv = bw[5 * SC_T * 64 + st * 32 + rw];
                    float sa = S[0] * a0[0] + S[1] * a0[1] + S[2] * a0[2] + S[3] * a0[3] + S[4] * a1[0] + S[5] * a1[1] + S[6] * a1[2] + S[7] * a1[3];
                    sa += __shfl_xor(sa, 1); sa += __shfl_xor(sa, 2); sa += __shfl_xor(sa, 4);
#pragma unroll
                    for (int q = 0; q < 4; ++q) { S[q] = S[q] * w0[q] + sa * b0[q] + vv * k0[q]; S[4 + q] = S[4 + q] * w1[q] + sa * b1[q] + vv * k1[q]; }
                    float y = S[0] * r0[0] + S[1] * r0[1] + S[2] * r0[2] + S[3] * r0[3] + S[4] * r1[0] + S[5] * r1[1] + S[6] * r1[2] + S[7] * r1[3];
                    y += __shfl_xor(y, 1); y += __shfl_xor(y, 2); y += __shfl_xor(y, 4);
                    if (sg == 0) yb[st * 32 + rw] = y;
                }
                __syncthreads();
            }
        }
        __syncthreads();
    }
}

__device__ __forceinline__ void ph_rwkv_out(const Frame& F, const bf16_t* Y0, const bf16_t* Y1, const bf16_t* Vb, const bf16_t* Gb, const float* CB, bf16_t* Z) {
    const int lane = F.lane;
    for (int r = F.bid * 8 + F.wave; r < ML; r += F.G * 8) {
        const size_t ro = (size_t)r * D + lane * 32;
        float y[32];
#pragma unroll
        for (int q = 0; q < 4; ++q) { const u32x4 a = *(const u32x4*)(Y0 + ro + q * 8), bq = *(const u32x4*)(Y1 + ro + q * 8);
#pragma unroll
            for (int j = 0; j < 4; ++j) { y[q * 8 + 2 * j] = bf_lo(a[j]) + bf_lo(bq[j]); y[q * 8 + 2 * j + 1] = bf_hi(a[j]) + bf_hi(bq[j]); } }
        float s = 0.f;
#pragma unroll
        for (int j = 0; j < 32; ++j) s += y[j];
        s += __shfl_xor(s, 1);
        const float mu = s * (1.f / 64.f);
        float vs = 0.f;
#pragma unroll
        for (int j = 0; j < 32; ++j) { const float d = y[j] - mu; vs += d * d; }
        vs += __shfl_xor(vs, 1);
        const float rstd = rsqrtf(vs * (1.f / 64.f) + 64e-5f);
        const int head = lane >> 1;
        const float cb = CB[(size_t)r * 32 + head] + CB[((size_t)ML + r) * 32 + head];
        const float* lw = F.A.in[I_LNW] + lane * 32; const float* lb = F.A.in[I_LNB] + lane * 32;
#pragma unroll
        for (int q = 0; q < 4; ++q) { const u32x4 vv = *(const u32x4*)(Vb + ro + q * 8), gg = *(const u32x4*)(Gb + ro + q * 8);
            u32x4 o;
#pragma unroll
            for (int j = 0; j < 4; ++j) { const int c = q * 8 + 2 * j;
                const float z0 = ((y[c] - mu) * rstd * lw[c] + lb[c] + cb * bf_lo(vv[j])) * bf_lo(gg[j]);
                const float z1 = ((y[c + 1] - mu) * rstd * lw[c + 1] + lb[c + 1] + cb * bf_hi(vv[j])) * bf_hi(gg[j]);
                o[j] = cvt_pk_bf16(z0, z1); }
            *(u32x4*)(Z + ro + q * 8) = o; }
    }
}

__device__ __forceinline__ void moe_prefix(const Frame& F, int layer, LAS int*& pref, LAS int*& cntl) {
    pref = (LAS int*)(F.lds + 131072 + 1024); cntl = pref + 40;
    __syncthreads();
    if (F.tid == 0) { const int* cnt = WSP(int, WS_CTL + CTL_CNT) + layer * NEXP; int s = 0; for (int e = 0; e < NEXP; ++e) { const int c = cnt[e]; cntl[e] = c; pref[e] = s; s += (c + 255) >> 8; } pref[NEXP] = s; }
    __syncthreads();
}
__device__ __forceinline__ void ph_moe_up(const Frame& F, int layer, const bf16_t* H, const bf16_t* W13, bf16_t* HID) {
    LAS int* pref; LAS int* cntl; moe_prefix(F, layer, pref, cntl);
    MoeSched S{pref, cntl, WSP(int, WS_TOKL), 4, F.G, F.bid, D, 2 * FF, true};
    pg8::EpiMoeUp E{HID};
    pg8::gemm_phase(F.lds, H, W13, D, S, E);
}
__device__ __forceinline__ void ph_moe_down(const Frame& F, int layer, const bf16_t* HID, const bf16_t* W2T, bf16_t* YS) {
    LAS int* pref; LAS int* cntl; moe_prefix(F, layer, pref, cntl);
    MoeSched S{pref, cntl, WSP(int, WS_TOKL), 8, F.G, F.bid, FF, D, false};
    pg8::EpiStoreBf16<0> E{YS, D, nullptr, 0, 0};
    pg8::gemm_phase(F.lds, HID, W2T, FF, S, E);
}
template <int ACT>
__device__ __forceinline__ void ph_gemm_bf16(const Frame& F, const bf16_t* A, const bf16_t* Bt, int M, int N, int K, bf16_t* O, int ldc, const float* vec, int split_cols, size_t split_stride) {
    pg8::DenseSched S; S.init(M, N, K, F.G, F.bid);
    pg8::EpiStoreBf16<ACT> E{O, ldc, vec, split_cols, split_stride};
    pg8::gemm_phase(F.lds, A, Bt, K, S, E);
}
__device__ __forceinline__ void ph_gemm_res(const Frame& F, const bf16_t* A, const bf16_t* Bt, int M, const float* xin_l, float* out_l, const float* xin_c, float* out_c, const float* gate) {
    pg8::DenseSched S; S.init(M, D, D, F.G, F.bid);
    pg8::EpiRes E{xin_l, out_l, xin_c, out_c, gate};
    pg8::gemm_phase(F.lds, A, Bt, D, S, E);
}

constexpr int LDS_BYTES = 131072 + 16384;
constexpr int N_PHASES = 34;
__global__ void __launch_bounds__(NTHR, 2) fwd(Args args) {
    extern __shared__ __attribute__((aligned(16))) unsigned char lds_raw[];
    Frame F(args);
    F.out = args.out; F.ws = args.ws; F.lds = (LAS unsigned char*)lds_raw;
    F.tid = threadIdx.x; F.lane = F.tid & 63; F.wave = __builtin_amdgcn_readfirstlane(F.tid >> 6); F.G = gridDim.x; F.bid = blockIdx.x;
    volatile LAS unsigned* misc = (volatile LAS unsigned*)(F.lds + 131072);
    if (F.tid < 4) misc[F.tid] = 0u;
    __syncthreads();
    XcdBarrier bar; bar.bar = (unsigned*)(F.ws + WS_CTL); bar.x = 0; bar.st = misc;
    const int lo = args.ph_lo, hi = args.ph_hi;
    if (hi - lo > 1) bar = xcd_barrier_post((unsigned*)(F.ws + WS_CTL), misc);
#ifndef PH_ONLY
#define PH_ONLY -1
#endif
#define IN(k) ((PH_ONLY < 0 || PH_ONLY == (k)) && lo <= (k) && (k) < hi)
#define SEAM(k) do { if (IN(k) && IN((k) + 1)) xcd_barrier(bar); } while (0)
    bf16_t* const S0 = WSP(bf16_t, SLOTP(0)); bf16_t* const S1 = WSP(bf16_t, SLOTP(1)); bf16_t* const S2 = WSP(bf16_t, SLOTP(2)); bf16_t* const S3 = WSP(bf16_t, SLOTP(3));
    bf16_t* const S4 = WSP(bf16_t, SLOTP(4)); bf16_t* const S5 = WSP(bf16_t, SLOTP(5)); bf16_t* const S6 = WSP(bf16_t, SLOTP(6)); bf16_t* const S7 = WSP(bf16_t, SLOTP(7));
    bf16_t* const S8 = WSP(bf16_t, SLOTP(8));
    float* const XC = WSP(float, WS_XC);
    float* const CB = WSP(float, WS_CB);
    const size_t W2OFF = (size_t)NEXP * 2 * FF * D;

    if (IN(0)) ph_prologue(F);
    SEAM(0);
    if (IN(1)) { RowOpts O{F.A.in[I_X], F.A.in[I_CTX], MT, false, 0, nullptr, nullptr, nullptr, true, 0, 0, S0, false}; ph_rows(F, O); }
    SEAM(1);
    if (IN(2)) ph_gemm_bf16<0>(F, S0, WSP(bf16_t, WT_IN), MT, QKVC, D, S1, QKVC, nullptr, 0, 0);
    SEAM(2);
    if (IN(3)) ph_qknorm(F, S1);
    SEAM(3);
    if (IN(4)) ph_attn_simple(F, S1, S4);
    SEAM(4);
    if (IN(5)) ph_gemm_res(F, S4, WSP(bf16_t, WT_OUT), MT, F.A.in[I_X], F.out, F.A.in[I_CTX], XC, mod_row(F, 0, 0) + 2 * D);
    SEAM(5);
    if (IN(6)) { RowOpts O{F.out, XC, MT, false, 0, nullptr, nullptr, nullptr, true, 0, 1, S0, true}; ph_rows(F, O); }
    SEAM(6);
    if (IN(7)) ph_moe_up(F, 0, S0, S6, S5);
    SEAM(7);
    if (IN(8)) ph_moe_down(F, 0, S5, S6 + W2OFF, S1);
    SEAM(8);
    if (IN(9)) { RowOpts O{F.out, XC, MT, true, 0, S1, F.out, XC, true, 1, 0, S0, false}; ph_rows(F, O); }
    SEAM(9);
    if (IN(10)) ph_mix(F, S0, S1, 1);
    SEAM(10);
    if (IN(11)) ph_gemm_bf16<1>(F, S1, WSP(bf16_t, WT_W1), MT, 256, D, WSP(bf16_t, WS_TW), 256, nullptr, 0, 0);
    SEAM(11);
    if (IN(12)) ph_mix(F, S0, S1, 4);
    SEAM(12);
    if (IN(13)) ph_gemm_bf16<0>(F, S1, WSP(bf16_t, WT_A1), MT, 256, D, WSP(bf16_t, WS_TA), 256, nullptr, 0, 0);
    SEAM(13);
    if (IN(14)) ph_mix(F, S0, S1, 5);
    SEAM(14);
    if (IN(15)) ph_gemm_bf16<2>(F, S1, WSP(bf16_t, WT_G1), MT, 256, D, WSP(bf16_t, WS_TG), 256, nullptr, 0, 0);
    SEAM(15);
    if (IN(16)) ph_mix(F, S0, S1, 0);
    SEAM(16);
    if (IN(17)) ph_gemm_bf16<0>(F, S1, WSP(bf16_t, WT_R), MT, D, D, S3, D, nullptr, 0, 0);
    SEAM(17);
    if (IN(18)) ph_mix(F, S0, S1, 2);
    SEAM(18);
    if (IN(19)) ph_gemm_bf16<0>(F, S1, WSP(bf16_t, WT_K), MT, D, D, S4, D, nullptr, 0, 0);
    SEAM(19);
    if (IN(20)) ph_mix(F, S0, S1, 3);
    SEAM(20);
    if (IN(21)) ph_gemm_bf16<0>(F, S1, WSP(bf16_t, WT_V), MT, D, D, S5, D, nullptr, 0, 0);
    SEAM(21);
    if (IN(22)) ph_gemm_bf16<3>(F, WSP(bf16_t, WS_TW), WSP(bf16_t, WT_W2), MT, 2 * D, 256, S0, D, F.A.in[I_W0], D, (size_t)(SLOTP(1) - SLOTP(0)) / 2);
    SEAM(22);
    if (IN(23)) ph_gemm_bf16<4>(F, WSP(bf16_t, WS_TA), WSP(bf16_t, WT_A2), MT, 2 * D, 256, S2, D, F.A.in[I_A0], D, (size_t)(SLOTP(6) - SLOTP(2)) / 2);
    SEAM(23);
    if (IN(24)) ph_scan(F, S3, S4, S5, S0, S1, S2, S6, S7, S8, CB);
    SEAM(24);
    if (IN(25)) ph_gemm_bf16<0>(F, WSP(bf16_t, WS_TG), WSP(bf16_t, WT_G2), ML, D, 256, S3, D, nullptr, 0, 0);
    SEAM(25);
    if (IN(26)) ph_rwkv_out(F, S7, S8, S5, S3, CB, S4);
    SEAM(26);
    if (IN(27)) ph_gemm_res(F, S4, WSP(bf16_t, WT_O), ML, F.out, F.out, XC, XC, mod_row(F, 1, 0) + 2 * D);
    SEAM(27);
    if (IN(28)) { int base = 0; cvt_moe(F, 1, S1, S1 + W2OFF, base); }
    SEAM(28);
    if (IN(29)) { RowOpts O{F.out, XC, ML, false, 0, nullptr, nullptr, nullptr, true, 1, 1, S0, true}; ph_rows(F, O); }
    SEAM(29);
    if (IN(30)) ph_moe_up(F, 1, S0, S1, S5);
    SEAM(30);
    if (IN(31)) ph_moe_down(F, 1, S5, S1 + W2OFF, S6);
    SEAM(31);
    if (IN(32)) { RowOpts O{F.out, XC, ML, true, 1, S6, F.out, XC, false, 1, 0, nullptr, false}; ph_rows(F, O); }
#undef IN
#undef SEAM
}

extern "C" void kernel_launch(void* const* d_in, const int* in_sizes, int n_in, void* d_out, int out_size, void* d_ws, size_t ws_size, hipStream_t stream) {
    static int grid = 0;
    if (grid == 0) {
        if (n_in != 39 || out_size != ML * D || ws_size < WS_END) { fprintf(stderr, "kernel_launch: unexpected shapes (n_in %d out %d ws %zu need %zu)\n", n_in, out_size, ws_size, (size_t)WS_END); grid = -1; return; }
        int dev = 0, cus = 0;
        if (hipGetDevice(&dev) != hipSuccess || hipDeviceGetAttribute(&cus, hipDeviceAttributeMultiprocessorCount, dev) != hipSuccess) { grid = -1; return; }
        if (hipFuncSetAttribute((const void*)fwd, hipFuncAttributeMaxDynamicSharedMemorySize, LDS_BYTES) != hipSuccess) { fprintf(stderr, "kernel_launch: hipFuncSetAttribute failed\n"); grid = -1; return; }
        int per_cu = 0;
        if (hipOccupancyMaxActiveBlocksPerMultiprocessor(&per_cu, (const void*)fwd, NTHR, LDS_BYTES) != hipSuccess || per_cu < 1) { fprintf(stderr, "kernel_launch: occupancy query says %d\n", per_cu); }
        (void)hipGetLastError();
        grid = cus;
    }
    if (grid < 0) return;
    (void)hipMemsetAsync((char*)d_ws + WS_CTL, 0, CTL_BYTES, stream);
    Args a{};
    for (int i = 0; i < 39; ++i) a.in[i] = (const float*)d_in[i];
    a.out = (float*)d_out; a.ws = (unsigned char*)d_ws;
#if ONE_LAUNCH
    a.ph_lo = 0; a.ph_hi = N_PHASES;
    hipLaunchKernelGGL(fwd, dim3(grid), dim3(NTHR), LDS_BYTES, stream, a);
#else
    for (int p = 0; p < 33; ++p) { a.ph_lo = p; a.ph_hi = p + 1; hipLaunchKernelGGL(fwd, dim3(grid), dim3(NTHR), LDS_BYTES, stream, a); }
#endif
}
```

```cpp
#include <hip/hip_runtime.h>
#include <stdint.h>
#include <stdio.h>

#ifndef ONE_LAUNCH
#define ONE_LAUNCH 1
#endif

#define LAS __attribute__((address_space(3)))
typedef unsigned short bf16_t;
typedef short bf16x8 __attribute__((ext_vector_type(8)));
typedef float f32x4 __attribute__((ext_vector_type(4)));
typedef float f32x2 __attribute__((ext_vector_type(2)));
typedef unsigned u32x4 __attribute__((ext_vector_type(4)));
typedef unsigned u32x2 __attribute__((ext_vector_type(2)));

constexpr int D = 2048, NB = 2, SEQ = 16384, ML = NB * SEQ, CTXL = 256, MC = NB * CTXL, MT = ML + MC;
constexpr int QKVC = 4608, QA0 = 0, KA0 = 1024, VA0 = 1280, QB0 = 1536, KB0 = 2560, VB0 = 3584;
constexpr int NEXP = 32, FF = 512, MAXSLOT = 2 * MT + NEXP * 256;
constexpr int MODW = 6 * D;
constexpr int NTHR = 512;

constexpr size_t MiB = 1ull << 20;
constexpr size_t WS_CTL = 0;
constexpr size_t CTL_BYTES = 64 * 1024;
constexpr size_t CTL_CNT = 16384;
constexpr size_t WS_MOD = 1 * MiB;
constexpr size_t WS_XC = 2 * MiB;
constexpr size_t WS_TOKL = 6 * MiB;
constexpr size_t WS_TOKSEL = 11 * MiB;
constexpr size_t WS_TOKGATE = 11 * MiB + 512 * 1024;
constexpr size_t WS_CB = 12 * MiB;
constexpr size_t WS_WT = 20 * MiB;
constexpr size_t WT_IN = WS_WT, WT_OUT = WS_WT + 18 * MiB, WT_R = WS_WT + 26 * MiB, WT_K = WS_WT + 34 * MiB, WT_V = WS_WT + 42 * MiB, WT_O = WS_WT + 50 * MiB;
constexpr size_t WT_W1 = WS_WT + 58 * MiB, WT_A1 = WS_WT + 59 * MiB, WT_G1 = WS_WT + 60 * MiB, WT_W2 = WS_WT + 61 * MiB, WT_A2 = WS_WT + 63 * MiB, WT_G2 = WS_WT + 65 * MiB;
constexpr size_t WS_TW = 86 * MiB, WS_TA = 103 * MiB, WS_TG = 120 * MiB;
constexpr size_t WS_SLOT0 = 140 * MiB, SLOT = 130 * MiB;
constexpr size_t WS_END = WS_SLOT0 + 9 * SLOT;
#define SLOTP(k) (WS_SLOT0 + (size_t)(k) * SLOT)

__device__ __forceinline__ unsigned cvt_pk_bf16(float lo, float hi) { unsigned r; asm volatile("v_cvt_pk_bf16_f32 %0, %1, %2" : "=v"(r) : "v"(lo), "v"(hi)); return r; }
__device__ __forceinline__ float bf_lo(unsigned u) { return __uint_as_float(u << 16); }
__device__ __forceinline__ float bf_hi(unsigned u) { return __uint_as_float(u & 0xffff0000u); }
__device__ __forceinline__ float bf2f(bf16_t v) { return __uint_as_float(((unsigned)v) << 16); }
__device__ __forceinline__ float wave_sum(float v) { for (int o = 32; o; o >>= 1) v += __shfl_xor(v, o); return v; }
__device__ __forceinline__ float wave_max(float v) { for (int o = 32; o; o >>= 1) v = fmaxf(v, __shfl_xor(v, o)); return v; }
__device__ __forceinline__ float sigmoidf_(float x) { return 1.f / (1.f + __expf(-x)); }
__device__ __forceinline__ void lds_fence() { asm volatile("s_waitcnt lgkmcnt(0)" ::: "memory"); }

struct Args { const float* in[39]; float* out; unsigned char* ws; int ph_lo, ph_hi; };
struct Frame {
    const Args& A; float* out; unsigned char* ws; LAS unsigned char* lds;
    int tid, lane, wave, G, bid;
    __device__ __forceinline__ Frame(const Args& a) : A(a) {}
};
enum { I_X = 0, I_C, I_CTX, I_CCTX, I_ADAW, I_ADAB, I_NMIX, I_NFFN, I_WIN, I_WOUT, I_AQG, I_AKG, I_ASINK, I_BQG, I_BKG, I_RPB, I_MU, I_WR, I_WK, I_WV, I_WO, I_W0, I_W1, I_W2,
       I_A0, I_A1, I_A2, I_G1, I_G2, I_KK, I_KA, I_RK, I_LNW, I_LNB, I_MGRP, I_MEXP, I_MW1, I_MW3, I_MW2 };

#define XB_TMO      128
#define XB_XCNT(j)  (256  + 64 * (j))
#define XB_XSUB(j)  (1280 + 64 * (j))
#define XB_XGEN(j)  (2304 + 64 * (j))
#define XB_TOP      3328
#define XB_TOPGEN   3392
#define XCD_BAR_WORDS 3456
#define XB_SPIN_CAP (1u << 18)
__device__ __forceinline__ unsigned xb_ld(unsigned* p)              { return __hip_atomic_load(p, __ATOMIC_RELAXED, __HIP_MEMORY_SCOPE_AGENT); }
__device__ __forceinline__ unsigned xb_add(unsigned* p, unsigned v) { return __hip_atomic_fetch_add(p, v, __ATOMIC_RELAXED, __HIP_MEMORY_SCOPE_AGENT); }
__device__ __forceinline__ unsigned xb_xcc_id() { return (unsigned)__builtin_amdgcn_s_getreg((3 << 11) | 20) & 0xFu; }
#define XB_SPIN(cond, bar) do { unsigned _sp = 0; while (cond) { __builtin_amdgcn_s_sleep(1); \
    if ((++_sp & 255u) == 0u) { if (xb_ld(&(bar)[XB_TMO])) break; if (_sp > XB_SPIN_CAP) { atomicAdd(&(bar)[XB_TMO], 1u); break; } } } } while (0)
struct XcdBarrier { unsigned* bar; unsigned x; volatile LAS unsigned* st; };
__device__ __forceinline__ XcdBarrier xcd_barrier_post(unsigned* bar, volatile LAS unsigned* st) {
    XcdBarrier b; b.bar = bar; b.x = xb_xcc_id(); b.st = st;
    if (threadIdx.x == 0) (void)xb_add(&bar[XB_XCNT(b.x)], 1u);
    return b;
}
__device__ __forceinline__ void xcd_barrier_complete(unsigned* bar, unsigned x, unsigned& nloc, unsigned& nx) {
    const unsigned G = gridDim.x * gridDim.y * gridDim.z;
    unsigned sum, cnt, mine, sp = 0u;
    for (;;) {
        sum = 0u; cnt = 0u; mine = 0u;
#pragma unroll
        for (unsigned j = 0; j < 16; ++j) { const unsigned c = xb_ld(&bar[XB_XCNT(j)]); sum += c; cnt += (c > 0u) ? 1u : 0u; mine = (j == x) ? c : mine; }
        if (sum == G) break;
        __builtin_amdgcn_s_sleep(1);
        if ((++sp & 255u) == 0u) { if (xb_ld(&bar[XB_TMO])) break; if (sp > XB_SPIN_CAP) { atomicAdd(&bar[XB_TMO], 1u); break; } }
    }
    nloc = mine > 0u ? mine : 1u; nx = cnt > 0u ? cnt : 1u;
}
__device__ __forceinline__ void xcd_barrier(const XcdBarrier& b) {
    asm volatile("s_waitcnt vmcnt(0)" ::: "memory");
    __syncthreads();
    if (threadIdx.x == 0) {
        unsigned* bar = b.bar;
        __builtin_amdgcn_s_waitcnt(0);
        unsigned nloc = b.st[0], nx = b.st[1];
        if (nloc == 0u) { xcd_barrier_complete(bar, b.x, nloc, nx); b.st[0] = nloc; b.st[1] = nx; }
        const unsigned old = xb_add(&bar[XB_XSUB(b.x)], 1u);
        const unsigned gen = old / nloc;
        if (old + 1u == (gen + 1u) * nloc) {
            __builtin_amdgcn_fence(__ATOMIC_RELEASE, "agent");
            asm volatile("s_waitcnt vmcnt(0)" ::: "memory");
            const unsigned og = xb_add(&bar[XB_TOP], 1u);
            const unsigned tg = og / nx;
            if (og + 1u == (tg + 1u) * nx) xb_add(&bar[XB_TOPGEN], 1u);
            else XB_SPIN(xb_ld(&bar[XB_TOPGEN]) == tg, bar);
            __builtin_amdgcn_fence(__ATOMIC_ACQUIRE, "agent");
            xb_add(&bar[XB_XGEN(b.x)], 1u);
            asm volatile("s_waitcnt vmcnt(0)" ::: "memory");
        } else {
            XB_SPIN(xb_ld(&bar[XB_XGEN(b.x)]) == gen, bar);
            __builtin_amdgcn_fence(__ATOMIC_ACQUIRE, "agent");
            asm volatile("s_waitcnt vmcnt(0)" ::: "memory");
        }
    }
    __syncthreads();
}

namespace pg8 {
constexpr int BM = 256, BK = 64, HALF = 128, HTB = HALF * BK * 2, STAGE_BYTES = 8 * HTB, NXCD = 8, WGM = 8;
__host__ __device__ __forceinline__ int lds_byte(int r, int c) { const int st = (r >> 4) * 2 + (c >> 5), rr = r & 15, cc = c & 31, ob = rr * 64 + cc * 2; return st * 1024 + (ob ^ (((ob >> 9) & 1) << 5)); }
__host__ __device__ __forceinline__ void stage_rc(int b, int& R, int& C) { const int st = b / 1024, sb = b % 1024, swz = sb ^ (((sb >> 9) & 1) << 5); R = (st >> 1) * 16 + swz / 64; C = (st & 1) * 32 + (swz % 64) / 2; }
__host__ __device__ __forceinline__ int perm32(int rho) { const int n = rho >> 4, i = rho & 15; return 8 * (i >> 2) + 4 * n + (i & 3); }

struct Unit { int arow0, brow0, col0, e, pbase, cnt; };

struct DenseSched {
    int nM, nN, nwg, G, c, K;
    __device__ void init(int M, int N, int K_, int G_, int c_) { nM = M / BM; nN = N / BM; nwg = nM * nN; G = G_; c = c_; K = K_; }
    __device__ bool next(int i, Unit& u) const {
        const long L = (long)i * G + c; if (L >= nwg) return false;
        int wgid = (int)L; { const int q = nwg / NXCD, r = nwg % NXCD, xcd = wgid % NXCD, off = wgid / NXCD; wgid = (xcd < r ? xcd * (q + 1) : r * (q + 1) + (xcd - r) * q) + off; }
        const int nig = WGM * nN, gid = wgid / nig, fm = gid * WGM, gsz = (nM - fm) < WGM ? (nM - fm) : WGM;
        const int pm = fm + ((wgid % nig) % gsz), pn = (wgid % nig) / gsz;
        u.arow0 = pm * BM; u.brow0 = pn * BM; u.col0 = pn * BM; u.e = 0; u.pbase = 0; u.cnt = 0; return true;
    }
    __device__ __forceinline__ unsigned a_off(const Unit& u, int r, int C) const { return (unsigned)((u.arow0 + r) * K + C) * 2u; }
};

template <class Epi, class Sched>
__device__ __forceinline__ void gemm_phase(LAS unsigned char* lds, const bf16_t* A, const bf16_t* Bt, const int K, const Sched& S, const Epi& E) {
    const int tid = threadIdx.x, wid = __builtin_amdgcn_readfirstlane(tid >> 6), lane = tid & 63, wr = wid >> 2, wc = wid & 3, fr = lane & 15, fq = lane >> 4;
    const int nt = K / BK;
    int Rr[2], Cc[2]; unsigned voffB[2];
#pragma unroll
    for (int i = 0; i < 2; ++i) { int R, C; stage_rc(tid * 16 + i * 8192, R, C); const int Rb = Epi::PERM ? ((R & ~31) + perm32(R & 31)) : R;
        Rr[i] = R; Cc[i] = C; voffB[i] = (unsigned)(Rb * K + C) * 2u; }
    const size_t kstep = (size_t)(BK * 2);
    const size_t hstepB = (size_t)HALF * K * 2;
    const unsigned ldsw = (unsigned)wid * 1024u;
    const int aoff = lds_byte(wr * 64 + fr, fq * 8), boff = lds_byte(wc * 32 + fr, fq * 8);
#define PG8_SA(b, h) (((b) * 2 + (h)) * HTB)
#define PG8_SB(b, h) ((4 + (b) * 2 + (h)) * HTB)
#define PG8_STAGE(bufoff, gbase, voff) do { _Pragma("unroll") for (int _i = 0; _i < 2; ++_i) \
        __builtin_amdgcn_global_load_lds((const unsigned*)((const char*)(gbase) + (voff)[_i]), (LAS unsigned*)(lds + (bufoff) + ldsw + _i * 8192), 16, 0, 0); } while (0)
#define PG8_LDA(dst, b, h) do { _Pragma("unroll") for (int m = 0; m < 4; ++m) _Pragma("unroll") for (int k = 0; k < 2; ++k) dst[m][k] = *(const LAS bf16x8*)(lds + PG8_SA(b, h) + aoff + m * 2048 + k * 1024); } while (0)
#define PG8_LDB(dst, b, h) do { _Pragma("unroll") for (int n = 0; n < 2; ++n) _Pragma("unroll") for (int k = 0; k < 2; ++k) dst[n][k] = *(const LAS bf16x8*)(lds + PG8_SB(b, h) + boff + n * 2048 + k * 1024); } while (0)
#define PG8_MMA(ai, bj, At, Bt_) do { __builtin_amdgcn_s_setprio(1); _Pragma("unroll") for (int m = 0; m < 4; ++m) _Pragma("unroll") for (int n = 0; n < 2; ++n) _Pragma("unroll") for (int k = 0; k < 2; ++k) \
        acc[ai][bj][m][n] = __builtin_amdgcn_mfma_f32_16x16x32_bf16(Bt_[n][k], At[m][k], acc[ai][bj][m][n], 0, 0, 0); __builtin_amdgcn_s_setprio(0); } while (0)
#define PG8_WAIT_V(n) asm volatile("s_waitcnt vmcnt(" #n ")" ::: "memory")
#define PG8_WAIT_L(n) asm volatile("s_waitcnt lgkmcnt(" #n ")" ::: "memory")
#define PG8_BAR __builtin_amdgcn_s_barrier()
#define PG8_SCHED __builtin_amdgcn_sched_barrier(0)
    Unit cur, nxt; int ui = 0;
    if (!S.next(0, cur)) return;
    f32x4 acc[2][2][4][2];
#pragma unroll
    for (int a = 0; a < 2; ++a)
#pragma unroll
        for (int b = 0; b < 2; ++b)
#pragma unroll
            for (int m = 0; m < 4; ++m)
#pragma unroll
                for (int n = 0; n < 2; ++n) acc[a][b][m][n] = (f32x4){0.f, 0.f, 0.f, 0.f};
    bf16x8 At[4][2], B0[2][2], B1[2][2];
    unsigned oC0[2], oC1[2], oN0[2], oN1[2];
#pragma unroll
    for (int i = 0; i < 2; ++i) { oC0[i] = S.a_off(cur, Rr[i], Cc[i]); oC1[i] = S.a_off(cur, HALF + Rr[i], Cc[i]); }
    const char* gA = (const char*)A;
    const char* cB = (const char*)Bt + (size_t)cur.brow0 * K * 2;
    PG8_STAGE(PG8_SB(0, 0), cB, voffB); PG8_STAGE(PG8_SA(0, 0), gA, oC0); PG8_STAGE(PG8_SB(0, 1), cB + hstepB, voffB); PG8_STAGE(PG8_SA(0, 1), gA, oC1);
    if (wr == 1) PG8_BAR;
    PG8_WAIT_V(4); PG8_BAR;
    PG8_STAGE(PG8_SB(1, 0), cB + kstep, voffB); PG8_STAGE(PG8_SA(1, 0), gA + kstep, oC0); PG8_STAGE(PG8_SB(1, 1), cB + hstepB + kstep, voffB);
    PG8_WAIT_V(6); PG8_BAR;
    for (;;) {
        const bool has_next = S.next(ui + 1, nxt);
        if (has_next) {
#pragma unroll
            for (int i = 0; i < 2; ++i) { oN0[i] = S.a_off(nxt, Rr[i], Cc[i]); oN1[i] = S.a_off(nxt, HALF + Rr[i], Cc[i]); }
        } else {
#pragma unroll
            for (int i = 0; i < 2; ++i) { oN0[i] = oC0[i]; oN1[i] = oC1[i]; }
        }
        const char* nB = has_next ? (const char*)Bt + (size_t)nxt.brow0 * K * 2 : cB;
        for (int t = 0; t < nt; t += 2) {
            const bool last = (t == nt - 2);
            const char* a1 = gA + (size_t)(t + 1) * kstep;
            const char* a2 = last ? gA : gA + (size_t)(t + 2) * kstep; const char* b2 = last ? nB : cB + (size_t)(t + 2) * kstep;
            const char* a3 = a2 + kstep; const char* b3 = b2 + kstep;
            unsigned o20[2], o21[2];
#pragma unroll
            for (int i = 0; i < 2; ++i) { o20[i] = last ? oN0[i] : oC0[i]; o21[i] = last ? oN1[i] : oC1[i]; }
            PG8_LDB(B0, 0, 0); PG8_SCHED; PG8_LDA(At, 0, 0); PG8_STAGE(PG8_SA(1, 1), a1, oC1);
            PG8_WAIT_L(8); PG8_BAR; PG8_WAIT_L(0); PG8_MMA(0, 0, At, B0); PG8_BAR; PG8_SCHED;
            PG8_LDB(B1, 0, 1); PG8_STAGE(PG8_SB(0, 0), b2, voffB);
            PG8_BAR; PG8_WAIT_L(0); PG8_MMA(0, 1, At, B1); PG8_BAR;
            PG8_LDA(At, 0, 1); PG8_STAGE(PG8_SA(0, 0), a2, o20);
            PG8_BAR; PG8_WAIT_L(0); PG8_MMA(1, 0, At, B0); PG8_BAR; PG8_SCHED;
            PG8_STAGE(PG8_SB(0, 1), b2 + hstepB, voffB);
            PG8_WAIT_V(6); PG8_BAR; PG8_MMA(1, 1, At, B1); PG8_BAR;
            PG8_LDB(B0, 1, 0); PG8_SCHED; PG8_LDA(At, 1, 0); PG8_STAGE(PG8_SA(0, 1), a2, o21);
            PG8_WAIT_L(8); PG8_BAR; PG8_WAIT_L(0); PG8_MMA(0, 0, At, B0); PG8_BAR; PG8_SCHED;
            PG8_LDB(B1, 1, 1); PG8_STAGE(PG8_SB(1, 0), b3, voffB);
            PG8_BAR; PG8_WAIT_L(0); PG8_MMA(0, 1, At, B1); PG8_BAR;
            PG8_LDA(At, 1, 1); PG8_STAGE(PG8_SA(1, 0), a3, o20);
            PG8_BAR; PG8_WAIT_L(0); PG8_MMA(1, 0, At, B0); PG8_BAR; PG8_SCHED;
            PG8_STAGE(PG8_SB(1, 1), b3 + hstepB, voffB);
            PG8_WAIT_V(6); PG8_BAR; PG8_MMA(1, 1, At, B1); PG8_BAR;
        }
        E(acc, cur, wr, wc, fr, fq);
        if (!has_next) break;
#pragma unroll
        for (int a = 0; a < 2; ++a)
#pragma unroll
            for (int b = 0; b < 2; ++b)
#pragma unroll
                for (int m = 0; m < 4; ++m)
#pragma unroll
                    for (int n = 0; n < 2; ++n) acc[a][b][m][n] = (f32x4){0.f, 0.f, 0.f, 0.f};
        cur = nxt; cB = nB; ++ui;
#pragma unroll
        for (int i = 0; i < 2; ++i) { oC0[i] = oN0[i]; oC1[i] = oN1[i]; }
    }
    PG8_WAIT_V(0);
    if (wr == 0) PG8_BAR;
    PG8_BAR;
#undef PG8_SA
#undef PG8_SB
#undef PG8_STAGE
#undef PG8_LDA
#undef PG8_LDB
#undef PG8_MMA
#undef PG8_WAIT_V
#undef PG8_WAIT_L
#undef PG8_BAR
#undef PG8_SCHED
}

template <int ACT> struct EpiStoreBf16 {
    static constexpr bool PERM = true;
    bf16_t* O; int ldc; const float* vec; int split_cols; size_t split_stride;
    __device__ __forceinline__ float act(float v, float b) const {
        if (ACT == 1) return 2.f * sigmoidf_(2.f * v) - 1.f;
        if (ACT == 2) return sigmoidf_(v);
        if (ACT == 3) return 0.60653065971f * sigmoidf_(v + b);
        if (ACT == 4) return sigmoidf_(v + b);
        return v;
    }
    __device__ __forceinline__ void operator()(const f32x4 (&acc)[2][2][4][2], const Unit& u, int wr, int wc, int fr, int fq) const {
        const int row0 = u.arow0 + wr * 64 + fr; int colt = u.col0; bf16_t* base = O;
        if (split_cols) { const int t = colt / split_cols; base += (size_t)t * split_stride; colt -= t * split_cols; }
        const int col0 = colt + wc * 32 + 8 * fq, bcol0 = u.col0 + wc * 32 + 8 * fq;
#pragma unroll
        for (int bj = 0; bj < 2; ++bj) {
            const f32x4 b0 = (ACT >= 3) ? *(const f32x4*)(vec + bcol0 + bj * HALF) : (f32x4){0.f, 0.f, 0.f, 0.f}, b1 = (ACT >= 3) ? *(const f32x4*)(vec + bcol0 + bj * HALF + 4) : (f32x4){0.f, 0.f, 0.f, 0.f};
#pragma unroll
            for (int ai = 0; ai < 2; ++ai)
#pragma unroll
                for (int m = 0; m < 4; ++m) { bf16_t* rowp = base + (size_t)(row0 + ai * HALF + m * 16) * ldc + col0; const f32x4 v0 = acc[ai][bj][m][0], v1 = acc[ai][bj][m][1];
                {
                    u32x4 o; o[0] = cvt_pk_bf16(act(v0[0], b0[0]), act(v0[1], b0[1])); o[1] = cvt_pk_bf16(act(v0[2], b0[2]), act(v0[3], b0[3]));
                    o[2] = cvt_pk_bf16(act(v1[0], b1[0]), act(v1[1], b1[1])); o[3] = cvt_pk_bf16(act(v1[2], b1[2]), act(v1[3], b1[3]));
                    *(u32x4*)(rowp + bj * HALF) = o; } }
        }
    }
};
struct EpiRes {
    static constexpr bool PERM = false;
    const float* xin_l; float* out_l; const float* xin_c; float* out_c; const float* gate;
    __device__ __forceinline__ void operator()(const f32x4 (&acc)[2][2][4][2], const Unit& u, int wr, int wc, int fr, int fq) const {
        const int row0 = u.arow0 + wr * 64 + fr, col0 = u.col0 + wc * 32 + 4 * fq;
        const bool isc = u.arow0 >= ML;
        const int gb = isc ? 2 : (u.arow0 / SEQ);
        const float* gp = gate + (size_t)gb * MODW + col0;
        f32x4 gv[2][2];
#pragma unroll
        for (int bj = 0; bj < 2; ++bj)
#pragma unroll
            for (int n = 0; n < 2; ++n) gv[bj][n] = *(const f32x4*)(gp + bj * HALF + n * 16);
        const float* xi = isc ? xin_c - (size_t)ML * D : xin_l; float* xo = isc ? out_c - (size_t)ML * D : out_l;
#pragma unroll
        for (int ai = 0; ai < 2; ++ai)
#pragma unroll
            for (int m = 0; m < 4; ++m) { const size_t ro = (size_t)(row0 + ai * HALF + m * 16) * D + col0;
#pragma unroll
                for (int bj = 0; bj < 2; ++bj)
#pragma unroll
                    for (int n = 0; n < 2; ++n) { const f32x4 xv = *(const f32x4*)(xi + ro + bj * HALF + n * 16);
                        *(f32x4*)(xo + ro + bj * HALF + n * 16) = xv + gv[bj][n] * acc[ai][bj][m][n]; } }
    }
};
struct EpiMoeUp {
    static constexpr bool PERM = false;
    bf16_t* H;
    __device__ __forceinline__ void operator()(const f32x4 (&acc)[2][2][4][2], const Unit& u, int wr, int wc, int fr, int fq) const {
        const int row0 = u.arow0 + wr * 64 + fr;
#pragma unroll
        for (int ai = 0; ai < 2; ++ai)
#pragma unroll
            for (int m = 0; m < 4; ++m) { bf16_t* rowp = H + (size_t)(row0 + ai * HALF + m * 16) * FF;
#pragma unroll
                for (int bj = 0; bj < 2; ++bj) { const int j = (u.col0 + bj * HALF + wc * 32) / 2 + 4 * fq; const f32x4 a = acc[ai][bj][m][0], b = acc[ai][bj][m][1];
                    float h[4];
#pragma unroll
                    for (int i = 0; i < 4; ++i) h[i] = a[i] * sigmoidf_(a[i]) * b[i];
                    u32x2 o; o[0] = cvt_pk_bf16(h[0], h[1]); o[1] = cvt_pk_bf16(h[2], h[3]);
                    *(u32x2*)(rowp + j) = o; } }
    }
};
}

struct MoeSched {
    const LAS int* pref; const LAS int* cnt; const int* tokl; int nN, G, c, K, rowsB; bool gather;
    __device__ bool next(int i, pg8::Unit& u) const {
        const long L = (long)i * G + c; const int T = __builtin_amdgcn_readfirstlane(pref[NEXP]);
        if (L >= (long)T * nN) return false;
        const int tl = (int)(L / nN), pn = (int)(L % nN);
        int e = 0;
        for (int k = 1; k < NEXP; ++k) e = (pref[k] <= tl) ? k : e;
        e = __builtin_amdgcn_readfirstlane(e);
        u.e = e; u.pbase = __builtin_amdgcn_readfirstlane((tl - pref[e]) * 256); u.cnt = __builtin_amdgcn_readfirstlane(cnt[e]); u.arow0 = tl * 256; u.brow0 = e * rowsB + pn * 256; u.col0 = pn * 256; return true;
    }
    __device__ __forceinline__ unsigned a_off(const pg8::Unit& u, int r, int C) const {
        if (gather) { const int p = u.pbase + r; const int tok = (p < u.cnt) ? tokl[(size_t)u.e * MT + p] : 0; return (unsigned)(tok * K + C) * 2u; }
        return (unsigned)((u.arow0 + r) * K + C) * 2u;
    }
};

#define WSP(T, off) ((T*)(F.ws + (off)))
__device__ __forceinline__ const float* mod_row(const Frame& F, int layer, int row3) { return (const float*)(F.ws + WS_MOD) + ((size_t)layer * 3 + row3) * MODW; }

struct CvtJob { const float* src; const float* src2; bf16_t* dst; int Ksrc, Nsrc, ld_src, Kdst, Ndst, koff, grp_rows; size_t grp_stride; int mode; };
struct CvtRegs { f32x4 v[4]; };
__device__ __forceinline__ void cvt_load(const CvtJob& J, int tile, int tid, CvtRegs& R) {
    const int ktiles = J.Kdst / 64, nt = tile / ktiles, kt = tile % ktiles, n0 = nt * 128, k0 = kt * 64;
    const int e = n0 / J.grp_rows, nl0 = n0 % J.grp_rows;
    const int kr = tid >> 3, c8 = tid & 7;
    const int ks = k0 + kr - J.koff;
    const bool kok = (ks >= 0) && (ks < J.Ksrc);
#pragma unroll
    for (int cc = 0; cc < 2; ++cc) {
        const int nl = nl0 + (c8 + cc * 8) * 8;
        const float* sp = J.src + (size_t)e * J.grp_stride; int ncol = nl;
        if (J.mode == 1) { const int g = nl >> 5, w = nl & 31; sp = (w < 16 ? J.src : J.src2) + (size_t)e * J.grp_stride; ncol = g * 16 + (w & 15); }
        if (kok && ncol + 8 <= J.Nsrc) { const float* p = sp + (size_t)ks * J.ld_src + ncol; R.v[cc * 2] = *(const f32x4*)p; R.v[cc * 2 + 1] = *(const f32x4*)(p + 4); }
        else { R.v[cc * 2] = (f32x4){0.f, 0.f, 0.f, 0.f}; R.v[cc * 2 + 1] = (f32x4){0.f, 0.f, 0.f, 0.f}; }
    }
}
__device__ __forceinline__ void cvt_job(const Frame& F, const CvtJob& J, int& base) {
    const int ntiles = (J.Ndst / 128) * (J.Kdst / 64), tid = F.tid;
    LAS float* tl = (LAS float*)F.lds;
    int t = ((F.bid - base) % F.G + F.G) % F.G;
    base = (base + ntiles) % F.G;
    if (t >= ntiles) return;
    CvtRegs cur, nxt; cvt_load(J, t, tid, cur);
    const int ktiles = J.Kdst / 64;
    for (; t < ntiles; t += F.G) {
        const bool hn = (t + F.G) < ntiles;
        if (hn) cvt_load(J, t + F.G, tid, nxt);
        const int kr = tid >> 3, c8 = tid & 7;
#pragma unroll
        for (int cc = 0; cc < 2; ++cc)
#pragma unroll
            for (int j = 0; j < 8; ++j) tl[kr * 129 + (c8 + cc * 8) * 8 + j] = cur.v[cc * 2 + (j >> 2)][j & 3];
        __syncthreads();
        const int nrow = tid >> 2, kq = tid & 3, nt = t / ktiles, kt = t % ktiles;
        float x[16];
#pragma unroll
        for (int j = 0; j < 16; ++j) x[j] = tl[(kq * 16 + j) * 129 + nrow];
        u32x4 o0, o1;
#pragma unroll
        for (int j = 0; j < 4; ++j) { o0[j] = cvt_pk_bf16(x[2 * j], x[2 * j + 1]); o1[j] = cvt_pk_bf16(x[8 + 2 * j], x[8 + 2 * j + 1]); }
        bf16_t* dp = J.dst + (size_t)(nt * 128 + nrow) * J.Kdst + kt * 64 + kq * 16;
        *(u32x4*)dp = o0; *(u32x4*)(dp + 8) = o1;
        __syncthreads();
        if (hn) cur = nxt;
    }
}
__device__ __forceinline__ void cvt_simple(const Frame& F, const float* src, bf16_t* dst, int Ksrc, int Nsrc, int& base) {
    CvtJob J{src, src, dst, Ksrc, Nsrc, Nsrc, Ksrc, Nsrc, 0, Nsrc, 0, 0}; cvt_job(F, J, base);
}
__device__ __forceinline__ void cvt_moe(const Frame& F, int layer, bf16_t* w13, bf16_t* w2t, int& base) {
    const size_t lo = (size_t)layer * NEXP * D * FF;
    CvtJob J1{F.A.in[I_MW1] + lo, F.A.in[I_MW3] + lo, w13, D, FF, FF, D, NEXP * 2 * FF, 0, 2 * FF, (size_t)D * FF, 1}; cvt_job(F, J1, base);
    CvtJob J2{F.A.in[I_MW2] + lo, F.A.in[I_MW2] + lo, w2t, FF, D, D, FF, NEXP * D, 0, D, (size_t)FF * D, 0}; cvt_job(F, J2, base);
}

__device__ __forceinline__ void ph_prologue(const Frame& F) {
    const int tid = F.tid;
    {
        LAS float* cv = (LAS float*)F.lds;
        LAS float* red = (LAS float*)(F.lds + 32768);
        for (int k = tid; k < D; k += NTHR) {
            const float c0 = F.A.in[I_C][k], c1 = F.A.in[I_C][D + k], c2 = F.A.in[I_CCTX][k];
            cv[k] = c0 * sigmoidf_(c0); cv[D + k] = c1 * sigmoidf_(c1); cv[2 * D + k] = c2 * sigmoidf_(c2);
        }
        __syncthreads();
        for (int item = F.bid; item < 2 * 96; item += F.G) {
            const int l = item / 96, n0 = (item % 96) * 128, c4 = tid & 31, kg = tid >> 5;
            float a[3][4];
#pragma unroll
            for (int r = 0; r < 3; ++r)
#pragma unroll
                for (int j = 0; j < 4; ++j) a[r][j] = 0.f;
            const float* wp = F.A.in[I_ADAW] + (size_t)l * D * MODW + n0 + c4 * 4;
#pragma unroll 4
            for (int k = kg; k < D; k += 16) {
                const f32x4 w = *(const f32x4*)(wp + (size_t)k * MODW);
                const float s0 = cv[k], s1 = cv[D + k], s2 = cv[2 * D + k];
#pragma unroll
                for (int j = 0; j < 4; ++j) { a[0][j] += s0 * w[j]; a[1][j] += s1 * w[j]; a[2][j] += s2 * w[j]; }
            }
#pragma unroll
            for (int r = 0; r < 3; ++r)
#pragma unroll
                for (int j = 0; j < 4; ++j) red[(kg * 3 + r) * 128 + c4 * 4 + j] = a[r][j];
            __syncthreads();
            if (tid < 384) { const int r = tid >> 7, n = tid & 127; float s = F.A.in[I_ADAB][(size_t)l * MODW + n0 + n];
                for (int g = 0; g < 16; ++g) s += red[(g * 3 + r) * 128 + n];
                WSP(float, WS_MOD)[((size_t)l * 3 + r) * MODW + n0 + n] = s; }
            __syncthreads();
        }
        __syncthreads();
    }
    int base = 0;
    cvt_simple(F, F.A.in[I_WIN], WSP(bf16_t, WT_IN), D, QKVC, base);
    cvt_simple(F, F.A.in[I_WOUT], WSP(bf16_t, WT_OUT), D, D, base);
    cvt_simple(F, F.A.in[I_WR], WSP(bf16_t, WT_R), D, D, base);
    cvt_simple(F, F.A.in[I_WK], WSP(bf16_t, WT_K), D, D, base);
    cvt_simple(F, F.A.in[I_WV], WSP(bf16_t, WT_V), D, D, base);
    cvt_simple(F, F.A.in[I_WO], WSP(bf16_t, WT_O), D, D, base);
    for (int d = 0; d < 2; ++d) {
        { CvtJob J{F.A.in[I_W1] + (size_t)d * D * 96, nullptr, WSP(bf16_t, WT_W1) + (size_t)d * 128 * D, D, 96, 96, D, 128, 0, 128, 0, 0}; cvt_job(F, J, base); }
        { CvtJob J{F.A.in[I_A1] + (size_t)d * D * 96, nullptr, WSP(bf16_t, WT_A1) + (size_t)d * 128 * D, D, 96, 96, D, 128, 0, 128, 0, 0}; cvt_job(F, J, base); }
        { CvtJob J{F.A.in[I_W2] + (size_t)d * 96 * D, nullptr, WSP(bf16_t, WT_W2) + (size_t)d * D * 256, 96, D, D, 256, D, 128 * d, D, 0, 0}; cvt_job(F, J, base); }
        { CvtJob J{F.A.in[I_A2] + (size_t)d * 96 * D, nullptr, WSP(bf16_t, WT_A2) + (size_t)d * D * 256, 96, D, D, 256, D, 128 * d, D, 0, 0}; cvt_job(F, J, base); }
    }
    cvt_simple(F, F.A.in[I_G1], WSP(bf16_t, WT_G1), D, 256, base);
    cvt_simple(F, F.A.in[I_G2], WSP(bf16_t, WT_G2), 256, D, base);
    cvt_moe(F, 0, WSP(bf16_t, SLOTP(6)), WSP(bf16_t, SLOTP(6)) + (size_t)NEXP * 2 * FF * D, base);
}

struct RowOpts {
    const float* src_l; const float* src_c;
    int nrows;
    bool combine; int comb_layer; const bf16_t* yslot; float* dst_l; float* dst_c;
    bool norm; int layer; int which;
    bf16_t* H;
    bool router;
};
__device__ __forceinline__ void ph_rows(const Frame& F, const RowOpts& O) {
    LAS int* pref = (LAS int*)(F.lds + 131072 + 1024);
    if (O.combine) {
        if (F.tid == 0) { const int* cnt = WSP(int, WS_CTL + CTL_CNT) + O.comb_layer * NEXP; int s = 0; for (int e = 0; e < NEXP; ++e) { pref[e] = s; s += (cnt[e] + 255) >> 8; } pref[NEXP] = s; }
        __syncthreads();
    }
    const int lane = F.lane;
    for (int r = F.bid * 8 + F.wave; r < O.nrows; r += F.G * 8) {
        const bool isc = r >= ML;
        const int mrow = isc ? 2 : r / SEQ;
        const float* sp = isc ? O.src_c + (size_t)(r - ML) * D : O.src_l + (size_t)r * D;
        f32x4 v[8];
#pragma unroll
        for (int i = 0; i < 8; ++i) v[i] = *(const f32x4*)(sp + i * 256 + lane * 4);
        if (O.combine) {
            const int s0 = WSP(int, WS_TOKSEL)[r * 2], s1 = WSP(int, WS_TOKSEL)[r * 2 + 1];
            const float g0 = WSP(float, WS_TOKGATE)[r * 2], g1 = WSP(float, WS_TOKGATE)[r * 2 + 1];
            const size_t y0 = ((size_t)pref[s0 >> 20] * 256 + (s0 & 0xfffff)) * D, y1 = ((size_t)pref[s1 >> 20] * 256 + (s1 & 0xfffff)) * D;
            const float* gt = mod_row(F, O.comb_layer, mrow) + 5 * D;
            float* dp = isc ? O.dst_c + (size_t)(r - ML) * D : O.dst_l + (size_t)r * D;
#pragma unroll
            for (int i = 0; i < 8; ++i) {
                const int col = i * 256 + lane * 4;
                const u32x2 a = *(const u32x2*)(O.yslot + y0 + col), b = *(const u32x2*)(O.yslot + y1 + col);
                const f32x4 g = *(const f32x4*)(gt + col);
                v[i][0] += g[0] * (g0 * bf_lo(a[0]) + g1 * bf_lo(b[0])); v[i][1] += g[1] * (g0 * bf_hi(a[0]) + g1 * bf_hi(b[0]));
                v[i][2] += g[2] * (g0 * bf_lo(a[1]) + g1 * bf_lo(b[1])); v[i][3] += g[3] * (g0 * bf_hi(a[1]) + g1 * bf_hi(b[1]));
                *(f32x4*)(dp + col) = v[i];
            }
        }
        if (!O.norm) continue;
        float ss = 0.f;
#pragma unroll
        for (int i = 0; i < 8; ++i) ss += v[i][0] * v[i][0] + v[i][1] * v[i][1] + v[i][2] * v[i][2] + v[i][3] * v[i][3];
        ss = wave_sum(ss);
        const float rstd = rsqrtf(ss * (1.f / D) + 1e-6f);
        const float* gn = (O.which ? F.A.in[I_NFFN] : F.A.in[I_NMIX]) + (size_t)O.layer * D;
        const float* mr = mod_row(F, O.layer, mrow);
        const float* shp = mr + (O.which ? 3 * D : 0); const float* scp = mr + (O.which ? 4 * D : D);
        bf16_t* hp = O.H + (size_t)r * D;
#pragma unroll
        for (int i = 0; i < 8; ++i) {
            const int col = i * 256 + lane * 4;
            const f32x4 g = *(const f32x4*)(gn + col), sc = *(const f32x4*)(scp + col), sh = *(const f32x4*)(shp + col);
#pragma unroll
            for (int j = 0; j < 4; ++j) v[i][j] = v[i][j] * rstd * g[j] * (1.f + sc[j]) + sh[j];
            u32x2 o; o[0] = cvt_pk_bf16(v[i][0], v[i][1]); o[1] = cvt_pk_bf16(v[i][2], v[i][3]);
            *(u32x2*)(hp + col) = o;
        }
        if (!O.router) continue;
        const float* wg = F.A.in[I_MGRP] + (size_t)O.layer * D * 4;
        const float* we = F.A.in[I_MEXP] + (size_t)O.layer * D * NEXP;
        LAS float* hs = (LAS float*)(F.lds + F.wave * 8192);
#pragma unroll
        for (int i = 0; i < 8; ++i) *(LAS f32x4*)(hs + i * 256 + lane * 4) = v[i];
        lds_fence();
        float gl[4] = {0.f, 0.f, 0.f, 0.f};
#pragma unroll 4
        for (int k = lane; k < D; k += 64) { const float h = hs[k]; const f32x4 w = *(const f32x4*)(wg + (size_t)k * 4);
            gl[0] += h * w[0]; gl[1] += h * w[1]; gl[2] += h * w[2]; gl[3] += h * w[3]; }
#pragma unroll
        for (int q = 0; q < 4; ++q) gl[q] = wave_sum(gl[q]);
        int gs = 0; float gm = gl[0];
#pragma unroll
        for (int q = 1; q < 4; ++q) if (gl[q] > gm) { gm = gl[q]; gs = q; }
        float den = 0.f;
#pragma unroll
        for (int q = 0; q < 4; ++q) den += __expf(gl[q] - gm);
        const float psel = 1.f / den;
        float el[8] = {0.f, 0.f, 0.f, 0.f, 0.f, 0.f, 0.f, 0.f};
#pragma unroll 4
        for (int k = lane; k < D; k += 64) { const float h = hs[k]; const float* wp = we + (size_t)k * NEXP + gs * 8; const f32x4 w0 = *(const f32x4*)wp, w1 = *(const f32x4*)(wp + 4);
            el[0] += h * w0[0]; el[1] += h * w0[1]; el[2] += h * w0[2]; el[3] += h * w0[3]; el[4] += h * w1[0]; el[5] += h * w1[1]; el[6] += h * w1[2]; el[7] += h * w1[3]; }
#pragma unroll
        for (int q = 0; q < 8; ++q) el[q] = wave_sum(el[q]);
        lds_fence();
        int i1 = 0; float v1 = el[0];
#pragma unroll
        for (int q = 1; q < 8; ++q) if (el[q] > v1) { v1 = el[q]; i1 = q; }
        int i2 = -1; float v2 = -3.0e38f;
#pragma unroll
        for (int q = 0; q < 8; ++q) if (q != i1 && el[q] > v2) { v2 = el[q]; i2 = q; }
        const float e2 = __expf(v2 - v1), w1g = psel / (1.f + e2), w2g = psel * e2 / (1.f + e2);
        if (lane == 0) {
            int* cnt = WSP(int, WS_CTL + CTL_CNT) + O.layer * NEXP;
            const int ea = gs * 8 + i1, eb = gs * 8 + i2;
            const int pa = atomicAdd(cnt + ea, 1), pb = atomicAdd(cnt + eb, 1);
            WSP(int, WS_TOKL)[(size_t)ea * MT + pa] = r; WSP(int, WS_TOKL)[(size_t)eb * MT + pb] = r;
            WSP(int, WS_TOKSEL)[r * 2] = (ea << 20) | pa; WSP(int, WS_TOKSEL)[r * 2 + 1] = (eb << 20) | pb;
            WSP(float, WS_TOKGATE)[r * 2] = w1g; WSP(float, WS_TOKGATE)[r * 2 + 1] = w2g;
        }
    }
}

__device__ __forceinline__ void ph_qknorm(const Frame& F, bf16_t* QKV) {
    const int lane = F.lane;
    const int il = lane & 15;
    const float f0 = exp2f(-(float)(2 * il) * (13.287712379549449f / 32.f)), f1 = exp2f(-(float)(2 * il + 1) * (13.287712379549449f / 32.f));
    for (int r = F.bid * 8 + F.wave; r < MT; r += F.G * 8) {
        const bool lat = r < ML; const int t = r % SEQ;
        const float pos = (lane < 32) ? (float)(t / 64) : (float)(t % 64);
        float c0 = 1.f, s0 = 0.f, c1 = 1.f, s1 = 0.f;
        if (lat) { const float r0_ = __builtin_amdgcn_fractf(pos * f0 * 0.15915494309189535f), r1_ = __builtin_amdgcn_fractf(pos * f1 * 0.15915494309189535f);
            s0 = __builtin_amdgcn_sinf(r0_); c0 = __builtin_amdgcn_cosf(r0_); s1 = __builtin_amdgcn_sinf(r1_); c1 = __builtin_amdgcn_cosf(r1_); }
        bf16_t* row = QKV + (size_t)r * QKVC;
        for (int hd = 0; hd < 26; ++hd) {
            int col; const float* gain; bool rope;
            if (hd < 8) { col = QA0 + hd * 128; gain = F.A.in[I_AQG]; rope = lat; }
            else if (hd < 10) { col = KA0 + (hd - 8) * 128; gain = F.A.in[I_AKG]; rope = lat; }
            else if (hd < 18) { col = QB0 + (hd - 10) * 128; gain = F.A.in[I_BQG]; rope = false; }
            else { col = KB0 + (hd - 18) * 128; gain = F.A.in[I_BKG]; rope = false; }
            unsigned* p = (unsigned*)(row + col + 2 * lane);
            const unsigned u = *p;
            float x0 = bf_lo(u), x1 = bf_hi(u);
            const float ss = wave_sum(x0 * x0 + x1 * x1);
            const float rstd = rsqrtf(ss * (1.f / 128.f) + 1e-6f);
            x0 = x0 * rstd * gain[2 * lane]; x1 = x1 * rstd * gain[2 * lane + 1];
            if (rope) {
                const float p0 = __shfl_xor(x0, 16), p1 = __shfl_xor(x1, 16);
                if ((lane & 16) == 0) { x0 = x0 * c0 - p0 * s0; x1 = x1 * c1 - p1 * s1; }
                else { x0 = p0 * s0 + x0 * c0; x1 = p1 * s1 + x1 * c1; }
            }
            *p = cvt_pk_bf16(x0, x1);
        }
    }
}

__device__ __forceinline__ void ph_attn_simple(const Frame& F, const bf16_t* QKV, bf16_t* YC) {
    const int lane = F.lane;
    LAS float* qs = (LAS float*)(F.lds + F.wave * 4096);
    LAS float* ps = qs + 128;
    const float scale = 0.08838834764831845f;
    for (int it = F.bid * 8 + F.wave; it < MT * 16; it += F.G * 8) {
        const int r = it >> 4, hh = it & 15; const bool tA = hh < 8; const int h = hh & 7;
        const int qcol = tA ? QA0 + h * 128 : QB0 + h * 128, kcol = tA ? KA0 + (h >> 2) * 128 : KB0 + h * 128, vcol = tA ? VA0 + (h >> 2) * 128 : VB0 + h * 128;
        { const unsigned u = *(const unsigned*)(QKV + (size_t)r * QKVC + qcol + 2 * lane); qs[2 * lane] = bf_lo(u); qs[2 * lane + 1] = bf_hi(u); }
        lds_fence();
        const bool lat = r < ML;
        const int b = lat ? r / SEQ : (r - ML) / CTXL, t = r % SEQ;
        int nloc, lo = 0, r0 = 0, c0 = 0, rr = 0, cq = 0;
        if (!lat) nloc = 0;
        else if (tA) { lo = max(0, t - 128); const int hi = min(SEQ - 1, t + 128); nloc = hi - lo + 1; }
        else { rr = t >> 6; cq = t & 63; r0 = min(max(rr - 4, 0), 248); c0 = min(max(cq - 8, 0), 48); nloc = 128; }
        const int nkeys = nloc + CTXL;
        const float* rpb = F.A.in[I_RPB] + (size_t)h * 15 * 31;
        float mloc = -3.0e38f;
        for (int j = lane; j < nkeys; j += 64) {
            int krow; float bias = 0.f;
            if (j >= nloc) krow = ML + b * CTXL + (j - nloc);
            else if (tA) krow = b * SEQ + lo + j;
            else { const int jr = j >> 4, jc = j & 15; krow = b * SEQ + (r0 + jr) * 64 + c0 + jc; bias = rpb[(r0 + jr - rr + 7) * 31 + (c0 + jc - cq + 15)]; }
            const bf16_t* kp = QKV + (size_t)krow * QKVC + kcol;
            float dot = 0.f;
#pragma unroll 4
            for (int d8 = 0; d8 < 16; ++d8) { const u32x4 kv = *(const u32x4*)(kp + d8 * 8);
#pragma unroll
                for (int q = 0; q < 4; ++q) dot += qs[d8 * 8 + 2 * q] * bf_lo(kv[q]) + qs[d8 * 8 + 2 * q + 1] * bf_hi(kv[q]); }
            const float s = dot * scale + bias;
            ps[j] = s; mloc = fmaxf(mloc, s);
        }
        float m = wave_max(mloc);
        const float sink = tA ? F.A.in[I_ASINK][h] : -3.0e38f;
        if (tA) m = fmaxf(m, sink);
        float sloc = 0.f;
        for (int j = lane; j < nkeys; j += 64) { const float p = __expf(ps[j] - m); ps[j] = p; sloc += p; }
        float l = wave_sum(sloc);
        if (tA) l += __expf(sink - m);
        lds_fence();
        float o0 = 0.f, o1 = 0.f;
        for (int j = 0; j < nkeys; ++j) {
            int krow;
            if (j >= nloc) krow = ML + b * CTXL + (j - nloc);
            else if (tA) krow = b * SEQ + lo + j;
            else krow = b * SEQ + (r0 + (j >> 4)) * 64 + c0 + (j & 15);
            const unsigned u = *(const unsigned*)(QKV + (size_t)krow * QKVC + vcol + 2 * lane);
            const float p = ps[j];
            o0 += p * bf_lo(u); o1 += p * bf_hi(u);
        }
        const float inv = 1.f / l;
        *(unsigned*)(YC + (size_t)r * D + hh * 128 + 2 * lane) = cvt_pk_bf16(o0 * inv, o1 * inv);
        lds_fence();
    }
}

__device__ __forceinline__ void ph_mix(const Frame& F, const bf16_t* H, bf16_t* XM, int m) {
    const int lane = F.lane;
    const float* mu = F.A.in[I_MU] + (size_t)m * D;
    for (int r = F.bid * 8 + F.wave; r < MT; r += F.G * 8) {
        const int sl = (r < ML) ? SEQ : CTXL, t = (r < ML) ? (r % SEQ) : ((r - ML) % CTXL);
        const bool hp = t > 0, hn = t < sl - 1;
#pragma unroll
        for (int i = 0; i < 4; ++i) {
            const int col = i * 512 + lane * 8;
            const u32x4 c = *(const u32x4*)(H + (size_t)r * D + col);
            u32x4 p = (u32x4){0u, 0u, 0u, 0u}, n = (u32x4){0u, 0u, 0u, 0u};
            if (hp) p = *(const u32x4*)(H + (size_t)(r - 1) * D + col);
            if (hn) n = *(const u32x4*)(H + (size_t)(r + 1) * D + col);
            const f32x4 m0 = *(const f32x4*)(mu + col), m1 = *(const f32x4*)(mu + col + 4);
            u32x4 o;
#pragma unroll
            for (int q = 0; q < 4; ++q) {
                const float cl = bf_lo(c[q]), ch = bf_hi(c[q]);
                const float xl = 0.5f * (bf_lo(p[q]) + bf_lo(n[q])) - cl, xh = 0.5f * (bf_hi(p[q]) + bf_hi(n[q])) - ch;
                const float ml = (q < 2) ? m0[2 * q] : m1[2 * q - 4], mh = (q < 2) ? m0[2 * q + 1] : m1[2 * q - 3];
                o[q] = cvt_pk_bf16(cl + xl * ml, ch + xh * mh);
            }
            *(u32x4*)(XM + (size_t)r * D + col) = o;
        }
    }
}

constexpr int SC_T = 32, SC_NCH = (CTXL + SEQ) / SC_T;
constexpr int SC_BUF = 5 * SC_T * 64 * 4 + SC_T * 32 * 4;
struct ScanRaw { u32x4 r, k, e, a; u32x2 v; };
__device__ __forceinline__ int scan_row(int dir, int b, int s) {
    if (s < CTXL) return ML + b * CTXL + (dir ? CTXL - 1 - s : s);
    const int t = s - CTXL; return b * SEQ + (dir ? SEQ - 1 - t : t);
}
__device__ __forceinline__ void ph_scan(const Frame& F, const bf16_t* Rb, const bf16_t* Kb, const bf16_t* Vb, const bf16_t* DEC0, const bf16_t* DEC1, const bf16_t* AS0, const bf16_t* AS1,
                                        bf16_t* Y0, bf16_t* Y1, float* CB) {
    const int tid = F.tid, lane = F.lane, wave = F.wave;
    LAS float* ybuf = (LAS float*)(F.lds + 2 * SC_BUF);
    for (int item = F.bid; item < 256; item += F.G) {
        const int dir = item >> 7, b = (item >> 6) & 1, head = (item >> 1) & 31, half = item & 1;
        const bf16_t* DEC = dir ? DEC1 : DEC0; const bf16_t* AS = dir ? AS1 : AS0; bf16_t* Y = dir ? Y1 : Y0;
        const int hc = head * 64;
        if (wave >= 4) {
            const int lt = tid - 256, st = lt >> 3, sg = lt & 7;
            f32x4 kk0 = *(const f32x4*)(F.A.in[I_KK] + hc + sg * 8), kk1 = *(const f32x4*)(F.A.in[I_KK] + hc + sg * 8 + 4);
            f32x4 ka0 = *(const f32x4*)(F.A.in[I_KA] + hc + sg * 8), ka1 = *(const f32x4*)(F.A.in[I_KA] + hc + sg * 8 + 4);
            f32x4 rk0 = *(const f32x4*)(F.A.in[I_RK] + hc + sg * 8), rk1 = *(const f32x4*)(F.A.in[I_RK] + hc + sg * 8 + 4);
            ScanRaw cur, nxt;
            auto ld = [&](int ch, ScanRaw& R) {
                const int row = scan_row(dir, b, ch * SC_T + st); const size_t o = (size_t)row * D + hc + sg * 8;
                R.r = *(const u32x4*)(Rb + o); R.k = *(const u32x4*)(Kb + o); R.e = *(const u32x4*)(DEC + o); R.a = *(const u32x4*)(AS + o);
                R.v = *(const u32x2*)(Vb + (size_t)row * D + hc + half * 32 + sg * 4);
            };
            auto put = [&](int ch, const ScanRaw& R) {
                LAS float* bw = (LAS float*)(F.lds + (ch & 1) * SC_BUF);
                float r_[8], k_[8], e_[8], a_[8], kkv[8], kav[8], rkv[8];
#pragma unroll
                for (int q = 0; q < 4; ++q) { r_[2 * q] = bf_lo(R.r[q]); r_[2 * q + 1] = bf_hi(R.r[q]); k_[2 * q] = bf_lo(R.k[q]); k_[2 * q + 1] = bf_hi(R.k[q]);
                    e_[2 * q] = bf_lo(R.e[q]); e_[2 * q + 1] = bf_hi(R.e[q]); a_[2 * q] = bf_lo(R.a[q]); a_[2 * q + 1] = bf_hi(R.a[q]);
                    kkv[q] = kk0[q]; kkv[4 + q] = kk1[q]; kav[q] = ka0[q]; kav[4 + q] = ka1[q]; rkv[q] = rk0[q]; rkv[4 + q] = rk1[q]; }
                float ss = 0.f, cb = 0.f, kkr[8], kd[8];
#pragma unroll
                for (int q = 0; q < 8; ++q) { kkr[q] = k_[q] * kkv[q]; ss += kkr[q] * kkr[q]; kd[q] = k_[q] * (1.f + (a_[q] - 1.f) * kav[q]); cb += r_[q] * kd[q] * rkv[q]; }
                ss += __shfl_xor(ss, 1); ss += __shfl_xor(ss, 2); ss += __shfl_xor(ss, 4);
                cb += __shfl_xor(cb, 1); cb += __shfl_xor(cb, 2); cb += __shfl_xor(cb, 4);
                const float rn = rsqrtf(ss + 1e-12f);
                LAS float* p = bw + st * 64 + sg * 8;
#pragma unroll
                for (int q = 0; q < 8; ++q) { const float kkn = kkr[q] * rn;
                    p[0 * SC_T * 64 + q] = __expf(-e_[q]);
                    p[1 * SC_T * 64 + q] = -kkn;
                    p[2 * SC_T * 64 + q] = kkn * a_[q];
                    p[3 * SC_T * 64 + q] = kd[q];
                    p[4 * SC_T * 64 + q] = r_[q]; }
                LAS float* pv = bw + 5 * SC_T * 64 + st * 32 + sg * 4;
                pv[0] = bf_lo(R.v[0]); pv[1] = bf_hi(R.v[0]); pv[2] = bf_lo(R.v[1]); pv[3] = bf_hi(R.v[1]);
                const int s = ch * SC_T + st;
                if (half == 0 && sg == 0 && s >= CTXL) CB[((size_t)dir * ML + scan_row(dir, b, s)) * 32 + head] = cb;
            };
            auto flush = [&](int ch) {
                if (ch * SC_T < CTXL) return;
                const LAS float* yb = ybuf + (ch & 1) * (SC_T * 32) + st * 32 + sg * 4;
                const int row = scan_row(dir, b, ch * SC_T + st);
                u32x2 o; o[0] = cvt_pk_bf16(yb[0], yb[1]); o[1] = cvt_pk_bf16(yb[2], yb[3]);
                *(u32x2*)(Y + (size_t)row * D + hc + half * 32 + sg * 4) = o;
            };
            ld(0, cur); put(0, cur); ld(1, cur);
            __syncthreads();
            for (int ch = 0; ch < SC_NCH; ++ch) {
                if (ch + 2 < SC_NCH) ld(ch + 2, nxt);
                if (ch + 1 < SC_NCH) put(ch + 1, cur);
                if (ch >= 1) flush(ch - 1);
                cur = nxt;
                __syncthreads();
            }
            flush(SC_NCH - 1);
        } else {
            const int rw = wave * 8 + (lane >> 3), sg = lane & 7;
            float S[8];
#pragma unroll
            for (int q = 0; q < 8; ++q) S[q] = 0.f;
            __syncthreads();
            for (int ch = 0; ch < SC_NCH; ++ch) {
                const LAS float* bw = (const LAS float*)(F.lds + (ch & 1) * SC_BUF);
                LAS float* yb = ybuf + (ch & 1) * (SC_T * 32);
#pragma unroll 2
                for (int st = 0; st < SC_T; ++st) {
                    const LAS float* p = bw + st * 64 + sg * 8;
                    const f32x4 w0 = *(const LAS f32x4*)(p), w1 = *(const LAS f32x4*)(p + 4);
                    const f32x4 a0 = *(const LAS f32x4*)(p + SC_T * 64), a1 = *(const LAS f32x4*)(p + SC_T * 64 + 4);
                    const f32x4 b0 = *(const LAS f32x4*)(p + 2 * SC_T * 64), b1 = *(const LAS f32x4*)(p + 2 * SC_T * 64 + 4);
                    const f32x4 k0 = *(const LAS f32x4*)(p + 3 * SC_T * 64), k1 = *(const LAS f32x4*)(p + 3 * SC_T * 64 + 4);
                    const f32x4 r0 = *(const LAS f32x4*)(p + 4 * SC_T * 64), r1 = *(const LAS f32x4*)(p + 4 * SC_T * 64 + 4);
                    const float vv = bw[5 * SC_T * 64 + st * 32 + rw];
                    float sa = S[0] * a0[0] + S[1] * a0[1] + S[2] * a0[2] + S[3] * a0[3] + S[4] * a1[0] + S[5] * a1[1] + S[6] * a1[2] + S[7] * a1[3];
                    sa += __shfl_xor(sa, 1); sa += __shfl_xor(sa, 2); sa += __shfl_xor(sa, 4);
#pragma unroll
                    for (int q = 0; q < 4; ++q) { S[q] = S[q] * w0[q] + sa * b0[q] + vv * k0[q]; S[4 + q] = S[4 + q] * w1[q] + sa * b1[q] + vv * k1[q]; }
                    float y = S[0] * r0[0] + S[1] * r0[1] + S[2] * r0[2] + S[3] * r0[3] + S[4] * r1[0] + S[5] * r1[1] + S[6] * r1[2] + S[7] * r1[3];
                    y += __shfl_xor(y, 1); y += __shfl_xor(y, 2); y += __shfl_xor(y, 4);
                    if (sg == 0) yb[st * 32 + rw] = y;
                }
                __syncthreads();
            }
        }
        __syncthreads();
    }
}

__device__ __forceinline__ void ph_rwkv_out(const Frame& F, const bf16_t* Y0, const bf16_t* Y1, const bf16_t* Vb, const bf16_t* Gb, const float* CB, bf16_t* Z) {
    const int lane = F.lane;
    for (int r = F.bid * 8 + F.wave; r < ML; r += F.G * 8) {
        const size_t ro = (size_t)r * D + lane * 32;
        float y[32];
#pragma unroll
        for (int q = 0; q < 4; ++q) { const u32x4 a = *(const u32x4*)(Y0 + ro + q * 8), bq = *(const u32x4*)(Y1 + ro + q * 8);
#pragma unroll
            for (int j = 0; j < 4; ++j) { y[q * 8 + 2 * j] = bf_lo(a[j]) + bf_lo(bq[j]); y[q * 8 + 2 * j + 1] = bf_hi(a[j]) + bf_hi(bq[j]); } }
        float s = 0.f;
#pragma unroll
        for (int j = 0; j < 32; ++j) s += y[j];
        s += __shfl_xor(s, 1);
        const float mu = s * (1.f / 64.f);
        float vs = 0.f;
#pragma unroll
        for (int j = 0; j < 32; ++j) { const float d = y[j] - mu; vs += d * d; }
        vs += __shfl_xor(vs, 1);
        const float rstd = rsqrtf(vs * (1.f / 64.f) + 64e-5f);
        const int head = lane >> 1;
        const float cb = CB[(size_t)r * 32 + head] + CB[((size_t)ML + r) * 32 + head];
        const float* lw = F.A.in[I_LNW] + lane * 32; const float* lb = F.A.in[I_LNB] + lane * 32;
#pragma unroll
        for (int q = 0; q < 4; ++q) { const u32x4 vv = *(const u32x4*)(Vb + ro + q * 8), gg = *(const u32x4*)(Gb + ro + q * 8);
            u32x4 o;
#pragma unroll
            for (int j = 0; j < 4; ++j) { const int c = q * 8 + 2 * j;
                const float z0 = ((y[c] - mu) * rstd * lw[c] + lb[c] + cb * bf_lo(vv[j])) * bf_lo(gg[j]);
                const float z1 = ((y[c + 1] - mu) * rstd * lw[c + 1] + lb[c + 1] + cb * bf_hi(vv[j])) * bf_hi(gg[j]);
                o[j] = cvt_pk_bf16(z0, z1); }
            *(u32x4*)(Z + ro + q * 8) = o; }
    }
}

__device__ __forceinline__ void moe_prefix(const Frame& F, int layer, LAS int*& pref, LAS int*& cntl) {
    pref = (LAS int*)(F.lds + 131072 + 1024); cntl = pref + 40;
    __syncthreads();
    if (F.tid == 0) { const int* cnt = WSP(int, WS_CTL + CTL_CNT) + layer * NEXP; int s = 0; for (int e = 0; e < NEXP; ++e) { const int c = cnt[e]; cntl[e] = c; pref[e] = s; s += (c + 255) >> 8; } pref[NEXP] = s; }
    __syncthreads();
}
__device__ __forceinline__ void ph_moe_up(const Frame& F, int layer, const bf16_t* H, const bf16_t* W13, bf16_t* HID) {
    LAS int* pref; LAS int* cntl; moe_prefix(F, layer, pref, cntl);
    MoeSched S{pref, cntl, WSP(int, WS_TOKL), 4, F.G, F.bid, D, 2 * FF, true};
    pg8::EpiMoeUp E{HID};
    pg8::gemm_phase(F.lds, H, W13, D, S, E);
}
__device__ __forceinline__ void ph_moe_down(const Frame& F, int layer, const bf16_t* HID, const bf16_t* W2T, bf16_t* YS) {
    LAS int* pref; LAS int* cntl; moe_prefix(F, layer, pref, cntl);
    MoeSched S{pref, cntl, WSP(int, WS_TOKL), 8, F.G, F.bid, FF, D, false};
    pg8::EpiStoreBf16<0> E{YS, D, nullptr, 0, 0};
    pg8::gemm_phase(F.lds, HID, W2T, FF, S, E);
}
template <int ACT>
__device__ __forceinline__ void ph_gemm_bf16(const Frame& F, const bf16_t* A, const bf16_t* Bt, int M, int N, int K, bf16_t* O, int ldc, const float* vec, int split_cols, size_t split_stride) {
    pg8::DenseSched S; S.init(M, N, K, F.G, F.bid);
    pg8::EpiStoreBf16<ACT> E{O, ldc, vec, split_cols, split_stride};
    pg8::gemm_phase(F.lds, A, Bt, K, S, E);
}
__device__ __forceinline__ void ph_gemm_res(const Frame& F, const bf16_t* A, const bf16_t* Bt, int M, const float* xin_l, float* out_l, const float* xin_c, float* out_c, const float* gate) {
    pg8::DenseSched S; S.init(M, D, D, F.G, F.bid);
    pg8::EpiRes E{xin_l, out_l, xin_c, out_c, gate};
    pg8::gemm_phase(F.lds, A, Bt, D, S, E);
}

constexpr int LDS_BYTES = 131072 + 16384;
constexpr int N_PHASES = 33;
__global__ void __launch_bounds__(NTHR, 2) fwd(Args args) {
    extern __shared__ __attribute__((aligned(16))) unsigned char lds_raw[];
    Frame F(args);
    F.out = args.out; F.ws = args.ws; F.lds = (LAS unsigned char*)lds_raw;
    F.tid = threadIdx.x; F.lane = F.tid & 63; F.wave = __builtin_amdgcn_readfirstlane(F.tid >> 6); F.G = gridDim.x; F.bid = blockIdx.x;
    volatile LAS unsigned* misc = (volatile LAS unsigned*)(F.lds + 131072);
    if (F.tid < 4) misc[F.tid] = 0u;
    __syncthreads();
    XcdBarrier bar; bar.bar = (unsigned*)(F.ws + WS_CTL); bar.x = 0; bar.st = misc;
    const int lo = args.ph_lo, hi = args.ph_hi;
    if (hi - lo > 1) bar = xcd_barrier_post((unsigned*)(F.ws + WS_CTL), misc);
#ifndef PH_ONLY
#define PH_ONLY -1
#endif
#define IN(k) ((PH_ONLY < 0 || PH_ONLY == (k)) && lo <= (k) && (k) < hi)
#define SEAM(k) do { if (IN(k) && IN((k) + 1)) xcd_barrier(bar); } while (0)
    bf16_t* const S0 = WSP(bf16_t, SLOTP(0)); bf16_t* const S1 = WSP(bf16_t, SLOTP(1)); bf16_t* const S2 = WSP(bf16_t, SLOTP(2)); bf16_t* const S3 = WSP(bf16_t, SLOTP(3));
    bf16_t* const S4 = WSP(bf16_t, SLOTP(4)); bf16_t* const S5 = WSP(bf16_t, SLOTP(5)); bf16_t* const S6 = WSP(bf16_t, SLOTP(6)); bf16_t* const S7 = WSP(bf16_t, SLOTP(7));
    bf16_t* const S8 = WSP(bf16_t, SLOTP(8));
    float* const XC = WSP(float, WS_XC);
    float* const CB = WSP(float, WS_CB);
    const size_t W2OFF = (size_t)NEXP * 2 * FF * D;

    if (IN(0)) ph_prologue(F);
    SEAM(0);
    if (IN(1)) { RowOpts O{F.A.in[I_X], F.A.in[I_CTX], MT, false, 0, nullptr, nullptr, nullptr, true, 0, 0, S0, false}; ph_rows(F, O); }
    SEAM(1);
    if (IN(2)) ph_gemm_bf16<0>(F, S0, WSP(bf16_t, WT_IN), MT, QKVC, D, S1, QKVC, nullptr, 0, 0);
    SEAM(2);
    if (IN(3)) ph_qknorm(F, S1);
    SEAM(3);
    if (IN(4)) ph_attn_simple(F, S1, S4);
    SEAM(4);
    if (IN(5)) ph_gemm_res(F, S4, WSP(bf16_t, WT_OUT), MT, F.A.in[I_X], F.out, F.A.in[I_CTX], XC, mod_row(F, 0, 0) + 2 * D);
    SEAM(5);
    if (IN(6)) { RowOpts O{F.out, XC, MT, false, 0, nullptr, nullptr, nullptr, true, 0, 1, S0, true}; ph_rows(F, O); }
    SEAM(6);
    if (IN(7)) ph_moe_up(F, 0, S0, S6, S5);
    SEAM(7);
    if (IN(8)) ph_moe_down(F, 0, S5, S6 + W2OFF, S1);
    SEAM(8);
    if (IN(9)) { RowOpts O{F.out, XC, MT, true, 0, S1, F.out, XC, true, 1, 0, S0, false}; ph_rows(F, O); }
    SEAM(9);
    if (IN(10)) ph_mix(F, S0, S1, 1);
    SEAM(10);
    if (IN(11)) ph_gemm_bf16<1>(F, S1, WSP(bf16_t, WT_W1), MT, 256, D, WSP(bf16_t, WS_TW), 256, nullptr, 0, 0);
    SEAM(11);
    if (IN(12)) ph_mix(F, S0, S1, 4);
    SEAM(12);
    if (IN(13)) ph_gemm_bf16<0>(F, S1, WSP(bf16_t, WT_A1), MT, 256, D, WSP(bf16_t, WS_TA), 256, nullptr, 0, 0);
    SEAM(13);
    if (IN(14)) ph_mix(F, S0, S1, 5);
    SEAM(14);
    if (IN(15)) ph_gemm_bf16<2>(F, S1, WSP(bf16_t, WT_G1), MT, 256, D, WSP(bf16_t, WS_TG), 256, nullptr, 0, 0);
    SEAM(15);
    if (IN(16)) ph_mix(F, S0, S1, 0);
    SEAM(16);
    if (IN(17)) ph_gemm_bf16<0>(F, S1, WSP(bf16_t, WT_R), MT, D, D, S3, D, nullptr, 0, 0);
    SEAM(17);
    if (IN(18)) ph_mix(F, S0, S1, 2);
    SEAM(18);
    if (IN(19)) ph_gemm_bf16<0>(F, S1, WSP(bf16_t, WT_K), MT, D, D, S4, D, nullptr, 0, 0);
    SEAM(19);
    if (IN(20)) ph_mix(F, S0, S1, 3);
    SEAM(20);
    if (IN(21)) ph_gemm_bf16<0>(F, S1, WSP(bf16_t, WT_V), MT, D, D, S5, D, nullptr, 0, 0);
    SEAM(21);
    if (IN(22)) ph_gemm_bf16<3>(F, WSP(bf16_t, WS_TW), WSP(bf16_t, WT_W2), MT, 2 * D, 256, S0, D, F.A.in[I_W0], D, (size_t)(SLOTP(1) - SLOTP(0)) / 2);
    SEAM(22);
    if (IN(23)) ph_gemm_bf16<4>(F, WSP(bf16_t, WS_TA), WSP(bf16_t, WT_A2), MT, 2 * D, 256, S2, D, F.A.in[I_A0], D, (size_t)(SLOTP(6) - SLOTP(2)) / 2);
    SEAM(23);
    if (IN(24)) ph_scan(F, S3, S4, S5, S0, S1, S2, S6, S7, S8, CB);
    SEAM(24);
    if (IN(25)) ph_gemm_bf16<0>(F, WSP(bf16_t, WS_TG), WSP(bf16_t, WT_G2), ML, D, 256, S3, D, nullptr, 0, 0);
    SEAM(25);
    if (IN(26)) ph_rwkv_out(F, S7, S8, S5, S3, CB, S4);
    SEAM(26);
    if (IN(27)) ph_gemm_res(F, S4, WSP(bf16_t, WT_O), ML, F.out, F.out, XC, XC, mod_row(F, 1, 0) + 2 * D);
    SEAM(27);
    if (IN(28)) { int base = 0; cvt_moe(F, 1, S1, S1 + W2OFF, base); }
    SEAM(28);
    if (IN(29)) { RowOpts O{F.out, XC, ML, false, 0, nullptr, nullptr, nullptr, true, 1, 1, S0, true}; ph_rows(F, O); }
    SEAM(29);
    if (IN(30)) ph_moe_up(F, 1, S0, S1, S5);
    SEAM(30);
    if (IN(31)) ph_moe_down(F, 1, S5, S1 + W2OFF, S6);
    SEAM(31);
    if (IN(32)) { RowOpts O{F.out, XC, ML, true, 1, S6, F.out, XC, false, 1, 0, nullptr, false}; ph_rows(F, O); }
#undef IN
#undef SEAM
}

extern "C" void kernel_launch(void* const* d_in, const int* in_sizes, int n_in, void* d_out, int out_size, void* d_ws, size_t ws_size, hipStream_t stream) {
    static int grid = 0;
    if (grid == 0) {
        if (n_in != 39 || out_size != ML * D || ws_size < WS_END) { fprintf(stderr, "kernel_launch: unexpected shapes (n_in %d out %d ws %zu need %zu)\n", n_in, out_size, ws_size, (size_t)WS_END); grid = -1; return; }
        int dev = 0, cus = 0;
        if (hipGetDevice(&dev) != hipSuccess || hipDeviceGetAttribute(&cus, hipDeviceAttributeMultiprocessorCount, dev) != hipSuccess) { grid = -1; return; }
        if (hipFuncSetAttribute((const void*)fwd, hipFuncAttributeMaxDynamicSharedMemorySize, LDS_BYTES) != hipSuccess) { fprintf(stderr, "kernel_launch: hipFuncSetAttribute failed\n"); grid = -1; return; }
        int per_cu = 0;
        if (hipOccupancyMaxActiveBlocksPerMultiprocessor(&per_cu, (const void*)fwd, NTHR, LDS_BYTES) != hipSuccess || per_cu < 1) { fprintf(stderr, "kernel_launch: occupancy query says %d\n", per_cu); }
        (void)hipGetLastError();
        grid = cus;
    }
    if (grid < 0) return;
    (void)hipMemsetAsync((char*)d_ws + WS_CTL, 0, CTL_BYTES, stream);
    Args a{};
    for (int i = 0; i < 39; ++i) a.in[i] = (const float*)d_in[i];
    a.out = (float*)d_out; a.ws = (unsigned char*)d_ws;
#if ONE_LAUNCH
    a.ph_lo = 0; a.ph_hi = N_PHASES;
    hipLaunchKernelGGL(fwd, dim3(grid), dim3(NTHR), LDS_BYTES, stream, a);
#else
    for (int p = 0; p < 33; ++p) { a.ph_lo = p; a.ph_hi = p + 1; hipLaunchKernelGGL(fwd, dim3(grid), dim3(NTHR), LDS_BYTES, stream, a); }
#endif
}
```

```cpp
#include <hip/hip_runtime.h>
#include <stdint.h>
#include <stdio.h>

#ifndef ONE_LAUNCH
#define ONE_LAUNCH 1
#endif

#define LAS __attribute__((address_space(3)))
typedef unsigned short bf16_t;
typedef short bf16x8 __attribute__((ext_vector_type(8)));
typedef float f32x4 __attribute__((ext_vector_type(4)));
typedef float f32x2 __attribute__((ext_vector_type(2)));
typedef unsigned u32x4 __attribute__((ext_vector_type(4)));
typedef unsigned u32x2 __attribute__((ext_vector_type(2)));

constexpr int D = 2048, NB = 2, SEQ = 16384, ML = NB * SEQ, CTXL = 256, MC = NB * CTXL, MT = ML + MC;
constexpr int QKVC = 4608, QA0 = 0, KA0 = 1024, VA0 = 1280, QB0 = 1536, KB0 = 2560, VB0 = 3584;
constexpr int NEXP = 32, FF = 512, MAXSLOT = 2 * MT + NEXP * 256;
constexpr int MODW = 6 * D;
constexpr int NTHR = 512;

constexpr size_t MiB = 1ull << 20;
constexpr size_t WS_CTL = 0;
constexpr size_t CTL_BYTES = 64 * 1024;
constexpr size_t CTL_CNT = 16384;
constexpr size_t WS_MOD = 1 * MiB;
constexpr size_t WS_XC = 2 * MiB;
constexpr size_t WS_TOKL = 6 * MiB;
constexpr size_t WS_TOKSEL = 11 * MiB;
constexpr size_t WS_TOKGATE = 11 * MiB + 512 * 1024;
constexpr size_t WS_CB = 12 * MiB;
constexpr size_t WS_WT = 20 * MiB;
constexpr size_t WT_IN = WS_WT, WT_OUT = WS_WT + 18 * MiB, WT_R = WS_WT + 26 * MiB, WT_K = WS_WT + 34 * MiB, WT_V = WS_WT + 42 * MiB, WT_O = WS_WT + 50 * MiB;
constexpr size_t WT_W1 = WS_WT + 58 * MiB, WT_A1 = WS_WT + 59 * MiB, WT_G1 = WS_WT + 60 * MiB, WT_W2 = WS_WT + 61 * MiB, WT_A2 = WS_WT + 63 * MiB, WT_G2 = WS_WT + 65 * MiB;
constexpr size_t WS_TW = 86 * MiB, WS_TA = 103 * MiB, WS_TG = 120 * MiB;
constexpr size_t WS_SLOT0 = 140 * MiB, SLOT = 130 * MiB;
constexpr size_t WS_END = WS_SLOT0 + 9 * SLOT;
#define SLOTP(k) (WS_SLOT0 + (size_t)(k) * SLOT)

__device__ __forceinline__ unsigned cvt_pk_bf16(float lo, float hi) { unsigned r; asm volatile("v_cvt_pk_bf16_f32 %0, %1, %2" : "=v"(r) : "v"(lo), "v"(hi)); return r; }
__device__ __forceinline__ float bf_lo(unsigned u) { return __uint_as_float(u << 16); }
__device__ __forceinline__ float bf_hi(unsigned u) { return __uint_as_float(u & 0xffff0000u); }
__device__ __forceinline__ float bf2f(bf16_t v) { return __uint_as_float(((unsigned)v) << 16); }
__device__ __forceinline__ float wave_sum(float v) { for (int o = 32; o; o >>= 1) v += __shfl_xor(v, o); return v; }
__device__ __forceinline__ float wave_max(float v) { for (int o = 32; o; o >>= 1) v = fmaxf(v, __shfl_xor(v, o)); return v; }
__device__ __forceinline__ float sigmoidf_(float x) { return 1.f / (1.f + __expf(-x)); }
__device__ __forceinline__ void lds_fence() { asm volatile("s_waitcnt lgkmcnt(0)" ::: "memory"); }

struct Args { const float* in[39]; float* out; unsigned char* ws; int ph_lo, ph_hi; };
struct Frame {
    const Args& A; float* out; unsigned char* ws; LAS unsigned char* lds;
    int tid, lane, wave, G, bid;
    __device__ __forceinline__ Frame(const Args& a) : A(a) {}
};
enum { I_X = 0, I_C, I_CTX, I_CCTX, I_ADAW, I_ADAB, I_NMIX, I_NFFN, I_WIN, I_WOUT, I_AQG, I_AKG, I_ASINK, I_BQG, I_BKG, I_RPB, I_MU, I_WR, I_WK, I_WV, I_WO, I_W0, I_W1, I_W2,
       I_A0, I_A1, I_A2, I_G1, I_G2, I_KK, I_KA, I_RK, I_LNW, I_LNB, I_MGRP, I_MEXP, I_MW1, I_MW3, I_MW2 };

#define XB_TMO      128
#define XB_XCNT(j)  (256  + 64 * (j))
#define XB_XSUB(j)  (1280 + 64 * (j))
#define XB_XGEN(j)  (2304 + 64 * (j))
#define XB_TOP      3328
#define XB_TOPGEN   3392
#define XCD_BAR_WORDS 3456
#define XB_SPIN_CAP (1u << 18)
__device__ __forceinline__ unsigned xb_ld(unsigned* p)              { return __hip_atomic_load(p, __ATOMIC_RELAXED, __HIP_MEMORY_SCOPE_AGENT); }
__device__ __forceinline__ unsigned xb_add(unsigned* p, unsigned v) { return __hip_atomic_fetch_add(p, v, __ATOMIC_RELAXED, __HIP_MEMORY_SCOPE_AGENT); }
__device__ __forceinline__ unsigned xb_xcc_id() { return (unsigned)__builtin_amdgcn_s_getreg((3 << 11) | 20) & 0xFu; }
#define XB_SPIN(cond, bar) do { unsigned _sp = 0; while (cond) { __builtin_amdgcn_s_sleep(1); \
    if ((++_sp & 255u) == 0u) { if (xb_ld(&(bar)[XB_TMO])) break; if (_sp > XB_SPIN_CAP) { atomicAdd(&(bar)[XB_TMO], 1u); break; } } } } while (0)
struct XcdBarrier { unsigned* bar; unsigned x; volatile LAS unsigned* st; };
__device__ __forceinline__ XcdBarrier xcd_barrier_post(unsigned* bar, volatile LAS unsigned* st) {
    XcdBarrier b; b.bar = bar; b.x = xb_xcc_id(); b.st = st;
    if (threadIdx.x == 0) (void)xb_add(&bar[XB_XCNT(b.x)], 1u);
    return b;
}
__device__ __forceinline__ void xcd_barrier_complete(unsigned* bar, unsigned x, unsigned& nloc, unsigned& nx) {
    const unsigned G = gridDim.x * gridDim.y * gridDim.z;
    unsigned sum, cnt, mine, sp = 0u;
    for (;;) {
        sum = 0u; cnt = 0u; mine = 0u;
#pragma unroll
        for (unsigned j = 0; j < 16; ++j) { const unsigned c = xb_ld(&bar[XB_XCNT(j)]); sum += c; cnt += (c > 0u) ? 1u : 0u; mine = (j == x) ? c : mine; }
        if (sum == G) break;
        __builtin_amdgcn_s_sleep(1);
        if ((++sp & 255u) == 0u) { if (xb_ld(&bar[XB_TMO])) break; if (sp > XB_SPIN_CAP) { atomicAdd(&bar[XB_TMO], 1u); break; } }
    }
    nloc = mine > 0u ? mine : 1u; nx = cnt > 0u ? cnt : 1u;
}
__device__ __forceinline__ void xcd_barrier(const XcdBarrier& b) {
    asm volatile("s_waitcnt vmcnt(0)" ::: "memory");
    __syncthreads();
    if (threadIdx.x == 0) {
        unsigned* bar = b.bar;
        __builtin_amdgcn_s_waitcnt(0);
        unsigned nloc = b.st[0], nx = b.st[1];
        if (nloc == 0u) { xcd_barrier_complete(bar, b.x, nloc, nx); b.st[0] = nloc; b.st[1] = nx; }
        const unsigned old = xb_add(&bar[XB_XSUB(b.x)], 1u);
        const unsigned gen = old / nloc;
        if (old + 1u == (gen + 1u) * nloc) {
            __builtin_amdgcn_fence(__ATOMIC_RELEASE, "agent");
            asm volatile("s_waitcnt vmcnt(0)" ::: "memory");
            const unsigned og = xb_add(&bar[XB_TOP], 1u);
            const unsigned tg = og / nx;
            if (og + 1u == (tg + 1u) * nx) xb_add(&bar[XB_TOPGEN], 1u);
            else XB_SPIN(xb_ld(&bar[XB_TOPGEN]) == tg, bar);
            __builtin_amdgcn_fence(__ATOMIC_ACQUIRE, "agent");
            xb_add(&bar[XB_XGEN(b.x)], 1u);
            asm volatile("s_waitcnt vmcnt(0)" ::: "memory");
        } else {
            XB_SPIN(xb_ld(&bar[XB_XGEN(b.x)]) == gen, bar);
            __builtin_amdgcn_fence(__ATOMIC_ACQUIRE, "agent");
            asm volatile("s_waitcnt vmcnt(0)" ::: "memory");
        }
    }
    __syncthreads();
}

namespace pg8 {
constexpr int BM = 256, BK = 64, HALF = 128, HTB = HALF * BK * 2, STAGE_BYTES = 8 * HTB, NXCD = 8, WGM = 8;
__host__ __device__ __forceinline__ int lds_byte(int r, int c) { const int st = (r >> 4) * 2 + (c >> 5), rr = r & 15, cc = c & 31, ob = rr * 64 + cc * 2; return st * 1024 + (ob ^ (((ob >> 9) & 1) << 5)); }
__host__ __device__ __forceinline__ void stage_rc(int b, int& R, int& C) { const int st = b / 1024, sb = b % 1024, swz = sb ^ (((sb >> 9) & 1) << 5); R = (st >> 1) * 16 + swz / 64; C = (st & 1) * 32 + (swz % 64) / 2; }
__host__ __device__ __forceinline__ int perm32(int rho) { const int n = rho >> 4, i = rho & 15; return 8 * (i >> 2) + 4 * n + (i & 3); }

struct Unit { int arow0, brow0, col0, e, pbase, cnt; };

struct DenseSched {
    int nM, nN, nwg, G, c, K;
    __device__ void init(int M, int N, int K_, int G_, int c_) { nM = M / BM; nN = N / BM; nwg = nM * nN; G = G_; c = c_; K = K_; }
    __device__ bool next(int i, Unit& u) const {
        const long L = (long)i * G + c; if (L >= nwg) return false;
        int wgid = (int)L; { const int q = nwg / NXCD, r = nwg % NXCD, xcd = wgid % NXCD, off = wgid / NXCD; wgid = (xcd < r ? xcd * (q + 1) : r * (q + 1) + (xcd - r) * q) + off; }
        const int nig = WGM * nN, gid = wgid / nig, fm = gid * WGM, gsz = (nM - fm) < WGM ? (nM - fm) : WGM;
        const int pm = fm + ((wgid % nig) % gsz), pn = (wgid % nig) / gsz;
        u.arow0 = pm * BM; u.brow0 = pn * BM; u.col0 = pn * BM; u.e = 0; u.pbase = 0; u.cnt = 0; return true;
    }
    __device__ __forceinline__ unsigned a_off(const Unit& u, int r, int C) const { return (unsigned)((u.arow0 + r) * K + C) * 2u; }
};

template <class Epi, class Sched>
__device__ __forceinline__ void gemm_phase(LAS unsigned char* lds, const bf16_t* A, const bf16_t* Bt, const int K, const Sched& S, const Epi& E) {
    const int tid = threadIdx.x, wid = __builtin_amdgcn_readfirstlane(tid >> 6), lane = tid & 63, wr = wid >> 2, wc = wid & 3, fr = lane & 15, fq = lane >> 4;
    const int nt = K / BK;
    int Rr[2], Cc[2]; unsigned voffB[2];
#pragma unroll
    for (int i = 0; i < 2; ++i) { int R, C; stage_rc(tid * 16 + i * 8192, R, C); const int Rb = Epi::PERM ? ((R & ~31) + perm32(R & 31)) : R;
        Rr[i] = R; Cc[i] = C; voffB[i] = (unsigned)(Rb * K + C) * 2u; }
    const size_t kstep = (size_t)(BK * 2);
    const size_t hstepB = (size_t)HALF * K * 2;
    const unsigned ldsw = (unsigned)wid * 1024u;
    const int aoff = lds_byte(wr * 64 + fr, fq * 8), boff = lds_byte(wc * 32 + fr, fq * 8);
#define PG8_SA(b, h) (((b) * 2 + (h)) * HTB)
#define PG8_SB(b, h) ((4 + (b) * 2 + (h)) * HTB)
#define PG8_STAGE(bufoff, gbase, voff) do { _Pragma("unroll") for (int _i = 0; _i < 2; ++_i) \
        __builtin_amdgcn_global_load_lds((const unsigned*)((const char*)(gbase) + (voff)[_i]), (LAS unsigned*)(lds + (bufoff) + ldsw + _i * 8192), 16, 0, 0); } while (0)
#define PG8_LDA(dst, b, h) do { _Pragma("unroll") for (int m = 0; m < 4; ++m) _Pragma("unroll") for (int k = 0; k < 2; ++k) dst[m][k] = *(const LAS bf16x8*)(lds + PG8_SA(b, h) + aoff + m * 2048 + k * 1024); } while (0)
#define PG8_LDB(dst, b, h) do { _Pragma("unroll") for (int n = 0; n < 2; ++n) _Pragma("unroll") for (int k = 0; k < 2; ++k) dst[n][k] = *(const LAS bf16x8*)(lds + PG8_SB(b, h) + boff + n * 2048 + k * 1024); } while (0)
#define PG8_MMA(ai, bj, At, Bt_) do { __builtin_amdgcn_s_setprio(1); _Pragma("unroll") for (int m = 0; m < 4; ++m) _Pragma("unroll") for (int n = 0; n < 2; ++n) _Pragma("unroll") for (int k = 0; k < 2; ++k) \
        acc[ai][bj][m][n] = __builtin_amdgcn_mfma_f32_16x16x32_bf16(Bt_[n][k], At[m][k], acc[ai][bj][m][n], 0, 0, 0); __builtin_amdgcn_s_setprio(0); } while (0)
#define PG8_WAIT_V(n) asm volatile("s_waitcnt vmcnt(" #n ")" ::: "memory")
#define PG8_WAIT_L(n) asm volatile("s_waitcnt lgkmcnt(" #n ")" ::: "memory")
#define PG8_BAR __builtin_amdgcn_s_barrier()
#define PG8_SCHED __builtin_amdgcn_sched_barrier(0)
    Unit cur, nxt; int ui = 0;
    if (!S.next(0, cur)) return;
    f32x4 acc[2][2][4][2];
#pragma unroll
    for (int a = 0; a < 2; ++a)
#pragma unroll
        for (int b = 0; b < 2; ++b)
#pragma unroll
            for (int m = 0; m < 4; ++m)
#pragma unroll
                for (int n = 0; n < 2; ++n) acc[a][b][m][n] = (f32x4){0.f, 0.f, 0.f, 0.f};
    bf16x8 At[4][2], B0[2][2], B1[2][2];
    unsigned oC0[2], oC1[2], oN0[2], oN1[2];
#pragma unroll
    for (int i = 0; i < 2; ++i) { oC0[i] = S.a_off(cur, Rr[i], Cc[i]); oC1[i] = S.a_off(cur, HALF + Rr[i], Cc[i]); }
    const char* gA = (const char*)A;
    const char* cB = (const char*)Bt + (size_t)cur.brow0 * K * 2;
    PG8_STAGE(PG8_SB(0, 0), cB, voffB); PG8_STAGE(PG8_SA(0, 0), gA, oC0); PG8_STAGE(PG8_SB(0, 1), cB + hstepB, voffB); PG8_STAGE(PG8_SA(0, 1), gA, oC1);
    if (wr == 1) PG8_BAR;
    PG8_WAIT_V(4); PG8_BAR;
    PG8_STAGE(PG8_SB(1, 0), cB + kstep, voffB); PG8_STAGE(PG8_SA(1, 0), gA + kstep, oC0); PG8_STAGE(PG8_SB(1, 1), cB + hstepB + kstep, voffB);
    PG8_WAIT_V(6); PG8_BAR;
    for (;;) {
        const bool has_next = S.next(ui + 1, nxt);
        if (has_next) {
#pragma unroll
            for (int i = 0; i < 2; ++i) { oN0[i] = S.a_off(nxt, Rr[i], Cc[i]); oN1[i] = S.a_off(nxt, HALF + Rr[i], Cc[i]); }
        } else {
#pragma unroll
            for (int i = 0; i < 2; ++i) { oN0[i] = oC0[i]; oN1[i] = oC1[i]; }
        }
        const char* nB = has_next ? (const char*)Bt + (size_t)nxt.brow0 * K * 2 : cB;
        for (int t = 0; t < nt; t += 2) {
            const bool last = (t == nt - 2);
            const char* a1 = gA + (size_t)(t + 1) * kstep;
            const char* a2 = last ? gA : gA + (size_t)(t + 2) * kstep; const char* b2 = last ? nB : cB + (size_t)(t + 2) * kstep;
            const char* a3 = a2 + kstep; const char* b3 = b2 + kstep;
            unsigned o20[2], o21[2];
#pragma unroll
            for (int i = 0; i < 2; ++i) { o20[i] = last ? oN0[i] : oC0[i]; o21[i] = last ? oN1[i] : oC1[i]; }
            PG8_LDB(B0, 0, 0); PG8_SCHED; PG8_LDA(At, 0, 0); PG8_STAGE(PG8_SA(1, 1), a1, oC1);
            PG8_WAIT_L(8); PG8_BAR; PG8_WAIT_L(0); PG8_MMA(0, 0, At, B0); PG8_BAR; PG8_SCHED;
            PG8_LDB(B1, 0, 1); PG8_STAGE(PG8_SB(0, 0), b2, voffB);
            PG8_BAR; PG8_WAIT_L(0); PG8_MMA(0, 1, At, B1); PG8_BAR;
            PG8_LDA(At, 0, 1); PG8_STAGE(PG8_SA(0, 0), a2, o20);
            PG8_BAR; PG8_WAIT_L(0); PG8_MMA(1, 0, At, B0); PG8_BAR; PG8_SCHED;
            PG8_STAGE(PG8_SB(0, 1), b2 + hstepB, voffB);
            PG8_WAIT_V(6); PG8_BAR; PG8_MMA(1, 1, At, B1); PG8_BAR;
            PG8_LDB(B0, 1, 0); PG8_SCHED; PG8_LDA(At, 1, 0); PG8_STAGE(PG8_SA(0, 1), a2, o21);
            PG8_WAIT_L(8); PG8_BAR; PG8_WAIT_L(0); PG8_MMA(0, 0, At, B0); PG8_BAR; PG8_SCHED;
            PG8_LDB(B1, 1, 1); PG8_STAGE(PG8_SB(1, 0), b3, voffB);
            PG8_BAR; PG8_WAIT_L(0); PG8_MMA(0, 1, At, B1); PG8_BAR;
            PG8_LDA(At, 1, 1); PG8_STAGE(PG8_SA(1, 0), a3, o20);
            PG8_BAR; PG8_WAIT_L(0); PG8_MMA(1, 0, At, B0); PG8_BAR; PG8_SCHED;
            PG8_STAGE(PG8_SB(1, 1), b3 + hstepB, voffB);
            PG8_WAIT_V(6); PG8_BAR; PG8_MMA(1, 1, At, B1); PG8_BAR;
        }
        E(acc, cur, wr, wc, fr, fq);
        if (!has_next) break;
#pragma unroll
        for (int a = 0; a < 2; ++a)
#pragma unroll
            for (int b = 0; b < 2; ++b)
#pragma unroll
                for (int m = 0; m < 4; ++m)
#pragma unroll
                    for (int n = 0; n < 2; ++n) acc[a][b][m][n] = (f32x4){0.f, 0.f, 0.f, 0.f};
        cur = nxt; cB = nB; ++ui;
#pragma unroll
        for (int i = 0; i < 2; ++i) { oC0[i] = oN0[i]; oC1[i] = oN1[i]; }
    }
    PG8_WAIT_V(0);
    if (wr == 0) PG8_BAR;
    PG8_BAR;
#undef PG8_SA
#undef PG8_SB
#undef PG8_STAGE
#undef PG8_LDA
#undef PG8_LDB
#undef PG8_MMA
#undef PG8_WAIT_V
#undef PG8_WAIT_L
#undef PG8_BAR
#undef PG8_SCHED
}

template <int ACT> struct EpiStoreBf16 {
    static constexpr bool PERM = true;
    bf16_t* O; int ldc; const float* vec; int split_cols; size_t split_stride;
    __device__ __forceinline__ float act(float v, float b) const {
        if (ACT == 1) return 2.f * sigmoidf_(2.f * v) - 1.f;
        if (ACT == 2) return sigmoidf_(v);
        if (ACT == 3) return 0.60653065971f * sigmoidf_(v + b);
        if (ACT == 4) return sigmoidf_(v + b);
        return v;
    }
    __device__ __forceinline__ void operator()(const f32x4 (&acc)[2][2][4][2], const Unit& u, int wr, int wc, int fr, int fq) const {
        const int row0 = u.arow0 + wr * 64 + fr; int colt = u.col0; bf16_t* base = O;
        if (split_cols) { const int t = colt / split_cols; base += (size_t)t * split_stride; colt -= t * split_cols; }
        const int col0 = colt + wc * 32 + 8 * fq, bcol0 = u.col0 + wc * 32 + 8 * fq;
#pragma unroll
        for (int bj = 0; bj < 2; ++bj) {
            const f32x4 b0 = (ACT >= 3) ? *(const f32x4*)(vec + bcol0 + bj * HALF) : (f32x4){0.f, 0.f, 0.f, 0.f}, b1 = (ACT >= 3) ? *(const f32x4*)(vec + bcol0 + bj * HALF + 4) : (f32x4){0.f, 0.f, 0.f, 0.f};
#pragma unroll
            for (int ai = 0; ai < 2; ++ai)
#pragma unroll
                for (int m = 0; m < 4; ++m) { bf16_t* rowp = base + (size_t)(row0 + ai * HALF + m * 16) * ldc + col0; const f32x4 v0 = acc[ai][bj][m][0], v1 = acc[ai][bj][m][1];
                {
                    u32x4 o; o[0] = cvt_pk_bf16(act(v0[0], b0[0]), act(v0[1], b0[1])); o[1] = cvt_pk_bf16(act(v0[2], b0[2]), act(v0[3], b0[3]));
                    o[2] = cvt_pk_bf16(act(v1[0], b1[0]), act(v1[1], b1[1])); o[3] = cvt_pk_bf16(act(v1[2], b1[2]), act(v1[3], b1[3]));
                    *(u32x4*)(rowp + bj * HALF) = o; } }
        }
    }
};
struct EpiRes {
    static constexpr bool PERM = false;
    const float* xin_l; float* out_l; const float* xin_c; float* out_c; const float* gate;
    __device__ __forceinline__ void operator()(const f32x4 (&acc)[2][2][4][2], const Unit& u, int wr, int wc, int fr, int fq) const {
        const int row0 = u.arow0 + wr * 64 + fr, col0 = u.col0 + wc * 32 + 4 * fq;
        const bool isc = u.arow0 >= ML;
        const int gb = isc ? 2 : (u.arow0 / SEQ);
        const float* gp = gate + (size_t)gb * MODW + col0;
        f32x4 gv[2][2];
#pragma unroll
        for (int bj = 0; bj < 2; ++bj)
#pragma unroll
            for (int n = 0; n < 2; ++n) gv[bj][n] = *(const f32x4*)(gp + bj * HALF + n * 16);
        const float* xi = isc ? xin_c - (size_t)ML * D : xin_l; float* xo = isc ? out_c - (size_t)ML * D : out_l;
#pragma unroll
        for (int ai = 0; ai < 2; ++ai)
#pragma unroll
            for (int m = 0; m < 4; ++m) { const size_t ro = (size_t)(row0 + ai * HALF + m * 16) * D + col0;
#pragma unroll
                for (int bj = 0; bj < 2; ++bj)
#pragma unroll
                    for (int n = 0; n < 2; ++n) { const f32x4 xv = *(const f32x4*)(xi + ro + bj * HALF + n * 16);
                        *(f32x4*)(xo + ro + bj * HALF + n * 16) = xv + gv[bj][n] * acc[ai][bj][m][n]; } }
    }
};
struct EpiMoeUp {
    static constexpr bool PERM = false;
    bf16_t* H;
    __device__ __forceinline__ void operator()(const f32x4 (&acc)[2][2][4][2], const Unit& u, int wr, int wc, int fr, int fq) const {
        const int row0 = u.arow0 + wr * 64 + fr;
#pragma unroll
        for (int ai = 0; ai < 2; ++ai)
#pragma unroll
            for (int m = 0; m < 4; ++m) { bf16_t* rowp = H + (size_t)(row0 + ai * HALF + m * 16) * FF;
#pragma unroll
                for (int bj = 0; bj < 2; ++bj) { const int j = (u.col0 + bj * HALF + wc * 32) / 2 + 4 * fq; const f32x4 a = acc[ai][bj][m][0], b = acc[ai][bj][m][1];
                    float h[4];
#pragma unroll
                    for (int i = 0; i < 4; ++i) h[i] = a[i] * sigmoidf_(a[i]) * b[i];
                    u32x2 o; o[0] = cvt_pk_bf16(h[0], h[1]); o[1] = cvt_pk_bf16(h[2], h[3]);
                    *(u32x2*)(rowp + j) = o; } }
    }
};
}

struct MoeSched {
    const LAS int* pref; const LAS int* cnt; const int* tokl; int nN, G, c, K, rowsB; bool gather;
    __device__ bool next(int i, pg8::Unit& u) const {
        const long L = (long)i * G + c; const int T = __builtin_amdgcn_readfirstlane(pref[NEXP]);
        if (L >= (long)T * nN) return false;
        const int tl = (int)(L / nN), pn = (int)(L % nN);
        int e = 0;
        for (int k = 1; k < NEXP; ++k) e = (pref[k] <= tl) ? k : e;
        e = __builtin_amdgcn_readfirstlane(e);
        u.e = e; u.pbase = __builtin_amdgcn_readfirstlane((tl - pref[e]) * 256); u.cnt = __builtin_amdgcn_readfirstlane(cnt[e]); u.arow0 = tl * 256; u.brow0 = e * rowsB + pn * 256; u.col0 = pn * 256; return true;
    }
    __device__ __forceinline__ unsigned a_off(const pg8::Unit& u, int r, int C) const {
        if (gather) { const int p = u.pbase + r; const int tok = (p < u.cnt) ? tokl[(size_t)u.e * MT + p] : 0; return (unsigned)(tok * K + C) * 2u; }
        return (unsigned)((u.arow0 + r) * K + C) * 2u;
    }
};

#define WSP(T, off) ((T*)(F.ws + (off)))
__device__ __forceinline__ const float* mod_row(const Frame& F, int layer, int row3) { return (const float*)(F.ws + WS_MOD) + ((size_t)layer * 3 + row3) * MODW; }

struct CvtJob { const float* src; const float* src2; bf16_t* dst; int Ksrc, Nsrc, ld_src, Kdst, Ndst, koff, grp_rows; size_t grp_stride; int mode; };
struct CvtRegs { f32x4 v[4]; };
__device__ __forceinline__ void cvt_load(const CvtJob& J, int tile, int tid, CvtRegs& R) {
    const int ktiles = J.Kdst / 64, nt = tile / ktiles, kt = tile % ktiles, n0 = nt * 128, k0 = kt * 64;
    const int e = n0 / J.grp_rows, nl0 = n0 % J.grp_rows;
    const int kr = tid >> 3, c8 = tid & 7;
    const int ks = k0 + kr - J.koff;
    const bool kok = (ks >= 0) && (ks < J.Ksrc);
#pragma unroll
    for (int cc = 0; cc < 2; ++cc) {
        const int nl = nl0 + (c8 + cc * 8) * 8;
        const float* sp = J.src + (size_t)e * J.grp_stride; int ncol = nl;
        if (J.mode == 1) { const int g = nl >> 5, w = nl & 31; sp = (w < 16 ? J.src : J.src2) + (size_t)e * J.grp_stride; ncol = g * 16 + (w & 15); }
        if (kok && ncol + 8 <= J.Nsrc) { const float* p = sp + (size_t)ks * J.ld_src + ncol; R.v[cc * 2] = *(const f32x4*)p; R.v[cc * 2 + 1] = *(const f32x4*)(p + 4); }
        else { R.v[cc * 2] = (f32x4){0.f, 0.f, 0.f, 0.f}; R.v[cc * 2 + 1] = (f32x4){0.f, 0.f, 0.f, 0.f}; }
    }
}
__device__ __forceinline__ void cvt_job(const Frame& F, const CvtJob& J, int& base) {
    const int ntiles = (J.Ndst / 128) * (J.Kdst / 64), tid = F.tid;
    LAS float* tl = (LAS float*)F.lds;
    int t = ((F.bid - base) % F.G + F.G) % F.G;
    base = (base + ntiles) % F.G;
    if (t >= ntiles) return;
    CvtRegs cur, nxt; cvt_load(J, t, tid, cur);
    const int ktiles = J.Kdst / 64;
    for (; t < ntiles; t += F.G) {
        const bool hn = (t + F.G) < ntiles;
        if (hn) cvt_load(J, t + F.G, tid, nxt);
        const int kr = tid >> 3, c8 = tid & 7;
#pragma unroll
        for (int cc = 0; cc < 2; ++cc)
#pragma unroll
            for (int j = 0; j < 8; ++j) tl[kr * 129 + (c8 + cc * 8) * 8 + j] = cur.v[cc * 2 + (j >> 2)][j & 3];
        __syncthreads();
        const int nrow = tid >> 2, kq = tid & 3, nt = t / ktiles, kt = t % ktiles;
        float x[16];
#pragma unroll
        for (int j = 0; j < 16; ++j) x[j] = tl[(kq * 16 + j) * 129 + nrow];
        u32x4 o0, o1;
#pragma unroll
        for (int j = 0; j < 4; ++j) { o0[j] = cvt_pk_bf16(x[2 * j], x[2 * j + 1]); o1[j] = cvt_pk_bf16(x[8 + 2 * j], x[8 + 2 * j + 1]); }
        bf16_t* dp = J.dst + (size_t)(nt * 128 + nrow) * J.Kdst + kt * 64 + kq * 16;
        *(u32x4*)dp = o0; *(u32x4*)(dp + 8) = o1;
        __syncthreads();
        if (hn) cur = nxt;
    }
}
__device__ __forceinline__ void cvt_simple(const Frame& F, const float* src, bf16_t* dst, int Ksrc, int Nsrc, int& base) {
    CvtJob J{src, src, dst, Ksrc, Nsrc, Nsrc, Ksrc, Nsrc, 0, Nsrc, 0, 0}; cvt_job(F, J, base);
}
__device__ __forceinline__ void cvt_moe(const Frame& F, int layer, bf16_t* w13, bf16_t* w2t, int& base) {
    const size_t lo = (size_t)layer * NEXP * D * FF;
    CvtJob J1{F.A.in[I_MW1] + lo, F.A.in[I_MW3] + lo, w13, D, FF, FF, D, NEXP * 2 * FF, 0, 2 * FF, (size_t)D * FF, 1}; cvt_job(F, J1, base);
    CvtJob J2{F.A.in[I_MW2] + lo, F.A.in[I_MW2] + lo, w2t, FF, D, D, FF, NEXP * D, 0, D, (size_t)FF * D, 0}; cvt_job(F, J2, base);
}

__device__ __forceinline__ void ph_prologue(const Frame& F) {
    const int tid = F.tid;
    {
        LAS float* cv = (LAS float*)F.lds;
        LAS float* red = (LAS float*)(F.lds + 32768);
        for (int k = tid; k < D; k += NTHR) {
            const float c0 = F.A.in[I_C][k], c1 = F.A.in[I_C][D + k], c2 = F.A.in[I_CCTX][k];
            cv[k] = c0 * sigmoidf_(c0); cv[D + k] = c1 * sigmoidf_(c1); cv[2 * D + k] = c2 * sigmoidf_(c2);
        }
        __syncthreads();
        for (int item = F.bid; item < 2 * 96; item += F.G) {
            const int l = item / 96, n0 = (item % 96) * 128, c4 = tid & 31, kg = tid >> 5;
            float a[3][4];
#pragma unroll
            for (int r = 0; r < 3; ++r)
#pragma unroll
                for (int j = 0; j < 4; ++j) a[r][j] = 0.f;
            const float* wp = F.A.in[I_ADAW] + (size_t)l * D * MODW + n0 + c4 * 4;
#pragma unroll 4
            for (int k = kg; k < D; k += 16) {
                const f32x4 w = *(const f32x4*)(wp + (size_t)k * MODW);
                const float s0 = cv[k], s1 = cv[D + k], s2 = cv[2 * D + k];
#pragma unroll
                for (int j = 0; j < 4; ++j) { a[0][j] += s0 * w[j]; a[1][j] += s1 * w[j]; a[2][j] += s2 * w[j]; }
            }
#pragma unroll
            for (int r = 0; r < 3; ++r)
#pragma unroll
                for (int j = 0; j < 4; ++j) red[(kg * 3 + r) * 128 + c4 * 4 + j] = a[r][j];
            __syncthreads();
            if (tid < 384) { const int r = tid >> 7, n = tid & 127; float s = F.A.in[I_ADAB][(size_t)l * MODW + n0 + n];
                for (int g = 0; g < 16; ++g) s += red[(g * 3 + r) * 128 + n];
                WSP(float, WS_MOD)[((size_t)l * 3 + r) * MODW + n0 + n] = s; }
            __syncthreads();
        }
        __syncthreads();
    }
    int base = 0;
    cvt_simple(F, F.A.in[I_WIN], WSP(bf16_t, WT_IN), D, QKVC, base);
    cvt_simple(F, F.A.in[I_WOUT], WSP(bf16_t, WT_OUT), D, D, base);
    cvt_simple(F, F.A.in[I_WR], WSP(bf16_t, WT_R), D, D, base);
    cvt_simple(F, F.A.in[I_WK], WSP(bf16_t, WT_K), D, D, base);
    cvt_simple(F, F.A.in[I_WV], WSP(bf16_t, WT_V), D, D, base);
    cvt_simple(F, F.A.in[I_WO], WSP(bf16_t, WT_O), D, D, base);
    for (int d = 0; d < 2; ++d) {
        { CvtJob J{F.A.in[I_W1] + (size_t)d * D * 96, nullptr, WSP(bf16_t, WT_W1) + (size_t)d * 128 * D, D, 96, 96, D, 128, 0, 128, 0, 0}; cvt_job(F, J, base); }
        { CvtJob J{F.A.in[I_A1] + (size_t)d * D * 96, nullptr, WSP(bf16_t, WT_A1) + (size_t)d * 128 * D, D, 96, 96, D, 128, 0, 128, 0, 0}; cvt_job(F, J, base); }
        { CvtJob J{F.A.in[I_W2] + (size_t)d * 96 * D, nullptr, WSP(bf16_t, WT_W2) + (size_t)d * D * 256, 96, D, D, 256, D, 128 * d, D, 0, 0}; cvt_job(F, J, base); }
        { CvtJob J{F.A.in[I_A2] + (size_t)d * 96 * D, nullptr, WSP(bf16_t, WT_A2) + (size_t)d * D * 256, 96, D, D, 256, D, 128 * d, D, 0, 0}; cvt_job(F, J, base); }
    }
    cvt_simple(F, F.A.in[I_G1], WSP(bf16_t, WT_G1), D, 256, base);
    cvt_simple(F, F.A.in[I_G2], WSP(bf16_t, WT_G2), 256, D, base);
    cvt_moe(F, 0, WSP(bf16_t, SLOTP(6)), WSP(bf16_t, SLOTP(6)) + (size_t)NEXP * 2 * FF * D, base);
}

struct RowOpts {
    const float* src_l; const float* src_c;
    int nrows;
    bool combine; int comb_layer; const bf16_t* yslot; float* dst_l; float* dst_c;
    bool norm; int layer; int which;
    bf16_t* H;
    bool router;
};
__device__ __forceinline__ void ph_rows(const Frame& F, const RowOpts& O) {
    LAS int* pref = (LAS int*)(F.lds + 131072 + 1024);
    if (O.combine) {
        if (F.tid == 0) { const int* cnt = WSP(int, WS_CTL + CTL_CNT) + O.comb_layer * NEXP; int s = 0; for (int e = 0; e < NEXP; ++e) { pref[e] = s; s += (cnt[e] + 255) >> 8; } pref[NEXP] = s; }
        __syncthreads();
    }
    const int lane = F.lane;
    for (int r = F.bid * 8 + F.wave; r < O.nrows; r += F.G * 8) {
        const bool isc = r >= ML;
        const int mrow = isc ? 2 : r / SEQ;
        const float* sp = isc ? O.src_c + (size_t)(r - ML) * D : O.src_l + (size_t)r * D;
        f32x4 v[8];
#pragma unroll
        for (int i = 0; i < 8; ++i) v[i] = *(const f32x4*)(sp + i * 256 + lane * 4);
        if (O.combine) {
            const int s0 = WSP(int, WS_TOKSEL)[r * 2], s1 = WSP(int, WS_TOKSEL)[r * 2 + 1];
            const float g0 = WSP(float, WS_TOKGATE)[r * 2], g1 = WSP(float, WS_TOKGATE)[r * 2 + 1];
            const size_t y0 = ((size_t)pref[s0 >> 20] * 256 + (s0 & 0xfffff)) * D, y1 = ((size_t)pref[s1 >> 20] * 256 + (s1 & 0xfffff)) * D;
            const float* gt = mod_row(F, O.comb_layer, mrow) + 5 * D;
            float* dp = isc ? O.dst_c + (size_t)(r - ML) * D : O.dst_l + (size_t)r * D;
#pragma unroll
            for (int i = 0; i < 8; ++i) {
                const int col = i * 256 + lane * 4;
                const u32x2 a = *(const u32x2*)(O.yslot + y0 + col), b = *(const u32x2*)(O.yslot + y1 + col);
                const f32x4 g = *(const f32x4*)(gt + col);
                v[i][0] += g[0] * (g0 * bf_lo(a[0]) + g1 * bf_lo(b[0])); v[i][1] += g[1] * (g0 * bf_hi(a[0]) + g1 * bf_hi(b[0]));
                v[i][2] += g[2] * (g0 * bf_lo(a[1]) + g1 * bf_lo(b[1])); v[i][3] += g[3] * (g0 * bf_hi(a[1]) + g1 * bf_hi(b[1]));
                *(f32x4*)(dp + col) = v[i];
            }
        }
        if (!O.norm) continue;
        float ss = 0.f;
#pragma unroll
        for (int i = 0; i < 8; ++i) ss += v[i][0] * v[i][0] + v[i][1] * v[i][1] + v[i][2] * v[i][2] + v[i][3] * v[i][3];
        ss = wave_sum(ss);
        const float rstd = rsqrtf(ss * (1.f / D) + 1e-6f);
        const float* gn = (O.which ? F.A.in[I_NFFN] : F.A.in[I_NMIX]) + (size_t)O.layer * D;
        const float* mr = mod_row(F, O.layer, mrow);
        const float* shp = mr + (O.which ? 3 * D : 0); const float* scp = mr + (O.which ? 4 * D : D);
        bf16_t* hp = O.H + (size_t)r * D;
#pragma unroll
        for (int i = 0; i < 8; ++i) {
            const int col = i * 256 + lane * 4;
            const f32x4 g = *(const f32x4*)(gn + col), sc = *(const f32x4*)(scp + col), sh = *(const f32x4*)(shp + col);
#pragma unroll
            for (int j = 0; j < 4; ++j) v[i][j] = v[i][j] * rstd * g[j] * (1.f + sc[j]) + sh[j];
            u32x2 o; o[0] = cvt_pk_bf16(v[i][0], v[i][1]); o[1] = cvt_pk_bf16(v[i][2], v[i][3]);
            *(u32x2*)(hp + col) = o;
        }
        if (!O.router) continue;
        const float* wg = F.A.in[I_MGRP] + (size_t)O.layer * D * 4;
        const float* we = F.A.in[I_MEXP] + (size_t)O.layer * D * NEXP;
        LAS float* hs = (LAS float*)(F.lds + F.wave * 8192);
#pragma unroll
        for (int i = 0; i < 8; ++i) *(LAS f32x4*)(hs + i * 256 + lane * 4) = v[i];
        lds_fence();
        float gl[4] = {0.f, 0.f, 0.f, 0.f};
#pragma unroll 4
        for (int k = lane; k < D; k += 64) { const float h = hs[k]; const f32x4 w = *(const f32x4*)(wg + (size_t)k * 4);
            gl[0] += h * w[0]; gl[1] += h * w[1]; gl[2] += h * w[2]; gl[3] += h * w[3]; }
#pragma unroll
        for (int q = 0; q < 4; ++q) gl[q] = wave_sum(gl[q]);
        int gs = 0; float gm = gl[0];
#pragma unroll
        for (int q = 1; q < 4; ++q) if (gl[q] > gm) { gm = gl[q]; gs = q; }
        float den = 0.f;
#pragma unroll
        for (int q = 0; q < 4; ++q) den += __expf(gl[q] - gm);
        const float psel = 1.f / den;
        float el[8] = {0.f, 0.f, 0.f, 0.f, 0.f, 0.f, 0.f, 0.f};
#pragma unroll 4
        for (int k = lane; k < D; k += 64) { const float h = hs[k]; const float* wp = we + (size_t)k * NEXP + gs * 8; const f32x4 w0 = *(const f32x4*)wp, w1 = *(const f32x4*)(wp + 4);
            el[0] += h * w0[0]; el[1] += h * w0[1]; el[2] += h * w0[2]; el[3] += h * w0[3]; el[4] += h * w1[0]; el[5] += h * w1[1]; el[6] += h * w1[2]; el[7] += h * w1[3]; }
#pragma unroll
        for (int q = 0; q < 8; ++q) el[q] = wave_sum(el[q]);
        lds_fence();
        int i1 = 0; float v1 = el[0];
#pragma unroll
        for (int q = 1; q < 8; ++q) if (el[q] > v1) { v1 = el[q]; i1 = q; }
        int i2 = -1; float v2 = -3.0e38f;
#pragma unroll
        for (int q = 0; q < 8; ++q) if (q != i1 && el[q] > v2) { v2 = el[q]; i2 = q; }
        const float e2 = __expf(v2 - v1), w1g = psel / (1.f + e2), w2g = psel * e2 / (1.f + e2);
        if (lane == 0) {
            int* cnt = WSP(int, WS_CTL + CTL_CNT) + O.layer * NEXP;
            const int ea = gs * 8 + i1, eb = gs * 8 + i2;
            const int pa = atomicAdd(cnt + ea, 1), pb = atomicAdd(cnt + eb, 1);
            WSP(int, WS_TOKL)[(size_t)ea * MT + pa] = r; WSP(int, WS_TOKL)[(size_t)eb * MT + pb] = r;
            WSP(int, WS_TOKSEL)[r * 2] = (ea << 20) | pa; WSP(int, WS_TOKSEL)[r * 2 + 1] = (eb << 20) | pb;
            WSP(float, WS_TOKGATE)[r * 2] = w1g; WSP(float, WS_TOKGATE)[r * 2 + 1] = w2g;
        }
    }
}

__device__ __forceinline__ void ph_qknorm(const Frame& F, bf16_t* QKV) {
    const int lane = F.lane;
    const int il = lane & 15;
    const float f0 = exp2f(-(float)(2 * il) * (13.287712379549449f / 32.f)), f1 = exp2f(-(float)(2 * il + 1) * (13.287712379549449f / 32.f));
    for (int r = F.bid * 8 + F.wave; r < MT; r += F.G * 8) {
        const bool lat = r < ML; const int t = r % SEQ;
        const float pos = (lane < 32) ? (float)(t / 64) : (float)(t % 64);
        float c0 = 1.f, s0 = 0.f, c1 = 1.f, s1 = 0.f;
        if (lat) { const float r0_ = __builtin_amdgcn_fractf(pos * f0 * 0.15915494309189535f), r1_ = __builtin_amdgcn_fractf(pos * f1 * 0.15915494309189535f);
            s0 = __builtin_amdgcn_sinf(r0_); c0 = __builtin_amdgcn_cosf(r0_); s1 = __builtin_amdgcn_sinf(r1_); c1 = __builtin_amdgcn_cosf(r1_); }
        bf16_t* row = QKV + (size_t)r * QKVC;
        for (int hd = 0; hd < 26; ++hd) {
            int col; const float* gain; bool rope;
            if (hd < 8) { col = QA0 + hd * 128; gain = F.A.in[I_AQG]; rope = lat; }
            else if (hd < 10) { col = KA0 + (hd - 8) * 128; gain = F.A.in[I_AKG]; rope = lat; }
            else if (hd < 18) { col = QB0 + (hd - 10) * 128; gain = F.A.in[I_BQG]; rope = false; }
            else { col = KB0 + (hd - 18) * 128; gain = F.A.in[I_BKG]; rope = false; }
            unsigned* p = (unsigned*)(row + col + 2 * lane);
            const unsigned u = *p;
            float x0 = bf_lo(u), x1 = bf_hi(u);
            const float ss = wave_sum(x0 * x0 + x1 * x1);
            const float rstd = rsqrtf(ss * (1.f / 128.f) + 1e-6f);
            x0 = x0 * rstd * gain[2 * lane]; x1 = x1 * rstd * gain[2 * lane + 1];
            if (rope) {
                const float p0 = __shfl_xor(x0, 16), p1 = __shfl_xor(x1, 16);
                if ((lane & 16) == 0) { x0 = x0 * c0 - p0 * s0; x1 = x1 * c1 - p1 * s1; }
                else { x0 = p0 * s0 + x0 * c0; x1 = p1 * s1 + x1 * c1; }
            }
            *p = cvt_pk_bf16(x0, x1);
        }
    }
}

__device__ __forceinline__ void ph_attn_simple(const Frame& F, const bf16_t* QKV, bf16_t* YC) {
    const int lane = F.lane;
    LAS float* qs = (LAS float*)(F.lds + F.wave * 4096);
    LAS float* ps = qs + 128;
    const float scale = 0.08838834764831845f;
    for (int it = F.bid * 8 + F.wave; it < MT * 16; it += F.G * 8) {
        const int r = it >> 4, hh = it & 15; const bool tA = hh < 8; const int h = hh & 7;
        const int qcol = tA ? QA0 + h * 128 : QB0 + h * 128, kcol = tA ? KA0 + (h >> 2) * 128 : KB0 + h * 128, vcol = tA ? VA0 + (h >> 2) * 128 : VB0 + h * 128;
        { const unsigned u = *(const unsigned*)(QKV + (size_t)r * QKVC + qcol + 2 * lane); qs[2 * lane] = bf_lo(u); qs[2 * lane + 1] = bf_hi(u); }
        lds_fence();
        const bool lat = r < ML;
        const int b = lat ? r / SEQ : (r - ML) / CTXL, t = r % SEQ;
        int nloc, lo = 0, r0 = 0, c0 = 0, rr = 0, cq = 0;
        if (!lat) nloc = 0;
        else if (tA) { lo = max(0, t - 128); const int hi = min(SEQ - 1, t + 128); nloc = hi - lo + 1; }
        else { rr = t >> 6; cq = t & 63; r0 = min(max(rr - 4, 0), 248); c0 = min(max(cq - 8, 0), 48); nloc = 128; }
        const int nkeys = nloc + CTXL;
        const float* rpb = F.A.in[I_RPB] + (size_t)h * 15 * 31;
        float mloc = -3.0e38f;
        for (int j = lane; j < nkeys; j += 64) {
            int krow; float bias = 0.f;
            if (j >= nloc) krow = ML + b * CTXL + (j - nloc);
            else if (tA) krow = b * SEQ + lo + j;
            else { const int jr = j >> 4, jc = j & 15; krow = b * SEQ + (r0 + jr) * 64 + c0 + jc; bias = rpb[(r0 + jr - rr + 7) * 31 + (c0 + jc - cq + 15)]; }
            const bf16_t* kp = QKV + (size_t)krow * QKVC + kcol;
            float dot = 0.f;
#pragma unroll 4
            for (int d8 = 0; d8 < 16; ++d8) { const u32x4 kv = *(const u32x4*)(kp + d8 * 8);
#pragma unroll
                for (int q = 0; q < 4; ++q) dot += qs[d8 * 8 + 2 * q] * bf_lo(kv[q]) + qs[d8 * 8 + 2 * q + 1] * bf_hi(kv[q]); }
            const float s = dot * scale + bias;
            ps[j] = s; mloc = fmaxf(mloc, s);
        }
        float m = wave_max(mloc);
        const float sink = tA ? F.A.in[I_ASINK][h] : -3.0e38f;
        if (tA) m = fmaxf(m, sink);
        float sloc = 0.f;
        for (int j = lane; j < nkeys; j += 64) { const float p = __expf(ps[j] - m); ps[j] = p; sloc += p; }
        float l = wave_sum(sloc);
        if (tA) l += __expf(sink - m);
        lds_fence();
        float o0 = 0.f, o1 = 0.f;
        for (int j = 0; j < nkeys; ++j) {
            int krow;
            if (j >= nloc) krow = ML + b * CTXL + (j - nloc);
            else if (tA) krow = b * SEQ + lo + j;
            else krow = b * SEQ + (r0 + (j >> 4)) * 64 + c0 + (j & 15);
            const unsigned u = *(const unsigned*)(QKV + (size_t)krow * QKVC + vcol + 2 * lane);
            const float p = ps[j];
            o0 += p * bf_lo(u); o1 += p * bf_hi(u);
        }
        const float inv = 1.f / l;
        *(unsigned*)(YC + (size_t)r * D + hh * 128 + 2 * lane) = cvt_pk_bf16(o0 * inv, o1 * inv);
        lds_fence();
    }
}

namespace att {
typedef float f32x16 __attribute__((ext_vector_type(16)));
typedef short s16x4 __attribute__((ext_vector_type(4)));
constexpr int KVBLK = 64;
constexpr float SCALE = 0.08838834764831845f, THR = 8.f;
constexpr int SHM_V = KVBLK * 128 * 2, SHM_K = KVBLK * 128 * 2;
#define KSWZ(row, colB) ((row) * 256 + ((colB) ^ (((row) & 7) << 4)))
#define SBAR() __builtin_amdgcn_sched_barrier(0)
__device__ __forceinline__ int crow(int r, int hi) { return (r & 3) + 8 * (r >> 2) + 4 * hi; }
__device__ __forceinline__ void partialSM(f32x16& p0, f32x16& p1, float& m_reg, float& mn, float& alpha) {
  constexpr float C = SCALE * 1.4426950408889634f;
  float pmax = p0[0];
#pragma unroll
  for (int r = 1; r < 16; ++r) pmax = fmaxf(pmax, p0[r]);
#pragma unroll
  for (int r = 0; r < 16; ++r) pmax = fmaxf(pmax, p1[r]);
  { auto rr = __builtin_amdgcn_permlane32_swap(__float_as_uint(pmax), __float_as_uint(pmax), false, false);
    pmax = fmaxf(__uint_as_float(rr[0]), __uint_as_float(rr[1])); }
  if (__builtin_expect(__all(pmax - m_reg <= THR / SCALE), 1)) { mn = m_reg; alpha = 1.f; }
  else { mn = fmaxf(m_reg, pmax); alpha = __builtin_amdgcn_exp2f((m_reg - mn) * C); m_reg = mn; }
  float mnC = -mn * C;
#pragma unroll
  for (int r = 0; r < 16; ++r) p0[r] = fmaf(p0[r], C, mnC);
#pragma unroll
  for (int r = 0; r < 16; ++r) p1[r] = fmaf(p1[r], C, mnC);
#pragma unroll
  for (int r = 0; r < 16; ++r) p0[r] = __builtin_amdgcn_exp2f(p0[r]);
}
__device__ __forceinline__ void finishSM(f32x16& p0, f32x16& p1, float alpha, float& l_reg, bf16x8& pa0, bf16x8& pa1, bf16x8& pa2, bf16x8& pa3) {
#pragma unroll
  for (int r = 0; r < 16; ++r) p1[r] = __builtin_amdgcn_exp2f(p1[r]);
  float ps = 0;
#pragma unroll
  for (int r = 0; r < 16; ++r) ps += p0[r];
#pragma unroll
  for (int r = 0; r < 16; ++r) ps += p1[r];
  { auto rr = __builtin_amdgcn_permlane32_swap(__float_as_uint(ps), __float_as_uint(ps), false, false);
    ps = __uint_as_float(rr[0]) + __uint_as_float(rr[1]); }
  l_reg = l_reg * alpha + ps;
#define PK4(P, BASE, OUT) do { unsigned a0 = cvt_pk_bf16(P[BASE + 0], P[BASE + 1]), a1 = cvt_pk_bf16(P[BASE + 2], P[BASE + 3]);   \
    unsigned b0 = cvt_pk_bf16(P[BASE + 4], P[BASE + 5]), b1 = cvt_pk_bf16(P[BASE + 6], P[BASE + 7]);                              \
    auto r0 = __builtin_amdgcn_permlane32_swap(a0, b0, false, false); auto r1 = __builtin_amdgcn_permlane32_swap(a1, b1, false, false); \
    u32x4 w = {r0[0], r1[0], r0[1], r1[1]}; OUT = *reinterpret_cast<bf16x8*>(&w); } while (0)
  PK4(p0, 0, pa0); PK4(p0, 8, pa1); PK4(p1, 0, pa2); PK4(p1, 8, pa3);
#undef PK4
}
__device__ __forceinline__ void qkt(f32x16& p0, f32x16& p1, const LAS char* Ks, const bf16x8* qr, int r32, int hi) {
  p0 = f32x16{}; p1 = f32x16{};
#pragma unroll
  for (int d0 = 0; d0 < 8; ++d0) { int cb = (d0 * 16 + hi * 8) * 2;
    bf16x8 b0 = *reinterpret_cast<const LAS bf16x8*>(Ks + KSWZ(r32, cb));
    bf16x8 b1 = *reinterpret_cast<const LAS bf16x8*>(Ks + KSWZ(32 + r32, cb));
    p0 = __builtin_amdgcn_mfma_f32_32x32x16_bf16(b0, qr[d0], p0, 0, 0, 0);
    p1 = __builtin_amdgcn_mfma_f32_32x32x16_bf16(b1, qr[d0], p1, 0, 0, 0); }
}
__device__ __forceinline__ int v_st(int k, int c) { const int kk = (k & ~0xC) | ((k & 4) << 1) | ((k & 8) >> 1); return ((kk >> 3) * 4 + (c >> 5)) * 512 + ((kk & 7) * 32 + (c & 31)) * 2; }
__device__ __forceinline__ int v_rd_base(int lane) { return ((lane & 3) << 3) | (((lane >> 2) & 3) << 6) | (((lane >> 4) & 1) << 5) | (((lane >> 5) & 1) << 8); }
constexpr int v_rd_off(int d0, int ks, int half) { return d0 * 512 + ks * 4096 + half * 2048; }
template <int OFF> __device__ __forceinline__ s16x4 tr_read(int vb) {
  s16x4 r; asm volatile("ds_read_b64_tr_b16 %0, %1 offset:%2" : "=&v"(r) : "v"(vb), "i"(OFF) : "memory"); return r;
}
template <int D0> __device__ __forceinline__ void pv_one(f32x16& od, int vb, bf16x8 pa0, bf16x8 pa1, bf16x8 pa2, bf16x8 pa3) {
  const s16x4 l0 = tr_read<v_rd_off(D0, 0, 0)>(vb), h0 = tr_read<v_rd_off(D0, 0, 1)>(vb), l1 = tr_read<v_rd_off(D0, 1, 0)>(vb), h1 = tr_read<v_rd_off(D0, 1, 1)>(vb);
  const s16x4 l2 = tr_read<v_rd_off(D0, 2, 0)>(vb), h2 = tr_read<v_rd_off(D0, 2, 1)>(vb), l3 = tr_read<v_rd_off(D0, 3, 0)>(vb), h3 = tr_read<v_rd_off(D0, 3, 1)>(vb);
  asm volatile("s_waitcnt lgkmcnt(0)" ::: "memory"); SBAR();
#define PK(L, H) (bf16x8){L[0], L[1], L[2], L[3], H[0], H[1], H[2], H[3]}
  od = __builtin_amdgcn_mfma_f32_32x32x16_bf16(pa0, PK(l0, h0), od, 0, 0, 0);
  od = __builtin_amdgcn_mfma_f32_32x32x16_bf16(pa1, PK(l1, h1), od, 0, 0, 0);
  od = __builtin_amdgcn_mfma_f32_32x32x16_bf16(pa2, PK(l2, h2), od, 0, 0, 0);
  od = __builtin_amdgcn_mfma_f32_32x32x16_bf16(pa3, PK(l3, h3), od, 0, 0, 0);
#undef PK
}
__device__ __forceinline__ void pv_d0(f32x16* o, int vb, bf16x8 pa0, bf16x8 pa1, bf16x8 pa2, bf16x8 pa3) {
  pv_one<0>(o[0], vb, pa0, pa1, pa2, pa3); pv_one<1>(o[1], vb, pa0, pa1, pa2, pa3); pv_one<2>(o[2], vb, pa0, pa1, pa2, pa3); pv_one<3>(o[3], vb, pa0, pa1, pa2, pa3);
}
struct UnitD {
  int nW, NT;
  int wrow0, crow0;
  int qt, wlo;
};
__device__ __forceinline__ void mask_add(f32x16& p0, f32x16& p1, int hi, const LAS float* tp) {
  const LAS float* tq = tp + 4 * hi;
#pragma unroll
  for (int g = 0; g < 4; ++g) {
#pragma unroll
    for (int q = 0; q < 4; ++q) { const int r = 4 * g + q, jc = q + 8 * g; p0[r] += tq[jc]; p1[r] += tq[jc + 32]; }
    SBAR();
  }
}

__device__ __forceinline__ void attn_unit(const int TYPE, const bf16_t* __restrict__ Qw_, const bf16_t* __restrict__ Kc, const bf16_t* __restrict__ Vc, bf16_t* __restrict__ Ow, const UnitD U,
                                          const int wrr  , const float sink_l2  , LAS char* lds) {
  const int tid = threadIdx.x, wid = __builtin_amdgcn_readfirstlane(tid >> 6), lane = tid & 63, r32 = lane & 31, hi = lane >> 5;
  LAS char* V_lds = lds; LAS char* K_lds = lds + 2 * SHM_V;
  LAS float* ws = (LAS float*)(lds + 2 * SHM_V + 2 * SHM_K) + wid * 64; LAS float* li_l = ws; LAS float* al_l = ws + 32;
  const LAS float* tbl = (const LAS float*)(lds + 2 * SHM_V + 2 * SHM_K + 2048);
  float m_reg = -1e4f, l_reg = 0; f32x16 o[4] = {}; bf16x8 qr[8];
  const bf16_t* Qw = Qw_ + (size_t)r32 * QKVC + hi * 8;
#pragma unroll
  for (int d0 = 0; d0 < 8; ++d0) qr[d0] = *reinterpret_cast<const bf16x8*>(Qw + d0 * 16);
  const int sr = tid >> 4, sc = (tid & 15) * 8, vst0 = v_st(sr, sc), vst1 = v_st(32 + sr, sc);
  const int vb0 = (int)(uintptr_t)V_lds + v_rd_base(lane);
  struct { bf16x8 vs0, vs1, ks0, ks1; } sr_[1];
  const int iq = (wid & 1) * 32 + r32;
  const int r0w = min(max(wrr - 4, 0), 248);
  const int c0q = min(max(iq - 8, 0), 48);
#define TROW(j) (((j) < U.nW) ? (U.wrow0 + (j) * 64) : (U.crow0 + (((j) - U.nW) & 3) * 64))
#define SLOAD(i, k0) do { const int _k0 = (k0); sr_[i].vs0 = *reinterpret_cast<const bf16x8*>(&Vc[(size_t)(_k0 + sr) * QKVC + sc]); sr_[i].vs1 = *reinterpret_cast<const bf16x8*>(&Vc[(size_t)(_k0 + 32 + sr) * QKVC + sc]); \
    sr_[i].ks0 = *reinterpret_cast<const bf16x8*>(&Kc[(size_t)(_k0 + sr) * QKVC + sc]); sr_[i].ks1 = *reinterpret_cast<const bf16x8*>(&Kc[(size_t)(_k0 + 32 + sr) * QKVC + sc]); } while (0)
#define SWRITE(b, i) do { *(LAS bf16x8*)(V_lds + (b) * SHM_V + vst0) = sr_[i].vs0;          \
    *(LAS bf16x8*)(V_lds + (b) * SHM_V + vst1) = sr_[i].vs1; int kc = sc * 2;               \
    *(LAS bf16x8*)(K_lds + (b) * SHM_K + KSWZ(sr, kc)) = sr_[i].ks0;                       \
    *(LAS bf16x8*)(K_lds + (b) * SHM_K + KSWZ(32 + sr, kc)) = sr_[i].ks1; } while (0)
#define RESC(a) do { if (__any((a) < 1.f)) { if (hi == 0) al_l[r32] = (a); asm volatile("s_waitcnt lgkmcnt(0)" ::: "memory"); \
    _Pragma("unroll") for (int d = 0; d < 4; ++d) _Pragma("unroll") for (int r = 0; r < 16; ++r) o[d][r] *= al_l[crow(r, hi)]; } } while (0)
#define MASK(j, P0, P1) do { const int _j = (j); \
    if (TYPE == 0) { if (_j < U.nW) { const int tix = U.wlo + _j; \
        if (tix == U.qt - 2) mask_add(P0, P1, hi, tbl + 17 * 128 + 64 - iq); else if (tix == U.qt + 2) mask_add(P0, P1, hi, tbl + 18 * 128 + 64 - iq); } } \
    else { if (_j < U.nW) { const int dr = U.wlo + _j - r0w; \
        if ((unsigned)dr < 8u) { mask_add(P0, P1, hi, tbl + (U.wlo + _j - wrr + 7) * 128 + 64 - iq); mask_add(P0, P1, hi, tbl + 16 * 128 + 48 - c0q); } \
        else mask_add(P0, P1, hi, tbl + 19 * 128); } } } while (0)
  f32x16 p0, p1; float mn, al = 1.f; bf16x8 pa0, pa1, pa2, pa3; const int NT = U.NT;
  SLOAD(0, TROW(0)); asm volatile("s_waitcnt vmcnt(0)" ::: "memory"); SWRITE(0, 0); SLOAD(0, TROW(1)); __syncthreads();
  for (int j = 0; j < NT; ++j) {
    const int par = j & 1;
    qkt(p0, p1, K_lds + par * SHM_K, qr, r32, hi);
    if (j + 1 < NT) { SWRITE(1 - par, 0); }
    if (j + 2 < NT) SLOAD(0, TROW(j + 2));
    MASK(j, p0, p1);
    partialSM(p0, p1, m_reg, mn, al);
    RESC(al);
    finishSM(p0, p1, al, l_reg, pa0, pa1, pa2, pa3); SBAR();
    pv_d0(o, vb0 + par * SHM_V, pa0, pa1, pa2, pa3);
    __syncthreads();
  }
  if (TYPE == 0) l_reg += __builtin_amdgcn_exp2f(sink_l2 - m_reg * (SCALE * 1.4426950408889634f));
  if (hi == 0) li_l[r32] = l_reg; asm volatile("s_waitcnt lgkmcnt(0)" ::: "memory");
  float rli[16];
#pragma unroll
  for (int r = 0; r < 16; ++r) rli[r] = __builtin_amdgcn_rcpf(li_l[crow(r, hi)]);
#pragma unroll
  for (int r = 0; r < 16; ++r) { const int orow = crow(r, hi);
#pragma unroll
    for (int d0 = 0; d0 < 4; ++d0) { const float x = o[d0][r] * rli[r]; Ow[(size_t)orow * D + d0 * 32 + r32] = (bf16_t)(cvt_pk_bf16(x, x) & 0xffffu); } }
#undef TROW
#undef SLOAD
#undef SWRITE
#undef RESC
#undef MASK
}
}

__device__ __forceinline__ void ph_attn(const Frame& F, const bf16_t* QKV, bf16_t* YC) {
    LAS char* lds = (LAS char*)F.lds;
    LAS float* tbl = (LAS float*)(lds + 2 * att::SHM_V + 2 * att::SHM_K + 2048);
    const int wid = F.wave;
    for (int i = F.tid; i < 5 * 128; i += NTHR) { const int row = 15 + (i >> 7), k = i & 127; float v = 0.f;
        if (row == 16) v = ((unsigned)(k - 56 + 8) < 16u) ? 0.f : -1e30f;
        if (row == 17) v = (k - 64 >= 0) ? 0.f : -1e30f;
        if (row == 18) v = (k - 64 <= 0) ? 0.f : -1e30f;
        if (row == 19) v = -1e30f;
        tbl[15 * 128 + i] = v; }
    for (int u = F.bid; u < 2080; u += F.G) {
        att::UnitD U; int type, qrow0, wrr = 0, qoff, koff, voff, ooff, wrow; float sink_l2 = 0.f;
        if (u < 1040) {
            const int b = u / 520, rem = u % 520, h = rem / 65, qg = rem % 65;
            for (int i = F.tid; i < 15 * 128; i += NTHR) { const int dr = i >> 7, k = (i & 127) - 49; tbl[i] = ((unsigned)k < 31u) ? F.A.in[I_RPB][(size_t)h * 465 + dr * 31 + k] * (1.f / att::SCALE) : 0.f; }
            type = 1;
            U.crow0 = ML + b * CTXL;
            if (qg < 64) { const int R0 = qg * 4; const int klo = min(max(R0 - 4, 0), 248), khi = min(max(R0 - 1, 0), 248) + 7;
                U.nW = khi - klo + 1; U.wrow0 = b * SEQ + klo * 64; U.wlo = klo; U.qt = R0; qrow0 = b * SEQ + R0 * 64; wrr = R0 + (wid >> 1); }
            else { U.nW = 0; U.wrow0 = 0; U.wlo = 0; U.qt = 0; qrow0 = ML + b * CTXL; }
            wrow = wid * 32; qoff = QB0 + h * 128; koff = KB0 + h * 128; voff = VB0 + h * 128; ooff = 1024 + h * 128;
        } else {
            const int v = u - 1040, b = v / 520, rem = v % 520, kvh = rem / 260, qt = rem % 260;
            const int g = wid >> 1, hq = kvh * 4 + g;
            type = 0;
            U.crow0 = ML + b * CTXL;
            if (qt < 256) { const int wlo = max(qt - 2, 0), whi = min(qt + 2, 255); U.nW = whi - wlo + 1; U.wlo = wlo; U.qt = qt; U.wrow0 = b * SEQ + wlo * 64; qrow0 = b * SEQ + qt * 64; }
            else { U.nW = 0; U.wlo = 0; U.qt = 1000; U.wrow0 = 0; qrow0 = ML + b * CTXL + (qt - 256) * 64; }
            sink_l2 = F.A.in[I_ASINK][hq] * 1.4426950408889634f;
            wrow = (wid & 1) * 32; qoff = QA0 + hq * 128; koff = KA0 + kvh * 128; voff = VA0 + kvh * 128; ooff = hq * 128;
        }
        U.NT = U.nW + 4;
        __syncthreads();
        att::attn_unit(type, QKV + (size_t)(qrow0 + wrow) * QKVC + qoff, QKV + koff, QKV + voff, YC + (size_t)(qrow0 + wrow) * D + ooff, U, wrr, sink_l2, lds);
        __syncthreads();
    }
}

__device__ __forceinline__ void ph_mix(const Frame& F, const bf16_t* H, bf16_t* XM, int m) {
    const int lane = F.lane;
    const float* mu = F.A.in[I_MU] + (size_t)m * D;
    for (int r = F.bid * 8 + F.wave; r < MT; r += F.G * 8) {
        const int sl = (r < ML) ? SEQ : CTXL, t = (r < ML) ? (r % SEQ) : ((r - ML) % CTXL);
        const bool hp = t > 0, hn = t < sl - 1;
#pragma unroll
        for (int i = 0; i < 4; ++i) {
            const int col = i * 512 + lane * 8;
            const u32x4 c = *(const u32x4*)(H + (size_t)r * D + col);
            u32x4 p = (u32x4){0u, 0u, 0u, 0u}, n = (u32x4){0u, 0u, 0u, 0u};
            if (hp) p = *(const u32x4*)(H + (size_t)(r - 1) * D + col);
            if (hn) n = *(const u32x4*)(H + (size_t)(r + 1) * D + col);
            const f32x4 m0 = *(const f32x4*)(mu + col), m1 = *(const f32x4*)(mu + col + 4);
            u32x4 o;
#pragma unroll
            for (int q = 0; q < 4; ++q) {
                const float cl = bf_lo(c[q]), ch = bf_hi(c[q]);
                const float xl = 0.5f * (bf_lo(p[q]) + bf_lo(n[q])) - cl, xh = 0.5f * (bf_hi(p[q]) + bf_hi(n[q])) - ch;
                const float ml = (q < 2) ? m0[2 * q] : m1[2 * q - 4], mh = (q < 2) ? m0[2 * q + 1] : m1[2 * q - 3];
                o[q] = cvt_pk_bf16(cl + xl * ml, ch + xh * mh);
            }
            *(u32x4*)(XM + (size_t)r * D + col) = o;
        }
    }
}

constexpr int SC_T = 32, SC_NCH = (CTXL + SEQ) / SC_T;
constexpr int SC_BUF = 5 * SC_T * 64 * 4 + SC_T * 32 * 4;
struct ScanRaw { u32x4 r, k, e, a; u32x2 v; };
__device__ __forceinline__ int scan_row(int dir, int b, int s) {
    if (s < CTXL) return ML + b * CTXL + (dir ? CTXL - 1 - s : s);
    const int t = s - CTXL; return b * SEQ + (dir ? SEQ - 1 - t : t);
}
__device__ __forceinline__ void ph_scan(const Frame& F, const bf16_t* Rb, const bf16_t* Kb, const bf16_t* Vb, const bf16_t* DEC0, const bf16_t* DEC1, const bf16_t* AS0, const bf16_t* AS1,
                                        bf16_t* Y0, bf16_t* Y1, float* CB) {
    const int tid = F.tid, lane = F.lane, wave = F.wave;
    LAS float* ybuf = (LAS float*)(F.lds + 2 * SC_BUF);
    for (int item = F.bid; item < 256; item += F.G) {
        const int dir = item >> 7, b = (item >> 6) & 1, head = (item >> 1) & 31, half = item & 1;
        const bf16_t* DEC = dir ? DEC1 : DEC0; const bf16_t* AS = dir ? AS1 : AS0; bf16_t* Y = dir ? Y1 : Y0;
        const int hc = head * 64;
        if (wave >= 4) {
            const int lt = tid - 256, st = lt >> 3, sg = lt & 7;
            f32x4 kk0 = *(const f32x4*)(F.A.in[I_KK] + hc + sg * 8), kk1 = *(const f32x4*)(F.A.in[I_KK] + hc + sg * 8 + 4);
            f32x4 ka0 = *(const f32x4*)(F.A.in[I_KA] + hc + sg * 8), ka1 = *(const f32x4*)(F.A.in[I_KA] + hc + sg * 8 + 4);
            f32x4 rk0 = *(const f32x4*)(F.A.in[I_RK] + hc + sg * 8), rk1 = *(const f32x4*)(F.A.in[I_RK] + hc + sg * 8 + 4);
            ScanRaw cur, nxt;
            auto ld = [&](int ch, ScanRaw& R) {
                const int row = scan_row(dir, b, ch * SC_T + st); const size_t o = (size_t)row * D + hc + sg * 8;
                R.r = *(const u32x4*)(Rb + o); R.k = *(const u32x4*)(Kb + o); R.e = *(const u32x4*)(DEC + o); R.a = *(const u32x4*)(AS + o);
                R.v = *(const u32x2*)(Vb + (size_t)row * D + hc + half * 32 + sg * 4);
            };
            auto put = [&](int ch, const ScanRaw& R) {
                LAS float* bw = (LAS float*)(F.lds + (ch & 1) * SC_BUF);
                float r_[8], k_[8], e_[8], a_[8], kkv[8], kav[8], rkv[8];
#pragma unroll
                for (int q = 0; q < 4; ++q) { r_[2 * q] = bf_lo(R.r[q]); r_[2 * q + 1] = bf_hi(R.r[q]); k_[2 * q] = bf_lo(R.k[q]); k_[2 * q + 1] = bf_hi(R.k[q]);
                    e_[2 * q] = bf_lo(R.e[q]); e_[2 * q + 1] = bf_hi(R.e[q]); a_[2 * q] = bf_lo(R.a[q]); a_[2 * q + 1] = bf_hi(R.a[q]);
                    kkv[q] = kk0[q]; kkv[4 + q] = kk1[q]; kav[q] = ka0[q]; kav[4 + q] = ka1[q]; rkv[q] = rk0[q]; rkv[4 + q] = rk1[q]; }
                float ss = 0.f, cb = 0.f, kkr[8], kd[8];
#pragma unroll
                for (int q = 0; q < 8; ++q) { kkr[q] = k_[q] * kkv[q]; ss += kkr[q] * kkr[q]; kd[q] = k_[q] * (1.f + (a_[q] - 1.f) * kav[q]); cb += r_[q] * kd[q] * rkv[q]; }
                ss += __shfl_xor(ss, 1); ss += __shfl_xor(ss, 2); ss += __shfl_xor(ss, 4);
                cb += __shfl_xor(cb, 1); cb += __shfl_xor(cb, 2); cb += __shfl_xor(cb, 4);
                const float rn = rsqrtf(ss + 1e-12f);
                LAS float* p = bw + st * 64 + sg * 8;
#pragma unroll
                for (int q = 0; q < 8; ++q) { const float kkn = kkr[q] * rn;
                    p[0 * SC_T * 64 + q] = __expf(-e_[q]);
                    p[1 * SC_T * 64 + q] = -kkn;
                    p[2 * SC_T * 64 + q] = kkn * a_[q];
                    p[3 * SC_T * 64 + q] = kd[q];
                    p[4 * SC_T * 64 + q] = r_[q]; }
                LAS float* pv = bw + 5 * SC_T * 64 + st * 32 + sg * 4;
                pv[0] = bf_lo(R.v[0]); pv[1] = bf_hi(R.v[0]); pv[2] = bf_lo(R.v[1]); pv[3] = bf_hi(R.v[1]);
                const int s = ch * SC_T + st;
                if (half == 0 && sg == 0 && s >= CTXL) CB[((size_t)dir * ML + scan_row(dir, b, s)) * 32 + head] = cb;
            };
            auto flush = [&](int ch) {
                if (ch * SC_T < CTXL) return;
                const LAS float* yb = ybuf + (ch & 1) * (SC_T * 32) + st * 32 + sg * 4;
                const int row = scan_row(dir, b, ch * SC_T + st);
                u32x2 o; o[0] = cvt_pk_bf16(yb[0], yb[1]); o[1] = cvt_pk_bf16(yb[2], yb[3]);
                *(u32x2*)(Y + (size_t)row * D + hc + half * 32 + sg * 4) = o;
            };
            ld(0, cur); put(0, cur); ld(1, cur);
            __syncthreads();
            for (int ch = 0; ch < SC_NCH; ++ch) {
                if (ch + 2 < SC_NCH) ld(ch + 2, nxt);
                if (ch + 1 < SC_NCH) put(ch + 1, cur);
                if (ch >= 1) flush(ch - 1);
                cur = nxt;
                __syncthreads();
            }
            flush(SC_NCH - 1);
        } else {
            const int rw = wave * 8 + (lane >> 3), sg = lane & 7;
            float S[8];
#pragma unroll
            for (int q = 0; q < 8; ++q) S[q] = 0.f;
            __syncthreads();
            for (int ch = 0; ch < SC_NCH; ++ch) {
                const LAS float* bw = (const LAS float*)(F.lds + (ch & 1) * SC_BUF);
                LAS float* yb = ybuf + (ch & 1) * (SC_T * 32);
#pragma unroll 2
                for (int st = 0; st < SC_T; ++st) {
                    const LAS float* p = bw + st * 64 + sg * 8;
                    const f32x4 w0 = *(const LAS f32x4*)(p), w1 = *(const LAS f32x4*)(p + 4);
                    const f32x4 a0 = *(const LAS f32x4*)(p + SC_T * 64), a1 = *(const LAS f32x4*)(p + SC_T * 64 + 4);
                    const f32x4 b0 = *(const LAS f32x4*)(p + 2 * SC_T * 64), b1 = *(const LAS f32x4*)(p + 2 * SC_T * 64 + 4);
                    const f32x4 k0 = *(const LAS f32x4*)(p + 3 * SC_T * 64), k1 = *(const LAS f32x4*)(p + 3 * SC_T * 64 + 4);
                    const f32x4 r0 = *(const LAS f32x4*)(p + 4 * SC_T * 64), r1 = *(const LAS f32x4*)(p + 4 * SC_T * 64 + 4);
                    const float vv = bw[5 * SC_T * 64 + st * 32 + rw];
                    float sa = S[0] * a0[0] + S[1] * a0[1] + S[2] * a0[2] + S[3] * a0[3] + S[4] * a1[0] + S[5] * a1[1] + S[6] * a1[2] + S[7] * a1[3];
                    sa += __shfl_xor(sa, 1); sa += __shfl_xor(sa, 2); sa += __shfl_xor(sa, 4);
#pragma unroll
                    for (int q = 0; q < 4; ++q) { S[q] = S[q] * w0[q] + sa * b0[q] + vv * k0[q]; S[4 + q] = S[4 + q] * w1[q] + sa * b1[q] + vv * k1[q]; }
                    float y = S[0] * r0[0] + S[1] * r0[1] + S[2] * r0[2] + S[3] * r0[3] + S[4] * r1[0] + S[5] * r1[1] + S[6] * r1[2] + S[7] * r1[3];
                    y += __shfl_xor(y, 1); y += __shfl_xor(y, 2); y += __shfl_xor(y, 4);
                    if (sg == 0) yb[st * 32 + rw] = y;
                }
                __syncthreads();
            }
        }
        __syncthreads();
    }
}

__device__ __forceinline__ void ph_rwkv_out(const Frame& F, const bf16_t* Y0, const bf16_t* Y1, const bf16_t* Vb, const bf16_t* Gb, const float* CB, bf16_t* Z) {
    const int lane = F.lane;
    for (int r = F.bid * 8 + F.wave; r < ML; r += F.G * 8) {
        const size_t ro = (size_t)r * D + lane * 32;
        float y[32];
#pragma unroll
        for (int q = 0; q < 4; ++q) { const u32x4 a = *(const u32x4*)(Y0 + ro + q * 8), bq = *(const u32x4*)(Y1 + ro + q * 8);
#pragma unroll
            for (int j = 0; j < 4; ++j) { y[q * 8 + 2 * j] = bf_lo(a[j]) + bf_lo(bq[j]); y[q * 8 + 2 * j + 1] = bf_hi(a[j]) + bf_hi(bq[j]); } }
        float s = 0.f;
#pragma unroll
        for (int j = 0; j < 32; ++j) s += y[j];
        s += __shfl_xor(s, 1);
        const float mu = s * (1.f / 64.f);
        float vs = 0.f;
#pragma unroll
        for (int j = 0; j < 32; ++j) { const float d = y[j] - mu; vs += d * d; }
        vs += __shfl_xor(vs, 1);
        const float rstd = rsqrtf(vs * (1.f / 64.f) + 64e-5f);
        const int head = lane >> 1;
        const float cb = CB[(size_t)r * 32 + head] + CB[((size_t)ML + r) * 32 + head];
        const float* lw = F.A.in[I_LNW] + lane * 32; const float* lb = F.A.in[I_LNB] + lane * 32;
#pragma unroll
        for (int q = 0; q < 4; ++q) { const u32x4 vv = *(const u32x4*)(Vb + ro + q * 8), gg = *(const u32x4*)(Gb + ro + q * 8);
            u32x4 o;
#pragma unroll
            for (int j = 0; j < 4; ++j) { const int c = q * 8 + 2 * j;
                const float z0 = ((y[c] - mu) * rstd * lw[c] + lb[c] + cb * bf_lo(vv[j])) * bf_lo(gg[j]);
                const float z1 = ((y[c + 1] - mu) * rstd * lw[c + 1] + lb[c + 1] + cb * bf_hi(vv[j])) * bf_hi(gg[j]);
                o[j] = cvt_pk_bf16(z0, z1); }
            *(u32x4*)(Z + ro + q * 8) = o; }
    }
}

__device__ __forceinline__ void moe_prefix(const Frame& F, int layer, LAS int*& pref, LAS int*& cntl) {
    pref = (LAS int*)(F.lds + 131072 + 1024); cntl = pref + 40;
    __syncthreads();
    if (F.tid == 0) { const int* cnt = WSP(int, WS_CTL + CTL_CNT) + layer * NEXP; int s = 0; for (int e = 0; e < NEXP; ++e) { const int c = cnt[e]; cntl[e] = c; pref[e] = s; s += (c + 255) >> 8; } pref[NEXP] = s; }
    __syncthreads();
}
__device__ __forceinline__ void ph_moe_up(const Frame& F, int layer, const bf16_t* H, const bf16_t* W13, bf16_t* HID) {
    LAS int* pref; LAS int* cntl; moe_prefix(F, layer, pref, cntl);
    MoeSched S{pref, cntl, WSP(int, WS_TOKL), 4, F.G, F.bid, D, 2 * FF, true};
    pg8::EpiMoeUp E{HID};
    pg8::gemm_phase(F.lds, H, W13, D, S, E);
}
__device__ __forceinline__ void ph_moe_down(const Frame& F, int layer, const bf16_t* HID, const bf16_t* W2T, bf16_t* YS) {
    LAS int* pref; LAS int* cntl; moe_prefix(F, layer, pref, cntl);
    MoeSched S{pref, cntl, WSP(int, WS_TOKL), 8, F.G, F.bid, FF, D, false};
    pg8::EpiStoreBf16<0> E{YS, D, nullptr, 0, 0};
    pg8::gemm_phase(F.lds, HID, W2T, FF, S, E);
}
template <int ACT>
__device__ __forceinline__ void ph_gemm_bf16(const Frame& F, const bf16_t* A, const bf16_t* Bt, int M, int N, int K, bf16_t* O, int ldc, const float* vec, int split_cols, size_t split_stride) {
    pg8::DenseSched S; S.init(M, N, K, F.G, F.bid);
    pg8::EpiStoreBf16<ACT> E{O, ldc, vec, split_cols, split_stride};
    pg8::gemm_phase(F.lds, A, Bt, K, S, E);
}
__device__ __forceinline__ void ph_gemm_res(const Frame& F, const bf16_t* A, const bf16_t* Bt, int M, const float* xin_l, float* out_l, const float* xin_c, float* out_c, const float* gate) {
    pg8::DenseSched S; S.init(M, D, D, F.G, F.bid);
    pg8::EpiRes E{xin_l, out_l, xin_c, out_c, gate};
    pg8::gemm_phase(F.lds, A, Bt, D, S, E);
}

constexpr int LDS_BYTES = 131072 + 16384;
constexpr int N_PHASES = 33;
__global__ void __launch_bounds__(NTHR, 2) fwd(Args args) {
    extern __shared__ __attribute__((aligned(16))) unsigned char lds_raw[];
    Frame F(args);
    F.out = args.out; F.ws = args.ws; F.lds = (LAS unsigned char*)lds_raw;
    F.tid = threadIdx.x; F.lane = F.tid & 63; F.wave = __builtin_amdgcn_readfirstlane(F.tid >> 6); F.G = gridDim.x; F.bid = blockIdx.x;
    volatile LAS unsigned* misc = (volatile LAS unsigned*)(F.lds + 131072);
    if (F.tid < 4) misc[F.tid] = 0u;
    __syncthreads();
    XcdBarrier bar; bar.bar = (unsigned*)(F.ws + WS_CTL); bar.x = 0; bar.st = misc;
    const int lo = args.ph_lo, hi = args.ph_hi;
    if (hi - lo > 1) bar = xcd_barrier_post((unsigned*)(F.ws + WS_CTL), misc);
#ifndef PH_ONLY
#define PH_ONLY -1
#endif
#define IN(k) ((PH_ONLY < 0 || PH_ONLY == (k)) && lo <= (k) && (k) < hi)
#define SEAM(k) do { if (IN(k) && IN((k) + 1)) xcd_barrier(bar); } while (0)
    bf16_t* const S0 = WSP(bf16_t, SLOTP(0)); bf16_t* const S1 = WSP(bf16_t, SLOTP(1)); bf16_t* const S2 = WSP(bf16_t, SLOTP(2)); bf16_t* const S3 = WSP(bf16_t, SLOTP(3));
    bf16_t* const S4 = WSP(bf16_t, SLOTP(4)); bf16_t* const S5 = WSP(bf16_t, SLOTP(5)); bf16_t* const S6 = WSP(bf16_t, SLOTP(6)); bf16_t* const S7 = WSP(bf16_t, SLOTP(7));
    bf16_t* const S8 = WSP(bf16_t, SLOTP(8));
    float* const XC = WSP(float, WS_XC);
    float* const CB = WSP(float, WS_CB);
    const size_t W2OFF = (size_t)NEXP * 2 * FF * D;

    if (IN(0)) ph_prologue(F);
    SEAM(0);
    if (IN(1)) { RowOpts O{F.A.in[I_X], F.A.in[I_CTX], MT, false, 0, nullptr, nullptr, nullptr, true, 0, 0, S0, false}; ph_rows(F, O); }
    SEAM(1);
    if (IN(2)) ph_gemm_bf16<0>(F, S0, WSP(bf16_t, WT_IN), MT, QKVC, D, S1, QKVC, nullptr, 0, 0);
    SEAM(2);
    if (IN(3)) ph_qknorm(F, S1);
    SEAM(3);
    if (IN(4)) ph_attn(F, S1, S4);
    SEAM(4);
    if (IN(5)) ph_gemm_res(F, S4, WSP(bf16_t, WT_OUT), MT, F.A.in[I_X], F.out, F.A.in[I_CTX], XC, mod_row(F, 0, 0) + 2 * D);
    SEAM(5);
    if (IN(6)) { RowOpts O{F.out, XC, MT, false, 0, nullptr, nullptr, nullptr, true, 0, 1, S0, true}; ph_rows(F, O); }
    SEAM(6);
    if (IN(7)) ph_moe_up(F, 0, S0, S6, S5);
    SEAM(7);
    if (IN(8)) ph_moe_down(F, 0, S5, S6 + W2OFF, S1);
    SEAM(8);
    if (IN(9)) { RowOpts O{F.out, XC, MT, true, 0, S1, F.out, XC, true, 1, 0, S0, false}; ph_rows(F, O); }
    SEAM(9);
    if (IN(10)) ph_mix(F, S0, S1, 1);
    SEAM(10);
    if (IN(11)) ph_gemm_bf16<1>(F, S1, WSP(bf16_t, WT_W1), MT, 256, D, WSP(bf16_t, WS_TW), 256, nullptr, 0, 0);
    SEAM(11);
    if (IN(12)) ph_mix(F, S0, S1, 4);
    SEAM(12);
    if (IN(13)) ph_gemm_bf16<0>(F, S1, WSP(bf16_t, WT_A1), MT, 256, D, WSP(bf16_t, WS_TA), 256, nullptr, 0, 0);
    SEAM(13);
    if (IN(14)) ph_mix(F, S0, S1, 5);
    SEAM(14);
    if (IN(15)) ph_gemm_bf16<2>(F, S1, WSP(bf16_t, WT_G1), MT, 256, D, WSP(bf16_t, WS_TG), 256, nullptr, 0, 0);
    SEAM(15);
    if (IN(16)) ph_mix(F, S0, S1, 0);
    SEAM(16);
    if (IN(17)) ph_gemm_bf16<0>(F, S1, WSP(bf16_t, WT_R), MT, D, D, S3, D, nullptr, 0, 0);
    SEAM(17);
    if (IN(18)) ph_mix(F, S0, S1, 2);
    SEAM(18);
    if (IN(19)) ph_gemm_bf16<0>(F, S1, WSP(bf16_t, WT_K), MT, D, D, S4, D, nullptr, 0, 0);
    SEAM(19);
    if (IN(20)) ph_mix(F, S0, S1, 3);
    SEAM(20);
    if (IN(21)) ph_gemm_bf16<0>(F, S1, WSP(bf16_t, WT_V), MT, D, D, S5, D, nullptr, 0, 0);
    SEAM(21);
    if (IN(22)) ph_gemm_bf16<3>(F, WSP(bf16_t, WS_TW), WSP(bf16_t, WT_W2), MT, 2 * D, 256, S0, D, F.A.in[I_W0], D, (size_t)(SLOTP(1) - SLOTP(0)) / 2);
    SEAM(22);
    if (IN(23)) ph_gemm_bf16<4>(F, WSP(bf16_t, WS_TA), WSP(bf16_t, WT_A2), MT, 2 * D, 256, S2, D, F.A.in[I_A0], D, (size_t)(SLOTP(6) - SLOTP(2)) / 2);
    SEAM(23);
    if (IN(24)) ph_scan(F, S3, S4, S5, S0, S1, S2, S6, S7, S8, CB);
    SEAM(24);
    if (IN(25)) ph_gemm_bf16<0>(F, WSP(bf16_t, WS_TG), WSP(bf16_t, WT_G2), ML, D, 256, S3, D, nullptr, 0, 0);
    SEAM(25);
    if (IN(26)) ph_rwkv_out(F, S7, S8, S5, S3, CB, S4);
    SEAM(26);
    if (IN(27)) ph_gemm_res(F, S4, WSP(bf16_t, WT_O), ML, F.out, F.out, XC, XC, mod_row(F, 1, 0) + 2 * D);
    SEAM(27);
    if (IN(28)) { int base = 0; cvt_moe(F, 1, S1, S1 + W2OFF, base); }
    SEAM(28);
    if (IN(29)) { RowOpts O{F.out, XC, ML, false, 0, nullptr, nullptr, nullptr, true, 1, 1, S0, true}; ph_rows(F, O); }
    SEAM(29);
    if (IN(30)) ph_moe_up(F, 1, S0, S1, S5);
    SEAM(30);
    if (IN(31)) ph_moe_down(F, 1, S5, S1 + W2OFF, S6);
    SEAM(31);
    if (IN(32)) { RowOpts O{F.out, XC, ML, true, 1, S6, F.out, XC, false, 1, 0, nullptr, false}; ph_rows(F, O); }
#undef IN
#undef SEAM
}

extern "C" void kernel_launch(void* const* d_in, const int* in_sizes, int n_in, void* d_out, int out_size, void* d_ws, size_t ws_size, hipStream_t stream) {
    static int grid = 0;
    if (grid == 0) {
        if (n_in != 39 || out_size != ML * D || ws_size < WS_END) { fprintf(stderr, "kernel_launch: unexpected shapes (n_in %d out %d ws %zu need %zu)\n", n_in, out_size, ws_size, (size_t)WS_END); grid = -1; return; }
        int dev = 0, cus = 0;
        if (hipGetDevice(&dev) != hipSuccess || hipDeviceGetAttribute(&cus, hipDeviceAttributeMultiprocessorCount, dev) != hipSuccess) { grid = -1; return; }
        if (hipFuncSetAttribute((const void*)fwd, hipFuncAttributeMaxDynamicSharedMemorySize, LDS_BYTES) != hipSuccess) { fprintf(stderr, "kernel_launch: hipFuncSetAttribute failed\n"); grid = -1; return; }
        int per_cu = 0;
        if (hipOccupancyMaxActiveBlocksPerMultiprocessor(&per_cu, (const void*)fwd, NTHR, LDS_BYTES) != hipSuccess || per_cu < 1) { fprintf(stderr, "kernel_launch: occupancy query says %d\n", per_cu); }
        (void)hipGetLastError();
        grid = cus;
    }
    if (grid < 0) return;
    (void)hipMemsetAsync((char*)d_ws + WS_CTL, 0, CTL_BYTES, stream);
    Args a{};
    for (int i = 0; i < 39; ++i) a.in[i] = (const float*)d_in[i];
    a.out = (float*)d_out; a.ws = (unsigned char*)d_ws;
#if ONE_LAUNCH
    a.ph_lo = 0; a.ph_hi = N_PHASES;
    hipLaunchKernelGGL(fwd, dim3(grid), dim3(NTHR), LDS_BYTES, stream, a);
#else
    for (int p = 0; p < 33; ++p) { a.ph_lo = p; a.ph_hi = p + 1; hipLaunchKernelGGL(fwd, dim3(grid), dim3(NTHR), LDS_BYTES, stream, a); }
#endif
}
```

```cpp
#include <hip/hip_runtime.h>
#include <stdint.h>
#include <stdio.h>

#ifndef ONE_LAUNCH
#define ONE_LAUNCH 1
#endif
#ifndef PROBE_MASK
#define PROBE_MASK 0ull
#endif

#define LAS __attribute__((address_space(3)))
typedef unsigned short bf16_t;
typedef short bf16x8 __attribute__((ext_vector_type(8)));
typedef float f32x4 __attribute__((ext_vector_type(4)));
typedef float f32x2 __attribute__((ext_vector_type(2)));
typedef unsigned u32x4 __attribute__((ext_vector_type(4)));
typedef unsigned u32x2 __attribute__((ext_vector_type(2)));

constexpr int D = 2048, NB = 2, SEQ = 16384, ML = NB * SEQ, CTXL = 256, MC = NB * CTXL, MT = ML + MC;
constexpr int QKVC = 4608, QA0 = 0, KA0 = 1024, VA0 = 1280, QB0 = 1536, KB0 = 2560, VB0 = 3584;
constexpr int NEXP = 32, FF = 512, MAXSLOT = 2 * MT + NEXP * 256;
constexpr int MODW = 6 * D;
constexpr int NTHR = 512;
constexpr int MISC_OFF = 131072 + 16384 - 2048;

constexpr size_t MiB = 1ull << 20;
constexpr size_t WS_CTL = 0;
constexpr size_t CTL_BYTES = 64 * 1024;
constexpr size_t CTL_CNT = 16384;
constexpr size_t WS_MOD = 1 * MiB;
constexpr size_t WS_XC = 2 * MiB;
constexpr size_t WS_TOKL = 6 * MiB;
constexpr size_t WS_TOKSEL = 11 * MiB;
constexpr size_t WS_TOKGATE = 11 * MiB + 512 * 1024;
constexpr size_t WS_CB = 12 * MiB;
constexpr size_t WS_WT = 20 * MiB;
constexpr size_t WT_IN = WS_WT, WT_OUT = WS_WT + 18 * MiB, WT_R = WS_WT + 26 * MiB, WT_K = WS_WT + 34 * MiB, WT_V = WS_WT + 42 * MiB, WT_O = WS_WT + 50 * MiB;
constexpr size_t WT_W1 = WS_WT + 58 * MiB, WT_A1 = WS_WT + 59 * MiB, WT_G1 = WS_WT + 60 * MiB, WT_W2 = WS_WT + 61 * MiB, WT_A2 = WS_WT + 63 * MiB, WT_G2 = WS_WT + 65 * MiB;
constexpr size_t WS_TW = 86 * MiB, WS_TA = 103 * MiB, WS_TG = 120 * MiB;
constexpr size_t WS_SLOT0 = 140 * MiB, SLOT = 130 * MiB;
constexpr size_t WS_END = WS_SLOT0 + 9 * SLOT;
#define SLOTP(k) (WS_SLOT0 + (size_t)(k) * SLOT)

typedef __bf16 bf16x2_t __attribute__((ext_vector_type(2)));
__device__ __forceinline__ unsigned cvt_pk_bf16(float lo, float hi) { f32x2 v = {lo, hi}; bf16x2_t r = __builtin_convertvector(v, bf16x2_t); return *reinterpret_cast<unsigned*>(&r); }
__device__ __forceinline__ float bf_lo(unsigned u) { return __uint_as_float(u << 16); }
__device__ __forceinline__ float bf_hi(unsigned u) { return __uint_as_float(u & 0xffff0000u); }
__device__ __forceinline__ float bf2f(bf16_t v) { return __uint_as_float(((unsigned)v) << 16); }
__device__ __forceinline__ float wave_sum(float v) { for (int o = 32; o; o >>= 1) v += __shfl_xor(v, o); return v; }
__device__ __forceinline__ float wave_max(float v) { for (int o = 32; o; o >>= 1) v = fmaxf(v, __shfl_xor(v, o)); return v; }
__device__ __forceinline__ float sigmoidf_(float x) { return 1.f / (1.f + __expf(-x)); }
__device__ __forceinline__ void lds_fence() { asm volatile("s_waitcnt lgkmcnt(0)" ::: "memory"); }

struct Args { const float* in[39]; float* out; unsigned char* ws; int ph_lo, ph_hi; };
struct Frame {
    const Args& A; float* out; unsigned char* ws; LAS unsigned char* lds;
    int wave, G, bid;
    __device__ __forceinline__ Frame(const Args& a) : A(a) {}
    __device__ __forceinline__ int lane_() const { return (int)threadIdx.x & 63; }
    __device__ __forceinline__ int tid_() const { return (int)threadIdx.x; }
};
enum { I_X = 0, I_C, I_CTX, I_CCTX, I_ADAW, I_ADAB, I_NMIX, I_NFFN, I_WIN, I_WOUT, I_AQG, I_AKG, I_ASINK, I_BQG, I_BKG, I_RPB, I_MU, I_WR, I_WK, I_WV, I_WO, I_W0, I_W1, I_W2,
       I_A0, I_A1, I_A2, I_G1, I_G2, I_KK, I_KA, I_RK, I_LNW, I_LNB, I_MGRP, I_MEXP, I_MW1, I_MW3, I_MW2 };

#define XB_TMO      128
#define XB_XCNT(j)  (256  + 64 * (j))
#define XB_XSUB(j)  (1280 + 64 * (j))
#define XB_XGEN(j)  (2304 + 64 * (j))
#define XB_TOP      3328
#define XB_TOPGEN   3392
#define XCD_BAR_WORDS 3456
#define XB_SPIN_CAP (1u << 18)
__device__ __forceinline__ unsigned xb_ld(unsigned* p)              { return __hip_atomic_load(p, __ATOMIC_RELAXED, __HIP_MEMORY_SCOPE_AGENT); }
__device__ __forceinline__ unsigned xb_add(unsigned* p, unsigned v) { return __hip_atomic_fetch_add(p, v, __ATOMIC_RELAXED, __HIP_MEMORY_SCOPE_AGENT); }
__device__ __forceinline__ unsigned xb_xcc_id() { return (unsigned)__builtin_amdgcn_s_getreg((3 << 11) | 20) & 0xFu; }
#define XB_SPIN(cond, bar) do { unsigned _sp = 0; while (cond) { __builtin_amdgcn_s_sleep(1); \
    if ((++_sp & 255u) == 0u) { if (xb_ld(&(bar)[XB_TMO])) break; if (_sp > XB_SPIN_CAP) { atomicAdd(&(bar)[XB_TMO], 1u); break; } } } } while (0)
struct XcdBarrier { unsigned* bar; unsigned x; volatile LAS unsigned* st; };
__device__ __forceinline__ XcdBarrier xcd_barrier_post(unsigned* bar, volatile LAS unsigned* st) {
    XcdBarrier b; b.bar = bar; b.x = xb_xcc_id(); b.st = st;
    if (threadIdx.x == 0) (void)xb_add(&bar[XB_XCNT(b.x)], 1u);
    return b;
}
__device__ __forceinline__ void xcd_barrier_complete(unsigned* bar, unsigned x, unsigned& nloc, unsigned& nx) {
    const unsigned G = gridDim.x * gridDim.y * gridDim.z;
    unsigned sum, cnt, mine, sp = 0u;
    for (;;) {
        sum = 0u; cnt = 0u; mine = 0u;
#pragma unroll
        for (unsigned j = 0; j < 16; ++j) { const unsigned c = xb_ld(&bar[XB_XCNT(j)]); sum += c; cnt += (c > 0u) ? 1u : 0u; mine = (j == x) ? c : mine; }
        if (sum == G) break;
        __builtin_amdgcn_s_sleep(1);
        if ((++sp & 255u) == 0u) { if (xb_ld(&bar[XB_TMO])) break; if (sp > XB_SPIN_CAP) { atomicAdd(&bar[XB_TMO], 1u); break; } }
    }
    nloc = mine > 0u ? mine : 1u; nx = cnt > 0u ? cnt : 1u;
}
__device__ __forceinline__ void xcd_barrier(const XcdBarrier& b) {
    asm volatile("s_waitcnt vmcnt(0)" ::: "memory");
    __syncthreads();
    if (threadIdx.x == 0) {
        unsigned* bar = b.bar;
        __builtin_amdgcn_s_waitcnt(0);
        unsigned nloc = b.st[0], nx = b.st[1];
        if (nloc == 0u) { xcd_barrier_complete(bar, b.x, nloc, nx); b.st[0] = nloc; b.st[1] = nx; }
        const unsigned old = xb_add(&bar[XB_XSUB(b.x)], 1u);
        const unsigned gen = old / nloc;
        if (old + 1u == (gen + 1u) * nloc) {
            __builtin_amdgcn_fence(__ATOMIC_RELEASE, "agent");
            asm volatile("s_waitcnt vmcnt(0)" ::: "memory");
            const unsigned og = xb_add(&bar[XB_TOP], 1u);
            const unsigned tg = og / nx;
            if (og + 1u == (tg + 1u) * nx) xb_add(&bar[XB_TOPGEN], 1u);
            else XB_SPIN(xb_ld(&bar[XB_TOPGEN]) == tg, bar);
            __builtin_amdgcn_fence(__ATOMIC_ACQUIRE, "agent");
            xb_add(&bar[XB_XGEN(b.x)], 1u);
            asm volatile("s_waitcnt vmcnt(0)" ::: "memory");
        } else {
            XB_SPIN(xb_ld(&bar[XB_XGEN(b.x)]) == gen, bar);
            __builtin_amdgcn_fence(__ATOMIC_ACQUIRE, "agent");
            asm volatile("s_waitcnt vmcnt(0)" ::: "memory");
        }
    }
    __syncthreads();
}

namespace pg8 {
constexpr int BM = 256, BK = 64, HALF = 128, HTB = HALF * BK * 2, STAGE_BYTES = 8 * HTB, NXCD = 8, WGM = 8;
__host__ __device__ __forceinline__ int lds_byte(int r, int c) { const int st = (r >> 4) * 2 + (c >> 5), rr = r & 15, cc = c & 31, ob = rr * 64 + cc * 2; return st * 1024 + (ob ^ (((ob >> 9) & 1) << 5)); }
__host__ __device__ __forceinline__ void stage_rc(int b, int& R, int& C) { const int st = b / 1024, sb = b % 1024, swz = sb ^ (((sb >> 9) & 1) << 5); R = (st >> 1) * 16 + swz / 64; C = (st & 1) * 32 + (swz % 64) / 2; }
__host__ __device__ __forceinline__ int perm32(int rho) { const int n = rho >> 4, i = rho & 15; return 8 * (i >> 2) + 4 * n + (i & 3); }

struct Unit { int arow0, brow0, col0, e, pbase, cnt; };

struct DenseSched {
    int nM, nN, nwg, G, c, K;
    __device__ void init(int M, int N, int K_, int G_, int c_) { nM = M / BM; nN = N / BM; nwg = nM * nN; G = G_; c = c_; K = K_; }
    __device__ bool next(int i, Unit& u) const {
        const long L = (long)i * G + c; if (L >= nwg) return false;
        int wgid = (int)L; { const int q = nwg / NXCD, r = nwg % NXCD, xcd = wgid % NXCD, off = wgid / NXCD; wgid = (xcd < r ? xcd * (q + 1) : r * (q + 1) + (xcd - r) * q) + off; }
        const int nig = WGM * nN, gid = wgid / nig, fm = gid * WGM, gsz = (nM - fm) < WGM ? (nM - fm) : WGM;
        const int pm = fm + ((wgid % nig) % gsz), pn = (wgid % nig) / gsz;
        u.arow0 = pm * BM; u.brow0 = pn * BM; u.col0 = pn * BM; u.e = 0; u.pbase = 0; u.cnt = 0; return true;
    }
    __device__ __forceinline__ unsigned a_off(const Unit& u, int r, int C) const { return (unsigned)((u.arow0 + r) * K + C) * 2u; }
};

template <class Epi, class Sched>
__device__ __forceinline__ void gemm_phase(LAS unsigned char* lds, const bf16_t* A, const bf16_t* Bt, const int K, const Sched& S, const Epi& E) {
    const int tid = threadIdx.x, wid = __builtin_amdgcn_readfirstlane(tid >> 6), lane = tid & 63, wr = wid >> 2, wc = wid & 3, fr = lane & 15, fq = lane >> 4;
    const int nt = K / BK;
    int Rr[2], Cc[2]; unsigned voffB[2];
#pragma unroll
    for (int i = 0; i < 2; ++i) { int R, C; stage_rc(tid * 16 + i * 8192, R, C); const int Rb = Epi::PERM ? ((R & ~31) + perm32(R & 31)) : R;
        Rr[i] = R; Cc[i] = C; voffB[i] = (unsigned)(Rb * K + C) * 2u; }
    const size_t kstep = (size_t)(BK * 2);
    const size_t hstepB = (size_t)HALF * K * 2;
    const unsigned ldsw = (unsigned)wid * 1024u;
    const int aoff = lds_byte(wr * 64 + fr, fq * 8), boff = lds_byte(wc * 32 + fr, fq * 8);
#define PG8_SA(b, h) (((b) * 2 + (h)) * HTB)
#define PG8_SB(b, h) ((4 + (b) * 2 + (h)) * HTB)
#define PG8_STAGE(bufoff, gbase, voff) do { _Pragma("unroll") for (int _i = 0; _i < 2; ++_i) \
        __builtin_amdgcn_global_load_lds((const unsigned*)((const char*)(gbase) + (voff)[_i]), (LAS unsigned*)(lds + (bufoff) + ldsw + _i * 8192), 16, 0, 0); } while (0)
#define PG8_LDA(dst, b, h) do { _Pragma("unroll") for (int m = 0; m < 4; ++m) _Pragma("unroll") for (int k = 0; k < 2; ++k) dst[m][k] = *(const LAS bf16x8*)(lds + PG8_SA(b, h) + aoff + m * 2048 + k * 1024); } while (0)
#define PG8_LDB(dst, b, h) do { _Pragma("unroll") for (int n = 0; n < 2; ++n) _Pragma("unroll") for (int k = 0; k < 2; ++k) dst[n][k] = *(const LAS bf16x8*)(lds + PG8_SB(b, h) + boff + n * 2048 + k * 1024); } while (0)
#define PG8_MMA(ai, bj, At, Bt_) do { __builtin_amdgcn_s_setprio(1); _Pragma("unroll") for (int m = 0; m < 4; ++m) _Pragma("unroll") for (int n = 0; n < 2; ++n) _Pragma("unroll") for (int k = 0; k < 2; ++k) \
        acc[ai][bj][m][n] = __builtin_amdgcn_mfma_f32_16x16x32_bf16(Bt_[n][k], At[m][k], acc[ai][bj][m][n], 0, 0, 0); __builtin_amdgcn_s_setprio(0); } while (0)
#define PG8_WAIT_V(n) asm volatile("s_waitcnt vmcnt(" #n ")" ::: "memory")
#define PG8_WAIT_L(n) asm volatile("s_waitcnt lgkmcnt(" #n ")" ::: "memory")
#define PG8_BAR __builtin_amdgcn_s_barrier()
#define PG8_SCHED __builtin_amdgcn_sched_barrier(0)
    Unit cur, nxt; int ui = 0;
    if (!S.next(0, cur)) return;
    f32x4 acc[2][2][4][2];
#pragma unroll
    for (int a = 0; a < 2; ++a)
#pragma unroll
        for (int b = 0; b < 2; ++b)
#pragma unroll
            for (int m = 0; m < 4; ++m)
#pragma unroll
                for (int n = 0; n < 2; ++n) acc[a][b][m][n] = (f32x4){0.f, 0.f, 0.f, 0.f};
    bf16x8 At[4][2], B0[2][2], B1[2][2];
    unsigned oC0[2], oC1[2], oN0[2], oN1[2];
#pragma unroll
    for (int i = 0; i < 2; ++i) { oC0[i] = S.a_off(cur, Rr[i], Cc[i]); oC1[i] = S.a_off(cur, HALF + Rr[i], Cc[i]); }
    const char* gA = (const char*)A;
    const char* cB = (const char*)Bt + (size_t)cur.brow0 * K * 2;
    PG8_STAGE(PG8_SB(0, 0), cB, voffB); PG8_STAGE(PG8_SA(0, 0), gA, oC0); PG8_STAGE(PG8_SB(0, 1), cB + hstepB, voffB); PG8_STAGE(PG8_SA(0, 1), gA, oC1);
    if (wr == 1) PG8_BAR;
    PG8_WAIT_V(4); PG8_BAR;
    PG8_STAGE(PG8_SB(1, 0), cB + kstep, voffB); PG8_STAGE(PG8_SA(1, 0), gA + kstep, oC0); PG8_STAGE(PG8_SB(1, 1), cB + hstepB + kstep, voffB);
    PG8_WAIT_V(6); PG8_BAR;
    for (;;) {
        const bool has_next = S.next(ui + 1, nxt);
        if (has_next) {
#pragma unroll
            for (int i = 0; i < 2; ++i) { oN0[i] = S.a_off(nxt, Rr[i], Cc[i]); oN1[i] = S.a_off(nxt, HALF + Rr[i], Cc[i]); }
        } else {
#pragma unroll
            for (int i = 0; i < 2; ++i) { oN0[i] = oC0[i]; oN1[i] = oC1[i]; }
        }
        const char* nB = has_next ? (const char*)Bt + (size_t)nxt.brow0 * K * 2 : cB;
        for (int t = 0; t < nt; t += 2) {
            const bool last = (t == nt - 2);
            const char* a1 = gA + (size_t)(t + 1) * kstep;
            const char* a2 = last ? gA : gA + (size_t)(t + 2) * kstep; const char* b2 = last ? nB : cB + (size_t)(t + 2) * kstep;
            const char* a3 = a2 + kstep; const char* b3 = b2 + kstep;
            unsigned o20[2], o21[2];
#pragma unroll
            for (int i = 0; i < 2; ++i) { o20[i] = last ? oN0[i] : oC0[i]; o21[i] = last ? oN1[i] : oC1[i]; }
            PG8_LDB(B0, 0, 0); PG8_SCHED; PG8_LDA(At, 0, 0); PG8_STAGE(PG8_SA(1, 1), a1, oC1);
            PG8_WAIT_L(8); PG8_BAR; PG8_WAIT_L(0); PG8_MMA(0, 0, At, B0); PG8_BAR; PG8_SCHED;
            PG8_LDB(B1, 0, 1); PG8_STAGE(PG8_SB(0, 0), b2, voffB);
            PG8_BAR; PG8_WAIT_L(0); PG8_MMA(0, 1, At, B1); PG8_BAR;
            PG8_LDA(At, 0, 1); PG8_STAGE(PG8_SA(0, 0), a2, o20);
            PG8_BAR; PG8_WAIT_L(0); PG8_MMA(1, 0, At, B0); PG8_BAR; PG8_SCHED;
            PG8_STAGE(PG8_SB(0, 1), b2 + hstepB, voffB);
            PG8_WAIT_V(6); PG8_BAR; PG8_MMA(1, 1, At, B1); PG8_BAR;
            PG8_LDB(B0, 1, 0); PG8_SCHED; PG8_LDA(At, 1, 0); PG8_STAGE(PG8_SA(0, 1), a2, o21);
            PG8_WAIT_L(8); PG8_BAR; PG8_WAIT_L(0); PG8_MMA(0, 0, At, B0); PG8_BAR; PG8_SCHED;
            PG8_LDB(B1, 1, 1); PG8_STAGE(PG8_SB(1, 0), b3, voffB);
            PG8_BAR; PG8_WAIT_L(0); PG8_MMA(0, 1, At, B1); PG8_BAR;
            PG8_LDA(At, 1, 1); PG8_STAGE(PG8_SA(1, 0), a3, o20);
            PG8_BAR; PG8_WAIT_L(0); PG8_MMA(1, 0, At, B0); PG8_BAR; PG8_SCHED;
            PG8_STAGE(PG8_SB(1, 1), b3 + hstepB, voffB);
            PG8_WAIT_V(6); PG8_BAR; PG8_MMA(1, 1, At, B1); PG8_BAR;
        }
        E(acc, cur, wr, wc, fr, fq);
        if (!has_next) break;
#pragma unroll
        for (int a = 0; a < 2; ++a)
#pragma unroll
            for (int b = 0; b < 2; ++b)
#pragma unroll
                for (int m = 0; m < 4; ++m)
#pragma unroll
                    for (int n = 0; n < 2; ++n) acc[a][b][m][n] = (f32x4){0.f, 0.f, 0.f, 0.f};
        cur = nxt; cB = nB; ++ui;
#pragma unroll
        for (int i = 0; i < 2; ++i) { oC0[i] = oN0[i]; oC1[i] = oN1[i]; }
    }
    PG8_WAIT_V(0);
    if (wr == 0) PG8_BAR;
    PG8_BAR;
#undef PG8_SA
#undef PG8_SB
#undef PG8_STAGE
#undef PG8_LDA
#undef PG8_LDB
#undef PG8_MMA
#undef PG8_WAIT_V
#undef PG8_WAIT_L
#undef PG8_BAR
#undef PG8_SCHED
}

template <int ACT> struct EpiStoreBf16 {
    static constexpr bool PERM = true;
    bf16_t* O; int ldc; const float* vec; int split_cols; size_t split_stride;
    __device__ __forceinline__ float act(float v, float b) const {
        if (ACT == 1) return 2.f * sigmoidf_(2.f * v) - 1.f;
        if (ACT == 2) return sigmoidf_(v);
        if (ACT == 3) return 0.60653065971f * sigmoidf_(v + b);
        if (ACT == 4) return sigmoidf_(v + b);
        return v;
    }
    __device__ __forceinline__ void operator()(const f32x4 (&acc)[2][2][4][2], const Unit& u, int wr, int wc, int fr, int fq) const {
        const int row0 = u.arow0 + wr * 64 + fr; int colt = u.col0; bf16_t* base = O;
        if (split_cols) { const int t = colt / split_cols; base += (size_t)t * split_stride; colt -= t * split_cols; }
        const int col0 = colt + wc * 32 + 8 * fq, bcol0 = u.col0 + wc * 32 + 8 * fq;
#pragma unroll
        for (int bj = 0; bj < 2; ++bj) {
            const f32x4 b0 = (ACT >= 3) ? *(const f32x4*)(vec + bcol0 + bj * HALF) : (f32x4){0.f, 0.f, 0.f, 0.f}, b1 = (ACT >= 3) ? *(const f32x4*)(vec + bcol0 + bj * HALF + 4) : (f32x4){0.f, 0.f, 0.f, 0.f};
#pragma unroll
            for (int ai = 0; ai < 2; ++ai)
#pragma unroll
                for (int m = 0; m < 4; ++m) { bf16_t* rowp = base + (size_t)(row0 + ai * HALF + m * 16) * ldc + col0; const f32x4 v0 = acc[ai][bj][m][0], v1 = acc[ai][bj][m][1];
                {
                    u32x4 o; o[0] = cvt_pk_bf16(act(v0[0], b0[0]), act(v0[1], b0[1])); o[1] = cvt_pk_bf16(act(v0[2], b0[2]), act(v0[3], b0[3]));
                    o[2] = cvt_pk_bf16(act(v1[0], b1[0]), act(v1[1], b1[1])); o[3] = cvt_pk_bf16(act(v1[2], b1[2]), act(v1[3], b1[3]));
                    *(u32x4*)(rowp + bj * HALF) = o; } }
        }
    }
};
struct EpiRes {
    static constexpr bool PERM = false;
    const float* xin_l; float* out_l; const float* xin_c; float* out_c; const float* gate;
    __device__ __forceinline__ void operator()(const f32x4 (&acc)[2][2][4][2], const Unit& u, int wr, int wc, int fr, int fq) const {
        const int row0 = u.arow0 + wr * 64 + fr, col0 = u.col0 + wc * 32 + 4 * fq;
        const bool isc = u.arow0 >= ML;
        const int gb = isc ? 2 : (u.arow0 / SEQ);
        const float* gp = gate + (size_t)gb * MODW + col0;
        f32x4 gv[2][2];
#pragma unroll
        for (int bj = 0; bj < 2; ++bj)
#pragma unroll
            for (int n = 0; n < 2; ++n) gv[bj][n] = *(const f32x4*)(gp + bj * HALF + n * 16);
        const float* xi = isc ? xin_c - (size_t)ML * D : xin_l; float* xo = isc ? out_c - (size_t)ML * D : out_l;
#pragma unroll
        for (int ai = 0; ai < 2; ++ai)
#pragma unroll
            for (int m = 0; m < 4; ++m) { const size_t ro = (size_t)(row0 + ai * HALF + m * 16) * D + col0;
#pragma unroll
                for (int bj = 0; bj < 2; ++bj)
#pragma unroll
                    for (int n = 0; n < 2; ++n) { const f32x4 xv = *(const f32x4*)(xi + ro + bj * HALF + n * 16);
                        *(f32x4*)(xo + ro + bj * HALF + n * 16) = xv + gv[bj][n] * acc[ai][bj][m][n]; } }
    }
};
struct EpiMoeUp {
    static constexpr bool PERM = false;
    bf16_t* H;
    __device__ __forceinline__ void operator()(const f32x4 (&acc)[2][2][4][2], const Unit& u, int wr, int wc, int fr, int fq) const {
        const int row0 = u.arow0 + wr * 64 + fr;
#pragma unroll
        for (int ai = 0; ai < 2; ++ai)
#pragma unroll
            for (int m = 0; m < 4; ++m) { bf16_t* rowp = H + (size_t)(row0 + ai * HALF + m * 16) * FF;
#pragma unroll
                for (int bj = 0; bj < 2; ++bj) { const int j = (u.col0 + bj * HALF + wc * 32) / 2 + 4 * fq; const f32x4 a = acc[ai][bj][m][0], b = acc[ai][bj][m][1];
                    float h[4];
#pragma unroll
                    for (int i = 0; i < 4; ++i) h[i] = a[i] * sigmoidf_(a[i]) * b[i];
                    u32x2 o; o[0] = cvt_pk_bf16(h[0], h[1]); o[1] = cvt_pk_bf16(h[2], h[3]);
                    *(u32x2*)(rowp + j) = o; } }
    }
};
}

struct MoeSched {
    const LAS int* pref; const LAS int* cnt; const int* tokl; int nN, G, c, K, rowsB; bool gather;
    __device__ bool next(int i, pg8::Unit& u) const {
        const long L = (long)i * G + c; const int T = __builtin_amdgcn_readfirstlane(pref[NEXP]);
        if (L >= (long)T * nN) return false;
        const int tl = (int)(L / nN), pn = (int)(L % nN);
        int e = 0;
        for (int k = 1; k < NEXP; ++k) e = (pref[k] <= tl) ? k : e;
        e = __builtin_amdgcn_readfirstlane(e);
        u.e = e; u.pbase = __builtin_amdgcn_readfirstlane((tl - pref[e]) * 256); u.cnt = __builtin_amdgcn_readfirstlane(cnt[e]); u.arow0 = tl * 256; u.brow0 = e * rowsB + pn * 256; u.col0 = pn * 256; return true;
    }
    __device__ __forceinline__ unsigned a_off(const pg8::Unit& u, int r, int C) const {
        if (gather) { const int p = u.pbase + r; const int tok = (p < u.cnt) ? tokl[(size_t)u.e * MT + p] : 0; return (unsigned)(tok * K + C) * 2u; }
        return (unsigned)((u.arow0 + r) * K + C) * 2u;
    }
};

#define WSP(T, off) ((T*)(F.ws + (off)))
__device__ __forceinline__ const float* mod_row(const Frame& F, int layer, int row3) { return (const float*)(F.ws + WS_MOD) + ((size_t)layer * 3 + row3) * MODW; }

struct CvtJob { const float* src; const float* src2; bf16_t* dst; int Ksrc, Nsrc, ld_src, Kdst, Ndst, koff, grp_rows; size_t grp_stride; int mode; };
struct CvtRegs { f32x4 v[4]; };
__device__ __forceinline__ void cvt_load(const CvtJob& J, int tile, int tid, CvtRegs& R) {
    const int ktiles = J.Kdst / 64, nt = tile / ktiles, kt = tile % ktiles, n0 = nt * 128, k0 = kt * 64;
    const int e = n0 / J.grp_rows, nl0 = n0 % J.grp_rows;
    const int kr = tid >> 3, c8 = tid & 7;
    const int ks = k0 + kr - J.koff;
    const bool kok = (ks >= 0) && (ks < J.Ksrc);
#pragma unroll
    for (int cc = 0; cc < 2; ++cc) {
        const int nl = nl0 + (c8 + cc * 8) * 8;
        const float* sp = J.src + (size_t)e * J.grp_stride; int ncol = nl;
        if (J.mode == 1) { const int g = nl >> 5, w = nl & 31; sp = (w < 16 ? J.src : J.src2) + (size_t)e * J.grp_stride; ncol = g * 16 + (w & 15); }
        if (kok && ncol + 8 <= J.Nsrc) { const float* p = sp + (size_t)ks * J.ld_src + ncol; R.v[cc * 2] = *(const f32x4*)p; R.v[cc * 2 + 1] = *(const f32x4*)(p + 4); }
        else { R.v[cc * 2] = (f32x4){0.f, 0.f, 0.f, 0.f}; R.v[cc * 2 + 1] = (f32x4){0.f, 0.f, 0.f, 0.f}; }
    }
}
__device__ __forceinline__ void cvt_job(const Frame& F, const CvtJob& J, int& base) {
    const int ntiles = (J.Ndst / 128) * (J.Kdst / 64), tid = F.tid_();
    LAS float* tl = (LAS float*)F.lds;
    int t = ((F.bid - base) % F.G + F.G) % F.G;
    base = (base + ntiles) % F.G;
    if (t >= ntiles) return;
    CvtRegs cur, nxt; cvt_load(J, t, tid, cur);
    const int ktiles = J.Kdst / 64;
    for (; t < ntiles; t += F.G) {
        const bool hn = (t + F.G) < ntiles;
        if (hn) cvt_load(J, t + F.G, tid, nxt);
        const int kr = tid >> 3, c8 = tid & 7;
#pragma unroll
        for (int cc = 0; cc < 2; ++cc)
#pragma unroll
            for (int j = 0; j < 8; ++j) tl[kr * 129 + (c8 + cc * 8) * 8 + j] = cur.v[cc * 2 + (j >> 2)][j & 3];
        __syncthreads();
        const int nrow = tid >> 2, kq = tid & 3, nt = t / ktiles, kt = t % ktiles;
        float x[16];
#pragma unroll
        for (int j = 0; j < 16; ++j) x[j] = tl[(kq * 16 + j) * 129 + nrow];
        u32x4 o0, o1;
#pragma unroll
        for (int j = 0; j < 4; ++j) { o0[j] = cvt_pk_bf16(x[2 * j], x[2 * j + 1]); o1[j] = cvt_pk_bf16(x[8 + 2 * j], x[8 + 2 * j + 1]); }
        bf16_t* dp = J.dst + (size_t)(nt * 128 + nrow) * J.Kdst + kt * 64 + kq * 16;
        *(u32x4*)dp = o0; *(u32x4*)(dp + 8) = o1;
        __syncthreads();
        if (hn) cur = nxt;
    }
}
__device__ __forceinline__ void cvt_simple(const Frame& F, const float* src, bf16_t* dst, int Ksrc, int Nsrc, int& base) {
    CvtJob J{src, src, dst, Ksrc, Nsrc, Nsrc, Ksrc, Nsrc, 0, Nsrc, 0, 0}; cvt_job(F, J, base);
}
__device__ __forceinline__ void cvt_moe(const Frame& F, int layer, bf16_t* w13, bf16_t* w2t, int& base) {
    const size_t lo = (size_t)layer * NEXP * D * FF;
    CvtJob J1{F.A.in[I_MW1] + lo, F.A.in[I_MW3] + lo, w13, D, FF, FF, D, NEXP * 2 * FF, 0, 2 * FF, (size_t)D * FF, 1}; cvt_job(F, J1, base);
    CvtJob J2{F.A.in[I_MW2] + lo, F.A.in[I_MW2] + lo, w2t, FF, D, D, FF, NEXP * D, 0, D, (size_t)FF * D, 0}; cvt_job(F, J2, base);
}

__device__ __forceinline__ void ph_prologue(const Frame& F) {
    const int tid = F.tid_();
    {
        LAS float* cv = (LAS float*)F.lds;
        LAS float* red = (LAS float*)(F.lds + 32768);
        for (int k = tid; k < D; k += NTHR) {
            const float c0 = F.A.in[I_C][k], c1 = F.A.in[I_C][D + k], c2 = F.A.in[I_CCTX][k];
            cv[k] = c0 * sigmoidf_(c0); cv[D + k] = c1 * sigmoidf_(c1); cv[2 * D + k] = c2 * sigmoidf_(c2);
        }
        __syncthreads();
        for (int item = F.bid; item < 2 * 96; item += F.G) {
            const int l = item / 96, n0 = (item % 96) * 128, c4 = tid & 31, kg = tid >> 5;
            float a[3][4];
#pragma unroll
            for (int r = 0; r < 3; ++r)
#pragma unroll
                for (int j = 0; j < 4; ++j) a[r][j] = 0.f;
            const float* wp = F.A.in[I_ADAW] + (size_t)l * D * MODW + n0 + c4 * 4;
#pragma unroll 4
            for (int k = kg; k < D; k += 16) {
                const f32x4 w = *(const f32x4*)(wp + (size_t)k * MODW);
                const float s0 = cv[k], s1 = cv[D + k], s2 = cv[2 * D + k];
#pragma unroll
                for (int j = 0; j < 4; ++j) { a[0][j] += s0 * w[j]; a[1][j] += s1 * w[j]; a[2][j] += s2 * w[j]; }
            }
#pragma unroll
            for (int r = 0; r < 3; ++r)
#pragma unroll
                for (int j = 0; j < 4; ++j) red[(kg * 3 + r) * 128 + c4 * 4 + j] = a[r][j];
            __syncthreads();
            if (tid < 384) { const int r = tid >> 7, n = tid & 127; float s = F.A.in[I_ADAB][(size_t)l * MODW + n0 + n];
                for (int g = 0; g < 16; ++g) s += red[(g * 3 + r) * 128 + n];
                WSP(float, WS_MOD)[((size_t)l * 3 + r) * MODW + n0 + n] = s; }
            __syncthreads();
        }
        __syncthreads();
    }
    int base = 0;
    cvt_simple(F, F.A.in[I_WIN], WSP(bf16_t, WT_IN), D, QKVC, base);
    cvt_simple(F, F.A.in[I_WOUT], WSP(bf16_t, WT_OUT), D, D, base);
    cvt_simple(F, F.A.in[I_WR], WSP(bf16_t, WT_R), D, D, base);
    cvt_simple(F, F.A.in[I_WK], WSP(bf16_t, WT_K), D, D, base);
    cvt_simple(F, F.A.in[I_WV], WSP(bf16_t, WT_V), D, D, base);
    cvt_simple(F, F.A.in[I_WO], WSP(bf16_t, WT_O), D, D, base);
    for (int d = 0; d < 2; ++d) {
        { CvtJob J{F.A.in[I_W1] + (size_t)d * D * 96, nullptr, WSP(bf16_t, WT_W1) + (size_t)d * 128 * D, D, 96, 96, D, 128, 0, 128, 0, 0}; cvt_job(F, J, base); }
        { CvtJob J{F.A.in[I_A1] + (size_t)d * D * 96, nullptr, WSP(bf16_t, WT_A1) + (size_t)d * 128 * D, D, 96, 96, D, 128, 0, 128, 0, 0}; cvt_job(F, J, base); }
        { CvtJob J{F.A.in[I_W2] + (size_t)d * 96 * D, nullptr, WSP(bf16_t, WT_W2) + (size_t)d * D * 256, 96, D, D, 256, D, 128 * d, D, 0, 0}; cvt_job(F, J, base); }
        { CvtJob J{F.A.in[I_A2] + (size_t)d * 96 * D, nullptr, WSP(bf16_t, WT_A2) + (size_t)d * D * 256, 96, D, D, 256, D, 128 * d, D, 0, 0}; cvt_job(F, J, base); }
    }
    cvt_simple(F, F.A.in[I_G1], WSP(bf16_t, WT_G1), D, 256, base);
    cvt_simple(F, F.A.in[I_G2], WSP(bf16_t, WT_G2), 256, D, base);
    cvt_moe(F, 0, WSP(bf16_t, SLOTP(6)), WSP(bf16_t, SLOTP(6)) + (size_t)NEXP * 2 * FF * D, base);
}

struct RowOpts {
    const float* src_l; const float* src_c;
    int nrows;
    bool combine; int comb_layer; const bf16_t* yslot; float* dst_l; float* dst_c;
    bool norm; int layer; int which;
    bf16_t* H;
    bool router;
};
__device__ __forceinline__ void ph_rows(const Frame& F, const RowOpts& O) {
    LAS int* pref = (LAS int*)(F.lds + MISC_OFF + 1024);
    if (O.combine) {
        if (F.tid_() == 0) { const int* cnt = WSP(int, WS_CTL + CTL_CNT) + O.comb_layer * NEXP; int s = 0; for (int e = 0; e < NEXP; ++e) { pref[e] = s; s += (cnt[e] + 255) >> 8; } pref[NEXP] = s; }
        __syncthreads();
    }
    const int lane = F.lane_();
    for (int r = F.bid * 8 + F.wave; r < O.nrows; r += F.G * 8) {
        const bool isc = r >= ML;
        const int mrow = isc ? 2 : r / SEQ;
        const float* sp = isc ? O.src_c + (size_t)(r - ML) * D : O.src_l + (size_t)r * D;
        f32x4 v[8];
#pragma unroll
        for (int i = 0; i < 8; ++i) v[i] = *(const f32x4*)(sp + i * 256 + lane * 4);
        if (O.combine) {
            const int s0 = WSP(int, WS_TOKSEL)[r * 2], s1 = WSP(int, WS_TOKSEL)[r * 2 + 1];
            const float g0 = WSP(float, WS_TOKGATE)[r * 2], g1 = WSP(float, WS_TOKGATE)[r * 2 + 1];
            const size_t y0 = ((size_t)pref[s0 >> 20] * 256 + (s0 & 0xfffff)) * D, y1 = ((size_t)pref[s1 >> 20] * 256 + (s1 & 0xfffff)) * D;
            const float* gt = mod_row(F, O.comb_layer, mrow) + 5 * D;
            float* dp = isc ? O.dst_c + (size_t)(r - ML) * D : O.dst_l + (size_t)r * D;
#pragma unroll
            for (int i = 0; i < 8; ++i) {
                const int col = i * 256 + lane * 4;
                const u32x2 a = *(const u32x2*)(O.yslot + y0 + col), b = *(const u32x2*)(O.yslot + y1 + col);
                const f32x4 g = *(const f32x4*)(gt + col);
                v[i][0] += g[0] * (g0 * bf_lo(a[0]) + g1 * bf_lo(b[0])); v[i][1] += g[1] * (g0 * bf_hi(a[0]) + g1 * bf_hi(b[0]));
                v[i][2] += g[2] * (g0 * bf_lo(a[1]) + g1 * bf_lo(b[1])); v[i][3] += g[3] * (g0 * bf_hi(a[1]) + g1 * bf_hi(b[1]));
                *(f32x4*)(dp + col) = v[i];
            }
        }
        if (!O.norm) continue;
        float ss = 0.f;
#pragma unroll
        for (int i = 0; i < 8; ++i) ss += v[i][0] * v[i][0] + v[i][1] * v[i][1] + v[i][2] * v[i][2] + v[i][3] * v[i][3];
        ss = wave_sum(ss);
        const float rstd = rsqrtf(ss * (1.f / D) + 1e-6f);
        const float* gn = (O.which ? F.A.in[I_NFFN] : F.A.in[I_NMIX]) + (size_t)O.layer * D;
        const float* mr = mod_row(F, O.layer, mrow);
        const float* shp = mr + (O.which ? 3 * D : 0); const float* scp = mr + (O.which ? 4 * D : D);
        bf16_t* hp = O.H + (size_t)r * D;
#pragma unroll
        for (int i = 0; i < 8; ++i) {
            const int col = i * 256 + lane * 4;
            const f32x4 g = *(const f32x4*)(gn + col), sc = *(const f32x4*)(scp + col), sh = *(const f32x4*)(shp + col);
#pragma unroll
            for (int j = 0; j < 4; ++j) v[i][j] = v[i][j] * rstd * g[j] * (1.f + sc[j]) + sh[j];
            u32x2 o; o[0] = cvt_pk_bf16(v[i][0], v[i][1]); o[1] = cvt_pk_bf16(v[i][2], v[i][3]);
            *(u32x2*)(hp + col) = o;
        }
        if (!O.router) continue;
        const float* wg = F.A.in[I_MGRP] + (size_t)O.layer * D * 4;
        const float* we = F.A.in[I_MEXP] + (size_t)O.layer * D * NEXP;
        LAS float* hs = (LAS float*)(F.lds + F.wave * 8192);
#pragma unroll
        for (int i = 0; i < 8; ++i) *(LAS f32x4*)(hs + i * 256 + lane * 4) = v[i];
        lds_fence();
        float gl[4] = {0.f, 0.f, 0.f, 0.f};
#pragma unroll 4
        for (int k = lane; k < D; k += 64) { const float h = hs[k]; const f32x4 w = *(const f32x4*)(wg + (size_t)k * 4);
            gl[0] += h * w[0]; gl[1] += h * w[1]; gl[2] += h * w[2]; gl[3] += h * w[3]; }
#pragma unroll
        for (int q = 0; q < 4; ++q) gl[q] = wave_sum(gl[q]);
        int gs = 0; float gm = gl[0];
#pragma unroll
        for (int q = 1; q < 4; ++q) if (gl[q] > gm) { gm = gl[q]; gs = q; }
        float den = 0.f;
#pragma unroll
        for (int q = 0; q < 4; ++q) den += __expf(gl[q] - gm);
        const float psel = 1.f / den;
        float el[8] = {0.f, 0.f, 0.f, 0.f, 0.f, 0.f, 0.f, 0.f};
#pragma unroll 4
        for (int k = lane; k < D; k += 64) { const float h = hs[k]; const float* wp = we + (size_t)k * NEXP + gs * 8; const f32x4 w0 = *(const f32x4*)wp, w1 = *(const f32x4*)(wp + 4);
            el[0] += h * w0[0]; el[1] += h * w0[1]; el[2] += h * w0[2]; el[3] += h * w0[3]; el[4] += h * w1[0]; el[5] += h * w1[1]; el[6] += h * w1[2]; el[7] += h * w1[3]; }
#pragma unroll
        for (int q = 0; q < 8; ++q) el[q] = wave_sum(el[q]);
        lds_fence();
        int i1 = 0; float v1 = el[0];
#pragma unroll
        for (int q = 1; q < 8; ++q) if (el[q] > v1) { v1 = el[q]; i1 = q; }
        int i2 = -1; float v2 = -3.0e38f;
#pragma unroll
        for (int q = 0; q < 8; ++q) if (q != i1 && el[q] > v2) { v2 = el[q]; i2 = q; }
        const float e2 = __expf(v2 - v1), w1g = psel / (1.f + e2), w2g = psel * e2 / (1.f + e2);
        if (lane == 0) {
            int* cnt = WSP(int, WS_CTL + CTL_CNT) + O.layer * NEXP;
            const int ea = gs * 8 + i1, eb = gs * 8 + i2;
            const int pa = atomicAdd(cnt + ea, 1), pb = atomicAdd(cnt + eb, 1);
            WSP(int, WS_TOKL)[(size_t)ea * MT + pa] = r; WSP(int, WS_TOKL)[(size_t)eb * MT + pb] = r;
            WSP(int, WS_TOKSEL)[r * 2] = (ea << 20) | pa; WSP(int, WS_TOKSEL)[r * 2 + 1] = (eb << 20) | pb;
            WSP(float, WS_TOKGATE)[r * 2] = w1g; WSP(float, WS_TOKGATE)[r * 2 + 1] = w2g;
        }
    }
}

__device__ __forceinline__ void ph_qknorm(const Frame& F, bf16_t* QKV) {
    const int lane = F.lane_();
    const int il = lane & 15;
    const float f0 = exp2f(-(float)(2 * il) * (13.287712379549449f / 32.f)), f1 = exp2f(-(float)(2 * il + 1) * (13.287712379549449f / 32.f));
    for (int r = F.bid * 8 + F.wave; r < MT; r += F.G * 8) {
        const bool lat = r < ML; const int t = r % SEQ;
        const float pos = (lane < 32) ? (float)(t / 64) : (float)(t % 64);
        float c0 = 1.f, s0 = 0.f, c1 = 1.f, s1 = 0.f;
        if (lat) { const float r0_ = __builtin_amdgcn_fractf(pos * f0 * 0.15915494309189535f), r1_ = __builtin_amdgcn_fractf(pos * f1 * 0.15915494309189535f);
            s0 = __builtin_amdgcn_sinf(r0_); c0 = __builtin_amdgcn_cosf(r0_); s1 = __builtin_amdgcn_sinf(r1_); c1 = __builtin_amdgcn_cosf(r1_); }
        bf16_t* row = QKV + (size_t)r * QKVC;
        for (int hd = 0; hd < 26; ++hd) {
            int col; const float* gain; bool rope;
            if (hd < 8) { col = QA0 + hd * 128; gain = F.A.in[I_AQG]; rope = lat; }
            else if (hd < 10) { col = KA0 + (hd - 8) * 128; gain = F.A.in[I_AKG]; rope = lat; }
            else if (hd < 18) { col = QB0 + (hd - 10) * 128; gain = F.A.in[I_BQG]; rope = false; }
            else { col = KB0 + (hd - 18) * 128; gain = F.A.in[I_BKG]; rope = false; }
            unsigned* p = (unsigned*)(row + col + 2 * lane);
            const unsigned u = *p;
            float x0 = bf_lo(u), x1 = bf_hi(u);
            const float ss = wave_sum(x0 * x0 + x1 * x1);
            const float rstd = rsqrtf(ss * (1.f / 128.f) + 1e-6f);
            x0 = x0 * rstd * gain[2 * lane]; x1 = x1 * rstd * gain[2 * lane + 1];
            if (rope) {
                const float p0 = __shfl_xor(x0, 16), p1 = __shfl_xor(x1, 16);
                if ((lane & 16) == 0) { x0 = x0 * c0 - p0 * s0; x1 = x1 * c1 - p1 * s1; }
                else { x0 = p0 * s0 + x0 * c0; x1 = p1 * s1 + x1 * c1; }
            }
            *p = cvt_pk_bf16(x0, x1);
        }
    }
}

__device__ __forceinline__ void ph_attn_simple(const Frame& F, const bf16_t* QKV, bf16_t* YC) {
    const int lane = F.lane_();
    LAS float* qs = (LAS float*)(F.lds + F.wave * 4096);
    LAS float* ps = qs + 128;
    const float scale = 0.08838834764831845f;
    for (int it = F.bid * 8 + F.wave; it < MT * 16; it += F.G * 8) {
        const int r = it >> 4, hh = it & 15; const bool tA = hh < 8; const int h = hh & 7;
        const int qcol = tA ? QA0 + h * 128 : QB0 + h * 128, kcol = tA ? KA0 + (h >> 2) * 128 : KB0 + h * 128, vcol = tA ? VA0 + (h >> 2) * 128 : VB0 + h * 128;
        { const unsigned u = *(const unsigned*)(QKV + (size_t)r * QKVC + qcol + 2 * lane); qs[2 * lane] = bf_lo(u); qs[2 * lane + 1] = bf_hi(u); }
        lds_fence();
        const bool lat = r < ML;
        const int b = lat ? r / SEQ : (r - ML) / CTXL, t = r % SEQ;
        int nloc, lo = 0, r0 = 0, c0 = 0, rr = 0, cq = 0;
        if (!lat) nloc = 0;
        else if (tA) { lo = max(0, t - 128); const int hi = min(SEQ - 1, t + 128); nloc = hi - lo + 1; }
        else { rr = t >> 6; cq = t & 63; r0 = min(max(rr - 4, 0), 248); c0 = min(max(cq - 8, 0), 48); nloc = 128; }
        const int nkeys = nloc + CTXL;
        const float* rpb = F.A.in[I_RPB] + (size_t)h * 15 * 31;
        float mloc = -3.0e38f;
        for (int j = lane; j < nkeys; j += 64) {
            int krow; float bias = 0.f;
            if (j >= nloc) krow = ML + b * CTXL + (j - nloc);
            else if (tA) krow = b * SEQ + lo + j;
            else { const int jr = j >> 4, jc = j & 15; krow = b * SEQ + (r0 + jr) * 64 + c0 + jc; bias = rpb[(r0 + jr - rr + 7) * 31 + (c0 + jc - cq + 15)]; }
            const bf16_t* kp = QKV + (size_t)krow * QKVC + kcol;
            float dot = 0.f;
#pragma unroll 4
            for (int d8 = 0; d8 < 16; ++d8) { const u32x4 kv = *(const u32x4*)(kp + d8 * 8);
#pragma unroll
                for (int q = 0; q < 4; ++q) dot += qs[d8 * 8 + 2 * q] * bf_lo(kv[q]) + qs[d8 * 8 + 2 * q + 1] * bf_hi(kv[q]); }
            const float s = dot * scale + bias;
            ps[j] = s; mloc = fmaxf(mloc, s);
        }
        float m = wave_max(mloc);
        const float sink = tA ? F.A.in[I_ASINK][h] : -3.0e38f;
        if (tA) m = fmaxf(m, sink);
        float sloc = 0.f;
        for (int j = lane; j < nkeys; j += 64) { const float p = __expf(ps[j] - m); ps[j] = p; sloc += p; }
        float l = wave_sum(sloc);
        if (tA) l += __expf(sink - m);
        lds_fence();
        float o0 = 0.f, o1 = 0.f;
        for (int j = 0; j < nkeys; ++j) {
            int krow;
            if (j >= nloc) krow = ML + b * CTXL + (j - nloc);
            else if (tA) krow = b * SEQ + lo + j;
            else krow = b * SEQ + (r0 + (j >> 4)) * 64 + c0 + (j & 15);
            const unsigned u = *(const unsigned*)(QKV + (size_t)krow * QKVC + vcol + 2 * lane);
            const float p = ps[j];
            o0 += p * bf_lo(u); o1 += p * bf_hi(u);
        }
        const float inv = 1.f / l;
        *(unsigned*)(YC + (size_t)r * D + hh * 128 + 2 * lane) = cvt_pk_bf16(o0 * inv, o1 * inv);
        lds_fence();
    }
}

namespace att {
typedef float f32x16 __attribute__((ext_vector_type(16)));
typedef short s16x4 __attribute__((ext_vector_type(4)));
constexpr int KVBLK = 64;
constexpr float SCALE = 0.08838834764831845f, THR = 8.f;
constexpr int SHM_V = KVBLK * 128 * 2, SHM_K = KVBLK * 128 * 2;
#define KSWZ(row, colB) ((row) * 256 + ((colB) ^ (((row) & 7) << 4)))
#define SBAR() __builtin_amdgcn_sched_barrier(0)
__device__ __forceinline__ int crow(int r, int hi) { return (r & 3) + 8 * (r >> 2) + 4 * hi; }
__device__ __forceinline__ void partialSM(f32x16& p0, f32x16& p1, float& m_reg, float& mn, float& alpha) {
  constexpr float C = SCALE * 1.4426950408889634f;
  float pmax = p0[0];
#pragma unroll
  for (int r = 1; r < 16; ++r) pmax = fmaxf(pmax, p0[r]);
#pragma unroll
  for (int r = 0; r < 16; ++r) pmax = fmaxf(pmax, p1[r]);
  { auto rr = __builtin_amdgcn_permlane32_swap(__float_as_uint(pmax), __float_as_uint(pmax), false, false);
    pmax = fmaxf(__uint_as_float(rr[0]), __uint_as_float(rr[1])); }
  if (__builtin_expect(__all(pmax - m_reg <= THR / SCALE), 1)) { mn = m_reg; alpha = 1.f; }
  else { mn = fmaxf(m_reg, pmax); alpha = __builtin_amdgcn_exp2f((m_reg - mn) * C); m_reg = mn; }
  float mnC = -mn * C;
#pragma unroll
  for (int r = 0; r < 16; ++r) p0[r] = fmaf(p0[r], C, mnC);
#pragma unroll
  for (int r = 0; r < 16; ++r) p1[r] = fmaf(p1[r], C, mnC);
#pragma unroll
  for (int r = 0; r < 16; ++r) p0[r] = __builtin_amdgcn_exp2f(p0[r]);
}
__device__ __forceinline__ void finishSM(f32x16& p0, f32x16& p1, float alpha, float& l_reg, bf16x8& pa0, bf16x8& pa1, bf16x8& pa2, bf16x8& pa3) {
#pragma unroll
  for (int r = 0; r < 16; ++r) p1[r] = __builtin_amdgcn_exp2f(p1[r]);
  float ps = 0;
#pragma unroll
  for (int r = 0; r < 16; ++r) ps += p0[r];
#pragma unroll
  for (int r = 0; r < 16; ++r) ps += p1[r];
  { auto rr = __builtin_amdgcn_permlane32_swap(__float_as_uint(ps), __float_as_uint(ps), false, false);
    ps = __uint_as_float(rr[0]) + __uint_as_float(rr[1]); }
  l_reg = l_reg * alpha + ps;
#define PK4(P, BASE, OUT) do { unsigned a0 = cvt_pk_bf16(P[BASE + 0], P[BASE + 1]), a1 = cvt_pk_bf16(P[BASE + 2], P[BASE + 3]);   \
    unsigned b0 = cvt_pk_bf16(P[BASE + 4], P[BASE + 5]), b1 = cvt_pk_bf16(P[BASE + 6], P[BASE + 7]);                              \
    auto r0 = __builtin_amdgcn_permlane32_swap(a0, b0, false, false); auto r1 = __builtin_amdgcn_permlane32_swap(a1, b1, false, false); \
    u32x4 w = {r0[0], r1[0], r0[1], r1[1]}; OUT = *reinterpret_cast<bf16x8*>(&w); } while (0)
  PK4(p0, 0, pa0); PK4(p0, 8, pa1); PK4(p1, 0, pa2); PK4(p1, 8, pa3);
#undef PK4
}
__device__ __forceinline__ void qkt(f32x16& p0, f32x16& p1, const LAS char* Ks, const bf16x8* qr, int r32, int hi) {
  p0 = f32x16{}; p1 = f32x16{};
#pragma unroll
  for (int d0 = 0; d0 < 8; ++d0) { int cb = (d0 * 16 + hi * 8) * 2;
    bf16x8 b0 = *reinterpret_cast<const LAS bf16x8*>(Ks + KSWZ(r32, cb));
    bf16x8 b1 = *reinterpret_cast<const LAS bf16x8*>(Ks + KSWZ(32 + r32, cb));
    p0 = __builtin_amdgcn_mfma_f32_32x32x16_bf16(b0, qr[d0], p0, 0, 0, 0);
    p1 = __builtin_amdgcn_mfma_f32_32x32x16_bf16(b1, qr[d0], p1, 0, 0, 0); }
}
__device__ __forceinline__ int v_st(int k, int c) { const int kk = (k & ~0xC) | ((k & 4) << 1) | ((k & 8) >> 1); return ((kk >> 3) * 4 + (c >> 5)) * 512 + ((kk & 7) * 32 + (c & 31)) * 2; }
__device__ __forceinline__ int v_rd_base(int lane) { return ((lane & 3) << 3) | (((lane >> 2) & 3) << 6) | (((lane >> 4) & 1) << 5) | (((lane >> 5) & 1) << 8); }
constexpr int v_rd_off(int d0, int ks, int half) { return d0 * 512 + ks * 4096 + half * 2048; }
template <int OFF> __device__ __forceinline__ s16x4 tr_read(int vb) {
  s16x4 r; asm volatile("ds_read_b64_tr_b16 %0, %1 offset:%2" : "=&v"(r) : "v"(vb), "i"(OFF) : "memory"); return r;
}
template <int D0> __device__ __forceinline__ void pv_one(f32x16& od, int vb, bf16x8 pa0, bf16x8 pa1, bf16x8 pa2, bf16x8 pa3) {
  const s16x4 l0 = tr_read<v_rd_off(D0, 0, 0)>(vb), h0 = tr_read<v_rd_off(D0, 0, 1)>(vb), l1 = tr_read<v_rd_off(D0, 1, 0)>(vb), h1 = tr_read<v_rd_off(D0, 1, 1)>(vb);
  const s16x4 l2 = tr_read<v_rd_off(D0, 2, 0)>(vb), h2 = tr_read<v_rd_off(D0, 2, 1)>(vb), l3 = tr_read<v_rd_off(D0, 3, 0)>(vb), h3 = tr_read<v_rd_off(D0, 3, 1)>(vb);
  asm volatile("s_waitcnt lgkmcnt(0)" ::: "memory"); SBAR();
#define PK(L, H) (bf16x8){L[0], L[1], L[2], L[3], H[0], H[1], H[2], H[3]}
  od = __builtin_amdgcn_mfma_f32_32x32x16_bf16(pa0, PK(l0, h0), od, 0, 0, 0);
  od = __builtin_amdgcn_mfma_f32_32x32x16_bf16(pa1, PK(l1, h1), od, 0, 0, 0);
  od = __builtin_amdgcn_mfma_f32_32x32x16_bf16(pa2, PK(l2, h2), od, 0, 0, 0);
  od = __builtin_amdgcn_mfma_f32_32x32x16_bf16(pa3, PK(l3, h3), od, 0, 0, 0);
#undef PK
}
__device__ __forceinline__ void pv_d0(f32x16* o, int vb, bf16x8 pa0, bf16x8 pa1, bf16x8 pa2, bf16x8 pa3) {
  pv_one<0>(o[0], vb, pa0, pa1, pa2, pa3); pv_one<1>(o[1], vb, pa0, pa1, pa2, pa3); pv_one<2>(o[2], vb, pa0, pa1, pa2, pa3); pv_one<3>(o[3], vb, pa0, pa1, pa2, pa3);
}
struct UnitD {
  int nW, NT;
  int wrow0, crow0;
  int qt, wlo;
};
__device__ __forceinline__ void mask_add(f32x16& p0, f32x16& p1, int hi, const LAS float* tp) {
  const LAS float* tq = tp + 4 * hi;
#pragma unroll
  for (int g = 0; g < 4; ++g) {
#pragma unroll
    for (int q = 0; q < 4; ++q) { const int r = 4 * g + q, jc = q + 8 * g; p0[r] += tq[jc]; p1[r] += tq[jc + 32]; }
    SBAR();
  }
}

__device__ __forceinline__ void attn_unit(const int TYPE, const bf16_t* __restrict__ Qw_, const bf16_t* __restrict__ Kc, const bf16_t* __restrict__ Vc, bf16_t* __restrict__ Ow, const UnitD U,
                                          const int wrr  , const float sink_l2  , LAS char* lds) {
  const int tid = threadIdx.x, wid = __builtin_amdgcn_readfirstlane(tid >> 6), lane = tid & 63, r32 = lane & 31, hi = lane >> 5;
  LAS char* V_lds = lds; LAS char* K_lds = lds + 2 * SHM_V;
  LAS float* ws = (LAS float*)(lds + 2 * SHM_V + 2 * SHM_K) + wid * 64; LAS float* li_l = ws; LAS float* al_l = ws + 32;
  const LAS float* tbl = (const LAS float*)(lds + 2 * SHM_V + 2 * SHM_K + 2048);
  float m_reg = -1e4f, l_reg = 0; f32x16 o[4] = {}; bf16x8 qr[8];
  const bf16_t* Qw = Qw_ + (size_t)r32 * QKVC + hi * 8;
#pragma unroll
  for (int d0 = 0; d0 < 8; ++d0) qr[d0] = *reinterpret_cast<const bf16x8*>(Qw + d0 * 16);
  const int sr = tid >> 4, sc = (tid & 15) * 8, vst0 = v_st(sr, sc), vst1 = v_st(32 + sr, sc);
  const int vb0 = (int)(uintptr_t)V_lds + v_rd_base(lane);
  struct { bf16x8 vs0, vs1, ks0, ks1; } sr_[1];
  const int iq = (wid & 1) * 32 + r32;
  const int r0w = min(max(wrr - 4, 0), 248);
  const int c0q = min(max(iq - 8, 0), 48);
#define TROW(j) (((j) < U.nW) ? (U.wrow0 + (j) * 64) : (U.crow0 + (((j) - U.nW) & 3) * 64))
#define SLOAD(i, k0) do { const int _k0 = (k0); sr_[i].vs0 = *reinterpret_cast<const bf16x8*>(&Vc[(size_t)(_k0 + sr) * QKVC + sc]); sr_[i].vs1 = *reinterpret_cast<const bf16x8*>(&Vc[(size_t)(_k0 + 32 + sr) * QKVC + sc]); \
    sr_[i].ks0 = *reinterpret_cast<const bf16x8*>(&Kc[(size_t)(_k0 + sr) * QKVC + sc]); sr_[i].ks1 = *reinterpret_cast<const bf16x8*>(&Kc[(size_t)(_k0 + 32 + sr) * QKVC + sc]); } while (0)
#define SWRITE(b, i) do { *(LAS bf16x8*)(V_lds + (b) * SHM_V + vst0) = sr_[i].vs0;          \
    *(LAS bf16x8*)(V_lds + (b) * SHM_V + vst1) = sr_[i].vs1; int kc = sc * 2;               \
    *(LAS bf16x8*)(K_lds + (b) * SHM_K + KSWZ(sr, kc)) = sr_[i].ks0;                       \
    *(LAS bf16x8*)(K_lds + (b) * SHM_K + KSWZ(32 + sr, kc)) = sr_[i].ks1; } while (0)
#define RESC(a) do { if (__any((a) < 1.f)) { if (hi == 0) al_l[r32] = (a); asm volatile("s_waitcnt lgkmcnt(0)" ::: "memory"); \
    _Pragma("unroll") for (int d = 0; d < 4; ++d) _Pragma("unroll") for (int r = 0; r < 16; ++r) o[d][r] *= al_l[crow(r, hi)]; } } while (0)
#define MASK(j, P0, P1) do { const int _j = (j); \
    if (TYPE == 0) { if (_j < U.nW) { const int tix = U.wlo + _j; \
        if (tix == U.qt - 2) mask_add(P0, P1, hi, tbl + 17 * 128 + 64 - iq); else if (tix == U.qt + 2) mask_add(P0, P1, hi, tbl + 18 * 128 + 64 - iq); } } \
    else { if (_j < U.nW) { const int dr = U.wlo + _j - r0w; \
        if ((unsigned)dr < 8u) { mask_add(P0, P1, hi, tbl + (U.wlo + _j - wrr + 7) * 128 + 64 - iq); mask_add(P0, P1, hi, tbl + 16 * 128 + 48 - c0q); } \
        else mask_add(P0, P1, hi, tbl + 19 * 128); } } } while (0)
  f32x16 p0, p1; float mn, al = 1.f; bf16x8 pa0, pa1, pa2, pa3; const int NT = U.NT;
  SLOAD(0, TROW(0)); asm volatile("s_waitcnt vmcnt(0)" ::: "memory"); SWRITE(0, 0); SLOAD(0, TROW(1)); __syncthreads();
  for (int j = 0; j < NT; ++j) {
    const int par = j & 1;
    qkt(p0, p1, K_lds + par * SHM_K, qr, r32, hi);
    if (j + 1 < NT) { SWRITE(1 - par, 0); }
    if (j + 2 < NT) SLOAD(0, TROW(j + 2));
    MASK(j, p0, p1);
    partialSM(p0, p1, m_reg, mn, al);
    RESC(al);
    finishSM(p0, p1, al, l_reg, pa0, pa1, pa2, pa3); SBAR();
    pv_d0(o, vb0 + par * SHM_V, pa0, pa1, pa2, pa3);
    __syncthreads();
  }
  if (TYPE == 0) l_reg += __builtin_amdgcn_exp2f(sink_l2 - m_reg * (SCALE * 1.4426950408889634f));
  if (hi == 0) li_l[r32] = l_reg; asm volatile("s_waitcnt lgkmcnt(0)" ::: "memory");
  float rli[16];
#pragma unroll
  for (int r = 0; r < 16; ++r) rli[r] = __builtin_amdgcn_rcpf(li_l[crow(r, hi)]);
#pragma unroll
  for (int r = 0; r < 16; ++r) { const int orow = crow(r, hi);
#pragma unroll
    for (int d0 = 0; d0 < 4; ++d0) { const float x = o[d0][r] * rli[r]; Ow[(size_t)orow * D + d0 * 32 + r32] = (bf16_t)(cvt_pk_bf16(x, x) & 0xffffu); } }
#undef TROW
#undef SLOAD
#undef SWRITE
#undef RESC
#undef MASK
}
}

__device__ __forceinline__ void ph_attn(const Frame& F, const bf16_t* QKV, bf16_t* YC) {
    LAS char* lds = (LAS char*)F.lds;
    LAS float* tbl = (LAS float*)(lds + 2 * att::SHM_V + 2 * att::SHM_K + 2048);
    const int wid = F.wave;
    for (int i = F.tid_(); i < 5 * 128; i += NTHR) { const int row = 15 + (i >> 7), k = i & 127; float v = 0.f;
        if (row == 16) v = ((unsigned)(k - 56 + 8) < 16u) ? 0.f : -1e30f;
        if (row == 17) v = (k - 64 >= 0) ? 0.f : -1e30f;
        if (row == 18) v = (k - 64 <= 0) ? 0.f : -1e30f;
        if (row == 19) v = -1e30f;
        tbl[15 * 128 + i] = v; }
    for (int u = F.bid; u < 2080; u += F.G) {
        att::UnitD U; int type, qrow0, wrr = 0, qoff, koff, voff, ooff, wrow; float sink_l2 = 0.f;
        if (u < 1040) {
            const int b = u / 520, rem = u % 520, h = rem / 65, qg = rem % 65;
            for (int i = F.tid_(); i < 15 * 128; i += NTHR) { const int dr = i >> 7, k = (i & 127) - 49; tbl[i] = ((unsigned)k < 31u) ? F.A.in[I_RPB][(size_t)h * 465 + dr * 31 + k] * (1.f / att::SCALE) : 0.f; }
            type = 1;
            U.crow0 = ML + b * CTXL;
            if (qg < 64) { const int R0 = qg * 4; const int klo = min(max(R0 - 4, 0), 248), khi = min(max(R0 - 1, 0), 248) + 7;
                U.nW = khi - klo + 1; U.wrow0 = b * SEQ + klo * 64; U.wlo = klo; U.qt = R0; qrow0 = b * SEQ + R0 * 64; wrr = R0 + (wid >> 1); }
            else { U.nW = 0; U.wrow0 = 0; U.wlo = 0; U.qt = 0; qrow0 = ML + b * CTXL; }
            wrow = wid * 32; qoff = QB0 + h * 128; koff = KB0 + h * 128; voff = VB0 + h * 128; ooff = 1024 + h * 128;
        } else {
            const int v = u - 1040, b = v / 520, rem = v % 520, kvh = rem / 260, qt = rem % 260;
            const int g = wid >> 1, hq = kvh * 4 + g;
            type = 0;
            U.crow0 = ML + b * CTXL;
            if (qt < 256) { const int wlo = max(qt - 2, 0), whi = min(qt + 2, 255); U.nW = whi - wlo + 1; U.wlo = wlo; U.qt = qt; U.wrow0 = b * SEQ + wlo * 64; qrow0 = b * SEQ + qt * 64; }
            else { U.nW = 0; U.wlo = 0; U.qt = 1000; U.wrow0 = 0; qrow0 = ML + b * CTXL + (qt - 256) * 64; }
            sink_l2 = F.A.in[I_ASINK][hq] * 1.4426950408889634f;
            wrow = (wid & 1) * 32; qoff = QA0 + hq * 128; koff = KA0 + kvh * 128; voff = VA0 + kvh * 128; ooff = hq * 128;
        }
        U.NT = U.nW + 4;
        __syncthreads();
        att::attn_unit(type, QKV + (size_t)(qrow0 + wrow) * QKVC + qoff, QKV + koff, QKV + voff, YC + (size_t)(qrow0 + wrow) * D + ooff, U, wrr, sink_l2, lds);
        __syncthreads();
    }
}

__device__ __forceinline__ void ph_mix(const Frame& F, const bf16_t* H, bf16_t* XM, int m) {
    const int lane = F.lane_();
    const float* mu = F.A.in[I_MU] + (size_t)m * D;
    for (int r = F.bid * 8 + F.wave; r < MT; r += F.G * 8) {
        const int sl = (r < ML) ? SEQ : CTXL, t = (r < ML) ? (r % SEQ) : ((r - ML) % CTXL);
        const bool hp = t > 0, hn = t < sl - 1;
#pragma unroll
        for (int i = 0; i < 4; ++i) {
            const int col = i * 512 + lane * 8;
            const u32x4 c = *(const u32x4*)(H + (size_t)r * D + col);
            u32x4 p = (u32x4){0u, 0u, 0u, 0u}, n = (u32x4){0u, 0u, 0u, 0u};
            if (hp) p = *(const u32x4*)(H + (size_t)(r - 1) * D + col);
            if (hn) n = *(const u32x4*)(H + (size_t)(r + 1) * D + col);
            const f32x4 m0 = *(const f32x4*)(mu + col), m1 = *(const f32x4*)(mu + col + 4);
            u32x4 o;
#pragma unroll
            for (int q = 0; q < 4; ++q) {
                const float cl = bf_lo(c[q]), ch = bf_hi(c[q]);
                const float xl = 0.5f * (bf_lo(p[q]) + bf_lo(n[q])) - cl, xh = 0.5f * (bf_hi(p[q]) + bf_hi(n[q])) - ch;
                const float ml = (q < 2) ? m0[2 * q] : m1[2 * q - 4], mh = (q < 2) ? m0[2 * q + 1] : m1[2 * q - 3];
                o[q] = cvt_pk_bf16(cl + xl * ml, ch + xh * mh);
            }
            *(u32x4*)(XM + (size_t)r * D + col) = o;
        }
    }
}

constexpr int SC_T = 32, SC_NCH = (CTXL + SEQ) / SC_T;
constexpr int SC_BUF = 5 * SC_T * 64 * 4 + SC_T * 32 * 4;
struct ScanRaw { u32x4 r, k, e, a; u32x2 v; };
template <int CTRL> __device__ __forceinline__ float dpp_f(float v) { return __int_as_float(__builtin_amdgcn_update_dpp(0, __float_as_int(v), CTRL, 0xf, 0xf, true)); }
__device__ __forceinline__ float red16(float v) {
    v += dpp_f<0xB1>(v); v += dpp_f<0x4E>(v); v += dpp_f<0x141>(v); v += dpp_f<0x140>(v); return v; }
__device__ __forceinline__ int scan_row(int dir, int b, int s) {
    if (s < CTXL) return ML + b * CTXL + (dir ? CTXL - 1 - s : s);
    const int t = s - CTXL; return b * SEQ + (dir ? SEQ - 1 - t : t);
}
__device__ __forceinline__ void ph_scan(const Frame& F, const bf16_t* Rb, const bf16_t* Kb, const bf16_t* Vb, const bf16_t* DEC0, const bf16_t* DEC1, const bf16_t* AS0, const bf16_t* AS1,
                                        bf16_t* Y0, bf16_t* Y1, float* CB) {
    const int tid = F.tid_(), lane = F.lane_(), wave = F.wave;
    LAS float* ybuf = (LAS float*)(F.lds + 2 * SC_BUF);
    for (int item = F.bid; item < 256; item += F.G) {
        const int dir = item >> 7, b = (item >> 6) & 1, head = (item >> 1) & 31, half = item & 1;
        const bf16_t* DEC = dir ? DEC1 : DEC0; const bf16_t* AS = dir ? AS1 : AS0; bf16_t* Y = dir ? Y1 : Y0;
        const int hc = head * 64;
        if (wave >= 4) {
            const int lt = tid - 256, st = lt >> 3, sg = lt & 7;
            f32x4 kk0 = *(const f32x4*)(F.A.in[I_KK] + hc + sg * 8), kk1 = *(const f32x4*)(F.A.in[I_KK] + hc + sg * 8 + 4);
            f32x4 ka0 = *(const f32x4*)(F.A.in[I_KA] + hc + sg * 8), ka1 = *(const f32x4*)(F.A.in[I_KA] + hc + sg * 8 + 4);
            f32x4 rk0 = *(const f32x4*)(F.A.in[I_RK] + hc + sg * 8), rk1 = *(const f32x4*)(F.A.in[I_RK] + hc + sg * 8 + 4);
            ScanRaw cur, nxt;
            auto ld = [&](int ch, ScanRaw& R) {
                const int row = scan_row(dir, b, ch * SC_T + st); const size_t o = (size_t)row * D + hc + sg * 8;
                R.r = *(const u32x4*)(Rb + o); R.k = *(const u32x4*)(Kb + o); R.e = *(const u32x4*)(DEC + o); R.a = *(const u32x4*)(AS + o);
                R.v = *(const u32x2*)(Vb + (size_t)row * D + hc + half * 32 + sg * 4);
            };
            auto put = [&](int ch, const ScanRaw& R) {
                LAS float* bw = (LAS float*)(F.lds + (ch & 1) * SC_BUF);
                float r_[8], k_[8], e_[8], a_[8], kkv[8], kav[8], rkv[8];
#pragma unroll
                for (int q = 0; q < 4; ++q) { r_[2 * q] = bf_lo(R.r[q]); r_[2 * q + 1] = bf_hi(R.r[q]); k_[2 * q] = bf_lo(R.k[q]); k_[2 * q + 1] = bf_hi(R.k[q]);
                    e_[2 * q] = bf_lo(R.e[q]); e_[2 * q + 1] = bf_hi(R.e[q]); a_[2 * q] = bf_lo(R.a[q]); a_[2 * q + 1] = bf_hi(R.a[q]);
                    kkv[q] = kk0[q]; kkv[4 + q] = kk1[q]; kav[q] = ka0[q]; kav[4 + q] = ka1[q]; rkv[q] = rk0[q]; rkv[4 + q] = rk1[q]; }
                float ss = 0.f, cb = 0.f, kkr[8], kd[8];
#pragma unroll
                for (int q = 0; q < 8; ++q) { kkr[q] = k_[q] * kkv[q]; ss += kkr[q] * kkr[q]; kd[q] = k_[q] * (1.f + (a_[q] - 1.f) * kav[q]); cb += r_[q] * kd[q] * rkv[q]; }
                ss += __shfl_xor(ss, 1); ss += __shfl_xor(ss, 2); ss += __shfl_xor(ss, 4);
                cb += __shfl_xor(cb, 1); cb += __shfl_xor(cb, 2); cb += __shfl_xor(cb, 4);
                const float rn = rsqrtf(ss + 1e-12f);
                LAS float* p = bw + st * 64 + sg * 8;
#pragma unroll
                for (int q = 0; q < 8; ++q) { const float kkn = kkr[q] * rn;
                    p[0 * SC_T * 64 + q] = __expf(-e_[q]);
                    p[1 * SC_T * 64 + q] = -kkn;
                    p[2 * SC_T * 64 + q] = kkn * a_[q];
                    p[3 * SC_T * 64 + q] = kd[q];
                    p[4 * SC_T * 64 + q] = r_[q]; }
                LAS float* pv = bw + 5 * SC_T * 64 + st * 32 + sg * 4;
                pv[0] = bf_lo(R.v[0]); pv[1] = bf_hi(R.v[0]); pv[2] = bf_lo(R.v[1]); pv[3] = bf_hi(R.v[1]);
                const int s = ch * SC_T + st;
                if (half == 0 && sg == 0 && s >= CTXL) CB[((size_t)dir * ML + scan_row(dir, b, s)) * 32 + head] = cb;
            };
            auto flush = [&](int ch) {
                if (ch * SC_T < CTXL) return;
                const LAS float* yb = ybuf + (ch & 1) * (SC_T * 32) + st * 32 + sg * 4;
                const int row = scan_row(dir, b, ch * SC_T + st);
                u32x2 o; o[0] = cvt_pk_bf16(yb[0], yb[1]); o[1] = cvt_pk_bf16(yb[2], yb[3]);
                *(u32x2*)(Y + (size_t)row * D + hc + half * 32 + sg * 4) = o;
            };
            ld(0, cur); put(0, cur); ld(1, cur);
            __syncthreads();
            for (int ch = 0; ch < SC_NCH; ++ch) {
                if (ch + 2 < SC_NCH) ld(ch + 2, nxt);
                if (ch + 1 < SC_NCH) put(ch + 1, cur);
                if (ch >= 1) flush(ch - 1);
                cur = nxt;
                __syncthreads();
            }
            flush(SC_NCH - 1);
        } else {
            const int rw0 = wave * 8 + (lane >> 4) * 2, sg = lane & 15;
            f32x4 Sa = (f32x4){0.f, 0.f, 0.f, 0.f}, Sb = (f32x4){0.f, 0.f, 0.f, 0.f};
            __syncthreads();
            for (int ch = 0; ch < SC_NCH; ++ch) {
                const LAS float* bw = (const LAS float*)(F.lds + (ch & 1) * SC_BUF);
                LAS float* yb = ybuf + (ch & 1) * (SC_T * 32);
#pragma unroll 2
                for (int st = 0; st < SC_T; ++st) {
                    const LAS float* p = bw + st * 64 + sg * 4;
                    const f32x4 w = *(const LAS f32x4*)(p), a = *(const LAS f32x4*)(p + SC_T * 64), bb = *(const LAS f32x4*)(p + 2 * SC_T * 64);
                    const f32x4 k = *(const LAS f32x4*)(p + 3 * SC_T * 64), r = *(const LAS f32x4*)(p + 4 * SC_T * 64);
                    const f32x2 vv = *(const LAS f32x2*)(bw + 5 * SC_T * 64 + st * 32 + rw0);
                    float sa0 = (Sa[0] * a[0] + Sa[1] * a[1]) + (Sa[2] * a[2] + Sa[3] * a[3]);
                    float sa1 = (Sb[0] * a[0] + Sb[1] * a[1]) + (Sb[2] * a[2] + Sb[3] * a[3]);
                    sa0 = red16(sa0); sa1 = red16(sa1);
                    Sa = Sa * w + (bb * sa0 + k * vv[0]);
                    Sb = Sb * w + (bb * sa1 + k * vv[1]);
                    float y0 = (Sa[0] * r[0] + Sa[1] * r[1]) + (Sa[2] * r[2] + Sa[3] * r[3]);
                    float y1 = (Sb[0] * r[0] + Sb[1] * r[1]) + (Sb[2] * r[2] + Sb[3] * r[3]);
                    y0 = red16(y0); y1 = red16(y1);
                    if (sg == 0) *(LAS f32x2*)(yb + st * 32 + rw0) = (f32x2){y0, y1};
                }
                __syncthreads();
            }
        }
        __syncthreads();
    }
}

__device__ __forceinline__ void ph_scan_prep(const Frame& F, const bf16_t* Rb, const bf16_t* Kb, const bf16_t* AS0, const bf16_t* AS1, bf16_t* KKN, float* CB) {
    const int lane = F.lane_();
    const float* kkp = F.A.in[I_KK] + lane * 32; const float* kap = F.A.in[I_KA] + lane * 32; const float* rkp = F.A.in[I_RK] + lane * 32;
    for (int r = F.bid * 8 + F.wave; r < MT; r += F.G * 8) {
        const size_t ro = (size_t)r * D + lane * 32;
        float ss = 0.f, c0 = 0.f, c1 = 0.f; float kkr[32];
#pragma unroll
        for (int q = 0; q < 4; ++q) { const u32x4 kv = *(const u32x4*)(Kb + ro + q * 8), rv = *(const u32x4*)(Rb + ro + q * 8), a0 = *(const u32x4*)(AS0 + ro + q * 8), a1 = *(const u32x4*)(AS1 + ro + q * 8);
#pragma unroll
            for (int j = 0; j < 8; ++j) { const int c = q * 8 + j; const unsigned kw = kv[j >> 1], rw = rv[j >> 1], aw0 = a0[j >> 1], aw1 = a1[j >> 1];
                const float k = (j & 1) ? bf_hi(kw) : bf_lo(kw), rr = (j & 1) ? bf_hi(rw) : bf_lo(rw), s0 = (j & 1) ? bf_hi(aw0) : bf_lo(aw0), s1 = (j & 1) ? bf_hi(aw1) : bf_lo(aw1);
                kkr[c] = k * kkp[c]; ss += kkr[c] * kkr[c];
                const float rk = rr * k * rkp[c];
                c0 += rk * (1.f + (s0 - 1.f) * kap[c]); c1 += rk * (1.f + (s1 - 1.f) * kap[c]); } }
        ss += __shfl_xor(ss, 1); c0 += __shfl_xor(c0, 1); c1 += __shfl_xor(c1, 1);
        const float rn = rsqrtf(ss + 1e-12f);
#pragma unroll
        for (int q = 0; q < 4; ++q) { u32x4 o;
#pragma unroll
            for (int j = 0; j < 4; ++j) o[j] = cvt_pk_bf16(kkr[q * 8 + 2 * j] * rn, kkr[q * 8 + 2 * j + 1] * rn);
            *(u32x4*)(KKN + ro + q * 8) = o; }
        if (r < ML && (lane & 1) == 0) { CB[(size_t)r * 32 + (lane >> 1)] = c0; CB[((size_t)ML + r) * 32 + (lane >> 1)] = c1; }
    }
}

namespace cs {
constexpr int CSLOT = 13056, SET = 4 * CSLOT, HP0 = 2 * SET, HPSZ = 10240, TP = 144;
constexpr int O_TA = 0, O_TR = 2304, O_A4 = 4608, O_A2 = 8704, O_A3 = 9728, O_VT = 10752, O_GC = 12800;
constexpr int O_BT = 0, O_KT = 2304, O_LAB = 4608, O_LAK = 5632;
typedef short s16x4 __attribute__((ext_vector_type(4)));
__device__ __forceinline__ u32x2 tr_issue(unsigned addr) { u32x2 r; asm volatile("ds_read_b64_tr_b16 %0, %1" : "=&v"(r) : "v"(addr) : "memory"); return r; }
__device__ __forceinline__ void tr_wait() { asm volatile("s_waitcnt lgkmcnt(0)" ::: "memory"); __builtin_amdgcn_sched_barrier(0); }
struct Raw { u32x4 v[6][2]; };
}
__device__ __forceinline__ void ph_scan_chunked(const Frame& F, const bf16_t* Rb, const bf16_t* Kb, const bf16_t* Vb, const bf16_t* KKN, bf16_t* DEC0, bf16_t* DEC1, const bf16_t* AS0, const bf16_t* AS1) {
    using namespace cs;
    const int lane = F.lane_(), wave = F.wave;
    LAS unsigned char* lds = F.lds;
    constexpr int NCH = (CTXL + SEQ) / 16, NSUP = NCH / 4;
    for (int item = F.bid; item < 128; item += F.G) {
        const int dir = item >> 6, b = (item >> 5) & 1, head = item & 31, hc = head * 64;
        bf16_t* DEC = dir ? DEC1 : DEC0; const bf16_t* AS = dir ? AS1 : AS0;
        if (wave >= 4) {
            const int h = wave - 4, k = lane;
            LAS unsigned char* hp = lds + HP0 + h * HPSZ;
            const float ka = F.A.in[I_KA][hc + k];
            Raw raw;
            auto gload = [&](int c) {
#pragma unroll
                for (int i = 0; i < 2; ++i) { const int pc = lane + 64 * i, t = pc >> 3, c8 = (pc & 7) * 8; const size_t o = (size_t)scan_row(dir, b, c * 16 + t) * D + hc + c8;
                    raw.v[0][i] = *(const u32x4*)(DEC + o); raw.v[1][i] = *(const u32x4*)(AS + o); raw.v[2][i] = *(const u32x4*)(Kb + o);
                    raw.v[3][i] = *(const u32x4*)(KKN + o); raw.v[4][i] = *(const u32x4*)(Rb + o); raw.v[5][i] = *(const u32x4*)(Vb + o); }
            };
            auto process = [&](int c, int set) {
                LAS unsigned char* sl = lds + set * SET + (c & 3) * CSLOT;
#pragma unroll
                for (int i = 0; i < 2; ++i) { const int pc = lane + 64 * i;
#pragma unroll
                    for (int v5 = 0; v5 < 5; ++v5) *(LAS u32x4*)(hp + v5 * 2048 + pc * 16) = raw.v[v5][i];
                    *(LAS u32x4*)(sl + O_VT + pc * 16) = raw.v[5][i]; }
                lds_fence();
                const unsigned trb = (unsigned)(uintptr_t)hp + (unsigned)(((lane >> 2) & 3) * 128 + ((lane >> 4) * 16 + (lane & 3) * 4) * 2);
                float e_[16], as_[16], k_[16], kn_[16], r_[16];
                u32x2 X0[4], X1[4], X2[4], X3[4], X4[4];
#pragma unroll
                for (int j = 0; j < 4; ++j) { X0[j] = tr_issue(trb + 0 * 2048 + j * 512); X1[j] = tr_issue(trb + 1 * 2048 + j * 512); X2[j] = tr_issue(trb + 2 * 2048 + j * 512);
                    X3[j] = tr_issue(trb + 3 * 2048 + j * 512); X4[j] = tr_issue(trb + 4 * 2048 + j * 512); }
                tr_wait();
#pragma unroll
                for (int j = 0; j < 4; ++j) {
                    const u32x2 x0 = X0[j], x1 = X1[j], x2 = X2[j], x3 = X3[j], x4 = X4[j];
                    e_[4 * j] = bf_lo(x0[0]); e_[4 * j + 1] = bf_hi(x0[0]); e_[4 * j + 2] = bf_lo(x0[1]); e_[4 * j + 3] = bf_hi(x0[1]);
                    as_[4 * j] = bf_lo(x1[0]); as_[4 * j + 1] = bf_hi(x1[0]); as_[4 * j + 2] = bf_lo(x1[1]); as_[4 * j + 3] = bf_hi(x1[1]);
                    k_[4 * j] = bf_lo(x2[0]); k_[4 * j + 1] = bf_hi(x2[0]); k_[4 * j + 2] = bf_lo(x2[1]); k_[4 * j + 3] = bf_hi(x2[1]);
                    kn_[4 * j] = bf_lo(x3[0]); kn_[4 * j + 1] = bf_hi(x3[0]); kn_[4 * j + 2] = bf_lo(x3[1]); kn_[4 * j + 3] = bf_hi(x3[1]);
                    r_[4 * j] = bf_lo(x4[0]); r_[4 * j + 1] = bf_hi(x4[0]); r_[4 * j + 2] = bf_lo(x4[1]); r_[4 * j + 3] = bf_hi(x4[1]);
                }
                float g = 1.f, bt[16], kt[16];
#pragma unroll
                for (int t = 0; t < 16; ++t) {
                    const float gp = g; g *= __expf(-e_[t]); const float ig = __builtin_amdgcn_rcpf(g);
                    const float bb = kn_[t] * as_[t], kd = k_[t] * (1.f + (as_[t] - 1.f) * ka);
                    bt[t] = bb * ig; kt[t] = kd * ig;
                    const unsigned w0 = cvt_pk_bf16(-kn_[t] * gp, r_[t] * g), w1 = cvt_pk_bf16(bt[t], kt[t]);
                    *(LAS unsigned short*)(sl + O_TA + t * TP + k * 2) = (unsigned short)(w0 & 0xffffu); *(LAS unsigned short*)(sl + O_TR + t * TP + k * 2) = (unsigned short)(w0 >> 16);
                    *(LAS unsigned short*)(hp + O_BT + t * TP + k * 2) = (unsigned short)(w1 & 0xffffu); *(LAS unsigned short*)(hp + O_KT + t * TP + k * 2) = (unsigned short)(w1 >> 16);
                }
#pragma unroll
                for (int q = 0; q < 4; ++q) { u32x4 o; o[0] = cvt_pk_bf16(bt[4 * q] * g, bt[4 * q + 1] * g); o[1] = cvt_pk_bf16(bt[4 * q + 2] * g, bt[4 * q + 3] * g);
                    o[2] = cvt_pk_bf16(kt[4 * q] * g, kt[4 * q + 1] * g); o[3] = cvt_pk_bf16(kt[4 * q + 2] * g, kt[4 * q + 3] * g);
                    *(LAS u32x4*)(sl + O_A4 + k * 64 + q * 16) = o; }
                *(LAS float*)(sl + O_GC + k * 4) = g;
                lds_fence();
                const int i16 = lane & 15, q4 = lane >> 4;
                f32x4 Lab = (f32x4){0.f, 0.f, 0.f, 0.f}, Lak = Lab, Urb = Lab, Urk = Lab;
#pragma unroll
                for (int s2 = 0; s2 < 2; ++s2) {
                    const bf16x8 a_ = *(const LAS bf16x8*)(sl + O_TA + i16 * TP + s2 * 64 + q4 * 16), r2 = *(const LAS bf16x8*)(sl + O_TR + i16 * TP + s2 * 64 + q4 * 16);
                    const bf16x8 b_ = *(const LAS bf16x8*)(hp + O_BT + i16 * TP + s2 * 64 + q4 * 16), k2 = *(const LAS bf16x8*)(hp + O_KT + i16 * TP + s2 * 64 + q4 * 16);
                    Lab = __builtin_amdgcn_mfma_f32_16x16x32_bf16(a_, b_, Lab, 0, 0, 0); Lak = __builtin_amdgcn_mfma_f32_16x16x32_bf16(a_, k2, Lak, 0, 0, 0);
                    Urb = __builtin_amdgcn_mfma_f32_16x16x32_bf16(r2, b_, Urb, 0, 0, 0); Urk = __builtin_amdgcn_mfma_f32_16x16x32_bf16(r2, k2, Urk, 0, 0, 0);
                }
#pragma unroll
                for (int j = 0; j < 4; ++j) { const int t = 4 * q4 + j;
                    const float lab = (i16 < t) ? Lab[j] : 0.f, lak = (i16 < t) ? Lak[j] : 0.f, urb = (i16 <= t) ? Urb[j] : 0.f, urk = (i16 <= t) ? Urk[j] : 0.f;
                    *(LAS float*)(hp + O_LAB + (t * 16 + i16) * 4) = lab; *(LAS float*)(hp + O_LAK + (t * 16 + i16) * 4) = lak;
                    const unsigned w = cvt_pk_bf16(urb, urk);
                    LAS unsigned char* ap = sl + O_A3 + (t * 4 + (i16 >> 2)) * 16 + (i16 & 3) * 2;
                    *(LAS unsigned short*)(ap) = (unsigned short)(w & 0xffffu); *(LAS unsigned short*)(ap + 8) = (unsigned short)(w >> 16); }
                lds_fence();
                const int cc = lane & 31;
                float x[16];
#pragma unroll
                for (int t = 0; t < 16; ++t) {
                    float acc = (cc < 16) ? ((cc == t) ? 1.f : 0.f) : *(const LAS float*)(hp + O_LAK + (t * 16 + (cc - 16)) * 4);
#pragma unroll
                    for (int i4 = 0; i4 * 4 < t; ++i4) { const f32x4 l4 = *(const LAS f32x4*)(hp + O_LAB + (t * 16 + i4 * 4) * 4);
#pragma unroll
                        for (int j = 0; j < 4; ++j) if (i4 * 4 + j < t) acc += l4[j] * x[i4 * 4 + j]; }
                    x[t] = acc;
                }
                if (lane < 32) {
#pragma unroll
                    for (int t = 0; t < 16; ++t) *(LAS unsigned short*)(sl + O_A2 + (t * 4 + ((cc & 15) >> 2)) * 16 + (cc & 3) * 2 + ((cc >> 4) * 8)) = (unsigned short)(cvt_pk_bf16(x[t], x[t]) & 0xffffu);
                }
            };
            gload(h); process(h, 0); gload(4 + h);
            __syncthreads();
            for (int s = 0; s < NSUP; ++s) {
                if (s + 1 < NSUP) { process(4 * (s + 1) + h, (s + 1) & 1); if (s + 2 < NSUP) gload(4 * (s + 2) + h); }
                __syncthreads();
            }
        } else {
            const int vb = wave * 16, t16 = lane & 15, q4 = lane >> 4;
            f32x4 St[4];
#pragma unroll
            for (int m = 0; m < 4; ++m) St[m] = (f32x4){0.f, 0.f, 0.f, 0.f};
            __syncthreads();
            for (int s = 0; s < NSUP; ++s) {
#pragma unroll 1
                for (int jc = 0; jc < 4; ++jc) {
                    const int c = 4 * s + jc;
                    LAS unsigned char* sl = lds + (s & 1) * SET + jc * CSLOT;
                    const u32x2 vt = tr_issue((unsigned)(uintptr_t)(sl + O_VT) + (unsigned)((4 * q4 + ((lane >> 2) & 3)) * 128 + (vb + (lane & 3) * 4) * 2));
                    bf16x8 Sb[2];
#pragma unroll
                    for (int s2 = 0; s2 < 2; ++s2) { u32x4 w; w[0] = cvt_pk_bf16(St[2 * s2][0], St[2 * s2][1]); w[1] = cvt_pk_bf16(St[2 * s2][2], St[2 * s2][3]);
                        w[2] = cvt_pk_bf16(St[2 * s2 + 1][0], St[2 * s2 + 1][1]); w[3] = cvt_pk_bf16(St[2 * s2 + 1][2], St[2 * s2 + 1][3]); Sb[s2] = *reinterpret_cast<bf16x8*>(&w); }
                    f32x4 Xa = (f32x4){0.f, 0.f, 0.f, 0.f}, Xr = Xa;
#pragma unroll
                    for (int s2 = 0; s2 < 2; ++s2) {
                        const u32x2 a0 = *(const LAS u32x2*)(sl + O_TA + t16 * TP + s2 * 64 + q4 * 8), a1 = *(const LAS u32x2*)(sl + O_TA + t16 * TP + s2 * 64 + 32 + q4 * 8);
                        const u32x2 r0 = *(const LAS u32x2*)(sl + O_TR + t16 * TP + s2 * 64 + q4 * 8), r1 = *(const LAS u32x2*)(sl + O_TR + t16 * TP + s2 * 64 + 32 + q4 * 8);
                        u32x4 aw = {a0[0], a0[1], a1[0], a1[1]}, rw = {r0[0], r0[1], r1[0], r1[1]};
                        Xa = __builtin_amdgcn_mfma_f32_16x16x32_bf16(*reinterpret_cast<bf16x8*>(&aw), Sb[s2], Xa, 0, 0, 0);
                        Xr = __builtin_amdgcn_mfma_f32_16x16x32_bf16(*reinterpret_cast<bf16x8*>(&rw), Sb[s2], Xr, 0, 0, 0);
                    }
                    tr_wait();
                    u32x4 b2 = {cvt_pk_bf16(Xa[0], Xa[1]), cvt_pk_bf16(Xa[2], Xa[3]), vt[0], vt[1]};
                    const bf16x8 A2 = *(const LAS bf16x8*)(sl + O_A2 + (t16 * 4 + q4) * 16), A3 = *(const LAS bf16x8*)(sl + O_A3 + (t16 * 4 + q4) * 16);
                    const f32x4 P = __builtin_amdgcn_mfma_f32_16x16x32_bf16(A2, *reinterpret_cast<bf16x8*>(&b2), (f32x4){0.f, 0.f, 0.f, 0.f}, 0, 0, 0);
                    u32x4 bp = {cvt_pk_bf16(P[0], P[1]), cvt_pk_bf16(P[2], P[3]), vt[0], vt[1]};
                    const bf16x8 Bpv = *reinterpret_cast<bf16x8*>(&bp);
                    const f32x4 Y = __builtin_amdgcn_mfma_f32_16x16x32_bf16(A3, Bpv, Xr, 0, 0, 0);
#pragma unroll
                    for (int m = 0; m < 4; ++m) { const f32x4 gc = *(const LAS f32x4*)(sl + O_GC + (16 * m + 4 * q4) * 4); const bf16x8 A4 = *(const LAS bf16x8*)(sl + O_A4 + ((16 * m + t16) * 4 + q4) * 16);
                        St[m] = __builtin_amdgcn_mfma_f32_16x16x32_bf16(A4, Bpv, St[m] * gc, 0, 0, 0); }
                    if (c >= CTXL / 16) {
#pragma unroll
                        for (int j = 0; j < 4; ++j) { const int row = scan_row(dir, b, c * 16 + 4 * q4 + j); DEC[(size_t)row * D + hc + vb + t16] = (bf16_t)(cvt_pk_bf16(Y[j], Y[j]) & 0xffffu); }
                    }
                }
                __syncthreads();
            }
        }
        __syncthreads();
    }
}

__device__ __forceinline__ void ph_rwkv_out(const Frame& F, const bf16_t* Y0, const bf16_t* Y1, const bf16_t* Vb, const bf16_t* Gb, const float* CB, bf16_t* Z) {
    const int lane = F.lane_();
    for (int r = F.bid * 8 + F.wave; r < ML; r += F.G * 8) {
        const size_t ro = (size_t)r * D + lane * 32;
        float y[32];
#pragma unroll
        for (int q = 0; q < 4; ++q) { const u32x4 a = *(const u32x4*)(Y0 + ro + q * 8), bq = *(const u32x4*)(Y1 + ro + q * 8);
#pragma unroll
            for (int j = 0; j < 4; ++j) { y[q * 8 + 2 * j] = bf_lo(a[j]) + bf_lo(bq[j]); y[q * 8 + 2 * j + 1] = bf_hi(a[j]) + bf_hi(bq[j]); } }
        float s = 0.f;
#pragma unroll
        for (int j = 0; j < 32; ++j) s += y[j];
        s += __shfl_xor(s, 1);
        const float mu = s * (1.f / 64.f);
        float vs = 0.f;
#pragma unroll
        for (int j = 0; j < 32; ++j) { const float d = y[j] - mu; vs += d * d; }
        vs += __shfl_xor(vs, 1);
        const float rstd = rsqrtf(vs * (1.f / 64.f) + 64e-5f);
        const int head = lane >> 1;
        const float cb = CB[(size_t)r * 32 + head] + CB[((size_t)ML + r) * 32 + head];
        const float* lw = F.A.in[I_LNW] + lane * 32; const float* lb = F.A.in[I_LNB] + lane * 32;
#pragma unroll
        for (int q = 0; q < 4; ++q) { const u32x4 vv = *(const u32x4*)(Vb + ro + q * 8), gg = *(const u32x4*)(Gb + ro + q * 8);
            u32x4 o;
#pragma unroll
            for (int j = 0; j < 4; ++j) { const int c = q * 8 + 2 * j;
                const float z0 = ((y[c] - mu) * rstd * lw[c] + lb[c] + cb * bf_lo(vv[j])) * bf_lo(gg[j]);
                const float z1 = ((y[c + 1] - mu) * rstd * lw[c + 1] + lb[c + 1] + cb * bf_hi(vv[j])) * bf_hi(gg[j]);
                o[j] = cvt_pk_bf16(z0, z1); }
            *(u32x4*)(Z + ro + q * 8) = o; }
    }
}

__device__ __forceinline__ void moe_prefix(const Frame& F, int layer, LAS int*& pref, LAS int*& cntl) {
    pref = (LAS int*)(F.lds + MISC_OFF + 1024); cntl = pref + 40;
    __syncthreads();
    if (F.tid_() == 0) { const int* cnt = WSP(int, WS_CTL + CTL_CNT) + layer * NEXP; int s = 0; for (int e = 0; e < NEXP; ++e) { const int c = cnt[e]; cntl[e] = c; pref[e] = s; s += (c + 255) >> 8; } pref[NEXP] = s; }
    __syncthreads();
}
__device__ __forceinline__ void ph_moe_up(const Frame& F, int layer, const bf16_t* H, const bf16_t* W13, bf16_t* HID) {
    LAS int* pref; LAS int* cntl; moe_prefix(F, layer, pref, cntl);
    MoeSched S{pref, cntl, WSP(int, WS_TOKL), 4, F.G, F.bid, D, 2 * FF, true};
    pg8::EpiMoeUp E{HID};
    pg8::gemm_phase(F.lds, H, W13, D, S, E);
}
__device__ __forceinline__ void ph_moe_down(const Frame& F, int layer, const bf16_t* HID, const bf16_t* W2T, bf16_t* YS) {
    LAS int* pref; LAS int* cntl; moe_prefix(F, layer, pref, cntl);
    MoeSched S{pref, cntl, WSP(int, WS_TOKL), 8, F.G, F.bid, FF, D, false};
    pg8::EpiStoreBf16<0> E{YS, D, nullptr, 0, 0};
    pg8::gemm_phase(F.lds, HID, W2T, FF, S, E);
}
template <int ACT>
__device__ __forceinline__ void ph_gemm_bf16(const Frame& F, const bf16_t* A, const bf16_t* Bt, int M, int N, int K, bf16_t* O, int ldc, const float* vec, int split_cols, size_t split_stride) {
    pg8::DenseSched S; S.init(M, N, K, F.G, F.bid);
    pg8::EpiStoreBf16<ACT> E{O, ldc, vec, split_cols, split_stride};
    pg8::gemm_phase(F.lds, A, Bt, K, S, E);
}
__device__ __forceinline__ void ph_gemm_res(const Frame& F, const bf16_t* A, const bf16_t* Bt, int M, const float* xin_l, float* out_l, const float* xin_c, float* out_c, const float* gate) {
    pg8::DenseSched S; S.init(M, D, D, F.G, F.bid);
    pg8::EpiRes E{xin_l, out_l, xin_c, out_c, gate};
    pg8::gemm_phase(F.lds, A, Bt, D, S, E);
}

constexpr int LDS_BYTES = 131072 + 16384;
constexpr int N_PHASES = 34;
__global__ void __launch_bounds__(NTHR, 2) fwd(Args args) {
    extern __shared__ __attribute__((aligned(16))) unsigned char lds_raw[];
    Frame F(args);
    F.out = args.out; F.ws = args.ws; F.lds = (LAS unsigned char*)lds_raw;
    F.wave = __builtin_amdgcn_readfirstlane((int)threadIdx.x >> 6); F.G = gridDim.x; F.bid = blockIdx.x;
    volatile LAS unsigned* misc = (volatile LAS unsigned*)(F.lds + MISC_OFF);
    if (F.tid_() < 4) misc[F.tid_()] = 0u;
    __syncthreads();
    XcdBarrier bar; bar.bar = (unsigned*)(F.ws + WS_CTL); bar.x = 0; bar.st = misc;
    const int lo = args.ph_lo, hi = args.ph_hi;
    if (hi - lo > 1) bar = xcd_barrier_post((unsigned*)(F.ws + WS_CTL), misc);
#ifndef PH_ONLY
#define PH_ONLY -1
#endif
#define IN(k) ((PH_ONLY < 0 || PH_ONLY == (k)) && lo <= (k) && (k) < hi)
#define SEAM(k) do { if (IN(k) && IN((k) + 1)) xcd_barrier(bar); } while (0)
#define S0 WSP(bf16_t, SLOTP(0))
#define S1 WSP(bf16_t, SLOTP(1))
#define S2 WSP(bf16_t, SLOTP(2))
#define S3 WSP(bf16_t, SLOTP(3))
#define S4 WSP(bf16_t, SLOTP(4))
#define S5 WSP(bf16_t, SLOTP(5))
#define S6 WSP(bf16_t, SLOTP(6))
#define S7 WSP(bf16_t, SLOTP(7))
#define S8 WSP(bf16_t, SLOTP(8))
#define XC WSP(float, WS_XC)
#define CB WSP(float, WS_CB)
    const size_t W2OFF = (size_t)NEXP * 2 * FF * D;

    if (IN(0)) ph_prologue(F);
    SEAM(0);
    if (IN(1)) { RowOpts O{F.A.in[I_X], F.A.in[I_CTX], MT, false, 0, nullptr, nullptr, nullptr, true, 0, 0, S0, false}; ph_rows(F, O); }
    SEAM(1);
    if (IN(2)) ph_gemm_bf16<0>(F, S0, WSP(bf16_t, WT_IN), MT, QKVC, D, S1, QKVC, nullptr, 0, 0);
    SEAM(2);
    if (IN(3)) ph_qknorm(F, S1);
    SEAM(3);
    if (IN(4)) ph_attn(F, S1, S4);
    SEAM(4);
    if (IN(5)) ph_gemm_res(F, S4, WSP(bf16_t, WT_OUT), MT, F.A.in[I_X], F.out, F.A.in[I_CTX], XC, mod_row(F, 0, 0) + 2 * D);
    SEAM(5);
    if (IN(6)) { RowOpts O{F.out, XC, MT, false, 0, nullptr, nullptr, nullptr, true, 0, 1, S0, true}; ph_rows(F, O); }
    SEAM(6);
    if (IN(7)) ph_moe_up(F, 0, S0, S6, S5);
    SEAM(7);
    if (IN(8)) ph_moe_down(F, 0, S5, S6 + W2OFF, S1);
    SEAM(8);
    if (IN(9)) { RowOpts O{F.out, XC, MT, true, 0, S1, F.out, XC, true, 1, 0, S0, false}; ph_rows(F, O); }
    SEAM(9);
    if (IN(10)) ph_mix(F, S0, S1, 1);
    SEAM(10);
    if (IN(11)) ph_gemm_bf16<1>(F, S1, WSP(bf16_t, WT_W1), MT, 256, D, WSP(bf16_t, WS_TW), 256, nullptr, 0, 0);
    SEAM(11);
    if (IN(12)) ph_mix(F, S0, S1, 4);
    SEAM(12);
    if (IN(13)) ph_gemm_bf16<0>(F, S1, WSP(bf16_t, WT_A1), MT, 256, D, WSP(bf16_t, WS_TA), 256, nullptr, 0, 0);
    SEAM(13);
    if (IN(14)) ph_mix(F, S0, S1, 5);
    SEAM(14);
    if (IN(15)) ph_gemm_bf16<2>(F, S1, WSP(bf16_t, WT_G1), MT, 256, D, WSP(bf16_t, WS_TG), 256, nullptr, 0, 0);
    SEAM(15);
    if (IN(16)) ph_mix(F, S0, S1, 0);
    SEAM(16);
    if (IN(17)) ph_gemm_bf16<0>(F, S1, WSP(bf16_t, WT_R), MT, D, D, S3, D, nullptr, 0, 0);
    SEAM(17);
    if (IN(18)) ph_mix(F, S0, S1, 2);
    SEAM(18);
    if (IN(19)) ph_gemm_bf16<0>(F, S1, WSP(bf16_t, WT_K), MT, D, D, S4, D, nullptr, 0, 0);
    SEAM(19);
    if (IN(20)) ph_mix(F, S0, S1, 3);
    SEAM(20);
    if (IN(21)) ph_gemm_bf16<0>(F, S1, WSP(bf16_t, WT_V), MT, D, D, S5, D, nullptr, 0, 0);
    SEAM(21);
    if (IN(22)) ph_gemm_bf16<3>(F, WSP(bf16_t, WS_TW), WSP(bf16_t, WT_W2), MT, 2 * D, 256, S0, D, F.A.in[I_W0], D, (size_t)(SLOTP(1) - SLOTP(0)) / 2);
    SEAM(22);
    if (IN(23)) ph_gemm_bf16<4>(F, WSP(bf16_t, WS_TA), WSP(bf16_t, WT_A2), MT, 2 * D, 256, S2, D, F.A.in[I_A0], D, (size_t)(SLOTP(6) - SLOTP(2)) / 2);
    SEAM(23);
    if (IN(24)) ph_scan_prep(F, S3, S4, S2, S6, S7, CB);
    SEAM(24);
    if (IN(25)) ph_scan_chunked(F, S3, S4, S5, S7, S0, S1, S2, S6);
    SEAM(25);
    if (IN(26)) ph_gemm_bf16<0>(F, WSP(bf16_t, WS_TG), WSP(bf16_t, WT_G2), ML, D, 256, S3, D, nullptr, 0, 0);
    SEAM(26);
    if (IN(27)) ph_rwkv_out(F, S0, S1, S5, S3, CB, S4);
    SEAM(27);
    if (IN(28)) ph_gemm_res(F, S4, WSP(bf16_t, WT_O), ML, F.out, F.out, XC, XC, mod_row(F, 1, 0) + 2 * D);
    SEAM(28);
    if (IN(29)) { int base = 0; cvt_moe(F, 1, S1, S1 + W2OFF, base); }
    SEAM(29);
    if (IN(30)) { RowOpts O{F.out, XC, ML, false, 0, nullptr, nullptr, nullptr, true, 1, 1, S0, true}; ph_rows(F, O); }
    SEAM(30);
    if (IN(31)) ph_moe_up(F, 1, S0, S1, S5);
    SEAM(31);
    if (IN(32)) ph_moe_down(F, 1, S5, S1 + W2OFF, S6);
    SEAM(32);
    if (IN(33)) { RowOpts O{F.out, XC, ML, true, 1, S6, F.out, XC, false, 1, 0, nullptr, false}; ph_rows(F, O); }
#undef IN
#undef SEAM
}

extern "C" void kernel_launch(void* const* d_in, const int* in_sizes, int n_in, void* d_out, int out_size, void* d_ws, size_t ws_size, hipStream_t stream) {
    static int grid = 0;
    if (grid == 0) {
        if (n_in != 39 || out_size != ML * D || ws_size < WS_END) { fprintf(stderr, "kernel_launch: unexpected shapes (n_in %d out %d ws %zu need %zu)\n", n_in, out_size, ws_size, (size_t)WS_END); grid = -1; return; }
        int dev = 0, cus = 0;
        if (hipGetDevice(&dev) != hipSuccess || hipDeviceGetAttribute(&cus, hipDeviceAttributeMultiprocessorCount, dev) != hipSuccess) { grid = -1; return; }
        if (hipFuncSetAttribute((const void*)fwd, hipFuncAttributeMaxDynamicSharedMemorySize, LDS_BYTES) != hipSuccess) { fprintf(stderr, "kernel_launch: hipFuncSetAttribute failed\n"); grid = -1; return; }
        int per_cu = 0;
        if (hipOccupancyMaxActiveBlocksPerMultiprocessor(&per_cu, (const void*)fwd, NTHR, LDS_BYTES) != hipSuccess || per_cu < 1) { fprintf(stderr, "kernel_launch: occupancy query says %d\n", per_cu); }
        (void)hipGetLastError();
        grid = cus;
    }
    if (grid < 0) return;
    (void)hipMemsetAsync((char*)d_ws + WS_CTL, 0, CTL_BYTES, stream);
    Args a{};
    for (int i = 0; i < 39; ++i) a.in[i] = (const float*)d_in[i];
    a.out = (float*)d_out; a.ws = (unsigned char*)d_ws;
#if ONE_LAUNCH
    a.ph_lo = 0; a.ph_hi = N_PHASES;
    hipLaunchKernelGGL(fwd, dim3(grid), dim3(NTHR), LDS_BYTES, stream, a);
#else
    for (int p = 0; p < N_PHASES; ++p) { a.ph_lo = p; a.ph_hi = p + 1; const int reps = 1 + (int)((PROBE_MASK >> p) & 1ull); for (int r = 0; r < reps; ++r) hipLaunchKernelGGL(fwd, dim3(grid), dim3(NTHR), LDS_BYTES, stream, a); }
#endif
}
```

```cpp
#include <hip/hip_runtime.h>
#include <stdint.h>
#include <stdio.h>

#ifndef ONE_LAUNCH
#define ONE_LAUNCH 1
#endif
#ifndef PROBE_MASK
#define PROBE_MASK 0ull
#endif
#ifndef TIME_PH
#define TIME_PH -1
#endif

#define LAS __attribute__((address_space(3)))
typedef unsigned short bf16_t;
typedef short bf16x8 __attribute__((ext_vector_type(8)));
typedef float f32x4 __attribute__((ext_vector_type(4)));
typedef float f32x2 __attribute__((ext_vector_type(2)));
typedef unsigned u32x4 __attribute__((ext_vector_type(4)));
typedef unsigned u32x2 __attribute__((ext_vector_type(2)));

constexpr int D = 2048, NB = 2, SEQ = 16384, ML = NB * SEQ, CTXL = 256, MC = NB * CTXL, MT = ML + MC;
constexpr int QKVC = 4608, QA0 = 0, KA0 = 1024, VA0 = 1280, QB0 = 1536, KB0 = 2560, VB0 = 3584;
constexpr int NEXP = 32, FF = 512, MAXSLOT = 2 * MT + NEXP * 256;
constexpr int MODW = 6 * D;
constexpr int NTHR = 512;
constexpr int MISC_OFF = 163840 - 2048;

constexpr size_t MiB = 1ull << 20;
constexpr size_t WS_CTL = 0;
constexpr size_t CTL_BYTES = 64 * 1024;
constexpr size_t CTL_CNT = 32768;
constexpr int CNT_STRIDE = 64;
constexpr size_t CTL_AQ = 24576;
constexpr size_t WS_MOD = 1 * MiB;
constexpr size_t WS_XC = 2 * MiB;
constexpr size_t WS_TOKL = 6 * MiB;
constexpr size_t WS_TOKSEL = 11 * MiB;
constexpr size_t WS_TOKGATE = 11 * MiB + 512 * 1024;
constexpr size_t WS_CB = 12 * MiB;
constexpr size_t WS_WT = 20 * MiB;
constexpr size_t WT_IN = WS_WT, WT_OUT = WS_WT + 18 * MiB, WT_R = WS_WT + 26 * MiB, WT_K = WS_WT + 34 * MiB, WT_V = WS_WT + 42 * MiB, WT_O = WS_WT + 50 * MiB;
constexpr size_t WT_W1 = WS_WT + 58 * MiB, WT_A1 = WS_WT + 59 * MiB, WT_G1 = WS_WT + 60 * MiB, WT_W2 = WS_WT + 61 * MiB, WT_A2 = WS_WT + 63 * MiB, WT_G2 = WS_WT + 65 * MiB;
constexpr size_t WS_TW = 86 * MiB, WS_TA = 103 * MiB, WS_TG = 120 * MiB;
constexpr size_t WS_WF = 137 * MiB;
constexpr size_t WS_CV = WS_WF + (size_t)2 * 3 * 2048 * 48 * 4;
constexpr size_t WS_SLOT0 = 140 * MiB, SLOT = 130 * MiB;
constexpr size_t WS_HALO = WS_SLOT0 + 9 * SLOT;
constexpr size_t WS_RN = WS_HALO + 4 * MiB;
constexpr size_t WS_END = WS_RN + 8 * MiB;
#define SLOTP(k) (WS_SLOT0 + (size_t)(k) * SLOT)

typedef __bf16 bf16x2_t __attribute__((ext_vector_type(2)));
__device__ __forceinline__ unsigned cvt_pk_bf16(float lo, float hi) { f32x2 v = {lo, hi}; bf16x2_t r = __builtin_convertvector(v, bf16x2_t); return *reinterpret_cast<unsigned*>(&r); }
__device__ __forceinline__ float bf_lo(unsigned u) { return __uint_as_float(u << 16); }
__device__ __forceinline__ float bf_hi(unsigned u) { return __uint_as_float(u & 0xffff0000u); }
__device__ __forceinline__ float bf2f(bf16_t v) { return __uint_as_float(((unsigned)v) << 16); }
template <int CTRL> __device__ __forceinline__ float dpp_mov(float v) { return __int_as_float(__builtin_amdgcn_update_dpp(0, __float_as_int(v), CTRL, 0xf, 0xf, true)); }
__device__ __forceinline__ float row_sum16(float v) { v += dpp_mov<0xB1>(v); v += dpp_mov<0x4E>(v); v += dpp_mov<0x141>(v); v += dpp_mov<0x140>(v); return v; }
__device__ __forceinline__ float wave_sum(float v) { v = row_sum16(v);
    const float a = __int_as_float(__builtin_amdgcn_readlane(__float_as_int(v), 0)), b = __int_as_float(__builtin_amdgcn_readlane(__float_as_int(v), 16));
    const float c = __int_as_float(__builtin_amdgcn_readlane(__float_as_int(v), 32)), d = __int_as_float(__builtin_amdgcn_readlane(__float_as_int(v), 48));
    return (a + b) + (c + d); }
__device__ __forceinline__ float wave_max(float v) { for (int o = 32; o; o >>= 1) v = fmaxf(v, __shfl_xor(v, o)); return v; }
__device__ __forceinline__ float sigmoidf_(float x) { return 1.f / (1.f + __expf(-x)); }
__device__ __forceinline__ void lds_fence() { asm volatile("s_waitcnt lgkmcnt(0)" ::: "memory"); }

struct Args { const float* in[39]; float* out; unsigned char* ws; int ph_lo, ph_hi; };
struct Frame {
    const Args& A; float* out; unsigned char* ws; LAS unsigned char* lds;
    int wave, G, bid;
    __device__ __forceinline__ Frame(const Args& a) : A(a) {}
    __device__ __forceinline__ int lane_() const { return (int)threadIdx.x & 63; }
    __device__ __forceinline__ int tid_() const { return (int)threadIdx.x; }
};
enum { I_X = 0, I_C, I_CTX, I_CCTX, I_ADAW, I_ADAB, I_NMIX, I_NFFN, I_WIN, I_WOUT, I_AQG, I_AKG, I_ASINK, I_BQG, I_BKG, I_RPB, I_MU, I_WR, I_WK, I_WV, I_WO, I_W0, I_W1, I_W2,
       I_A0, I_A1, I_A2, I_G1, I_G2, I_KK, I_KA, I_RK, I_LNW, I_LNB, I_MGRP, I_MEXP, I_MW1, I_MW3, I_MW2 };

#define XB_TMO      128
#define XB_XCNT(j)  (256  + 64 * (j))
#define XB_XSUB(j)  (1280 + 64 * (j))
#define XB_XGEN(j)  (2304 + 64 * (j))
#define XB_TOP      3328
#define XB_TOPGEN   3392
#define XCD_BAR_WORDS 3456
#define XB_SPIN_CAP (1u << 18)
__device__ __forceinline__ unsigned xb_ld(unsigned* p)              { return __hip_atomic_load(p, __ATOMIC_RELAXED, __HIP_MEMORY_SCOPE_AGENT); }
__device__ __forceinline__ unsigned xb_add(unsigned* p, unsigned v) { return __hip_atomic_fetch_add(p, v, __ATOMIC_RELAXED, __HIP_MEMORY_SCOPE_AGENT); }
__device__ __forceinline__ unsigned xb_xcc_id() { return (unsigned)__builtin_amdgcn_s_getreg((3 << 11) | 20) & 0xFu; }
#define XB_SPIN(cond, bar) do { unsigned _sp = 0; while (cond) { __builtin_amdgcn_s_sleep(1); \
    if ((++_sp & 255u) == 0u) { if (xb_ld(&(bar)[XB_TMO])) break; if (_sp > XB_SPIN_CAP) { atomicAdd(&(bar)[XB_TMO], 1u); break; } } } } while (0)
struct XcdBarrier { unsigned* bar; unsigned x; volatile LAS unsigned* st; };
__device__ __forceinline__ XcdBarrier xcd_barrier_post(unsigned* bar, volatile LAS unsigned* st) {
    XcdBarrier b; b.bar = bar; b.x = xb_xcc_id(); b.st = st;
    if (threadIdx.x == 0) (void)xb_add(&bar[XB_XCNT(b.x)], 1u);
    return b;
}
__device__ __forceinline__ void xcd_barrier_complete(unsigned* bar, unsigned x, unsigned& nloc, unsigned& nx) {
    const unsigned G = gridDim.x * gridDim.y * gridDim.z;
    unsigned sum, cnt, mine, sp = 0u;
    for (;;) {
        sum = 0u; cnt = 0u; mine = 0u;
#pragma unroll
        for (unsigned j = 0; j < 16; ++j) { const unsigned c = xb_ld(&bar[XB_XCNT(j)]); sum += c; cnt += (c > 0u) ? 1u : 0u; mine = (j == x) ? c : mine; }
        if (sum == G) break;
        __builtin_amdgcn_s_sleep(1);
        if ((++sp & 255u) == 0u) { if (xb_ld(&bar[XB_TMO])) break; if (sp > XB_SPIN_CAP) { atomicAdd(&bar[XB_TMO], 1u); break; } }
    }
    nloc = mine > 0u ? mine : 1u; nx = cnt > 0u ? cnt : 1u;
}
__device__ __forceinline__ void xcd_barrier(const XcdBarrier& b) {
    asm volatile("s_waitcnt vmcnt(0)" ::: "memory");
    __syncthreads();
    if (threadIdx.x == 0) {
        unsigned* bar = b.bar;
        __builtin_amdgcn_s_waitcnt(0);
        unsigned nloc = b.st[0], nx = b.st[1];
        if (nloc == 0u) { xcd_barrier_complete(bar, b.x, nloc, nx); b.st[0] = nloc; b.st[1] = nx; }
        const unsigned old = xb_add(&bar[XB_XSUB(b.x)], 1u);
        const unsigned gen = old / nloc;
        if (old + 1u == (gen + 1u) * nloc) {
            __builtin_amdgcn_fence(__ATOMIC_RELEASE, "agent");
            asm volatile("s_waitcnt vmcnt(0)" ::: "memory");
            const unsigned og = xb_add(&bar[XB_TOP], 1u);
            const unsigned tg = og / nx;
            if (og + 1u == (tg + 1u) * nx) xb_add(&bar[XB_TOPGEN], 1u);
            else XB_SPIN(xb_ld(&bar[XB_TOPGEN]) == tg, bar);
            __builtin_amdgcn_fence(__ATOMIC_ACQUIRE, "agent");
            xb_add(&bar[XB_XGEN(b.x)], 1u);
            asm volatile("s_waitcnt vmcnt(0)" ::: "memory");
        } else {
            XB_SPIN(xb_ld(&bar[XB_XGEN(b.x)]) == gen, bar);
            __builtin_amdgcn_fence(__ATOMIC_ACQUIRE, "agent");
            asm volatile("s_waitcnt vmcnt(0)" ::: "memory");
        }
    }
    __syncthreads();
}

namespace pg8 {
constexpr int BM = 256, BK = 64, HALF = 128, HTB = HALF * BK * 2, STAGE_BYTES = 8 * HTB, NXCD = 8, WGM = 8;
__host__ __device__ __forceinline__ int lds_byte(int r, int c) { const int st = (r >> 4) * 2 + (c >> 5), rr = r & 15, cc = c & 31, ob = rr * 64 + cc * 2; return st * 1024 + (ob ^ (((ob >> 9) & 1) << 5)); }
__host__ __device__ __forceinline__ void stage_rc(int b, int& R, int& C) { const int st = b / 1024, sb = b % 1024, swz = sb ^ (((sb >> 9) & 1) << 5); R = (st >> 1) * 16 + swz / 64; C = (st & 1) * 32 + (swz % 64) / 2; }
__host__ __device__ __forceinline__ int perm32(int rho) { const int n = rho >> 4, i = rho & 15; return 8 * (i >> 2) + 4 * n + (i & 3); }

struct Unit { int arow0, brow0, col0, e, pbase, cnt; };

struct DenseSched {
    int nM, nN, nwg, G, c, K;
    __device__ void init(int M, int N, int K_, int G_, int c_) { nM = M / BM; nN = N / BM; nwg = nM * nN; G = G_; c = c_; K = K_; }
    __device__ bool next(int i, Unit& u) const {
        const long L = (long)i * G + c; if (L >= nwg) return false;
        int wgid = (int)L; { const int q = nwg / NXCD, r = nwg % NXCD, xcd = wgid % NXCD, off = wgid / NXCD; wgid = (xcd < r ? xcd * (q + 1) : r * (q + 1) + (xcd - r) * q) + off; }
        const int nig = WGM * nN, gid = wgid / nig, fm = gid * WGM, gsz = (nM - fm) < WGM ? (nM - fm) : WGM;
        const int pm = fm + ((wgid % nig) % gsz), pn = (wgid % nig) / gsz;
        u.arow0 = pm * BM; u.brow0 = pn * BM; u.col0 = pn * BM; u.e = 0; u.pbase = 0; u.cnt = 0; return true;
    }
    __device__ __forceinline__ unsigned a_off(const Unit& u, int r, int C) const { return (unsigned)((u.arow0 + r) * K + C) * 2u; }
};

struct MultiSched {
    int nM, nN, nwg, ng, G, c, lda; unsigned a0, a1, a2, a3; int b0, b1, b2, b3;
    __device__ __forceinline__ void init(int M, int N, int lda_, int ng_, int G_, int c_) { nM = M / BM; nN = N / BM; nwg = nM * nN; ng = ng_; G = G_; c = c_; lda = lda_; }
    __device__ __forceinline__ bool next(int i, Unit& u) const {
        const long L = (long)i * G + c; if (L >= (long)nwg * ng) return false;
        const int w = (int)(L / nwg); int wgid = (int)(L % nwg);
        { const int q = nwg / NXCD, r = nwg % NXCD, xcd = wgid % NXCD, off = wgid / NXCD; wgid = (xcd < r ? xcd * (q + 1) : r * (q + 1) + (xcd - r) * q) + off; }
        const int nig = WGM * nN, gid = wgid / nig, fm = gid * WGM, gsz = (nM - fm) < WGM ? (nM - fm) : WGM;
        const int pm = fm + ((wgid % nig) % gsz), pn = (wgid % nig) / gsz;
        u.arow0 = pm * BM; u.brow0 = (w == 0 ? b0 : w == 1 ? b1 : w == 2 ? b2 : b3) + pn * BM; u.col0 = pn * BM; u.e = w; u.pbase = 0; u.cnt = 0; return true;
    }
    __device__ __forceinline__ unsigned a_off(const Unit& u, int r, int C) const { return (u.e == 0 ? a0 : u.e == 1 ? a1 : u.e == 2 ? a2 : a3) + (unsigned)((u.arow0 + r) * lda + C) * 2u; }
};

template <class Epi, class Sched>
__device__ __forceinline__ void gemm_phase(LAS unsigned char* lds, const bf16_t* A, const bf16_t* Bt, const int K, const Sched& S, const Epi& E) {
    const int tid = threadIdx.x, wid = __builtin_amdgcn_readfirstlane(tid >> 6), lane = tid & 63, wr = wid >> 2, wc = wid & 3, fr = lane & 15, fq = lane >> 4;
    const int nt = K / BK;
    int Rr[2], Cc[2]; unsigned voffB[2];
#pragma unroll
    for (int i = 0; i < 2; ++i) { int R, C; stage_rc(tid * 16 + i * 8192, R, C); const int Rb = Epi::PERM ? ((R & ~31) + perm32(R & 31)) : R;
        Rr[i] = R; Cc[i] = C; voffB[i] = (unsigned)(Rb * K + C) * 2u; }
    const size_t kstep = (size_t)(BK * 2);
    const size_t hstepB = (size_t)HALF * K * 2;
    const unsigned ldsw = (unsigned)wid * 1024u;
    const int aoff = lds_byte(wr * 64 + fr, fq * 8), boff = lds_byte(wc * 32 + fr, fq * 8);
#define PG8_SA(b, h) (((b) * 2 + (h)) * HTB)
#define PG8_SB(b, h) ((4 + (b) * 2 + (h)) * HTB)
#define PG8_STAGE(bufoff, gbase, voff) do { _Pragma("unroll") for (int _i = 0; _i < 2; ++_i) \
        __builtin_amdgcn_global_load_lds((const unsigned*)((const char*)(gbase) + (voff)[_i]), (LAS unsigned*)(lds + (bufoff) + ldsw + _i * 8192), 16, 0, 0); } while (0)
#define PG8_LDA(dst, b, h) do { _Pragma("unroll") for (int m = 0; m < 4; ++m) _Pragma("unroll") for (int k = 0; k < 2; ++k) dst[m][k] = *(const LAS bf16x8*)(lds + PG8_SA(b, h) + aoff + m * 2048 + k * 1024); } while (0)
#define PG8_LDB(dst, b, h) do { _Pragma("unroll") for (int n = 0; n < 2; ++n) _Pragma("unroll") for (int k = 0; k < 2; ++k) dst[n][k] = *(const LAS bf16x8*)(lds + PG8_SB(b, h) + boff + n * 2048 + k * 1024); } while (0)
#define PG8_MMA(ai, bj, At, Bt_) do { __builtin_amdgcn_s_setprio(1); _Pragma("unroll") for (int m = 0; m < 4; ++m) _Pragma("unroll") for (int n = 0; n < 2; ++n) _Pragma("unroll") for (int k = 0; k < 2; ++k) \
        acc[ai][bj][m][n] = __builtin_amdgcn_mfma_f32_16x16x32_bf16(Bt_[n][k], At[m][k], acc[ai][bj][m][n], 0, 0, 0); __builtin_amdgcn_s_setprio(0); } while (0)
#define PG8_WAIT_V(n) asm volatile("s_waitcnt vmcnt(" #n ")" ::: "memory")
#define PG8_WAIT_L(n) asm volatile("s_waitcnt lgkmcnt(" #n ")" ::: "memory")
#define PG8_BAR __builtin_amdgcn_s_barrier()
#define PG8_SCHED __builtin_amdgcn_sched_barrier(0)
    Unit cur, nxt; int ui = 0;
    if (!S.next(0, cur)) return;
    f32x4 acc[2][2][4][2];
#pragma unroll
    for (int a = 0; a < 2; ++a)
#pragma unroll
        for (int b = 0; b < 2; ++b)
#pragma unroll
            for (int m = 0; m < 4; ++m)
#pragma unroll
                for (int n = 0; n < 2; ++n) acc[a][b][m][n] = (f32x4){0.f, 0.f, 0.f, 0.f};
    bf16x8 At[4][2], B0[2][2], B1[2][2];
    unsigned oC0[2], oC1[2], oN0[2], oN1[2];
#pragma unroll
    for (int i = 0; i < 2; ++i) { oC0[i] = S.a_off(cur, Rr[i], Cc[i]); oC1[i] = S.a_off(cur, HALF + Rr[i], Cc[i]); }
    const char* gA = (const char*)A;
    const char* cB = (const char*)Bt + (size_t)cur.brow0 * K * 2;
    PG8_STAGE(PG8_SB(0, 0), cB, voffB); PG8_STAGE(PG8_SA(0, 0), gA, oC0); PG8_STAGE(PG8_SB(0, 1), cB + hstepB, voffB); PG8_STAGE(PG8_SA(0, 1), gA, oC1);
    if (wr == 1) PG8_BAR;
    PG8_WAIT_V(4); PG8_BAR;
    PG8_STAGE(PG8_SB(1, 0), cB + kstep, voffB); PG8_STAGE(PG8_SA(1, 0), gA + kstep, oC0); PG8_STAGE(PG8_SB(1, 1), cB + hstepB + kstep, voffB);
    PG8_WAIT_V(6); PG8_BAR;
    for (;;) {
        const bool has_next = S.next(ui + 1, nxt);
        if (has_next) {
#pragma unroll
            for (int i = 0; i < 2; ++i) { oN0[i] = S.a_off(nxt, Rr[i], Cc[i]); oN1[i] = S.a_off(nxt, HALF + Rr[i], Cc[i]); }
        } else {
#pragma unroll
            for (int i = 0; i < 2; ++i) { oN0[i] = oC0[i]; oN1[i] = oC1[i]; }
        }
        const char* nB = has_next ? (const char*)Bt + (size_t)nxt.brow0 * K * 2 : cB;
        for (int t = 0; t < nt; t += 2) {
            const bool last = (t == nt - 2);
            const char* a1 = gA + (size_t)(t + 1) * kstep;
            const char* a2 = last ? gA : gA + (size_t)(t + 2) * kstep; const char* b2 = last ? nB : cB + (size_t)(t + 2) * kstep;
            const char* a3 = a2 + kstep; const char* b3 = b2 + kstep;
            unsigned o20[2], o21[2];
#pragma unroll
            for (int i = 0; i < 2; ++i) { o20[i] = last ? oN0[i] : oC0[i]; o21[i] = last ? oN1[i] : oC1[i]; }
            PG8_LDB(B0, 0, 0); PG8_SCHED; PG8_LDA(At, 0, 0); PG8_STAGE(PG8_SA(1, 1), a1, oC1);
            PG8_WAIT_L(8); PG8_BAR; PG8_WAIT_L(0); PG8_MMA(0, 0, At, B0); PG8_BAR; PG8_SCHED;
            PG8_LDB(B1, 0, 1); PG8_STAGE(PG8_SB(0, 0), b2, voffB);
            PG8_BAR; PG8_WAIT_L(0); PG8_MMA(0, 1, At, B1); PG8_BAR;
            PG8_LDA(At, 0, 1); PG8_STAGE(PG8_SA(0, 0), a2, o20);
            PG8_BAR; PG8_WAIT_L(0); PG8_MMA(1, 0, At, B0); PG8_BAR; PG8_SCHED;
            PG8_STAGE(PG8_SB(0, 1), b2 + hstepB, voffB);
            PG8_WAIT_V(6); PG8_BAR; PG8_MMA(1, 1, At, B1); PG8_BAR;
            PG8_LDB(B0, 1, 0); PG8_SCHED; PG8_LDA(At, 1, 0); PG8_STAGE(PG8_SA(0, 1), a2, o21);
            PG8_WAIT_L(8); PG8_BAR; PG8_WAIT_L(0); PG8_MMA(0, 0, At, B0); PG8_BAR; PG8_SCHED;
            PG8_LDB(B1, 1, 1); PG8_STAGE(PG8_SB(1, 0), b3, voffB);
            PG8_BAR; PG8_WAIT_L(0); PG8_MMA(0, 1, At, B1); PG8_BAR;
            PG8_LDA(At, 1, 1); PG8_STAGE(PG8_SA(1, 0), a3, o20);
            PG8_BAR; PG8_WAIT_L(0); PG8_MMA(1, 0, At, B0); PG8_BAR; PG8_SCHED;
            PG8_STAGE(PG8_SB(1, 1), b3 + hstepB, voffB);
            PG8_WAIT_V(6); PG8_BAR; PG8_MMA(1, 1, At, B1); PG8_BAR;
        }
        E(acc, cur, wr, wc, fr, fq);
        if (!has_next) break;
#pragma unroll
        for (int a = 0; a < 2; ++a)
#pragma unroll
            for (int b = 0; b < 2; ++b)
#pragma unroll
                for (int m = 0; m < 4; ++m)
#pragma unroll
                    for (int n = 0; n < 2; ++n) acc[a][b][m][n] = (f32x4){0.f, 0.f, 0.f, 0.f};
        cur = nxt; cB = nB; ++ui;
#pragma unroll
        for (int i = 0; i < 2; ++i) { oC0[i] = oN0[i]; oC1[i] = oN1[i]; }
    }
    PG8_WAIT_V(0);
    if (wr == 0) PG8_BAR;
    PG8_BAR;
#undef PG8_SA
#undef PG8_SB
#undef PG8_STAGE
#undef PG8_LDA
#undef PG8_LDB
#undef PG8_MMA
#undef PG8_WAIT_V
#undef PG8_WAIT_L
#undef PG8_BAR
#undef PG8_SCHED
}

template <int ACT> struct EpiStoreBf16 {
    static constexpr bool PERM = true;
    bf16_t* O; int ldc; const float* vec; int split_cols; size_t split_stride;
    __device__ __forceinline__ float act(float v, float b) const {
        if (ACT == 1) return 2.f * sigmoidf_(2.f * v) - 1.f;
        if (ACT == 2) return sigmoidf_(v);
        if (ACT == 3) return 0.60653065971f * sigmoidf_(v + b);
        if (ACT == 4) return sigmoidf_(v + b);
        return v;
    }
    __device__ __forceinline__ void operator()(const f32x4 (&acc)[2][2][4][2], const Unit& u, int wr, int wc, int fr, int fq) const {
        const int row0 = u.arow0 + wr * 64 + fr; int colt = u.col0; bf16_t* base = O;
        if (split_cols) { const int t = colt / split_cols; base += (size_t)t * split_stride; colt -= t * split_cols; }
        const int col0 = colt + wc * 32 + 8 * fq, bcol0 = u.col0 + wc * 32 + 8 * fq;
#pragma unroll
        for (int bj = 0; bj < 2; ++bj) {
            const f32x4 b0 = (ACT >= 3) ? *(const f32x4*)(vec + bcol0 + bj * HALF) : (f32x4){0.f, 0.f, 0.f, 0.f}, b1 = (ACT >= 3) ? *(const f32x4*)(vec + bcol0 + bj * HALF + 4) : (f32x4){0.f, 0.f, 0.f, 0.f};
#pragma unroll
            for (int ai = 0; ai < 2; ++ai)
#pragma unroll
                for (int m = 0; m < 4; ++m) { bf16_t* rowp = base + (size_t)(row0 + ai * HALF + m * 16) * ldc + col0; const f32x4 v0 = acc[ai][bj][m][0], v1 = acc[ai][bj][m][1];
                {
                    u32x4 o; o[0] = cvt_pk_bf16(act(v0[0], b0[0]), act(v0[1], b0[1])); o[1] = cvt_pk_bf16(act(v0[2], b0[2]), act(v0[3], b0[3]));
                    o[2] = cvt_pk_bf16(act(v1[0], b1[0]), act(v1[1], b1[1])); o[3] = cvt_pk_bf16(act(v1[2], b1[2]), act(v1[3], b1[3]));
                    *(u32x4*)(rowp + bj * HALF) = o; } }
        }
    }
};
struct EpiMultiBf16 {
    static constexpr bool PERM = true;
    bf16_t* O; size_t ostride; unsigned omap; int ldc; unsigned acts; const float* V; long vd2; int vd1;
    __device__ __forceinline__ void operator()(const f32x4 (&acc)[2][2][4][2], const Unit& u, int wr, int wc, int fr, int fq) const {
        const int w = u.e; bf16_t* base = O + (size_t)((omap >> (4 * w)) & 15u) * ostride; const float* vec = V + (w >= 2 ? vd2 : 0l) + (w & 1) * vd1;
        const unsigned a = (acts >> (4 * w)) & 15u;
        const bool lin = a == 0u, hasb = a >= 3u;
        const float alpha = a == 1u ? 2.f : a == 3u ? 0.60653065971f : 1.f, beta = a == 1u ? 2.f : 1.f, gamma = a == 1u ? -1.f : 0.f;
        const int row0 = u.arow0 + wr * 64 + fr, col0 = u.col0 + wc * 32 + 8 * fq;
#pragma unroll
        for (int bj = 0; bj < 2; ++bj) {
            f32x4 b0 = (f32x4){0.f, 0.f, 0.f, 0.f}, b1 = b0;
            if (hasb) { b0 = *(const f32x4*)(vec + col0 + bj * HALF); b1 = *(const f32x4*)(vec + col0 + bj * HALF + 4); }
#pragma unroll
            for (int ai = 0; ai < 2; ++ai)
#pragma unroll
                for (int m = 0; m < 4; ++m) { bf16_t* rowp = base + (size_t)(row0 + ai * HALF + m * 16) * ldc + col0; const f32x4 x0 = acc[ai][bj][m][0], x1 = acc[ai][bj][m][1];
                    float r[8];
#pragma unroll
                    for (int j = 0; j < 4; ++j) { const float s0 = alpha * sigmoidf_(beta * x0[j] + b0[j]) + gamma, s1 = alpha * sigmoidf_(beta * x1[j] + b1[j]) + gamma;
                        r[j] = lin ? x0[j] : s0; r[4 + j] = lin ? x1[j] : s1; }
                    u32x4 o; o[0] = cvt_pk_bf16(r[0], r[1]); o[1] = cvt_pk_bf16(r[2], r[3]); o[2] = cvt_pk_bf16(r[4], r[5]); o[3] = cvt_pk_bf16(r[6], r[7]);
                    *(u32x4*)(rowp + bj * HALF) = o; }
        }
    }
};
struct EpiRes {
    static constexpr bool PERM = false;
    const float* xin_l; float* out_l; const float* xin_c; float* out_c; const float* gate;
    __device__ __forceinline__ void operator()(const f32x4 (&acc)[2][2][4][2], const Unit& u, int wr, int wc, int fr, int fq) const {
        const int row0 = u.arow0 + wr * 64 + fr, col0 = u.col0 + wc * 32 + 4 * fq;
        const bool isc = u.arow0 >= ML;
        const int gb = isc ? 2 : (u.arow0 / SEQ);
        const float* gp = gate + (size_t)gb * MODW + col0;
        f32x4 gv[2][2];
#pragma unroll
        for (int bj = 0; bj < 2; ++bj)
#pragma unroll
            for (int n = 0; n < 2; ++n) gv[bj][n] = *(const f32x4*)(gp + bj * HALF + n * 16);
        const float* xi = isc ? xin_c - (size_t)ML * D : xin_l; float* xo = isc ? out_c - (size_t)ML * D : out_l;
#pragma unroll
        for (int ai = 0; ai < 2; ++ai) {
            f32x4 xv[4][2][2];
#pragma unroll
            for (int m = 0; m < 4; ++m) { const size_t ro = (size_t)(row0 + ai * HALF + m * 16) * D + col0;
#pragma unroll
                for (int bj = 0; bj < 2; ++bj)
#pragma unroll
                    for (int n = 0; n < 2; ++n) xv[m][bj][n] = *(const f32x4*)(xi + ro + bj * HALF + n * 16); }
            __builtin_amdgcn_sched_barrier(0);
#pragma unroll
            for (int m = 0; m < 4; ++m) { const size_t ro = (size_t)(row0 + ai * HALF + m * 16) * D + col0;
#pragma unroll
                for (int bj = 0; bj < 2; ++bj)
#pragma unroll
                    for (int n = 0; n < 2; ++n) *(f32x4*)(xo + ro + bj * HALF + n * 16) = xv[m][bj][n] + gv[bj][n] * acc[ai][bj][m][n]; }
        }
    }
};
struct EpiMoeUp {
    static constexpr bool PERM = false;
    bf16_t* H;
    __device__ __forceinline__ void operator()(const f32x4 (&acc)[2][2][4][2], const Unit& u, int wr, int wc, int fr, int fq) const {
        const int row0 = u.arow0 + wr * 64 + fr;
#pragma unroll
        for (int ai = 0; ai < 2; ++ai)
#pragma unroll
            for (int m = 0; m < 4; ++m) { bf16_t* rowp = H + (size_t)(row0 + ai * HALF + m * 16) * FF;
#pragma unroll
                for (int bj = 0; bj < 2; ++bj) { const int j = (u.col0 + bj * HALF + wc * 32) / 2 + 4 * fq; const f32x4 a = acc[ai][bj][m][0], b = acc[ai][bj][m][1];
                    float h[4];
#pragma unroll
                    for (int i = 0; i < 4; ++i) h[i] = a[i] * sigmoidf_(a[i]) * b[i];
                    u32x2 o; o[0] = cvt_pk_bf16(h[0], h[1]); o[1] = cvt_pk_bf16(h[2], h[3]);
                    *(u32x2*)(rowp + j) = o; } }
    }
};
}

struct MoeSched {
    const LAS int* pref; const LAS int* cnt; const int* tokl; int nN, G, c, K, rowsB; bool gather;
    __device__ bool next(int i, pg8::Unit& u) const {
        const long L = (long)i * G + c; const int T = __builtin_amdgcn_readfirstlane(pref[NEXP]);
        if (L >= (long)T * nN) return false;
        const int tl = (int)(L / nN), pn = (int)(L % nN);
        int e = 0;
        for (int k = 1; k < NEXP; ++k) e = (pref[k] <= tl) ? k : e;
        e = __builtin_amdgcn_readfirstlane(e);
        u.e = e; u.pbase = __builtin_amdgcn_readfirstlane((tl - pref[e]) * 256); u.cnt = __builtin_amdgcn_readfirstlane(cnt[e]); u.arow0 = tl * 256; u.brow0 = e * rowsB + pn * 256; u.col0 = pn * 256; return true;
    }
    __device__ __forceinline__ unsigned a_off(const pg8::Unit& u, int r, int C) const {
        if (gather) { const int p = u.pbase + r; const int t_ = tokl[(size_t)u.e * MT + min(p, u.cnt - 1)]; const int tok = (p < u.cnt) ? t_ : 0; return (unsigned)(tok * K + C) * 2u; }
        return (unsigned)((u.arow0 + r) * K + C) * 2u;
    }
};

#define WSP(T, off) ((T*)(F.ws + (off)))
__device__ __forceinline__ const float* mod_row(const Frame& F, int layer, int row3) { return (const float*)(F.ws + WS_MOD) + ((size_t)layer * 3 + row3) * MODW; }

__device__ __forceinline__ void expert_prefix(const Frame& F, int layer, LAS int* pref, LAS int* cntl) {
    if (F.wave == 0) {
        const int lane = F.lane_();
        int c = 0; if (lane < NEXP) c = WSP(int, WS_CTL + CTL_CNT)[(size_t)(layer * NEXP + lane) * CNT_STRIDE];
        const int t = (c + 255) >> 8; int sc_ = t;
#pragma unroll
        for (int d = 1; d < NEXP; d <<= 1) { const int o = __shfl_up(sc_, d); if (lane >= d) sc_ += o; }
        if (lane < NEXP) { pref[lane] = sc_ - t; if (cntl) cntl[lane] = c; }
        if (lane == NEXP - 1) pref[NEXP] = sc_;
    }
    __syncthreads();
}

struct CvtJob { const float* src; const float* src2; bf16_t* dst; int Ksrc, Nsrc, ld_src, Kdst, Ndst, koff, grp_rows; size_t grp_stride; int mode; };
struct CvtRegs { f32x4 v[4]; };
__device__ __forceinline__ void cvt_load(const CvtJob& J, int tile, int tid, CvtRegs& R) {
    const int ktiles = J.Kdst / 64, nt = tile / ktiles, kt = tile % ktiles, n0 = nt * 128, k0 = kt * 64;
    const int e = n0 / J.grp_rows, nl0 = n0 % J.grp_rows;
    const int kr = tid >> 3, c8 = tid & 7;
    const int ks = k0 + kr - J.koff;
    const bool kok = (ks >= 0) && (ks < J.Ksrc);
#pragma unroll
    for (int cc = 0; cc < 2; ++cc) {
        const int nl = nl0 + (c8 + cc * 8) * 8;
        const float* sp = J.src + (size_t)e * J.grp_stride; int ncol = nl;
        if (J.mode == 1) { const int g = nl >> 5, w = nl & 31; sp = (w < 16 ? J.src : J.src2) + (size_t)e * J.grp_stride; ncol = g * 16 + (w & 15); }
        if (kok && ncol + 8 <= J.Nsrc) { const float* p = sp + (size_t)ks * J.ld_src + ncol; R.v[cc * 2] = *(const f32x4*)p; R.v[cc * 2 + 1] = *(const f32x4*)(p + 4); }
        else { R.v[cc * 2] = (f32x4){0.f, 0.f, 0.f, 0.f}; R.v[cc * 2 + 1] = (f32x4){0.f, 0.f, 0.f, 0.f}; }
    }
}
__device__ __forceinline__ void cvt_job(const Frame& F, const CvtJob& J, int& base, int nw = 0, int wi = 0) {
    const int ntiles = (J.Ndst / 128) * (J.Kdst / 64), tid = F.tid_();
    LAS float* tl = (LAS float*)F.lds;
    const int G_ = nw > 0 ? nw : F.G, me = nw > 0 ? wi : F.bid;
    if (me < 0) return;
    int t = ((me - base) % G_ + G_) % G_;
    base = (base + ntiles) % G_;
    if (t >= ntiles) return;
    CvtRegs cur, nxt; cvt_load(J, t, tid, cur);
    const int ktiles = J.Kdst / 64;
    for (; t < ntiles; t += G_) {
        const bool hn = (t + G_) < ntiles;
        if (hn) cvt_load(J, t + G_, tid, nxt);
        const int kr = tid >> 3, c8 = tid & 7;
#pragma unroll
        for (int cc = 0; cc < 2; ++cc)
#pragma unroll
            for (int j = 0; j < 8; ++j) tl[kr * 129 + (c8 + cc * 8) * 8 + j] = cur.v[cc * 2 + (j >> 2)][j & 3];
        __syncthreads();
        const int nrow = tid >> 2, kq = tid & 3, nt = t / ktiles, kt = t % ktiles;
        float x[16];
#pragma unroll
        for (int j = 0; j < 16; ++j) x[j] = tl[(kq * 16 + j) * 129 + nrow];
        u32x4 o0, o1;
#pragma unroll
        for (int j = 0; j < 4; ++j) { o0[j] = cvt_pk_bf16(x[2 * j], x[2 * j + 1]); o1[j] = cvt_pk_bf16(x[8 + 2 * j], x[8 + 2 * j + 1]); }
        bf16_t* dp = J.dst + (size_t)(nt * 128 + nrow) * J.Kdst + kt * 64 + kq * 16;
        *(u32x4*)dp = o0; *(u32x4*)(dp + 8) = o1;
        __syncthreads();
        if (hn) cur = nxt;
    }
}
__device__ __forceinline__ void cvt_simple(const Frame& F, const float* src, bf16_t* dst, int Ksrc, int Nsrc, int& base) {
    CvtJob J{src, src, dst, Ksrc, Nsrc, Nsrc, Ksrc, Nsrc, 0, Nsrc, 0, 0}; cvt_job(F, J, base);
}
__device__ __forceinline__ void cvt_moe13(const Frame& F, int layer, bf16_t* w13, int& base, int nw = 0, int wi = 0) {
    const size_t lo = (size_t)layer * NEXP * D * FF;
    CvtJob J1{F.A.in[I_MW1] + lo, F.A.in[I_MW3] + lo, w13, D, FF, FF, D, NEXP * 2 * FF, 0, 2 * FF, (size_t)D * FF, 1}; cvt_job(F, J1, base, nw, wi);
}
__device__ __forceinline__ void cvt_moe2(const Frame& F, int layer, bf16_t* w2t, int& base, int nw = 0, int wi = 0) {
    const size_t lo = (size_t)layer * NEXP * D * FF;
    CvtJob J2{F.A.in[I_MW2] + lo, F.A.in[I_MW2] + lo, w2t, FF, D, D, FF, NEXP * D, 0, D, (size_t)FF * D, 0}; cvt_job(F, J2, base, nw, wi);
}
__device__ __forceinline__ void cvt_moe(const Frame& F, int layer, bf16_t* w13, bf16_t* w2t, int& base) { cvt_moe13(F, layer, w13, base); cvt_moe2(F, layer, w2t, base); }

__device__ __forceinline__ void ph_prologue(const Frame& F) {
    const int tid = F.tid_();
    {
        LAS float* cv = (LAS float*)F.lds;
        LAS float* red = (LAS float*)(F.lds + 32768);
        for (int k = tid; k < D; k += NTHR) {
            const float c0 = F.A.in[I_C][k], c1 = F.A.in[I_C][D + k], c2 = F.A.in[I_CCTX][k];
            cv[k] = c0 * sigmoidf_(c0); cv[D + k] = c1 * sigmoidf_(c1); cv[2 * D + k] = c2 * sigmoidf_(c2);
        }
        __syncthreads();
        for (int item = F.bid; item < 2 * 96; item += F.G) {
            const int l = item / 96, n0 = (item % 96) * 128, c4 = tid & 31, kg = tid >> 5;
            float a[3][4];
#pragma unroll
            for (int r = 0; r < 3; ++r)
#pragma unroll
                for (int j = 0; j < 4; ++j) a[r][j] = 0.f;
            const float* wp = F.A.in[I_ADAW] + (size_t)l * D * MODW + n0 + c4 * 4;
#pragma unroll 1
            for (int kb = kg; kb < D; kb += 16 * 16) {
                f32x4 w[16];
#pragma unroll
                for (int u = 0; u < 16; ++u) w[u] = *(const f32x4*)(wp + (size_t)(kb + 16 * u) * MODW);
                __builtin_amdgcn_sched_barrier(0);
#pragma unroll
                for (int u = 0; u < 16; ++u) { const int k = kb + 16 * u; const float s0 = cv[k], s1 = cv[D + k], s2 = cv[2 * D + k];
#pragma unroll
                    for (int j = 0; j < 4; ++j) { a[0][j] += s0 * w[u][j]; a[1][j] += s1 * w[u][j]; a[2][j] += s2 * w[u][j]; } }
            }
#pragma unroll
            for (int r = 0; r < 3; ++r)
#pragma unroll
                for (int j = 0; j < 4; ++j) red[(kg * 3 + r) * 128 + c4 * 4 + j] = a[r][j];
            __syncthreads();
            if (tid < 384) { const int r = tid >> 7, n = tid & 127; float s = F.A.in[I_ADAB][(size_t)l * MODW + n0 + n];
                for (int g = 0; g < 16; ++g) s += red[(g * 3 + r) * 128 + n];
                WSP(float, WS_MOD)[((size_t)l * 3 + r) * MODW + n0 + n] = s; }
            __syncthreads();
        }
        __syncthreads();
    }
    int base = 0;
    cvt_simple(F, F.A.in[I_WIN], WSP(bf16_t, WT_IN), D, QKVC, base);
    cvt_simple(F, F.A.in[I_WOUT], WSP(bf16_t, WT_OUT), D, D, base);
    cvt_simple(F, F.A.in[I_WR], WSP(bf16_t, WT_R), D, D, base);
    cvt_simple(F, F.A.in[I_WK], WSP(bf16_t, WT_K), D, D, base);
    cvt_simple(F, F.A.in[I_WV], WSP(bf16_t, WT_V), D, D, base);
    cvt_simple(F, F.A.in[I_WO], WSP(bf16_t, WT_O), D, D, base);
    for (int d = 0; d < 2; ++d) {
        { CvtJob J{F.A.in[I_W1] + (size_t)d * D * 96, nullptr, WSP(bf16_t, WT_W1) + (size_t)d * 128 * D, D, 96, 96, D, 128, 0, 128, 0, 0}; cvt_job(F, J, base); }
        { CvtJob J{F.A.in[I_A1] + (size_t)d * D * 96, nullptr, WSP(bf16_t, WT_A1) + (size_t)d * 128 * D, D, 96, 96, D, 128, 0, 128, 0, 0}; cvt_job(F, J, base); }
        { CvtJob J{F.A.in[I_W2] + (size_t)d * 96 * D, nullptr, WSP(bf16_t, WT_W2) + (size_t)d * D * 128, 96, D, D, 128, D, 0, D, 0, 0}; cvt_job(F, J, base); }
        { CvtJob J{F.A.in[I_A2] + (size_t)d * 96 * D, nullptr, WSP(bf16_t, WT_A2) + (size_t)d * D * 128, 96, D, D, 128, D, 0, D, 0, 0}; cvt_job(F, J, base); }
    }
    cvt_simple(F, F.A.in[I_G1], WSP(bf16_t, WT_G1), D, 256, base);
    cvt_simple(F, F.A.in[I_G2], WSP(bf16_t, WT_G2), 256, D, base);
}

struct RowOpts {
    const float* src_l; const float* src_c;
    int nrows;
    bool combine; int comb_layer; const bf16_t* yslot; float* dst_l; float* dst_c;
    bool norm; int layer; int which;
    bf16_t* H;
    bool router;
};
__device__ __forceinline__ void ph_rows(const Frame& F, const RowOpts& O) {
    LAS int* pref = (LAS int*)(F.lds + MISC_OFF + 1024);
    if (O.combine) expert_prefix(F, O.comb_layer, pref, (LAS int*)nullptr);
    const int lane = F.lane_(), stride = F.G * 8;
    LAS float* PA = (LAS float*)F.lds; LAS float* PB = PA + 3 * D; LAS float* PG = PA + 6 * D;
    int t0 = F.tid_(); asm volatile("" : "+v"(t0));
    for (int idx = t0; idx < 3 * D / 4; idx += NTHR) {
        const int m = idx / (D / 4), c = (idx % (D / 4)) * 4;
        if (O.norm) {
            const float* gn = (O.which ? F.A.in[I_NFFN] : F.A.in[I_NMIX]) + (size_t)O.layer * D; const float* mr = mod_row(F, O.layer, m);
            const f32x4 g = *(const f32x4*)(gn + c), sc = *(const f32x4*)(mr + (O.which ? 4 * D : D) + c), sh = *(const f32x4*)(mr + (O.which ? 3 * D : 0) + c);
            f32x4 a;
#pragma unroll
            for (int j = 0; j < 4; ++j) a[j] = g[j] * (1.f + sc[j]);
            *(LAS f32x4*)(PA + m * D + c) = a; *(LAS f32x4*)(PB + m * D + c) = sh;
        }
        if (O.combine) *(LAS f32x4*)(PG + m * D + c) = *(const f32x4*)(mod_row(F, O.comb_layer, m) + 5 * D + c);
    }
    __syncthreads();
    struct RowIn { f32x4 v[8]; int s0, s1; float g0, g1; };
    auto loadrow = [&](int r, RowIn& R) {
        const float* sp = (r >= ML) ? O.src_c + (size_t)(r - ML) * D : O.src_l + (size_t)r * D;
#pragma unroll
        for (int i = 0; i < 8; ++i) R.v[i] = *(const f32x4*)(sp + i * 256 + lane * 4);
        if (O.combine) { R.s0 = WSP(int, WS_TOKSEL)[r * 2]; R.s1 = WSP(int, WS_TOKSEL)[r * 2 + 1]; R.g0 = WSP(float, WS_TOKGATE)[r * 2]; R.g1 = WSP(float, WS_TOKGATE)[r * 2 + 1]; }
    };
    RowIn cur, nxt;
    int r = F.bid * 8 + F.wave;
    if (r < O.nrows) loadrow(r, cur);
    for (; r < O.nrows; r += stride) {
        if (r + stride < O.nrows) loadrow(r + stride, nxt);
        const bool isc = r >= ML;
        const int mrow = isc ? 2 : r / SEQ;
        f32x4 v[8];
#pragma unroll
        for (int i = 0; i < 8; ++i) v[i] = cur.v[i];
        if (O.combine) {
            const int s0 = cur.s0, s1 = cur.s1; const float g0 = cur.g0, g1 = cur.g1;
            const size_t y0 = ((size_t)pref[s0 >> 20] * 256 + (s0 & 0xfffff)) * D, y1 = ((size_t)pref[s1 >> 20] * 256 + (s1 & 0xfffff)) * D;
            const LAS float* gt = PG + mrow * D;
            float* dp = isc ? O.dst_c + (size_t)(r - ML) * D : O.dst_l + (size_t)r * D;
            u32x2 ya[8], yb[8];
#pragma unroll
            for (int i = 0; i < 8; ++i) { ya[i] = *(const u32x2*)(O.yslot + y0 + i * 256 + lane * 4); yb[i] = *(const u32x2*)(O.yslot + y1 + i * 256 + lane * 4); }
#pragma unroll
            for (int i = 0; i < 8; ++i) {
                const int col = i * 256 + lane * 4;
                const u32x2 a = ya[i], b = yb[i];
                const f32x4 g = *(const LAS f32x4*)(gt + col);
                v[i][0] += g[0] * (g0 * bf_lo(a[0]) + g1 * bf_lo(b[0])); v[i][1] += g[1] * (g0 * bf_hi(a[0]) + g1 * bf_hi(b[0]));
                v[i][2] += g[2] * (g0 * bf_lo(a[1]) + g1 * bf_lo(b[1])); v[i][3] += g[3] * (g0 * bf_hi(a[1]) + g1 * bf_hi(b[1]));
                if (TIME_PH >= 0 && !O.norm) { const float tsc = 1.f + sqrtf(*WSP(float, WS_CTL + 20496) * 1e-6f); v[i] *= tsc; }
                *(f32x4*)(dp + col) = v[i];
            }
        }
        if (O.norm) {
            float ss = 0.f;
#pragma unroll
            for (int i = 0; i < 8; ++i) ss += v[i][0] * v[i][0] + v[i][1] * v[i][1] + v[i][2] * v[i][2] + v[i][3] * v[i][3];
            ss = wave_sum(ss);
            const float rstd = rsqrtf(ss * (1.f / D) + 1e-6f);
            const LAS float* pa = PA + mrow * D; const LAS float* pb = PB + mrow * D;
            bf16_t* hp = O.H + (size_t)r * D;
#pragma unroll
            for (int i = 0; i < 8; ++i) {
                const int col = i * 256 + lane * 4;
                const f32x4 ga = *(const LAS f32x4*)(pa + col), sh = *(const LAS f32x4*)(pb + col);
#pragma unroll
                for (int j = 0; j < 4; ++j) v[i][j] = v[i][j] * rstd * ga[j] + sh[j];
                u32x2 o; o[0] = cvt_pk_bf16(v[i][0], v[i][1]); o[1] = cvt_pk_bf16(v[i][2], v[i][3]);
                *(u32x2*)(hp + col) = o;
            }
        }
        cur = nxt;
    }
}

__device__ __forceinline__ void ph_router_fold(const Frame& F) {
    const int tid = F.tid_();
    bf16_t* WFH = WSP(bf16_t, WS_WF); bf16_t* WFL = WFH + (size_t)6 * 48 * D; float* CV = WSP(float, WS_CV);
    for (int idx = F.bid * NTHR + tid; idx < 6 * 48 * (D / 8); idx += F.G * NTHR) {
        const int ln = idx & 63, j3 = (idx >> 6) % 3, s8 = (idx / 192) & 7, wv = (idx / 1536) & 7, lb = idx / 12288, l = lb / 3, b = lb % 3;
        const int n = j3 * 16 + (ln & 15), k8 = wv * 32 + s8 * 4 + (ln >> 4);
        const float* mr = mod_row(F, l, b);
        float v[8];
#pragma unroll
        for (int j = 0; j < 8; ++j) { const int k = k8 * 8 + j;
            const float sc = F.A.in[I_NFFN][(size_t)l * D + k] * (1.f + mr[4 * D + k]);
            const float w = n < 4 ? F.A.in[I_MGRP][((size_t)l * D + k) * 4 + n] : n < 36 ? F.A.in[I_MEXP][((size_t)l * D + k) * NEXP + n - 4] : 0.f;
            v[j] = w * sc; }
        u32x4 hi, lo;
#pragma unroll
        for (int j = 0; j < 4; ++j) { hi[j] = cvt_pk_bf16(v[2 * j], v[2 * j + 1]); lo[j] = cvt_pk_bf16(v[2 * j] - bf_lo(hi[j]), v[2 * j + 1] - bf_hi(hi[j])); }
        *(u32x4*)(WFH + (size_t)idx * 8) = hi; *(u32x4*)(WFL + (size_t)idx * 8) = lo;
    }
    const int lane = F.lane_();
    for (int it = F.bid * 8 + F.wave; it < 2 * 3 * 48; it += F.G * 8) {
        const int n = it % 48, lb = it / 48, l = lb / 3, b = lb % 3;
        const float* sh = mod_row(F, l, b) + 3 * D;
        float a = 0.f;
        if (n < 36) for (int k = lane; k < D; k += 64) { const float w = n < 4 ? F.A.in[I_MGRP][((size_t)l * D + k) * 4 + n] : F.A.in[I_MEXP][((size_t)l * D + k) * NEXP + n - 4]; a += sh[k] * w; }
        a = wave_sum(a);
        if (lane == 0) CV[lb * 48 + n] = a;
    }
}
__device__ __forceinline__ void ph_rows_router(const Frame& F, const float* src_l, const float* src_c, int nrows, int layer, bf16_t* H) {
    const int lane = F.lane_(), wave = F.wave, l15 = lane & 15, q4 = lane >> 4;
    LAS float* lt = (LAS float*)(F.lds + wave * 16640);
    LAS float* pa = (LAS float*)(F.lds + 8 * 16640);
    LAS float* l0 = pa;
    const float* gn = F.A.in[I_NFFN] + (size_t)layer * D;
    f32x4 xv[16];
    auto loadx = [&](int tl, f32x4 (&x)[16]) { const int r0 = tl * 16; const float* sp = (r0 >= ML) ? src_c + (size_t)(r0 - ML) * D : src_l + (size_t)r0 * D;
#pragma unroll
        for (int i = 0; i < 16; ++i) x[i] = *(const f32x4*)(sp + (size_t)i * D + wave * 256 + lane * 4); };
    if (F.bid * 16 < nrows) loadx(F.bid, xv);
    for (int tl = F.bid; tl * 16 < nrows; tl += F.G) {
        const int r0 = tl * 16; const bool isc = r0 >= ML; const int mrow = isc ? 2 : r0 / SEQ;
        const bf16_t* Wh = WSP(bf16_t, WS_WF) + (size_t)(layer * 3 + mrow) * 48 * D; const bf16_t* Wl = Wh + (size_t)6 * 48 * D; const float* cv = WSP(float, WS_CV) + (layer * 3 + mrow) * 48;
        f32x4 acc0 = (f32x4){0.f, 0.f, 0.f, 0.f}, acc1 = acc0, acc2 = acc0; float ssq[16];
#pragma unroll
        for (int i = 0; i < 16; ++i) { ssq[i] = xv[i][0] * xv[i][0] + xv[i][1] * xv[i][1] + xv[i][2] * xv[i][2] + xv[i][3] * xv[i][3]; *(LAS f32x4*)(lt + i * 260 + lane * 4) = xv[i]; }
        LAS float* pw_ = pa + wave * 784;
#pragma unroll
        for (int i = 0; i < 16; ++i) { const float t = wave_sum(ssq[i]); if (lane == i) pw_[768 + i] = t; }
        lds_fence();
        f32x4 pg, psc, psh; float cv0, cv1, cv2;
        {
            const bf16_t* wph = Wh + ((size_t)wave * 1536 + lane) * 8; const bf16_t* wpl = Wl + ((size_t)wave * 1536 + lane) * 8;
            const LAS float* ap = lt + l15 * 260 + q4 * 8;
            bf16x8 hA[2][3], lA[2][3], hB[2][3], lB[2][3];
#define RT_LOAD(kb, H_, L_) do { _Pragma("unroll") for (int s2 = 0; s2 < 2; ++s2) _Pragma("unroll") for (int j = 0; j < 3; ++j) { const size_t o = (size_t)((((kb) * 2 + s2) * 3 + j) * 64) * 8; \
                H_[s2][j] = *(const bf16x8*)(wph + o); L_[s2][j] = *(const bf16x8*)(wpl + o); } } while (0)
#define RT_MMA(kb, H_, L_) do { _Pragma("unroll") for (int s2 = 0; s2 < 2; ++s2) { const f32x4 xa = *(const LAS f32x4*)(ap + ((kb) * 2 + s2) * 32), xb = *(const LAS f32x4*)(ap + ((kb) * 2 + s2) * 32 + 4); \
                u32x4 xh_, xl_; \
                xh_[0] = cvt_pk_bf16(xa[0], xa[1]); xh_[1] = cvt_pk_bf16(xa[2], xa[3]); xh_[2] = cvt_pk_bf16(xb[0], xb[1]); xh_[3] = cvt_pk_bf16(xb[2], xb[3]); \
                xl_[0] = cvt_pk_bf16(xa[0] - bf_lo(xh_[0]), xa[1] - bf_hi(xh_[0])); xl_[1] = cvt_pk_bf16(xa[2] - bf_lo(xh_[1]), xa[3] - bf_hi(xh_[1])); \
                xl_[2] = cvt_pk_bf16(xb[0] - bf_lo(xh_[2]), xb[1] - bf_hi(xh_[2])); xl_[3] = cvt_pk_bf16(xb[2] - bf_lo(xh_[3]), xb[3] - bf_hi(xh_[3])); \
                const bf16x8 ah = *reinterpret_cast<const bf16x8*>(&xh_), al = *reinterpret_cast<const bf16x8*>(&xl_); \
                acc0 = __builtin_amdgcn_mfma_f32_16x16x32_bf16(ah, H_[s2][0], acc0, 0, 0, 0); acc1 = __builtin_amdgcn_mfma_f32_16x16x32_bf16(ah, H_[s2][1], acc1, 0, 0, 0); acc2 = __builtin_amdgcn_mfma_f32_16x16x32_bf16(ah, H_[s2][2], acc2, 0, 0, 0); \
                acc0 = __builtin_amdgcn_mfma_f32_16x16x32_bf16(ah, L_[s2][0], acc0, 0, 0, 0); acc1 = __builtin_amdgcn_mfma_f32_16x16x32_bf16(ah, L_[s2][1], acc1, 0, 0, 0); acc2 = __builtin_amdgcn_mfma_f32_16x16x32_bf16(ah, L_[s2][2], acc2, 0, 0, 0); \
                acc0 = __builtin_amdgcn_mfma_f32_16x16x32_bf16(al, H_[s2][0], acc0, 0, 0, 0); acc1 = __builtin_amdgcn_mfma_f32_16x16x32_bf16(al, H_[s2][1], acc1, 0, 0, 0); acc2 = __builtin_amdgcn_mfma_f32_16x16x32_bf16(al, H_[s2][2], acc2, 0, 0, 0); } } while (0)
            RT_LOAD(0, hA, lA); __builtin_amdgcn_sched_barrier(0);
            RT_LOAD(1, hB, lB); __builtin_amdgcn_sched_barrier(0);
            { const float* mr = mod_row(F, layer, mrow); const int col = wave * 256 + lane * 4;
              pg = *(const f32x4*)(gn + col); psc = *(const f32x4*)(mr + 4 * D + col); psh = *(const f32x4*)(mr + 3 * D + col); cv0 = cv[l15]; cv1 = cv[16 + l15]; cv2 = cv[32 + l15]; }
            __builtin_amdgcn_sched_barrier(0);
            loadx((tl + F.G) * 16 < nrows ? tl + F.G : tl, xv);
            __builtin_amdgcn_sched_barrier(0);
            RT_MMA(0, hA, lA); __builtin_amdgcn_sched_barrier(0);
            RT_LOAD(2, hA, lA); __builtin_amdgcn_sched_barrier(0);
            RT_MMA(1, hB, lB); __builtin_amdgcn_sched_barrier(0);
            RT_LOAD(3, hB, lB); __builtin_amdgcn_sched_barrier(0);
            RT_MMA(2, hA, lA); __builtin_amdgcn_sched_barrier(0);
            RT_MMA(3, hB, lB); __builtin_amdgcn_sched_barrier(0);
#undef RT_LOAD
#undef RT_MMA
        }
#pragma unroll
        for (int j = 0; j < 4; ++j) { pw_[lane * 12 + j] = acc0[j]; pw_[lane * 12 + 4 + j] = acc1[j]; pw_[lane * 12 + 8 + j] = acc2[j]; }
        __syncthreads();
        float sst = 0.f; f32x4 t0 = (f32x4){0.f, 0.f, 0.f, 0.f}, t1 = t0, t2 = t0;
#pragma unroll
        for (int w = 0; w < 8; ++w) { const LAS float* pw = pa + w * 784; sst += pw[768 + l15];
            if (wave == 0) {
#pragma unroll
                for (int j = 0; j < 4; ++j) { t0[j] += pw[lane * 12 + j]; t1[j] += pw[lane * 12 + 4 + j]; t2[j] += pw[lane * 12 + 8 + j]; } } }
        const float rs_own = rsqrtf(sst * (1.f / D) + 1e-6f);
        __syncthreads();
        int ea = 0, eb = 0, pa_ = 0, pb_ = 0; float w1g = 0.f, w2g = 0.f;
        if (wave == 0) {
#pragma unroll
            for (int j = 0; j < 4; ++j) { const int row = 4 * q4 + j; const float rs = __shfl(rs_own, row);
                l0[row * 48 + l15] = rs * t0[j] + cv0; l0[row * 48 + 16 + l15] = rs * t1[j] + cv1; l0[row * 48 + 32 + l15] = rs * t2[j] + cv2; }
            lds_fence();
            if (lane < 16) {
                const LAS float* lg = l0 + lane * 48;
                int gs = 0; float gm = lg[0];
#pragma unroll
                for (int q = 1; q < 4; ++q) if (lg[q] > gm) { gm = lg[q]; gs = q; }
                float den = 0.f;
#pragma unroll
                for (int q = 0; q < 4; ++q) den += __expf(lg[q] - gm);
                const float psel = 1.f / den;
                const LAS float* el = lg + 4 + gs * 8;
                int i1 = 0; float v1 = el[0];
#pragma unroll
                for (int q = 1; q < 8; ++q) if (el[q] > v1) { v1 = el[q]; i1 = q; }
                int i2 = -1; float v2 = -3.0e38f;
#pragma unroll
                for (int q = 0; q < 8; ++q) if (q != i1 && el[q] > v2) { v2 = el[q]; i2 = q; }
                const float e2 = __expf(v2 - v1); w1g = psel / (1.f + e2); w2g = psel * e2 / (1.f + e2);
                int* cnt = WSP(int, WS_CTL + CTL_CNT) + layer * NEXP * CNT_STRIDE;
                ea = gs * 8 + i1; eb = gs * 8 + i2;
                pa_ = atomicAdd(cnt + ea * CNT_STRIDE, 1); pb_ = atomicAdd(cnt + eb * CNT_STRIDE, 1);
            }
        }
        {
            const int col = wave * 256 + lane * 4;
            const f32x4 sh = psh;
            f32x4 m;
#pragma unroll
            for (int j = 0; j < 4; ++j) m[j] = pg[j] * (1.f + psc[j]);
#pragma unroll
            for (int i = 0; i < 16; ++i) { const float rs = __int_as_float(__builtin_amdgcn_readlane(__float_as_int(rs_own), i)); const f32x4 x = *(const LAS f32x4*)(lt + i * 260 + lane * 4);
                u32x2 o; o[0] = cvt_pk_bf16(x[0] * rs * m[0] + sh[0], x[1] * rs * m[1] + sh[1]); o[1] = cvt_pk_bf16(x[2] * rs * m[2] + sh[2], x[3] * rs * m[3] + sh[3]);
                *(u32x2*)(H + (size_t)(r0 + i) * D + col) = o; }
        }
        if (wave == 0 && lane < 16) { const int r = r0 + lane;
            WSP(int, WS_TOKL)[(size_t)ea * MT + pa_] = r; WSP(int, WS_TOKL)[(size_t)eb * MT + pb_] = r;
            WSP(int, WS_TOKSEL)[r * 2] = (ea << 20) | pa_; WSP(int, WS_TOKSEL)[r * 2 + 1] = (eb << 20) | pb_;
            WSP(float, WS_TOKGATE)[r * 2] = w1g; WSP(float, WS_TOKGATE)[r * 2 + 1] = w2g; }
    }
    __syncthreads();
}

__device__ __forceinline__ void ph_qknorm(const Frame& F, bf16_t* QKV) {
    const int lane = F.lane_();
    const int il = lane & 15;
    const float f0 = exp2f(-(float)(2 * il) * (13.287712379549449f / 32.f)), f1 = exp2f(-(float)(2 * il + 1) * (13.287712379549449f / 32.f));
    const int stride = F.G * 8;
    auto loadrow = [&](int r, unsigned (&u)[10]) {
        const bf16_t* row = QKV + (size_t)r * QKVC;
#pragma unroll
        for (int hd = 0; hd < 10; ++hd) { const int col = hd < 2 ? KA0 + hd * 128 : KB0 + (hd - 2) * 128;
            u[hd] = *(const unsigned*)(row + col + 2 * lane); }
    };
    unsigned u[10], un[10];
    const f32x2 gga = *(const f32x2*)(F.A.in[I_AKG] + 2 * lane), ggb = *(const f32x2*)(F.A.in[I_BKG] + 2 * lane);
    int r = F.bid * 8 + F.wave;
    if (r < MT) loadrow(r, u);
    for (; r < MT; r += stride) {
        if (r + stride < MT) loadrow(r + stride, un);
        const bool lat = r < ML; const int t = r % SEQ;
        const float pos = (lane < 32) ? (float)(t / 64) : (float)(t % 64);
        float c0 = 1.f, s0 = 0.f, c1 = 1.f, s1 = 0.f;
        if (lat) { const float r0_ = __builtin_amdgcn_fractf(pos * f0 * 0.15915494309189535f), r1_ = __builtin_amdgcn_fractf(pos * f1 * 0.15915494309189535f);
            s0 = __builtin_amdgcn_sinf(r0_); c0 = __builtin_amdgcn_cosf(r0_); s1 = __builtin_amdgcn_sinf(r1_); c1 = __builtin_amdgcn_cosf(r1_); }
        bf16_t* row = QKV + (size_t)r * QKVC;
        float ss[10];
#pragma unroll
        for (int hd = 0; hd < 10; ++hd) { const float x0 = bf_lo(u[hd]), x1 = bf_hi(u[hd]); ss[hd] = x0 * x0 + x1 * x1; }
#pragma unroll
        for (int hd = 0; hd < 10; ++hd) ss[hd] = wave_sum(ss[hd]);
#pragma unroll
        for (int hd = 0; hd < 10; ++hd) { const int col = hd < 2 ? KA0 + hd * 128 : KB0 + (hd - 2) * 128;
            const f32x2 gg = hd < 2 ? gga : ggb;
            const float rstd = rsqrtf(ss[hd] * (1.f / 128.f) + 1e-6f);
            float x0 = bf_lo(u[hd]) * rstd * gg[0], x1 = bf_hi(u[hd]) * rstd * gg[1];
            if (hd < 2 && lat) {
                const float p0 = __shfl_xor(x0, 16), p1 = __shfl_xor(x1, 16);
                if ((lane & 16) == 0) { x0 = x0 * c0 - p0 * s0; x1 = x1 * c1 - p1 * s1; }
                else { x0 = p0 * s0 + x0 * c0; x1 = p1 * s1 + x1 * c1; }
            }
            *(unsigned*)(row + col + 2 * lane) = cvt_pk_bf16(x0, x1); }
#pragma unroll
        for (int hd = 0; hd < 10; ++hd) u[hd] = un[hd];
    }
}

namespace att {
typedef float f32x16 __attribute__((ext_vector_type(16)));
typedef short s16x4 __attribute__((ext_vector_type(4)));
constexpr int KVBLK = 64;
constexpr float SCALE = 0.08838834764831845f, THR = 8.f;
constexpr int SHM_V = KVBLK * 128 * 2, SHM_K = KVBLK * 128 * 2;
#define KSWZ(row, colB) ((row) * 256 + ((colB) ^ (((row) & 7) << 4)))
#define SBAR() __builtin_amdgcn_sched_barrier(0)
__device__ __forceinline__ int crow(int r, int hi) { return (r & 3) + 8 * (r >> 2) + 4 * hi; }
__device__ __forceinline__ void partialSM(f32x16& p0, f32x16& p1, float& m_reg, float& mn, float& alpha) {
  constexpr float C = SCALE * 1.4426950408889634f;
  float pmax = p0[0];
#pragma unroll
  for (int r = 1; r < 16; ++r) pmax = fmaxf(pmax, p0[r]);
#pragma unroll
  for (int r = 0; r < 16; ++r) pmax = fmaxf(pmax, p1[r]);
  { auto rr = __builtin_amdgcn_permlane32_swap(__float_as_uint(pmax), __float_as_uint(pmax), false, false);
    pmax = fmaxf(__uint_as_float(rr[0]), __uint_as_float(rr[1])); }
  if (__builtin_expect(__all(pmax - m_reg <= THR / SCALE), 1)) { mn = m_reg; alpha = 1.f; }
  else { mn = fmaxf(m_reg, pmax); alpha = __builtin_amdgcn_exp2f((m_reg - mn) * C); m_reg = mn; }
  float mnC = -mn * C;
#pragma unroll
  for (int r = 0; r < 16; ++r) p0[r] = fmaf(p0[r], C, mnC);
#pragma unroll
  for (int r = 0; r < 16; ++r) p1[r] = fmaf(p1[r], C, mnC);
#pragma unroll
  for (int r = 0; r < 16; ++r) p0[r] = __builtin_amdgcn_exp2f(p0[r]);
}
__device__ __forceinline__ void finishSM(f32x16& p0, f32x16& p1, float alpha, float& l_reg, bf16x8& pa0, bf16x8& pa1, bf16x8& pa2, bf16x8& pa3) {
#pragma unroll
  for (int r = 0; r < 16; ++r) p1[r] = __builtin_amdgcn_exp2f(p1[r]);
  float ps = 0;
#pragma unroll
  for (int r = 0; r < 16; ++r) ps += p0[r];
#pragma unroll
  for (int r = 0; r < 16; ++r) ps += p1[r];
  { auto rr = __builtin_amdgcn_permlane32_swap(__float_as_uint(ps), __float_as_uint(ps), false, false);
    ps = __uint_as_float(rr[0]) + __uint_as_float(rr[1]); }
  l_reg = l_reg * alpha + ps;
#define PK4(P, BASE, OUT) do { unsigned a0 = cvt_pk_bf16(P[BASE + 0], P[BASE + 1]), a1 = cvt_pk_bf16(P[BASE + 2], P[BASE + 3]);   \
    unsigned b0 = cvt_pk_bf16(P[BASE + 4], P[BASE + 5]), b1 = cvt_pk_bf16(P[BASE + 6], P[BASE + 7]);                              \
    auto r0 = __builtin_amdgcn_permlane32_swap(a0, b0, false, false); auto r1 = __builtin_amdgcn_permlane32_swap(a1, b1, false, false); \
    u32x4 w = {r0[0], r1[0], r0[1], r1[1]}; OUT = *reinterpret_cast<bf16x8*>(&w); } while (0)
  PK4(p0, 0, pa0); PK4(p0, 8, pa1); PK4(p1, 0, pa2); PK4(p1, 8, pa3);
#undef PK4
}
__device__ __forceinline__ void qkt(f32x16& p0, f32x16& p1, const LAS char* Ks, const bf16x8* qr, int r32, int hi) {
  asm volatile("" : "+v"(r32));
  p0 = f32x16{}; p1 = f32x16{};
#pragma unroll
  for (int d0 = 0; d0 < 8; ++d0) { int cb = (d0 * 16 + hi * 8) * 2;
    bf16x8 b0 = *reinterpret_cast<const LAS bf16x8*>(Ks + KSWZ(r32, cb));
    bf16x8 b1 = *reinterpret_cast<const LAS bf16x8*>(Ks + KSWZ(32 + r32, cb));
    p0 = __builtin_amdgcn_mfma_f32_32x32x16_bf16(b0, qr[d0], p0, 0, 0, 0);
    p1 = __builtin_amdgcn_mfma_f32_32x32x16_bf16(b1, qr[d0], p1, 0, 0, 0); }
}
__device__ __forceinline__ int v_st(int k, int c) { const int kk = (k & ~0xC) | ((k & 4) << 1) | ((k & 8) >> 1); return ((kk >> 3) * 4 + (c >> 5)) * 512 + ((kk & 7) * 32 + (c & 31)) * 2; }
__device__ __forceinline__ int v_rd_base(int lane) { return ((lane & 3) << 3) | (((lane >> 2) & 3) << 6) | (((lane >> 4) & 1) << 5) | (((lane >> 5) & 1) << 8); }
constexpr int v_rd_off(int d0, int ks, int half) { return d0 * 512 + ks * 4096 + half * 2048; }
template <int OFF> __device__ __forceinline__ s16x4 tr_read(int vb) {
  s16x4 r; asm volatile("ds_read_b64_tr_b16 %0, %1 offset:%2" : "=&v"(r) : "v"(vb), "i"(OFF) : "memory"); return r;
}
template <int D0> __device__ __forceinline__ void pv_one(f32x16& od, int vb, bf16x8 pa0, bf16x8 pa1, bf16x8 pa2, bf16x8 pa3) {
  const s16x4 l0 = tr_read<v_rd_off(D0, 0, 0)>(vb), h0 = tr_read<v_rd_off(D0, 0, 1)>(vb), l1 = tr_read<v_rd_off(D0, 1, 0)>(vb), h1 = tr_read<v_rd_off(D0, 1, 1)>(vb);
  const s16x4 l2 = tr_read<v_rd_off(D0, 2, 0)>(vb), h2 = tr_read<v_rd_off(D0, 2, 1)>(vb), l3 = tr_read<v_rd_off(D0, 3, 0)>(vb), h3 = tr_read<v_rd_off(D0, 3, 1)>(vb);
  asm volatile("s_waitcnt lgkmcnt(0)" ::: "memory"); SBAR();
#define PK(L, H) (bf16x8){L[0], L[1], L[2], L[3], H[0], H[1], H[2], H[3]}
  od = __builtin_amdgcn_mfma_f32_32x32x16_bf16(pa0, PK(l0, h0), od, 0, 0, 0);
  od = __builtin_amdgcn_mfma_f32_32x32x16_bf16(pa1, PK(l1, h1), od, 0, 0, 0);
  od = __builtin_amdgcn_mfma_f32_32x32x16_bf16(pa2, PK(l2, h2), od, 0, 0, 0);
  od = __builtin_amdgcn_mfma_f32_32x32x16_bf16(pa3, PK(l3, h3), od, 0, 0, 0);
#undef PK
}
__device__ __forceinline__ void pv_d0(f32x16* o, int vb, bf16x8 pa0, bf16x8 pa1, bf16x8 pa2, bf16x8 pa3) {
  pv_one<0>(o[0], vb, pa0, pa1, pa2, pa3); pv_one<1>(o[1], vb, pa0, pa1, pa2, pa3); pv_one<2>(o[2], vb, pa0, pa1, pa2, pa3); pv_one<3>(o[3], vb, pa0, pa1, pa2, pa3);
}
struct UnitD {
  int nW, NT;
  int wrow0, crow0;
  int qt, wlo;
};
__device__ __forceinline__ void mask_add(f32x16& p0, f32x16& p1, int hi, const LAS float* tp) {
  const LAS float* tq = tp + 4 * hi;
#pragma unroll
  for (int g2 = 0; g2 < 2; ++g2) {
    float a[8], b[8];
#pragma unroll
    for (int q = 0; q < 8; ++q) { const int jc = (q & 3) + 8 * (2 * g2 + (q >> 2)); a[q] = tq[jc]; b[q] = tq[jc + 32]; }
#pragma unroll
    for (int q = 0; q < 8; ++q) { const int r = 8 * g2 + q; p0[r] += a[q]; p1[r] += b[q]; }
    SBAR();
  }
}
__device__ __forceinline__ void mask_add2(f32x16& p0, f32x16& p1, int hi, const LAS float* tpA, const LAS float* tpB) {
  const LAS float* ta = tpA + 4 * hi; const LAS float* tb = tpB + 4 * hi;
#pragma unroll
  for (int g = 0; g < 4; ++g) {
    float a0[4], a1[4], b0[4], b1[4];
#pragma unroll
    for (int q = 0; q < 4; ++q) { const int jc = q + 8 * g; a0[q] = ta[jc]; a1[q] = ta[jc + 32]; b0[q] = tb[jc]; b1[q] = tb[jc + 32]; }
#pragma unroll
    for (int q = 0; q < 4; ++q) { const int r = 4 * g + q; p0[r] += a0[q] + b0[q]; p1[r] += a1[q] + b1[q]; }
    SBAR();
  }
}

__device__ __forceinline__ void attn_unit(const int TYPE, const bf16_t* __restrict__ Qw_, const bf16_t* __restrict__ Kc, const bf16_t* __restrict__ Vc, bf16_t* __restrict__ Ow, const UnitD U,
                                          const int wrr  , const float sink_l2  , LAS char* lds,
                                          const LAS float* qgain  , const bool qrope, const int qt0  ,
                                          int* aq, int& unext  ) {
  const int tid = threadIdx.x, wid = __builtin_amdgcn_readfirstlane(tid >> 6), lane = tid & 63, r32 = lane & 31, hi = lane >> 5;
  LAS char* V_lds = lds; LAS char* K_lds = lds + 2 * SHM_V;
  LAS float* ws = (LAS float*)(lds + 2 * SHM_V + 2 * SHM_K) + wid * 64; LAS float* li_l = ws; LAS float* al_l = ws + 32;
  const LAS float* tbl = (const LAS float*)(lds + 2 * SHM_V + 2 * SHM_K + 2048);
  float m_reg = -1e4f, l_reg = 0; bf16x8 qr[8];
  const bf16_t* Qw = Qw_ + (size_t)r32 * QKVC + hi * 8;
  const int sr = tid >> 4, sc = (tid & 15) * 8;
  struct { bf16x8 vs0, vs1, ks0, ks1; } sr_[1];
#define TROW(j) (((j) < U.nW) ? (U.wrow0 + (j) * 64) : (U.crow0 + (((j) - U.nW) & 3) * 64))
#define SLOAD(i, k0) do { const int _k0 = (k0); sr_[i].vs0 = *reinterpret_cast<const bf16x8*>(&Vc[(size_t)(_k0 + sr) * QKVC + sc]); sr_[i].vs1 = *reinterpret_cast<const bf16x8*>(&Vc[(size_t)(_k0 + 32 + sr) * QKVC + sc]); \
    sr_[i].ks0 = *reinterpret_cast<const bf16x8*>(&Kc[(size_t)(_k0 + sr) * QKVC + sc]); sr_[i].ks1 = *reinterpret_cast<const bf16x8*>(&Kc[(size_t)(_k0 + 32 + sr) * QKVC + sc]); } while (0)
  SLOAD(0, TROW(0)); __builtin_amdgcn_sched_barrier(0);
  {
    u32x4 raw[8]; float ssq = 0.f;
#pragma unroll
    for (int d0 = 0; d0 < 8; ++d0) raw[d0] = *reinterpret_cast<const u32x4*>(Qw + d0 * 16);
    __builtin_amdgcn_sched_barrier(0);
    if (tid == 0) unext = atomicAdd(aq, 1);
    __builtin_amdgcn_sched_barrier(0);
#pragma unroll
    for (int d0 = 0; d0 < 8; ++d0) {
#pragma unroll
      for (int j = 0; j < 4; ++j) { const float a = bf_lo(raw[d0][j]), b = bf_hi(raw[d0][j]); ssq += a * a + b * b; } }
    ssq += __shfl_xor(ssq, 32);
    const float rstd = rsqrtf(ssq * (1.f / 128.f) + 1e-6f);
    const int t = qt0 + r32;
    int hi_l = hi; asm volatile("" : "+v"(hi_l));
#pragma unroll
    for (int hf = 0; hf < 2; ++hf) {
      float q[4][8];
#pragma unroll
      for (int dd = 0; dd < 4; ++dd) { const int d0 = hf * 4 + dd; const f32x4 g0 = *(const LAS f32x4*)(qgain + d0 * 16 + hi_l * 8), g1 = *(const LAS f32x4*)(qgain + d0 * 16 + hi_l * 8 + 4);
#pragma unroll
        for (int j = 0; j < 4; ++j) { q[dd][2 * j] = bf_lo(raw[d0][j]); q[dd][2 * j + 1] = bf_hi(raw[d0][j]); }
#pragma unroll
        for (int j = 0; j < 4; ++j) { q[dd][j] *= rstd * g0[j]; q[dd][4 + j] *= rstd * g1[j]; } }
      if (qrope) { const float pos = hf == 0 ? (float)(t >> 6) : (float)(t & 63);
#pragma unroll
        for (int dd = 0; dd < 2; ++dd)
#pragma unroll
          for (int j = 0; j < 8; ++j) { const int i = dd * 16 + hi_l * 8 + j;
            const float fr = __builtin_amdgcn_fractf(pos * exp2f(-(float)i * (13.287712379549449f / 32.f)) * 0.15915494309189535f);
            const float sn = __builtin_amdgcn_sinf(fr), cs = __builtin_amdgcn_cosf(fr);
            const float x1 = q[dd][j], x2 = q[2 + dd][j];
            q[dd][j] = x1 * cs - x2 * sn; q[2 + dd][j] = x1 * sn + x2 * cs; } }
#pragma unroll
      for (int dd = 0; dd < 4; ++dd) { u32x4 w;
#pragma unroll
        for (int j = 0; j < 4; ++j) w[j] = cvt_pk_bf16(q[dd][2 * j], q[dd][2 * j + 1]);
        qr[hf * 4 + dd] = *reinterpret_cast<bf16x8*>(&w); }
    }
  }
  f32x16 o[4] = {};
  const int vst0 = v_st(sr, sc), vst1 = v_st(32 + sr, sc);
  const int vb0 = (int)(uintptr_t)V_lds + v_rd_base(lane);
  const int iq = (wid & 1) * 32 + r32;
  const int r0w = min(max(wrr - 4, 0), 248);
  const int c0q = min(max(iq - 8, 0), 48);
#define SWRITE(b, i) do { *(LAS bf16x8*)(V_lds + (b) * SHM_V + vst0) = sr_[i].vs0;          \
    *(LAS bf16x8*)(V_lds + (b) * SHM_V + vst1) = sr_[i].vs1; int kc = sc * 2;               \
    *(LAS bf16x8*)(K_lds + (b) * SHM_K + KSWZ(sr, kc)) = sr_[i].ks0;                       \
    *(LAS bf16x8*)(K_lds + (b) * SHM_K + KSWZ(32 + sr, kc)) = sr_[i].ks1; } while (0)
#define RESC(a) do { if (__any((a) < 1.f)) { if (hi == 0) al_l[r32] = (a); asm volatile("s_waitcnt lgkmcnt(0)" ::: "memory"); \
    _Pragma("unroll") for (int d = 0; d < 4; ++d) _Pragma("unroll") for (int r = 0; r < 16; ++r) o[d][r] *= al_l[crow(r, hi)]; } } while (0)
#define MASK(j, P0, P1) do { const int _j = (j); \
    if (TYPE == 0) { if (_j < U.nW) { const int tix = U.wlo + _j; \
        if (tix == U.qt - 2) mask_add(P0, P1, hi, tbl + 17 * 128 + 64 - iq); else if (tix == U.qt + 2) mask_add(P0, P1, hi, tbl + 18 * 128 + 64 - iq); } } \
    else { if (_j < U.nW) { const int dr = U.wlo + _j - r0w; \
        if ((unsigned)dr < 8u) mask_add2(P0, P1, hi, tbl + (U.wlo + _j - wrr + 7) * 128 + 64 - iq, tbl + 16 * 128 + 48 - c0q); \
        else mask_add(P0, P1, hi, tbl + 19 * 128); } } } while (0)
  f32x16 p0, p1; float mn, al = 1.f; bf16x8 pa0, pa1, pa2, pa3; const int NT = U.NT;
  asm volatile("s_waitcnt vmcnt(0)" ::: "memory"); SWRITE(0, 0); SLOAD(0, TROW(1)); __syncthreads();
  for (int j = 0; j < NT; ++j) {
    const int par = j & 1;
    const bool skip = (TYPE == 1) && (j < U.nW) && ((unsigned)(U.wlo + j - r0w) >= 8u);
    if (!skip) qkt(p0, p1, K_lds + par * SHM_K, qr, r32, hi);
    if (j + 1 < NT) { SWRITE(1 - par, 0); }
    if (j + 2 < NT) SLOAD(0, TROW(j + 2));
    if (!skip) {
      MASK(j, p0, p1);
      partialSM(p0, p1, m_reg, mn, al);
      RESC(al);
      finishSM(p0, p1, al, l_reg, pa0, pa1, pa2, pa3); SBAR();
      pv_d0(o, vb0 + par * SHM_V, pa0, pa1, pa2, pa3);
    }
    __syncthreads();
  }
  if (TYPE == 0) l_reg += __builtin_amdgcn_exp2f(sink_l2 - m_reg * (SCALE * 1.4426950408889634f));
  int r32e = r32, hie = hi; asm volatile("" : "+v"(r32e), "+v"(hie));
  if (hie == 0) li_l[r32e] = l_reg; asm volatile("s_waitcnt lgkmcnt(0)" ::: "memory");
  float rli[16];
#pragma unroll
  for (int r = 0; r < 16; ++r) rli[r] = __builtin_amdgcn_rcpf(li_l[crow(r, hie)]);
#pragma unroll
  for (int r = 0; r < 16; ++r) { const int orow = crow(r, hie);
#pragma unroll
    for (int d0 = 0; d0 < 4; ++d0) { const float x = o[d0][r] * rli[r]; Ow[(size_t)orow * D + d0 * 32 + r32e] = (bf16_t)(cvt_pk_bf16(x, x) & 0xffffu); } }
#undef TROW
#undef SLOAD
#undef SWRITE
#undef RESC
#undef MASK
}
}

__device__ __forceinline__ void ph_attn(const Frame& F, const bf16_t* QKV, bf16_t* YC) {
    LAS char* lds = (LAS char*)F.lds;
    LAS float* tbl = (LAS float*)(lds + 2 * att::SHM_V + 2 * att::SHM_K + 2048);
    const int wid = F.wave;
    for (int i = F.tid_(); i < 5 * 128; i += NTHR) { const int row = 15 + (i >> 7), k = i & 127; float v = 0.f;
        if (row == 16) v = ((unsigned)(k - 56 + 8) < 16u) ? 0.f : -1e30f;
        if (row == 17) v = (k - 64 >= 0) ? 0.f : -1e30f;
        if (row == 18) v = (k - 64 <= 0) ? 0.f : -1e30f;
        if (row == 19) v = -1e30f;
        tbl[15 * 128 + i] = v; }
    if (F.tid_() < 256) tbl[20 * 128 + F.tid_()] = F.tid_() < 128 ? F.A.in[I_AQG][F.tid_()] : F.A.in[I_BQG][F.tid_() - 128];
    if (F.tid_() < 16) tbl[22 * 128 + F.tid_()] = F.A.in[I_ASINK][F.tid_()] * 1.4426950408889634f;
    int hprev = -1;
    volatile LAS int* qslot = (volatile LAS int*)(F.lds + MISC_OFF + 768);
    if (F.tid_() == 0) qslot[0] = atomicAdd(WSP(int, WS_CTL + CTL_AQ), 1);
    __syncthreads();
    for (;;) {
        const int u = __builtin_amdgcn_readfirstlane(qslot[0]);
        __syncthreads();
        if (u >= 2080) break;
        int unext = 0;
        att::UnitD U; int type, qrow0, wrr = 0, qoff, koff, voff, ooff, wrow; float sink_l2 = 0.f;
        if (u < 1040) {
            const int b = u / 520, rem = u % 520, h = rem / 65, qg = rem % 65;
            if (h != hprev) {
                int ti = F.tid_(); asm volatile("" : "+v"(ti));
                for (int i = ti; i < 15 * 128; i += NTHR) { const int dr = i >> 7, k = (i & 127) - 49; tbl[i] = ((unsigned)k < 31u) ? F.A.in[I_RPB][(size_t)h * 465 + dr * 31 + k] * (1.f / att::SCALE) : 0.f; }
                hprev = h;
            }
            type = 1;
            U.crow0 = ML + b * CTXL;
            if (qg < 64) { const int R0 = qg * 4; const int klo = min(max(R0 - 4, 0), 248), khi = min(max(R0 - 1, 0), 248) + 7;
                U.nW = khi - klo + 1; U.wrow0 = b * SEQ + klo * 64; U.wlo = klo; U.qt = R0; qrow0 = b * SEQ + R0 * 64; wrr = R0 + (wid >> 1); }
            else { U.nW = 0; U.wrow0 = 0; U.wlo = 0; U.qt = 0; qrow0 = ML + b * CTXL; }
            wrow = wid * 32; qoff = QB0 + h * 128; koff = KB0 + h * 128; voff = VB0 + h * 128; ooff = 1024 + h * 128;
        } else {
            const int v = u - 1040, b = v / 520, rem = v % 520, kvh = rem / 260, qt = rem % 260;
            const int g = wid >> 1, hq = kvh * 4 + g;
            type = 0;
            U.crow0 = ML + b * CTXL;
            if (qt < 256) { const int wlo = max(qt - 2, 0), whi = min(qt + 2, 255); U.nW = whi - wlo + 1; U.wlo = wlo; U.qt = qt; U.wrow0 = b * SEQ + wlo * 64; qrow0 = b * SEQ + qt * 64; }
            else { U.nW = 0; U.wlo = 0; U.qt = 1000; U.wrow0 = 0; qrow0 = ML + b * CTXL + (qt - 256) * 64; }
            sink_l2 = tbl[22 * 128 + hq];
            wrow = (wid & 1) * 32; qoff = QA0 + hq * 128; koff = KA0 + kvh * 128; voff = VA0 + kvh * 128; ooff = hq * 128;
        }
        U.NT = U.nW + 4;
        __syncthreads();
        att::attn_unit(type, QKV + (size_t)(qrow0 + wrow) * QKVC + qoff, QKV + koff, QKV + voff, YC + (size_t)(qrow0 + wrow) * D + ooff, U, wrr, sink_l2, lds,
                       tbl + (20 + type) * 128, (type == 0) && (qrow0 < ML), (qrow0 + wrow) % SEQ, WSP(int, WS_CTL + CTL_AQ), unext);
        if (F.tid_() == 0) qslot[0] = unext;
        __syncthreads();
    }
}

__device__ __forceinline__ void rows_y(const Frame& F, int s0, int s1, const LAS int* pref, const bf16_t* yslot, u32x2 (&ya)[8], u32x2 (&yb)[8]) {
    const int lane = F.lane_();
    const size_t y0 = ((size_t)pref[s0 >> 20] * 256 + (s0 & 0xfffff)) * D, y1 = ((size_t)pref[s1 >> 20] * 256 + (s1 & 0xfffff)) * D;
#pragma unroll
    for (int i = 0; i < 8; ++i) { ya[i] = *(const u32x2*)(yslot + y0 + i * 256 + lane * 4); yb[i] = *(const u32x2*)(yslot + y1 + i * 256 + lane * 4); }
}
template <bool LP>
__device__ __forceinline__ void rows_h(const Frame& F, int r, const f32x4 (&xin)[8], const u32x2 (&ya)[8], const u32x2 (&yb)[8], float g0, float g1, bool writeback, f32x4 (&v)[8], const LAS float* P) {
    const int lane = F.lane_(); const bool isc = r >= ML; const int mrow = isc ? 2 : r / SEQ;
    const float* gt = mod_row(F, 0, mrow) + 5 * D;
    float* dp = isc ? WSP(float, WS_XC) + (size_t)(r - ML) * D : F.out + (size_t)r * D;
    float ss = 0.f;
#pragma unroll
    for (int i = 0; i < 8; ++i) { const int col = i * 256 + lane * 4; const u32x2 a = ya[i], b = yb[i]; const f32x4 g = LP ? *(const LAS f32x4*)(P + 2 * D + col) : *(const f32x4*)(gt + col);
        v[i] = xin[i];
        v[i][0] += g[0] * (g0 * bf_lo(a[0]) + g1 * bf_lo(b[0])); v[i][1] += g[1] * (g0 * bf_hi(a[0]) + g1 * bf_hi(b[0]));
        v[i][2] += g[2] * (g0 * bf_lo(a[1]) + g1 * bf_lo(b[1])); v[i][3] += g[3] * (g0 * bf_hi(a[1]) + g1 * bf_hi(b[1]));
        if (writeback) *(f32x4*)(dp + col) = v[i];
        ss += v[i][0] * v[i][0] + v[i][1] * v[i][1] + v[i][2] * v[i][2] + v[i][3] * v[i][3]; }
    ss = wave_sum(ss);
    const float rstd = rsqrtf(ss * (1.f / D) + 1e-6f);
    const float* gn = F.A.in[I_NMIX] + (size_t)D; const float* mr = mod_row(F, 1, mrow);
#pragma unroll
    for (int i = 0; i < 8; ++i) { const int col = i * 256 + lane * 4;
        if (LP) { const f32x4 ga = *(const LAS f32x4*)(P + col), sh = *(const LAS f32x4*)(P + D + col);
#pragma unroll
            for (int j = 0; j < 4; ++j) v[i][j] = v[i][j] * rstd * ga[j] + sh[j]; }
        else { const f32x4 g = *(const f32x4*)(gn + col), sc = *(const f32x4*)(mr + D + col), sh = *(const f32x4*)(mr + col);
#pragma unroll
            for (int j = 0; j < 4; ++j) v[i][j] = v[i][j] * rstd * (g[j] * (1.f + sc[j])) + sh[j]; } }
}
__device__ __forceinline__ void mix_block(int G, int bid, int& blk0, int& nown) {
    const int nc = max(G / 64, 1), nl = (G - nc) / 2;
    if (bid < 2 * nl) { const int seg = bid >= nl, i = bid - seg * nl, q = SEQ / nl, rm = SEQ % nl; blk0 = seg * SEQ + i * q + min(i, rm); nown = q + (i < rm); }
    else if (bid < 2 * nl + nc) { const int i = bid - 2 * nl, q = 2 * CTXL / nc, rm = (2 * CTXL) % nc; blk0 = ML + i * q + min(i, rm); nown = q + (i < rm); }
    else { blk0 = MT; nown = 0; }
}
struct RowIn2 { f32x4 v[8]; int s0, s1; float g0, g1; };
__device__ __forceinline__ void rows_load(const Frame& F, int r, RowIn2& R) {
    const int lane = F.lane_();
    const float* sp = (r >= ML) ? WSP(float, WS_XC) + (size_t)(r - ML) * D : F.out + (size_t)r * D;
#pragma unroll
    for (int i = 0; i < 8; ++i) R.v[i] = *(const f32x4*)(sp + i * 256 + lane * 4);
    R.s0 = WSP(int, WS_TOKSEL)[r * 2]; R.s1 = WSP(int, WS_TOKSEL)[r * 2 + 1]; R.g0 = WSP(float, WS_TOKGATE)[r * 2]; R.g1 = WSP(float, WS_TOKGATE)[r * 2 + 1];
}
__device__ __forceinline__ void rows_pref(const Frame& F, LAS int* pref) {
    expert_prefix(F, 0, pref, (LAS int*)nullptr);
}
__device__ __forceinline__ void ph_rows_halo(const Frame& F, const bf16_t* yslot) {
    LAS int* pref = (LAS int*)(F.lds + MISC_OFF + 1024); rows_pref(F, pref);
    int blk0, nown; mix_block(F.G, F.bid, blk0, nown); const int lane = F.lane_();
    if (F.wave < 2) {
        const int r = F.wave == 0 ? blk0 - 1 : blk0 + nown;
        if (r >= 0 && r < MT && nown > 0) {
            RowIn2 R; rows_load(F, r, R); u32x2 ya[8], yb[8]; rows_y(F, R.s0, R.s1, pref, yslot, ya, yb); f32x4 v[8]; rows_h<false>(F, r, R.v, ya, yb, R.g0, R.g1, false, v, (const LAS float*)nullptr);
            bf16_t* hp = WSP(bf16_t, WS_HALO) + ((size_t)F.bid * 2 + F.wave) * D;
#pragma unroll
            for (int i = 0; i < 8; ++i) { u32x2 o; o[0] = cvt_pk_bf16(v[i][0], v[i][1]); o[1] = cvt_pk_bf16(v[i][2], v[i][3]); *(u32x2*)(hp + i * 256 + lane * 4) = o; }
        }
    }
}
__device__ __forceinline__ void ph_rows_mix6(const Frame& F, const bf16_t* yslot, bf16_t* Xw, bf16_t* Xa, bf16_t* Xg, bf16_t* Xr, bf16_t* Xk, bf16_t* Xv) {
    const int lane = F.lane_(), wave = F.wave;
    int blk0, nown; mix_block(F.G, F.bid, blk0, nown);
    LAS unsigned char* ring = F.lds;
    LAS float* MU = (LAS float*)(F.lds + 20 * 4096);
    LAS float* P = MU + 6 * D;
    if (nown > 0) {
        const int mrow = blk0 >= ML ? 2 : blk0 / SEQ;
        int t0 = F.tid_(); asm volatile("" : "+v"(t0));
        for (int idx = t0; idx < 6 * D / 4; idx += NTHR) *(LAS f32x4*)(MU + idx * 4) = *(const f32x4*)(F.A.in[I_MU] + idx * 4);
        for (int idx = t0; idx < D / 4; idx += NTHR) { const int c = idx * 4; const float* mr = mod_row(F, 1, mrow);
            const f32x4 g = *(const f32x4*)(F.A.in[I_NMIX] + (size_t)D + c), sc = *(const f32x4*)(mr + D + c);
            f32x4 a;
#pragma unroll
            for (int j = 0; j < 4; ++j) a[j] = g[j] * (1.f + sc[j]);
            *(LAS f32x4*)(P + c) = a; *(LAS f32x4*)(P + D + c) = *(const f32x4*)(mr + c); *(LAS f32x4*)(P + 2 * D + c) = *(const f32x4*)(mod_row(F, 0, mrow) + 5 * D + c); }
    }
    LAS int* pref = (LAS int*)(F.lds + MISC_OFF + 1024); rows_pref(F, pref);
    if (nown <= 0) return;
    const int NIT = (nown + 2 + 7) / 8;
    RowIn2 cur, nxt; u32x2 ya[8], yb[8];
    { const int q = wave; if (q >= 1 && q <= nown) { rows_load(F, blk0 + q - 1, cur); rows_y(F, cur.s0, cur.s1, pref, yslot, ya, yb); } }
    for (int it = 0; it < NIT + 1; ++it) {
        const int q = it * 8 + wave, qn = q + 8;
        if (qn >= 1 && qn <= nown) rows_load(F, blk0 + qn - 1, nxt);
        if (q == 0 || q == nown + 1) {
            const bf16_t* hp = WSP(bf16_t, WS_HALO) + ((size_t)F.bid * 2 + (q ? 1 : 0)) * D;
#pragma unroll
            for (int i = 0; i < 4; ++i) *(LAS u32x4*)(ring + (q % 20) * 4096 + (i * 512 + lane * 8) * 2) = *(const u32x4*)(hp + i * 512 + lane * 8);
        } else if (q >= 1 && q <= nown) {
            f32x4 v[8]; rows_h<true>(F, blk0 + q - 1, cur.v, ya, yb, cur.g0, cur.g1, true, v, P);
#pragma unroll
            for (int i = 0; i < 8; ++i) { u32x2 o; o[0] = cvt_pk_bf16(v[i][0], v[i][1]); o[1] = cvt_pk_bf16(v[i][2], v[i][3]); *(LAS u32x2*)(ring + (q % 20) * 4096 + (i * 256 + lane * 4) * 2) = o; }
        }
        cur = nxt;
        if (qn >= 1 && qn <= nown) rows_y(F, cur.s0, cur.s1, pref, yslot, ya, yb);
        __syncthreads();
        const int qm = it * 8 - 1 + wave;
        if (qm >= 1 && qm <= nown) {
            const int r = blk0 + qm - 1;
            const int sl = (r < ML) ? SEQ : CTXL, t = (r < ML) ? (r % SEQ) : ((r - ML) % CTXL);
            const float fp = (t > 0) ? 0.5f : 0.f, fn = (t < sl - 1) ? 0.5f : 0.f;
            const LAS unsigned char* rc = ring + (qm % 20) * 4096 + lane * 16; const LAS unsigned char* rp = ring + ((qm + 19) % 20) * 4096 + lane * 16; const LAS unsigned char* rn = ring + ((qm + 1) % 20) * 4096 + lane * 16;
#pragma unroll
            for (int i = 0; i < 4; ++i) {
                const int col = i * 512 + lane * 8;
                const u32x4 c = *(const LAS u32x4*)(rc + i * 1024), p = *(const LAS u32x4*)(rp + i * 1024), n = *(const LAS u32x4*)(rn + i * 1024);
                float cv[8], xv[8];
#pragma unroll
                for (int k = 0; k < 4; ++k) { cv[2 * k] = bf_lo(c[k]); cv[2 * k + 1] = bf_hi(c[k]);
                    const float pl = (t > 0) ? bf_lo(p[k]) : 0.f, ph = (t > 0) ? bf_hi(p[k]) : 0.f, nl = (t < sl - 1) ? bf_lo(n[k]) : 0.f, nh = (t < sl - 1) ? bf_hi(n[k]) : 0.f;
                    xv[2 * k] = (fp * pl + fn * nl) - cv[2 * k]; xv[2 * k + 1] = (fp * ph + fn * nh) - cv[2 * k + 1]; }
#pragma unroll
                for (int w = 0; w < 6; ++w) {
                    const int m = w == 0 ? 1 : w == 1 ? 4 : w == 2 ? 5 : w == 3 ? 0 : w == 4 ? 2 : 3;
                    bf16_t* X = w == 0 ? Xw : w == 1 ? Xa : w == 2 ? Xg : w == 3 ? Xr : w == 4 ? Xk : Xv;
                    const LAS float* mu = MU + m * D;
                    const f32x4 ma = *(const LAS f32x4*)(mu + col), mb = *(const LAS f32x4*)(mu + col + 4);
                    u32x4 o;
#pragma unroll
                    for (int k = 0; k < 4; ++k) { const float ml = (k < 2) ? ma[2 * k] : mb[2 * k - 4], mh = (k < 2) ? ma[2 * k + 1] : mb[2 * k - 3];
                        o[k] = cvt_pk_bf16(cv[2 * k] + xv[2 * k] * ml, cv[2 * k + 1] + xv[2 * k + 1] * mh); }
                    *(u32x4*)(X + (size_t)r * D + col) = o;
                }
            }
        }
    }
    __syncthreads();
}

__device__ __forceinline__ int scan_row(int dir, int b, int s) {
    if (s < CTXL) return ML + b * CTXL + (dir ? CTXL - 1 - s : s);
    const int t = s - CTXL; return b * SEQ + (dir ? SEQ - 1 - t : t);
}

namespace cs {
constexpr int CSLOT = 13056, SET = 4 * CSLOT, HP0 = 2 * SET, HPSZ = 10240, TP = 144;
constexpr int O_TA = 0, O_TR = 2304, O_A4 = 4608, O_A2 = 8704, O_A3 = 9728, O_VT = 10752, O_GC = 12800;
constexpr int O_BT = 0, O_KT = 2304;
constexpr int LQ0 = HP0 + 4 * HPSZ, LQSZ = 2048, O_LAB = 0, O_LAK = 1024;
constexpr int FLAG_OFF = MISC_OFF + 512;
typedef short s16x4 __attribute__((ext_vector_type(4)));
__device__ __forceinline__ u32x2 tr_issue(unsigned addr) { u32x2 r; asm volatile("ds_read_b64_tr_b16 %0, %1" : "=&v"(r) : "v"(addr) : "memory"); return r; }
__device__ __forceinline__ void tr_wait() { asm volatile("s_waitcnt lgkmcnt(0)" ::: "memory"); __builtin_amdgcn_sched_barrier(0); }
struct Raw { u32x4 v[5][2]; float rn; };
}
__device__ __forceinline__ void scan_cb(const Frame& F, const bf16_t* Rb, const bf16_t* Kb, const bf16_t* AS0, const bf16_t* AS1, float* CB, int nw, int wi) {
    const int lane = F.lane_(), stride = nw * 8;
    struct In { u32x4 k[4], r[4], a0[4], a1[4]; };
    auto loadrow = [&](int r, In& R) {
#pragma unroll
        for (int i = 0; i < 4; ++i) { const size_t ro = (size_t)r * D + i * 512 + lane * 8;
            R.k[i] = *(const u32x4*)(Kb + ro); R.r[i] = *(const u32x4*)(Rb + ro); R.a0[i] = *(const u32x4*)(AS0 + ro); R.a1[i] = *(const u32x4*)(AS1 + ro); }
    };
    In cur, nxt;
    int r = wi * 8 + F.wave;
    if (r < ML) loadrow(r, cur);
    for (; r < ML; r += stride) {
        if (r + stride < ML) loadrow(r + stride, nxt);
#pragma unroll
        for (int i = 0; i < 4; ++i) {
            const int col = i * 512 + lane * 8;
            const u32x4 kv = cur.k[i], rv = cur.r[i], a0 = cur.a0[i], a1 = cur.a1[i];
            const f32x4 ka0 = *(const f32x4*)(F.A.in[I_KA] + col), ka1 = *(const f32x4*)(F.A.in[I_KA] + col + 4), rk0 = *(const f32x4*)(F.A.in[I_RK] + col), rk1 = *(const f32x4*)(F.A.in[I_RK] + col + 4);
            float c0 = 0.f, c1 = 0.f;
#pragma unroll
            for (int j = 0; j < 8; ++j) { const unsigned kw = kv[j >> 1], rw = rv[j >> 1], aw0 = a0[j >> 1], aw1 = a1[j >> 1];
                const float k = (j & 1) ? bf_hi(kw) : bf_lo(kw), rr = (j & 1) ? bf_hi(rw) : bf_lo(rw), s0 = (j & 1) ? bf_hi(aw0) : bf_lo(aw0), s1 = (j & 1) ? bf_hi(aw1) : bf_lo(aw1);
                const float kac = j < 4 ? ka0[j] : ka1[j - 4], rkc = j < 4 ? rk0[j] : rk1[j - 4];
                const float rk = rr * k * rkc;
                c0 += rk * (1.f + (s0 - 1.f) * kac); c1 += rk * (1.f + (s1 - 1.f) * kac); }
            c0 += dpp_mov<0xB1>(c0); c0 += dpp_mov<0x4E>(c0); c0 += dpp_mov<0x141>(c0);
            c1 += dpp_mov<0xB1>(c1); c1 += dpp_mov<0x4E>(c1); c1 += dpp_mov<0x141>(c1);
            if ((lane & 7) == 0) { const int head = i * 8 + (lane >> 3); CB[(size_t)r * 32 + head] = c0; CB[((size_t)ML + r) * 32 + head] = c1; }
        }
        cur = nxt;
    }
}
__device__ __forceinline__ void ph_kkn(const Frame& F, const bf16_t* Kb, float* RN) {
    const int lane = F.lane_(), stride = F.G * 8;
    u32x4 cur[4], nxt[4];
    f32x4 kk[4][2];
#pragma unroll
    for (int i = 0; i < 4; ++i) { kk[i][0] = *(const f32x4*)(F.A.in[I_KK] + i * 512 + lane * 8); kk[i][1] = *(const f32x4*)(F.A.in[I_KK] + i * 512 + lane * 8 + 4); }
    int r = F.bid * 8 + F.wave;
    if (r < MT) {
#pragma unroll
        for (int i = 0; i < 4; ++i) cur[i] = *(const u32x4*)(Kb + (size_t)r * D + i * 512 + lane * 8); }
    for (; r < MT; r += stride) {
        if (r + stride < MT) {
#pragma unroll
            for (int i = 0; i < 4; ++i) nxt[i] = *(const u32x4*)(Kb + (size_t)(r + stride) * D + i * 512 + lane * 8); }
#pragma unroll
        for (int i = 0; i < 4; ++i) {
            const f32x4 kk0 = kk[i][0], kk1 = kk[i][1];
            float ss = 0.f;
#pragma unroll
            for (int j = 0; j < 4; ++j) { const float a = bf_lo(cur[i][j]) * (j < 2 ? kk0[2 * j] : kk1[2 * j - 4]), b = bf_hi(cur[i][j]) * (j < 2 ? kk0[2 * j + 1] : kk1[2 * j - 3]); ss += a * a + b * b; }
            ss += dpp_mov<0xB1>(ss); ss += dpp_mov<0x4E>(ss); ss += dpp_mov<0x141>(ss);
            if ((lane & 7) == 0) RN[(size_t)r * 32 + i * 8 + (lane >> 3)] = rsqrtf(ss + 1e-12f);
        }
#pragma unroll
        for (int i = 0; i < 4; ++i) cur[i] = nxt[i];
    }
}
__device__ __forceinline__ void ph_scan_chunked(const Frame& F, const bf16_t* Rb, const bf16_t* Kb, const bf16_t* Vb, const float* RN, bf16_t* DEC0, bf16_t* DEC1, const bf16_t* AS0, const bf16_t* AS1) {
    using namespace cs;
    const int lane = F.lane_(), wave = F.wave;
    LAS unsigned char* lds = F.lds;
    constexpr int NCH = (CTXL + SEQ) / 16, NSUP = NCH / 4;
    for (int item = F.bid; item < 128; item += F.G) {
        const int dir = item >> 6, b = (item >> 5) & 1, head = item & 31, hc = head * 64;
        bf16_t* DEC = dir ? DEC1 : DEC0; const bf16_t* AS = dir ? AS1 : AS0;
        if (wave >= 4) {
            const int h = wave - 4, k = lane;
            LAS unsigned char* hp = lds + HP0 + h * HPSZ;
            const float ka = F.A.in[I_KA][hc + k], kkc = F.A.in[I_KK][hc + k];
            Raw raw;
            auto gload = [&](int c) {
#pragma unroll
                for (int i = 0; i < 2; ++i) { const int pc = lane + 64 * i, t = pc >> 3, c8 = (pc & 7) * 8; const size_t o = (size_t)scan_row(dir, b, c * 16 + t) * D + hc + c8;
                    raw.v[0][i] = *(const u32x4*)(DEC + o); raw.v[1][i] = *(const u32x4*)(AS + o); raw.v[2][i] = *(const u32x4*)(Kb + o);
                    raw.v[3][i] = *(const u32x4*)(Rb + o); raw.v[4][i] = *(const u32x4*)(Vb + o); }
                raw.rn = RN[(size_t)scan_row(dir, b, c * 16 + (lane & 15)) * 32 + head];
            };
            auto process = [&](int c, int set, int cnext) {
                LAS unsigned char* sl = lds + set * SET + (c & 3) * CSLOT; LAS unsigned char* lq = lds + LQ0 + (set * 4 + (c & 3)) * LQSZ;
#pragma unroll
                for (int i = 0; i < 2; ++i) { const int pc = lane + 64 * i;
#pragma unroll
                    for (int v5 = 0; v5 < 4; ++v5) *(LAS u32x4*)(hp + v5 * 2048 + pc * 16) = raw.v[v5][i];
                    *(LAS u32x4*)(sl + O_VT + pc * 16) = raw.v[4][i]; }
                const float rn_c = raw.rn;
                lds_fence();
                if (cnext >= 0) gload(cnext);
                const unsigned trb = (unsigned)(uintptr_t)hp + (unsigned)(((lane >> 2) & 3) * 128 + ((lane >> 4) * 16 + (lane & 3) * 4) * 2);
                float e_[16], as_[16], k_[16], kn_[16], r_[16];
                u32x2 X0[4], X1[4], X2[4], X4[4];
#pragma unroll
                for (int j = 0; j < 4; ++j) { X0[j] = tr_issue(trb + 0 * 2048 + j * 512); X1[j] = tr_issue(trb + 1 * 2048 + j * 512); X2[j] = tr_issue(trb + 2 * 2048 + j * 512);
                    X4[j] = tr_issue(trb + 3 * 2048 + j * 512); }
                tr_wait();
#pragma unroll
                for (int j = 0; j < 4; ++j) {
                    const u32x2 x0 = X0[j], x1 = X1[j], x2 = X2[j], x4 = X4[j];
                    e_[4 * j] = bf_lo(x0[0]); e_[4 * j + 1] = bf_hi(x0[0]); e_[4 * j + 2] = bf_lo(x0[1]); e_[4 * j + 3] = bf_hi(x0[1]);
                    as_[4 * j] = bf_lo(x1[0]); as_[4 * j + 1] = bf_hi(x1[0]); as_[4 * j + 2] = bf_lo(x1[1]); as_[4 * j + 3] = bf_hi(x1[1]);
                    k_[4 * j] = bf_lo(x2[0]); k_[4 * j + 1] = bf_hi(x2[0]); k_[4 * j + 2] = bf_lo(x2[1]); k_[4 * j + 3] = bf_hi(x2[1]);
                    r_[4 * j] = bf_lo(x4[0]); r_[4 * j + 1] = bf_hi(x4[0]); r_[4 * j + 2] = bf_lo(x4[1]); r_[4 * j + 3] = bf_hi(x4[1]);
                }
#pragma unroll
                for (int t = 0; t < 16; ++t) kn_[t] = k_[t] * (kkc * __int_as_float(__builtin_amdgcn_readlane(__float_as_int(rn_c), t)));
                float g = 1.f, cs = 0.f, bt[16], kt[16];
#pragma unroll
                for (int t = 0; t < 16; ++t) {
                    const float gp = g; cs += e_[t]; const float m2 = cs * 1.4426950408889634f; g = __builtin_amdgcn_exp2f(-m2); const float ig = __builtin_amdgcn_exp2f(m2);
                    const float bb = kn_[t] * as_[t], kd = k_[t] * (1.f + (as_[t] - 1.f) * ka);
                    bt[t] = bb * ig; kt[t] = kd * ig;
                    const unsigned w0 = cvt_pk_bf16(-kn_[t] * gp, r_[t] * g), w1 = cvt_pk_bf16(bt[t], kt[t]);
                    *(LAS unsigned short*)(sl + O_TA + t * TP + k * 2) = (unsigned short)(w0 & 0xffffu); *(LAS unsigned short*)(sl + O_TR + t * TP + k * 2) = (unsigned short)(w0 >> 16);
                    *(LAS unsigned short*)(hp + O_BT + t * TP + k * 2) = (unsigned short)(w1 & 0xffffu); *(LAS unsigned short*)(hp + O_KT + t * TP + k * 2) = (unsigned short)(w1 >> 16);
                }
#pragma unroll
                for (int q = 0; q < 4; ++q) { u32x4 o; o[0] = cvt_pk_bf16(bt[4 * q] * g, bt[4 * q + 1] * g); o[1] = cvt_pk_bf16(bt[4 * q + 2] * g, bt[4 * q + 3] * g);
                    o[2] = cvt_pk_bf16(kt[4 * q] * g, kt[4 * q + 1] * g); o[3] = cvt_pk_bf16(kt[4 * q + 2] * g, kt[4 * q + 3] * g);
                    *(LAS u32x4*)(sl + O_A4 + k * 64 + q * 16) = o; }
                *(LAS float*)(sl + O_GC + k * 4) = g;
                lds_fence();
                const int i16 = lane & 15, q4 = lane >> 4;
                f32x4 Lab = (f32x4){0.f, 0.f, 0.f, 0.f}, Lak = Lab, Urb = Lab, Urk = Lab;
#pragma unroll
                for (int s2 = 0; s2 < 2; ++s2) {
                    const bf16x8 a_ = *(const LAS bf16x8*)(sl + O_TA + i16 * TP + s2 * 64 + q4 * 16), r2 = *(const LAS bf16x8*)(sl + O_TR + i16 * TP + s2 * 64 + q4 * 16);
                    const bf16x8 b_ = *(const LAS bf16x8*)(hp + O_BT + i16 * TP + s2 * 64 + q4 * 16), k2 = *(const LAS bf16x8*)(hp + O_KT + i16 * TP + s2 * 64 + q4 * 16);
                    Lab = __builtin_amdgcn_mfma_f32_16x16x32_bf16(a_, b_, Lab, 0, 0, 0); Lak = __builtin_amdgcn_mfma_f32_16x16x32_bf16(a_, k2, Lak, 0, 0, 0);
                    Urb = __builtin_amdgcn_mfma_f32_16x16x32_bf16(r2, b_, Urb, 0, 0, 0); Urk = __builtin_amdgcn_mfma_f32_16x16x32_bf16(r2, k2, Urk, 0, 0, 0);
                }
#pragma unroll
                for (int j = 0; j < 4; ++j) { const int t = 4 * q4 + j;
                    const float lab = (i16 < t) ? Lab[j] : 0.f, lak = (i16 < t) ? Lak[j] : 0.f, urb = (i16 <= t) ? Urb[j] : 0.f, urk = (i16 <= t) ? Urk[j] : 0.f;
                    *(LAS float*)(lq + O_LAB + (t * 16 + i16) * 4) = lab; *(LAS float*)(lq + O_LAK + (t * 16 + i16) * 4) = lak;
                    const unsigned w = cvt_pk_bf16(urb, urk);
                    LAS unsigned char* ap = sl + O_A3 + (t * 4 + (i16 >> 2)) * 16 + (i16 & 3) * 2;
                    *(LAS unsigned short*)(ap) = (unsigned short)(w & 0xffffu); *(LAS unsigned short*)(ap + 8) = (unsigned short)(w >> 16); }
            };
            gload(h); process(h, 0, 4 + h);
            __syncthreads();
            for (int s = 0; s < NSUP; ++s) {
                if (s + 1 < NSUP) process(4 * (s + 1) + h, (s + 1) & 1, (s + 2 < NSUP) ? 4 * (s + 2) + h : -1);
                __syncthreads();
            }
        } else {
            const int vb = wave * 16, t16 = lane & 15, q4 = lane >> 4;
            f32x4 St[4];
#pragma unroll
            for (int m = 0; m < 4; ++m) St[m] = (f32x4){0.f, 0.f, 0.f, 0.f};
            volatile LAS int* flag = (volatile LAS int*)(lds + FLAG_OFF);
            if (lane == 0) flag[wave] = 0;
            __syncthreads();
            for (int s = 0; s < NSUP; ++s) {
                {
                    const LAS unsigned char* lq = lds + LQ0 + ((s & 1) * 4 + wave) * LQSZ; LAS unsigned char* sl = lds + (s & 1) * SET + wave * CSLOT;
                    const int cc = lane & 31;
                    float x[16]; f32x4 Lr[16][4];
#pragma unroll
                    for (int t = 0; t < 16; ++t) x[t] = *(const LAS float*)(lq + O_LAK + (t * 16 + (cc & 15)) * 4);
#pragma unroll
                    for (int t = 1; t < 16; ++t)
#pragma unroll
                        for (int i4 = 0; i4 * 4 < t; ++i4) Lr[t][i4] = *(const LAS f32x4*)(lq + O_LAB + (t * 16 + i4 * 4) * 4);
                    asm volatile("s_waitcnt lgkmcnt(0)" ::: "memory"); __builtin_amdgcn_sched_barrier(0);
#pragma unroll
                    for (int t = 0; t < 16; ++t) x[t] = (cc < 16) ? ((cc == t) ? 1.f : 0.f) : x[t];
#pragma unroll
                    for (int i = 0; i < 15; ++i)
#pragma unroll
                        for (int t = i + 1; t < 16; ++t) x[t] += Lr[t][i >> 2][i & 3] * x[i];
                    if (lane < 32) {
#pragma unroll
                        for (int t = 0; t < 16; ++t) *(LAS unsigned short*)(sl + O_A2 + (t * 4 + ((cc & 15) >> 2)) * 16 + (cc & 3) * 2 + ((cc >> 4) * 8)) = (unsigned short)(cvt_pk_bf16(x[t], x[t]) & 0xffffu);
                    }
                    lds_fence();
                    if (lane == 0) flag[wave] = s + 1;
                }
#pragma unroll 1
                for (int jc = 0; jc < 4; ++jc) {
                    const int c = 4 * s + jc;
                    LAS unsigned char* sl = lds + (s & 1) * SET + jc * CSLOT;
                    while (flag[jc] < s + 1) __builtin_amdgcn_s_sleep(1);
                    asm volatile("" ::: "memory");
                    const u32x2 vt = tr_issue((unsigned)(uintptr_t)(sl + O_VT) + (unsigned)((4 * q4 + ((lane >> 2) & 3)) * 128 + (vb + (lane & 3) * 4) * 2));
                    bf16x8 Sb[2];
#pragma unroll
                    for (int s2 = 0; s2 < 2; ++s2) { u32x4 w; w[0] = cvt_pk_bf16(St[2 * s2][0], St[2 * s2][1]); w[1] = cvt_pk_bf16(St[2 * s2][2], St[2 * s2][3]);
                        w[2] = cvt_pk_bf16(St[2 * s2 + 1][0], St[2 * s2 + 1][1]); w[3] = cvt_pk_bf16(St[2 * s2 + 1][2], St[2 * s2 + 1][3]); Sb[s2] = *reinterpret_cast<bf16x8*>(&w); }
                    f32x4 Xa = (f32x4){0.f, 0.f, 0.f, 0.f}, Xr = Xa;
#pragma unroll
                    for (int s2 = 0; s2 < 2; ++s2) {
                        const u32x2 a0 = *(const LAS u32x2*)(sl + O_TA + t16 * TP + s2 * 64 + q4 * 8), a1 = *(const LAS u32x2*)(sl + O_TA + t16 * TP + s2 * 64 + 32 + q4 * 8);
                        const u32x2 r0 = *(const LAS u32x2*)(sl + O_TR + t16 * TP + s2 * 64 + q4 * 8), r1 = *(const LAS u32x2*)(sl + O_TR + t16 * TP + s2 * 64 + 32 + q4 * 8);
                        u32x4 aw = {a0[0], a0[1], a1[0], a1[1]}, rw = {r0[0], r0[1], r1[0], r1[1]};
                        Xa = __builtin_amdgcn_mfma_f32_16x16x32_bf16(*reinterpret_cast<bf16x8*>(&aw), Sb[s2], Xa, 0, 0, 0);
                        Xr = __builtin_amdgcn_mfma_f32_16x16x32_bf16(*reinterpret_cast<bf16x8*>(&rw), Sb[s2], Xr, 0, 0, 0);
                    }
                    tr_wait();
                    u32x4 b2 = {cvt_pk_bf16(Xa[0], Xa[1]), cvt_pk_bf16(Xa[2], Xa[3]), vt[0], vt[1]};
                    const bf16x8 A2 = *(const LAS bf16x8*)(sl + O_A2 + (t16 * 4 + q4) * 16), A3 = *(const LAS bf16x8*)(sl + O_A3 + (t16 * 4 + q4) * 16);
                    const f32x4 P = __builtin_amdgcn_mfma_f32_16x16x32_bf16(A2, *reinterpret_cast<bf16x8*>(&b2), (f32x4){0.f, 0.f, 0.f, 0.f}, 0, 0, 0);
                    u32x4 bp = {cvt_pk_bf16(P[0], P[1]), cvt_pk_bf16(P[2], P[3]), vt[0], vt[1]};
                    const bf16x8 Bpv = *reinterpret_cast<bf16x8*>(&bp);
                    const f32x4 Y = __builtin_amdgcn_mfma_f32_16x16x32_bf16(A3, Bpv, Xr, 0, 0, 0);
#pragma unroll
                    for (int m = 0; m < 4; ++m) { const f32x4 gc = *(const LAS f32x4*)(sl + O_GC + (16 * m + 4 * q4) * 4); const bf16x8 A4 = *(const LAS bf16x8*)(sl + O_A4 + ((16 * m + t16) * 4 + q4) * 16);
                        St[m] = __builtin_amdgcn_mfma_f32_16x16x32_bf16(A4, Bpv, St[m] * gc, 0, 0, 0); }
                    if (c >= CTXL / 16) {
#pragma unroll
                        for (int j = 0; j < 4; ++j) { const int row = scan_row(dir, b, c * 16 + 4 * q4 + j); DEC[(size_t)row * D + hc + vb + t16] = (bf16_t)(cvt_pk_bf16(Y[j], Y[j]) & 0xffffu); }
                    }
                }
                __syncthreads();
            }
        }
        __syncthreads();
    }
}

__device__ __forceinline__ void ph_rwkv_out(const Frame& F, const bf16_t* Y0, const bf16_t* Y1, const bf16_t* Vb, const bf16_t* Gb, const float* CB, bf16_t* Z) {
    const int lane = F.lane_(), stride = F.G * 8;
    struct In { u32x4 a[4], b[4], v[4], g[4]; };
    auto loadrow = [&](int r, In& R) {
#pragma unroll
        for (int i = 0; i < 4; ++i) { const size_t ro = (size_t)r * D + i * 512 + lane * 8;
            R.a[i] = *(const u32x4*)(Y0 + ro); R.b[i] = *(const u32x4*)(Y1 + ro); R.v[i] = *(const u32x4*)(Vb + ro); R.g[i] = *(const u32x4*)(Gb + ro); }
    };
    In cur, nxt;
    int r = F.bid * 8 + F.wave;
    if (r < ML) loadrow(r, cur);
    for (; r < ML; r += stride) {
        if (r + stride < ML) loadrow(r + stride, nxt);
#pragma unroll
        for (int i = 0; i < 4; ++i) {
            const int col = i * 512 + lane * 8, head = i * 8 + (lane >> 3);
            float y[8]; float s = 0.f;
#pragma unroll
            for (int j = 0; j < 4; ++j) { y[2 * j] = bf_lo(cur.a[i][j]) + bf_lo(cur.b[i][j]); y[2 * j + 1] = bf_hi(cur.a[i][j]) + bf_hi(cur.b[i][j]); s += y[2 * j] + y[2 * j + 1]; }
            s += dpp_mov<0xB1>(s); s += dpp_mov<0x4E>(s); s += dpp_mov<0x141>(s);
            const float mu = s * (1.f / 64.f);
            float vs = 0.f;
#pragma unroll
            for (int j = 0; j < 8; ++j) { const float d = y[j] - mu; vs += d * d; }
            vs += dpp_mov<0xB1>(vs); vs += dpp_mov<0x4E>(vs); vs += dpp_mov<0x141>(vs);
            const float rstd = rsqrtf(vs * (1.f / 64.f) + 64e-5f);
            const float cb = CB[(size_t)r * 32 + head] + CB[((size_t)ML + r) * 32 + head];
            const f32x4 lw0 = *(const f32x4*)(F.A.in[I_LNW] + col), lw1 = *(const f32x4*)(F.A.in[I_LNW] + col + 4), lb0 = *(const f32x4*)(F.A.in[I_LNB] + col), lb1 = *(const f32x4*)(F.A.in[I_LNB] + col + 4);
            u32x4 o;
#pragma unroll
            for (int j = 0; j < 4; ++j) { const int c = 2 * j;
                const float w0 = c < 4 ? lw0[c] : lw1[c - 4], w1 = c + 1 < 4 ? lw0[c + 1] : lw1[c - 3], b0 = c < 4 ? lb0[c] : lb1[c - 4], b1 = c + 1 < 4 ? lb0[c + 1] : lb1[c - 3];
                const float z0 = ((y[c] - mu) * rstd * w0 + b0 + cb * bf_lo(cur.v[i][j])) * bf_lo(cur.g[i][j]);
                const float z1 = ((y[c + 1] - mu) * rstd * w1 + b1 + cb * bf_hi(cur.v[i][j])) * bf_hi(cur.g[i][j]);
                o[j] = cvt_pk_bf16(z0, z1); }
            *(u32x4*)(Z + (size_t)r * D + col) = o;
        }
        cur = nxt;
    }
}

__device__ __forceinline__ void moe_prefix(const Frame& F, int layer, LAS int*& pref, LAS int*& cntl) {
    pref = (LAS int*)(F.lds + MISC_OFF + 1024); cntl = pref + 40;
    __syncthreads();
    expert_prefix(F, layer, pref, cntl);
}
__device__ __forceinline__ void ph_moe_up(const Frame& F, int layer, const bf16_t* H, const bf16_t* W13, bf16_t* HID) {
    LAS int* pref; LAS int* cntl; moe_prefix(F, layer, pref, cntl);
    MoeSched S{pref, cntl, WSP(int, WS_TOKL), 4, F.G, F.bid, D, 2 * FF, true};
    pg8::EpiMoeUp E{HID};
    pg8::gemm_phase(F.lds, H, W13, D, S, E);
}
__device__ __forceinline__ void ph_moe_down(const Frame& F, int layer, const bf16_t* HID, const bf16_t* W2T, bf16_t* YS) {
    LAS int* pref; LAS int* cntl; moe_prefix(F, layer, pref, cntl);
    MoeSched S{pref, cntl, WSP(int, WS_TOKL), 8, F.G, F.bid, FF, D, false};
    pg8::EpiStoreBf16<0> E{YS, D, nullptr, 0, 0};
    pg8::gemm_phase(F.lds, HID, W2T, FF, S, E);
}
template <int ACT>
__device__ __forceinline__ void ph_gemm_bf16(const Frame& F, const bf16_t* A, const bf16_t* Bt, int M, int N, int K, bf16_t* O, int ldc, const float* vec, int split_cols, size_t split_stride) {
    pg8::DenseSched S; S.init(M, N, K, F.G, F.bid);
    pg8::EpiStoreBf16<ACT> E{O, ldc, vec, split_cols, split_stride};
    pg8::gemm_phase(F.lds, A, Bt, K, S, E);
}
__device__ __forceinline__ void ph_gemm_multi(const Frame& F, const pg8::MultiSched& S, const bf16_t* Abase, const bf16_t* Bt, int K, const pg8::EpiMultiBf16& E) {
    pg8::gemm_phase(F.lds, Abase, Bt, K, S, E);
}
__device__ __forceinline__ void ph_gemm_res(const Frame& F, const bf16_t* A, const bf16_t* Bt, int M, const float* xin_l, float* out_l, const float* xin_c, float* out_c, const float* gate) {
    pg8::DenseSched S; S.init(M, D, D, F.G, F.bid);
    pg8::EpiRes E{xin_l, out_l, xin_c, out_c, gate};
    pg8::gemm_phase(F.lds, A, Bt, D, S, E);
}

constexpr int LDS_BYTES = 163840;
constexpr int N_PHASES = 20;
__global__ void __launch_bounds__(NTHR, 2) fwd(Args args) {
    extern __shared__ __attribute__((aligned(16))) unsigned char lds_raw[];
    Frame F(args);
    F.out = args.out; F.ws = args.ws; F.lds = (LAS unsigned char*)lds_raw;
    F.wave = __builtin_amdgcn_readfirstlane((int)threadIdx.x >> 6); F.G = gridDim.x; F.bid = blockIdx.x;
    volatile LAS unsigned* misc = (volatile LAS unsigned*)(F.lds + MISC_OFF);
    if (F.tid_() < 4) misc[F.tid_()] = 0u;
    __syncthreads();
    XcdBarrier bar; bar.bar = (unsigned*)(F.ws + WS_CTL); bar.x = 0; bar.st = misc;
    const int lo = args.ph_lo, hi = args.ph_hi;
    if (hi - lo > 1) bar = xcd_barrier_post((unsigned*)(F.ws + WS_CTL), misc);
#ifndef PH_ONLY
#define PH_ONLY -1
#endif
#define IN(k) ((PH_ONLY < 0 || PH_ONLY == (k)) && lo <= (k) && (k) < hi)
#define SEAM(k) do { if (IN(k) && IN((k) + 1)) xcd_barrier(bar); } while (0)
#define S0 WSP(bf16_t, SLOTP(0))
#define S1 WSP(bf16_t, SLOTP(1))
#define S2 WSP(bf16_t, SLOTP(2))
#define S3 WSP(bf16_t, SLOTP(3))
#define S4 WSP(bf16_t, SLOTP(4))
#define S5 WSP(bf16_t, SLOTP(5))
#define S6 WSP(bf16_t, SLOTP(6))
#define S7 WSP(bf16_t, SLOTP(7))
#define S8 WSP(bf16_t, SLOTP(8))
#define XC WSP(float, WS_XC)
#define CB WSP(float, WS_CB)
    const size_t W2OFF = (size_t)NEXP * 2 * FF * D;

#define TSTART(k) do { if (TIME_PH == (k) && blockIdx.x == 0 && threadIdx.x == 0) *WSP(unsigned long long, WS_CTL + 20480) = wall_clock64(); } while (0)
#define TSTOP(k) do { if (TIME_PH == (k) && blockIdx.x == 0 && threadIdx.x == 0) *WSP(float, WS_CTL + 20496) = (float)(wall_clock64() - *WSP(unsigned long long, WS_CTL + 20480)) * 0.01f; } while (0)
    TSTART(0);
    if (IN(0)) ph_prologue(F);
    SEAM(0);
    TSTOP(0);
    TSTART(1);
    if (IN(1)) { { RowOpts O{F.A.in[I_X], F.A.in[I_CTX], MT, false, 0, nullptr, nullptr, nullptr, true, 0, 0, S0, false}; ph_rows(F, O); } ph_router_fold(F); }
    SEAM(1);
    TSTOP(1);
    TSTART(2);
    if (IN(2)) { ph_gemm_bf16<0>(F, S0, WSP(bf16_t, WT_IN), MT, QKVC, D, S1, QKVC, nullptr, 0, 0);
                 const int rem = ((MT / 256) * (QKVC / 256)) % F.G; int base = 0;
                 cvt_moe2(F, 0, S6 + W2OFF, base, F.G - rem, F.bid - rem); }
    SEAM(2);
    TSTOP(2);
    TSTART(3);
    if (IN(3)) ph_qknorm(F, S1);
    SEAM(3);
    TSTOP(3);
    TSTART(4);
    if (IN(4)) ph_attn(F, S1, S4);
    SEAM(4);
    TSTOP(4);
    TSTART(5);
    if (IN(5)) { ph_gemm_res(F, S4, WSP(bf16_t, WT_OUT), MT, F.A.in[I_X], F.out, F.A.in[I_CTX], XC, mod_row(F, 0, 0) + 2 * D);
                 const int rem = ((MT / 256) * (D / 256)) % F.G; int base = 0;
                 cvt_moe13(F, 0, S6, base, F.G - rem, F.bid - rem); }
    SEAM(5);
    TSTOP(5);
    TSTART(6);
    if (IN(6)) ph_rows_router(F, F.out, XC, MT, 0, S0);
    SEAM(6);
    TSTOP(6);
    TSTART(7);
    if (IN(7)) ph_moe_up(F, 0, S0, S6, S5);
    SEAM(7);
    TSTOP(7);
    TSTART(8);
    if (IN(8)) ph_moe_down(F, 0, S5, S6 + W2OFF, S1);
    SEAM(8);
    TSTOP(8);
    TSTART(9);
    if (IN(9)) ph_rows_halo(F, S1);
    SEAM(9);
    TSTOP(9);
    TSTART(10);
    if (IN(10)) ph_rows_mix6(F, S1, S4, S5, S7, S0, S6, S8);
    SEAM(10);
    TSTOP(10);
    TSTART(11);
    if (IN(11)) { { pg8::MultiSched S; S.init(MT, 256, D, 3, F.G, F.bid); S.a0 = (unsigned)SLOTP(4); S.a1 = (unsigned)SLOTP(5); S.a2 = (unsigned)SLOTP(7); S.a3 = 0; S.b0 = 0; S.b1 = 256; S.b2 = 512; S.b3 = 0;
                    pg8::EpiMultiBf16 E{WSP(bf16_t, WS_TW), (size_t)(WS_TA - WS_TW) / 2, 0x210u, 256, 0x201u, F.A.in[I_W0], 0l, 0};
                    ph_gemm_multi(F, S, (const bf16_t*)F.ws, WSP(bf16_t, WT_W1), D, E); }
                  { pg8::MultiSched S; S.init(MT, D, D, 3, F.G, (F.bid + F.G / 2) % F.G);
                    S.a0 = (unsigned)SLOTP(0); S.a1 = (unsigned)SLOTP(6); S.a2 = (unsigned)SLOTP(8); S.a3 = 0; S.b0 = 0; S.b1 = D; S.b2 = 2 * D; S.b3 = 0;
                    pg8::EpiMultiBf16 E{S1, (size_t)SLOT / 2, 0x210u, D, 0u, F.A.in[I_W0], 0l, 0};
                    ph_gemm_multi(F, S, (const bf16_t*)F.ws, WSP(bf16_t, WT_R), D, E); } }
    SEAM(11);
    TSTOP(11);
    TSTART(12);
    if (IN(12)) { pg8::MultiSched S; S.init(MT, D, 256, 4, F.G, F.bid); S.a0 = (unsigned)WS_TW; S.a1 = (unsigned)WS_TW + 256u; S.a2 = (unsigned)WS_TA; S.a3 = (unsigned)WS_TA + 256u;
                  S.b0 = 0; S.b1 = D; S.b2 = (int)((WT_A2 - WT_W2) / 256); S.b3 = (int)((WT_A2 - WT_W2) / 256) + D;
                  pg8::EpiMultiBf16 E{S0, (size_t)SLOT / 2, 0x6540u, D, 0x4433u, F.A.in[I_W0], (long)(F.A.in[I_A0] - F.A.in[I_W0]), D};
                  ph_gemm_multi(F, S, (const bf16_t*)F.ws, WSP(bf16_t, WT_W2), 128, E);
                  ph_kkn(F, S2, WSP(float, WS_RN)); }
    SEAM(12);
    TSTOP(12);
    TSTART(13);
    if (IN(13)) { ph_scan_chunked(F, S1, S2, S3, WSP(float, WS_RN), S0, S4, S5, S6);
                  const int gw = F.G > 128 ? F.G - 128 : F.G, gc = F.G > 128 ? F.bid - 128 : F.bid;
                  if (gc >= 0) {
                      pg8::DenseSched S; S.init(ML, D, 256, gw, gc); pg8::EpiStoreBf16<0> E{S8, D, nullptr, 0, 0};
                      pg8::gemm_phase(F.lds, WSP(bf16_t, WS_TG), WSP(bf16_t, WT_G2), 256, S, E);
                      scan_cb(F, S1, S2, S5, S6, CB, gw, gc);
                      __syncthreads(); int base = 0; cvt_moe13(F, 1, S7, base, gw, gc); } }
    SEAM(13);
    TSTOP(13);
    TSTART(14);
    if (IN(14)) ph_rwkv_out(F, S0, S4, S3, S8, CB, S2);
    SEAM(14);
    TSTOP(14);
    TSTART(15);
    if (IN(15)) ph_gemm_res(F, S2, WSP(bf16_t, WT_O), ML, F.out, F.out, XC, XC, mod_row(F, 1, 0) + 2 * D);
    SEAM(15);
    TSTOP(15);
    TSTART(16);
    if (IN(16)) { ph_rows_router(F, F.out, XC, ML, 1, S0);
                  __syncthreads(); int base = 0; cvt_moe2(F, 1, S5, base); }
    SEAM(16);
    TSTOP(16);
    TSTART(17);
    if (IN(17)) ph_moe_up(F, 1, S0, S7, S4);
    SEAM(17);
    TSTOP(17);
    TSTART(18);
    if (IN(18)) ph_moe_down(F, 1, S4, S5, S1);
    SEAM(18);
    TSTOP(18);
    TSTART(19);
    if (IN(19)) { RowOpts O{F.out, XC, ML, true, 1, S1, F.out, XC, false, 1, 0, nullptr, false}; ph_rows(F, O); }
#undef IN
#undef SEAM
}

extern "C" void kernel_launch(void* const* d_in, const int* in_sizes, int n_in, void* d_out, int out_size, void* d_ws, size_t ws_size, hipStream_t stream) {
    static int grid = 0;
    if (grid == 0) {
        if (n_in != 39 || out_size != ML * D || ws_size < WS_END) { fprintf(stderr, "kernel_launch: unexpected shapes (n_in %d out %d ws %zu need %zu)\n", n_in, out_size, ws_size, (size_t)WS_END); grid = -1; return; }
        int dev = 0, cus = 0;
        if (hipGetDevice(&dev) != hipSuccess || hipDeviceGetAttribute(&cus, hipDeviceAttributeMultiprocessorCount, dev) != hipSuccess) { grid = -1; return; }
        if (hipFuncSetAttribute((const void*)fwd, hipFuncAttributeMaxDynamicSharedMemorySize, LDS_BYTES) != hipSuccess) { fprintf(stderr, "kernel_launch: hipFuncSetAttribute failed\n"); grid = -1; return; }
        int per_cu = 0;
        if (hipOccupancyMaxActiveBlocksPerMultiprocessor(&per_cu, (const void*)fwd, NTHR, LDS_BYTES) != hipSuccess || per_cu < 1) { fprintf(stderr, "kernel_launch: occupancy query says %d\n", per_cu); }
        (void)hipGetLastError();
        grid = cus;
    }
    if (grid < 0) return;
    (void)hipMemsetAsync((char*)d_ws + WS_CTL, 0, CTL_BYTES, stream);
    Args a{};
    for (int i = 0; i < 39; ++i) a.in[i] = (const float*)d_in[i];
    a.out = (float*)d_out; a.ws = (unsigned char*)d_ws;
#if ONE_LAUNCH
    a.ph_lo = 0; a.ph_hi = N_PHASES;
    hipLaunchKernelGGL(fwd, dim3(grid), dim3(NTHR), LDS_BYTES, stream, a);
#else
    for (int p = 0; p < N_PHASES; ++p) { a.ph_lo = p; a.ph_hi = p + 1; const int reps = 1 + (int)((PROBE_MASK >> p) & 1ull); for (int r = 0; r < reps; ++r) hipLaunchKernelGGL(fwd, dim3(grid), dim3(NTHR), LDS_BYTES, stream, a); }
#endif
}
```

```cpp
#include <hip/hip_runtime.h>
#include <stdint.h>
#include <stdio.h>

#ifndef ONE_LAUNCH
#define ONE_LAUNCH 1
#endif
#ifndef PROBE_MASK
#define PROBE_MASK 0ull
#endif
#ifndef TIME_PH
#define TIME_PH -1
#endif

#define LAS __attribute__((address_space(3)))
typedef unsigned short bf16_t;
typedef short bf16x8 __attribute__((ext_vector_type(8)));
typedef float f32x4 __attribute__((ext_vector_type(4)));
typedef float f32x2 __attribute__((ext_vector_type(2)));
typedef unsigned u32x4 __attribute__((ext_vector_type(4)));
typedef unsigned u32x2 __attribute__((ext_vector_type(2)));

constexpr int D = 2048, NB = 2, SEQ = 16384, ML = NB * SEQ, CTXL = 256, MC = NB * CTXL, MT = ML + MC;
constexpr int QKVC = 4608, QA0 = 0, KA0 = 1024, VA0 = 1280, QB0 = 1536, KB0 = 2560, VB0 = 3584;
constexpr int NEXP = 32, FF = 512, MAXSLOT = 2 * MT + NEXP * 256;
constexpr int MODW = 6 * D;
constexpr int NTHR = 512;
constexpr int MISC_OFF = 163840 - 2048;

constexpr size_t MiB = 1ull << 20;
constexpr size_t WS_CTL = 0;
constexpr size_t CTL_BYTES = 64 * 1024;
constexpr size_t CTL_CNT = 32768;
constexpr int CNT_STRIDE = 64;
constexpr size_t CTL_AQ = 24576;
constexpr size_t WS_MOD = 1 * MiB;
constexpr size_t WS_XC = 2 * MiB;
constexpr size_t WS_TOKL = 6 * MiB;
constexpr size_t WS_TOKSEL = 11 * MiB;
constexpr size_t WS_TOKGATE = 11 * MiB + 512 * 1024;
constexpr size_t WS_CB = 12 * MiB;
constexpr size_t WS_WT = 20 * MiB;
constexpr size_t WT_IN = WS_WT, WT_OUT = WS_WT + 18 * MiB, WT_R = WS_WT + 26 * MiB, WT_K = WS_WT + 34 * MiB, WT_V = WS_WT + 42 * MiB, WT_O = WS_WT + 50 * MiB;
constexpr size_t WT_W1 = WS_WT + 58 * MiB, WT_A1 = WS_WT + 59 * MiB, WT_G1 = WS_WT + 60 * MiB, WT_W2 = WS_WT + 61 * MiB, WT_A2 = WS_WT + 63 * MiB, WT_G2 = WS_WT + 65 * MiB;
constexpr size_t WS_TW = 86 * MiB, WS_TA = 103 * MiB, WS_TG = 120 * MiB;
constexpr size_t WS_WF = 137 * MiB;
constexpr size_t WS_CV = WS_WF + (size_t)2 * 3 * 2048 * 48 * 4;
constexpr size_t WS_SLOT0 = 140 * MiB, SLOT = 130 * MiB;
constexpr size_t WS_HALO = WS_SLOT0 + 9 * SLOT;
constexpr size_t WS_RN = WS_HALO + 4 * MiB;
constexpr size_t WS_END = WS_RN + 8 * MiB;
#define SLOTP(k) (WS_SLOT0 + (size_t)(k) * SLOT)

typedef __bf16 bf16x2_t __attribute__((ext_vector_type(2)));
__device__ __forceinline__ unsigned cvt_pk_bf16(float lo, float hi) { f32x2 v = {lo, hi}; bf16x2_t r = __builtin_convertvector(v, bf16x2_t); return *reinterpret_cast<unsigned*>(&r); }
__device__ __forceinline__ float bf_lo(unsigned u) { return __uint_as_float(u << 16); }
__device__ __forceinline__ float bf_hi(unsigned u) { return __uint_as_float(u & 0xffff0000u); }
__device__ __forceinline__ float bf2f(bf16_t v) { return __uint_as_float(((unsigned)v) << 16); }
template <int CTRL> __device__ __forceinline__ float dpp_mov(float v) { return __int_as_float(__builtin_amdgcn_update_dpp(0, __float_as_int(v), CTRL, 0xf, 0xf, true)); }
__device__ __forceinline__ float row_sum16(float v) { v += dpp_mov<0xB1>(v); v += dpp_mov<0x4E>(v); v += dpp_mov<0x141>(v); v += dpp_mov<0x140>(v); return v; }
__device__ __forceinline__ float wave_sum(float v) { v = row_sum16(v);
    const float a = __int_as_float(__builtin_amdgcn_readlane(__float_as_int(v), 0)), b = __int_as_float(__builtin_amdgcn_readlane(__float_as_int(v), 16));
    const float c = __int_as_float(__builtin_amdgcn_readlane(__float_as_int(v), 32)), d = __int_as_float(__builtin_amdgcn_readlane(__float_as_int(v), 48));
    return (a + b) + (c + d); }
__device__ __forceinline__ float wave_max(float v) { for (int o = 32; o; o >>= 1) v = fmaxf(v, __shfl_xor(v, o)); return v; }
__device__ __forceinline__ float sigmoidf_(float x) { return 1.f / (1.f + __expf(-x)); }
__device__ __forceinline__ void lds_fence() { asm volatile("s_waitcnt lgkmcnt(0)" ::: "memory"); }

struct Args { const float* in[39]; float* out; unsigned char* ws; int ph_lo, ph_hi; };
struct Frame {
    const Args& A; float* out; unsigned char* ws; LAS unsigned char* lds;
    int wave, G, bid;
    __device__ __forceinline__ Frame(const Args& a) : A(a) {}
    __device__ __forceinline__ int lane_() const { return (int)threadIdx.x & 63; }
    __device__ __forceinline__ int tid_() const { return (int)threadIdx.x; }
};
enum { I_X = 0, I_C, I_CTX, I_CCTX, I_ADAW, I_ADAB, I_NMIX, I_NFFN, I_WIN, I_WOUT, I_AQG, I_AKG, I_ASINK, I_BQG, I_BKG, I_RPB, I_MU, I_WR, I_WK, I_WV, I_WO, I_W0, I_W1, I_W2,
       I_A0, I_A1, I_A2, I_G1, I_G2, I_KK, I_KA, I_RK, I_LNW, I_LNB, I_MGRP, I_MEXP, I_MW1, I_MW3, I_MW2 };

#define XB_TMO      128
#define XB_XCNT(j)  (256  + 64 * (j))
#define XB_XSUB(j)  (1280 + 64 * (j))
#define XB_XGEN(j)  (2304 + 64 * (j))
#define XB_TOP      3328
#define XB_TOPGEN   3392
#define XCD_BAR_WORDS 3456
#define XB_SPIN_CAP (1u << 18)
__device__ __forceinline__ unsigned xb_ld(unsigned* p)              { return __hip_atomic_load(p, __ATOMIC_RELAXED, __HIP_MEMORY_SCOPE_AGENT); }
__device__ __forceinline__ unsigned xb_add(unsigned* p, unsigned v) { return __hip_atomic_fetch_add(p, v, __ATOMIC_RELAXED, __HIP_MEMORY_SCOPE_AGENT); }
__device__ __forceinline__ unsigned xb_xcc_id() { return (unsigned)__builtin_amdgcn_s_getreg((3 << 11) | 20) & 0xFu; }
#define XB_SPIN(cond, bar) do { unsigned _sp = 0; while (cond) { __builtin_amdgcn_s_sleep(1); \
    if ((++_sp & 255u) == 0u) { if (xb_ld(&(bar)[XB_TMO])) break; if (_sp > XB_SPIN_CAP) { atomicAdd(&(bar)[XB_TMO], 1u); break; } } } } while (0)
struct XcdBarrier { unsigned* bar; unsigned x; volatile LAS unsigned* st; };
__device__ __forceinline__ XcdBarrier xcd_barrier_post(unsigned* bar, volatile LAS unsigned* st) {
    XcdBarrier b; b.bar = bar; b.x = xb_xcc_id(); b.st = st;
    if (threadIdx.x == 0) (void)xb_add(&bar[XB_XCNT(b.x)], 1u);
    return b;
}
__device__ __forceinline__ void xcd_barrier_complete(unsigned* bar, unsigned x, unsigned& nloc, unsigned& nx) {
    const unsigned G = gridDim.x * gridDim.y * gridDim.z;
    unsigned sum, cnt, mine, sp = 0u;
    for (;;) {
        sum = 0u; cnt = 0u; mine = 0u;
#pragma unroll
        for (unsigned j = 0; j < 16; ++j) { const unsigned c = xb_ld(&bar[XB_XCNT(j)]); sum += c; cnt += (c > 0u) ? 1u : 0u; mine = (j == x) ? c : mine; }
        if (sum == G) break;
        __builtin_amdgcn_s_sleep(1);
        if ((++sp & 255u) == 0u) { if (xb_ld(&bar[XB_TMO])) break; if (sp > XB_SPIN_CAP) { atomicAdd(&bar[XB_TMO], 1u); break; } }
    }
    nloc = mine > 0u ? mine : 1u; nx = cnt > 0u ? cnt : 1u;
}
__device__ __forceinline__ void xcd_barrier(const XcdBarrier& b) {
    asm volatile("s_waitcnt vmcnt(0)" ::: "memory");
    __syncthreads();
    if (threadIdx.x == 0) {
        unsigned* bar = b.bar;
        __builtin_amdgcn_s_waitcnt(0);
        unsigned nloc = b.st[0], nx = b.st[1];
        if (nloc == 0u) { xcd_barrier_complete(bar, b.x, nloc, nx); b.st[0] = nloc; b.st[1] = nx; }
        const unsigned old = xb_add(&bar[XB_XSUB(b.x)], 1u);
        const unsigned gen = old / nloc;
        if (old + 1u == (gen + 1u) * nloc) {
            __builtin_amdgcn_fence(__ATOMIC_RELEASE, "agent");
            asm volatile("s_waitcnt vmcnt(0)" ::: "memory");
            const unsigned og = xb_add(&bar[XB_TOP], 1u);
            const unsigned tg = og / nx;
            if (og + 1u == (tg + 1u) * nx) xb_add(&bar[XB_TOPGEN], 1u);
            else XB_SPIN(xb_ld(&bar[XB_TOPGEN]) == tg, bar);
            __builtin_amdgcn_fence(__ATOMIC_ACQUIRE, "agent");
            xb_add(&bar[XB_XGEN(b.x)], 1u);
            asm volatile("s_waitcnt vmcnt(0)" ::: "memory");
        } else {
            XB_SPIN(xb_ld(&bar[XB_XGEN(b.x)]) == gen, bar);
            __builtin_amdgcn_fence(__ATOMIC_ACQUIRE, "agent");
            asm volatile("s_waitcnt vmcnt(0)" ::: "memory");
        }
    }
    __syncthreads();
}

namespace pg8 {
constexpr int BM = 256, BK = 64, HALF = 128, HTB = HALF * BK * 2, STAGE_BYTES = 8 * HTB, NXCD = 8, WGM = 8;
__host__ __device__ __forceinline__ int lds_byte(int r, int c) { const int st = (r >> 4) * 2 + (c >> 5), rr = r & 15, cc = c & 31, ob = rr * 64 + cc * 2; return st * 1024 + (ob ^ (((ob >> 9) & 1) << 5)); }
__host__ __device__ __forceinline__ void stage_rc(int b, int& R, int& C) { const int st = b / 1024, sb = b % 1024, swz = sb ^ (((sb >> 9) & 1) << 5); R = (st >> 1) * 16 + swz / 64; C = (st & 1) * 32 + (swz % 64) / 2; }
__host__ __device__ __forceinline__ int perm32(int rho) { const int n = rho >> 4, i = rho & 15; return 8 * (i >> 2) + 4 * n + (i & 3); }

struct Unit { int arow0, brow0, col0, e, pbase, cnt; };

struct DenseSched {
    int nM, nN, nwg, G, c, K;
    __device__ void init(int M, int N, int K_, int G_, int c_) { nM = M / BM; nN = N / BM; nwg = nM * nN; G = G_; c = c_; K = K_; }
    __device__ bool next(int i, Unit& u) const {
        const long L = (long)i * G + c; if (L >= nwg) return false;
        int wgid = (int)L; { const int q = nwg / NXCD, r = nwg % NXCD, xcd = wgid % NXCD, off = wgid / NXCD; wgid = (xcd < r ? xcd * (q + 1) : r * (q + 1) + (xcd - r) * q) + off; }
        const int nig = WGM * nN, gid = wgid / nig, fm = gid * WGM, gsz = (nM - fm) < WGM ? (nM - fm) : WGM;
        const int pm = fm + ((wgid % nig) % gsz), pn = (wgid % nig) / gsz;
        u.arow0 = pm * BM; u.brow0 = pn * BM; u.col0 = pn * BM; u.e = 0; u.pbase = 0; u.cnt = 0; return true;
    }
    __device__ __forceinline__ unsigned a_off(const Unit& u, int r, int C) const { return (unsigned)((u.arow0 + r) * K + C) * 2u; }
};

struct MultiSched {
    int nM, nN, nwg, ng, G, c, lda; unsigned a0, a1, a2, a3; int b0, b1, b2, b3;
    __device__ __forceinline__ void init(int M, int N, int lda_, int ng_, int G_, int c_) { nM = M / BM; nN = N / BM; nwg = nM * nN; ng = ng_; G = G_; c = c_; lda = lda_; }
    __device__ __forceinline__ bool next(int i, Unit& u) const {
        const long L = (long)i * G + c; if (L >= (long)nwg * ng) return false;
        const int w = (int)(L / nwg); int wgid = (int)(L % nwg);
        { const int q = nwg / NXCD, r = nwg % NXCD, xcd = wgid % NXCD, off = wgid / NXCD; wgid = (xcd < r ? xcd * (q + 1) : r * (q + 1) + (xcd - r) * q) + off; }
        const int nig = WGM * nN, gid = wgid / nig, fm = gid * WGM, gsz = (nM - fm) < WGM ? (nM - fm) : WGM;
        const int pm = fm + ((wgid % nig) % gsz), pn = (wgid % nig) / gsz;
        u.arow0 = pm * BM; u.brow0 = (w == 0 ? b0 : w == 1 ? b1 : w == 2 ? b2 : b3) + pn * BM; u.col0 = pn * BM; u.e = w; u.pbase = 0; u.cnt = 0; return true;
    }
    __device__ __forceinline__ unsigned a_off(const Unit& u, int r, int C) const { return (u.e == 0 ? a0 : u.e == 1 ? a1 : u.e == 2 ? a2 : a3) + (unsigned)((u.arow0 + r) * lda + C) * 2u; }
};

template <class Epi, class Sched>
__device__ __forceinline__ void gemm_phase(LAS unsigned char* lds, const bf16_t* A, const bf16_t* Bt, const int K, const Sched& S, const Epi& E) {
    const int tid = threadIdx.x, wid = __builtin_amdgcn_readfirstlane(tid >> 6), lane = tid & 63, wr = wid >> 2, wc = wid & 3, fr = lane & 15, fq = lane >> 4;
    const int nt = K / BK;
    int Rr[2], Cc[2]; unsigned voffB[2];
#pragma unroll
    for (int i = 0; i < 2; ++i) { int R, C; stage_rc(tid * 16 + i * 8192, R, C); const int Rb = Epi::PERM ? ((R & ~31) + perm32(R & 31)) : R;
        Rr[i] = R; Cc[i] = C; voffB[i] = (unsigned)(Rb * K + C) * 2u; }
    const size_t kstep = (size_t)(BK * 2);
    const size_t hstepB = (size_t)HALF * K * 2;
    const unsigned ldsw = (unsigned)wid * 1024u;
    const int aoff = lds_byte(wr * 64 + fr, fq * 8), boff = lds_byte(wc * 32 + fr, fq * 8);
#define PG8_SA(b, h) (((b) * 2 + (h)) * HTB)
#define PG8_SB(b, h) ((4 + (b) * 2 + (h)) * HTB)
#define PG8_STAGE(bufoff, gbase, voff) do { _Pragma("unroll") for (int _i = 0; _i < 2; ++_i) \
        __builtin_amdgcn_global_load_lds((const unsigned*)((const char*)(gbase) + (voff)[_i]), (LAS unsigned*)(lds + (bufoff) + ldsw + _i * 8192), 16, 0, 0); } while (0)
#define PG8_LDA(dst, b, h) do { _Pragma("unroll") for (int m = 0; m < 4; ++m) _Pragma("unroll") for (int k = 0; k < 2; ++k) dst[m][k] = *(const LAS bf16x8*)(lds + PG8_SA(b, h) + aoff + m * 2048 + k * 1024); } while (0)
#define PG8_LDB(dst, b, h) do { _Pragma("unroll") for (int n = 0; n < 2; ++n) _Pragma("unroll") for (int k = 0; k < 2; ++k) dst[n][k] = *(const LAS bf16x8*)(lds + PG8_SB(b, h) + boff + n * 2048 + k * 1024); } while (0)
#define PG8_MMA(ai, bj, At, Bt_) do { __builtin_amdgcn_s_setprio(1); _Pragma("unroll") for (int m = 0; m < 4; ++m) _Pragma("unroll") for (int n = 0; n < 2; ++n) _Pragma("unroll") for (int k = 0; k < 2; ++k) \
        acc[ai][bj][m][n] = __builtin_amdgcn_mfma_f32_16x16x32_bf16(Bt_[n][k], At[m][k], acc[ai][bj][m][n], 0, 0, 0); __builtin_amdgcn_s_setprio(0); } while (0)
#define PG8_WAIT_V(n) asm volatile("s_waitcnt vmcnt(" #n ")" ::: "memory")
#define PG8_WAIT_L(n) asm volatile("s_waitcnt lgkmcnt(" #n ")" ::: "memory")
#define PG8_BAR __builtin_amdgcn_s_barrier()
#define PG8_SCHED __builtin_amdgcn_sched_barrier(0)
    Unit cur, nxt; int ui = 0;
    if (!S.next(0, cur)) return;
    f32x4 acc[2][2][4][2];
#pragma unroll
    for (int a = 0; a < 2; ++a)
#pragma unroll
        for (int b = 0; b < 2; ++b)
#pragma unroll
            for (int m = 0; m < 4; ++m)
#pragma unroll
                for (int n = 0; n < 2; ++n) acc[a][b][m][n] = (f32x4){0.f, 0.f, 0.f, 0.f};
    bf16x8 At[4][2], B0[2][2], B1[2][2];
    unsigned oC0[2], oC1[2], oN0[2], oN1[2];
#pragma unroll
    for (int i = 0; i < 2; ++i) { oC0[i] = S.a_off(cur, Rr[i], Cc[i]); oC1[i] = S.a_off(cur, HALF + Rr[i], Cc[i]); }
    const char* gA = (const char*)A;
    const char* cB = (const char*)Bt + (size_t)cur.brow0 * K * 2;
    PG8_STAGE(PG8_SB(0, 0), cB, voffB); PG8_STAGE(PG8_SA(0, 0), gA, oC0); PG8_STAGE(PG8_SB(0, 1), cB + hstepB, voffB); PG8_STAGE(PG8_SA(0, 1), gA, oC1);
    if (wr == 1) PG8_BAR;
    PG8_WAIT_V(4); PG8_BAR;
    PG8_STAGE(PG8_SB(1, 0), cB + kstep, voffB); PG8_STAGE(PG8_SA(1, 0), gA + kstep, oC0); PG8_STAGE(PG8_SB(1, 1), cB + hstepB + kstep, voffB);
    PG8_WAIT_V(6); PG8_BAR;
    for (;;) {
        const bool has_next = S.next(ui + 1, nxt);
        if (has_next) {
#pragma unroll
            for (int i = 0; i < 2; ++i) { oN0[i] = S.a_off(nxt, Rr[i], Cc[i]); oN1[i] = S.a_off(nxt, HALF + Rr[i], Cc[i]); }
        } else {
#pragma unroll
            for (int i = 0; i < 2; ++i) { oN0[i] = oC0[i]; oN1[i] = oC1[i]; }
        }
        const char* nB = has_next ? (const char*)Bt + (size_t)nxt.brow0 * K * 2 : cB;
        for (int t = 0; t < nt; t += 2) {
            const bool last = (t == nt - 2);
            const char* a1 = gA + (size_t)(t + 1) * kstep;
            const char* a2 = last ? gA : gA + (size_t)(t + 2) * kstep; const char* b2 = last ? nB : cB + (size_t)(t + 2) * kstep;
            const char* a3 = a2 + kstep; const char* b3 = b2 + kstep;
            unsigned o20[2], o21[2];
#pragma unroll
            for (int i = 0; i < 2; ++i) { o20[i] = last ? oN0[i] : oC0[i]; o21[i] = last ? oN1[i] : oC1[i]; }
            PG8_LDB(B0, 0, 0); PG8_SCHED; PG8_LDA(At, 0, 0); PG8_STAGE(PG8_SA(1, 1), a1, oC1);
            PG8_WAIT_L(8); PG8_BAR; PG8_WAIT_L(0); PG8_MMA(0, 0, At, B0); PG8_BAR; PG8_SCHED;
            PG8_LDB(B1, 0, 1); PG8_STAGE(PG8_SB(0, 0), b2, voffB);
            PG8_BAR; PG8_WAIT_L(0); PG8_MMA(0, 1, At, B1); PG8_BAR;
            PG8_LDA(At, 0, 1); PG8_STAGE(PG8_SA(0, 0), a2, o20);
            PG8_BAR; PG8_WAIT_L(0); PG8_MMA(1, 0, At, B0); PG8_BAR; PG8_SCHED;
            PG8_STAGE(PG8_SB(0, 1), b2 + hstepB, voffB);
            PG8_WAIT_V(6); PG8_BAR; PG8_MMA(1, 1, At, B1); PG8_BAR;
            PG8_LDB(B0, 1, 0); PG8_SCHED; PG8_LDA(At, 1, 0); PG8_STAGE(PG8_SA(0, 1), a2, o21);
            PG8_WAIT_L(8); PG8_BAR; PG8_WAIT_L(0); PG8_MMA(0, 0, At, B0); PG8_BAR; PG8_SCHED;
            PG8_LDB(B1, 1, 1); PG8_STAGE(PG8_SB(1, 0), b3, voffB);
            PG8_BAR; PG8_WAIT_L(0); PG8_MMA(0, 1, At, B1); PG8_BAR;
            PG8_LDA(At, 1, 1); PG8_STAGE(PG8_SA(1, 0), a3, o20);
            PG8_BAR; PG8_WAIT_L(0); PG8_MMA(1, 0, At, B0); PG8_BAR; PG8_SCHED;
            PG8_STAGE(PG8_SB(1, 1), b3 + hstepB, voffB);
            PG8_WAIT_V(6); PG8_BAR; PG8_MMA(1, 1, At, B1); PG8_BAR;
        }
        E(acc, cur, wr, wc, fr, fq);
        if (!has_next) break;
#pragma unroll
        for (int a = 0; a < 2; ++a)
#pragma unroll
            for (int b = 0; b < 2; ++b)
#pragma unroll
                for (int m = 0; m < 4; ++m)
#pragma unroll
                    for (int n = 0; n < 2; ++n) acc[a][b][m][n] = (f32x4){0.f, 0.f, 0.f, 0.f};
        cur = nxt; cB = nB; ++ui;
#pragma unroll
        for (int i = 0; i < 2; ++i) { oC0[i] = oN0[i]; oC1[i] = oN1[i]; }
    }
    PG8_WAIT_V(0);
    if (wr == 0) PG8_BAR;
    PG8_BAR;
#undef PG8_SA
#undef PG8_SB
#undef PG8_STAGE
#undef PG8_LDA
#undef PG8_LDB
#undef PG8_MMA
#undef PG8_WAIT_V
#undef PG8_WAIT_L
#undef PG8_BAR
#undef PG8_SCHED
}

template <int ACT> struct EpiStoreBf16 {
    static constexpr bool PERM = true;
    bf16_t* O; int ldc; const float* vec; int split_cols; size_t split_stride;
    __device__ __forceinline__ float act(float v, float b) const {
        if (ACT == 1) return 2.f * sigmoidf_(2.f * v) - 1.f;
        if (ACT == 2) return sigmoidf_(v);
        if (ACT == 3) return 0.60653065971f * sigmoidf_(v + b);
        if (ACT == 4) return sigmoidf_(v + b);
        return v;
    }
    __device__ __forceinline__ void operator()(const f32x4 (&acc)[2][2][4][2], const Unit& u, int wr, int wc, int fr, int fq) const {
        const int row0 = u.arow0 + wr * 64 + fr; int colt = u.col0; bf16_t* base = O;
        if (split_cols) { const int t = colt / split_cols; base += (size_t)t * split_stride; colt -= t * split_cols; }
        const int col0 = colt + wc * 32 + 8 * fq, bcol0 = u.col0 + wc * 32 + 8 * fq;
#pragma unroll
        for (int bj = 0; bj < 2; ++bj) {
            const f32x4 b0 = (ACT >= 3) ? *(const f32x4*)(vec + bcol0 + bj * HALF) : (f32x4){0.f, 0.f, 0.f, 0.f}, b1 = (ACT >= 3) ? *(const f32x4*)(vec + bcol0 + bj * HALF + 4) : (f32x4){0.f, 0.f, 0.f, 0.f};
#pragma unroll
            for (int ai = 0; ai < 2; ++ai)
#pragma unroll
                for (int m = 0; m < 4; ++m) { bf16_t* rowp = base + (size_t)(row0 + ai * HALF + m * 16) * ldc + col0; const f32x4 v0 = acc[ai][bj][m][0], v1 = acc[ai][bj][m][1];
                {
                    u32x4 o; o[0] = cvt_pk_bf16(act(v0[0], b0[0]), act(v0[1], b0[1])); o[1] = cvt_pk_bf16(act(v0[2], b0[2]), act(v0[3], b0[3]));
                    o[2] = cvt_pk_bf16(act(v1[0], b1[0]), act(v1[1], b1[1])); o[3] = cvt_pk_bf16(act(v1[2], b1[2]), act(v1[3], b1[3]));
                    *(u32x4*)(rowp + bj * HALF) = o; } }
        }
    }
};
struct EpiMultiBf16 {
    static constexpr bool PERM = true;
    bf16_t* O; size_t ostride; unsigned omap; int ldc; unsigned acts; const float* V; long vd2; int vd1;
    __device__ __forceinline__ void operator()(const f32x4 (&acc)[2][2][4][2], const Unit& u, int wr, int wc, int fr, int fq) const {
        const int w = u.e; bf16_t* base = O + (size_t)((omap >> (4 * w)) & 15u) * ostride; const float* vec = V + (w >= 2 ? vd2 : 0l) + (w & 1) * vd1;
        const unsigned a = (acts >> (4 * w)) & 15u;
        const bool lin = a == 0u, hasb = a >= 3u;
        const float alpha = a == 1u ? 2.f : a == 3u ? 0.60653065971f : 1.f, beta = a == 1u ? 2.f : 1.f, gamma = a == 1u ? -1.f : 0.f;
        const int row0 = u.arow0 + wr * 64 + fr, col0 = u.col0 + wc * 32 + 8 * fq;
        if (lin) {
#pragma unroll
            for (int bj = 0; bj < 2; ++bj)
#pragma unroll
                for (int ai = 0; ai < 2; ++ai)
#pragma unroll
                    for (int m = 0; m < 4; ++m) { bf16_t* rowp = base + (size_t)(row0 + ai * HALF + m * 16) * ldc + col0; const f32x4 x0 = acc[ai][bj][m][0], x1 = acc[ai][bj][m][1];
                        u32x4 o; o[0] = cvt_pk_bf16(x0[0], x0[1]); o[1] = cvt_pk_bf16(x0[2], x0[3]); o[2] = cvt_pk_bf16(x1[0], x1[1]); o[3] = cvt_pk_bf16(x1[2], x1[3]);
                        *(u32x4*)(rowp + bj * HALF) = o; }
            return;
        }
#pragma unroll
        for (int bj = 0; bj < 2; ++bj) {
            f32x4 b0 = (f32x4){0.f, 0.f, 0.f, 0.f}, b1 = b0;
            if (hasb) { b0 = *(const f32x4*)(vec + col0 + bj * HALF); b1 = *(const f32x4*)(vec + col0 + bj * HALF + 4); }
#pragma unroll
            for (int ai = 0; ai < 2; ++ai)
#pragma unroll
                for (int m = 0; m < 4; ++m) { bf16_t* rowp = base + (size_t)(row0 + ai * HALF + m * 16) * ldc + col0; const f32x4 x0 = acc[ai][bj][m][0], x1 = acc[ai][bj][m][1];
                    float r[8];
#pragma unroll
                    for (int j = 0; j < 4; ++j) { r[j] = alpha * sigmoidf_(beta * x0[j] + b0[j]) + gamma; r[4 + j] = alpha * sigmoidf_(beta * x1[j] + b1[j]) + gamma; }
                    u32x4 o; o[0] = cvt_pk_bf16(r[0], r[1]); o[1] = cvt_pk_bf16(r[2], r[3]); o[2] = cvt_pk_bf16(r[4], r[5]); o[3] = cvt_pk_bf16(r[6], r[7]);
                    *(u32x4*)(rowp + bj * HALF) = o; }
        }
    }
};
struct EpiRes {
    static constexpr bool PERM = false;
    const float* xin_l; float* out_l; const float* xin_c; float* out_c; const float* gate;
    __device__ __forceinline__ void operator()(const f32x4 (&acc)[2][2][4][2], const Unit& u, int wr, int wc, int fr, int fq) const {
        const int row0 = u.arow0 + wr * 64 + fr, col0 = u.col0 + wc * 32 + 4 * fq;
        const bool isc = u.arow0 >= ML;
        const int gb = isc ? 2 : (u.arow0 / SEQ);
        const float* gp = gate + (size_t)gb * MODW + col0;
        f32x4 gv[2][2];
#pragma unroll
        for (int bj = 0; bj < 2; ++bj)
#pragma unroll
            for (int n = 0; n < 2; ++n) gv[bj][n] = *(const f32x4*)(gp + bj * HALF + n * 16);
        const float* xi = isc ? xin_c - (size_t)ML * D : xin_l; float* xo = isc ? out_c - (size_t)ML * D : out_l;
#pragma unroll
        for (int ai = 0; ai < 2; ++ai) {
            f32x4 xv[4][2][2];
#pragma unroll
            for (int m = 0; m < 4; ++m) { const size_t ro = (size_t)(row0 + ai * HALF + m * 16) * D + col0;
#pragma unroll
                for (int bj = 0; bj < 2; ++bj)
#pragma unroll
                    for (int n = 0; n < 2; ++n) xv[m][bj][n] = *(const f32x4*)(xi + ro + bj * HALF + n * 16); }
            __builtin_amdgcn_sched_barrier(0);
#pragma unroll
            for (int m = 0; m < 4; ++m) { const size_t ro = (size_t)(row0 + ai * HALF + m * 16) * D + col0;
#pragma unroll
                for (int bj = 0; bj < 2; ++bj)
#pragma unroll
                    for (int n = 0; n < 2; ++n) *(f32x4*)(xo + ro + bj * HALF + n * 16) = xv[m][bj][n] + gv[bj][n] * acc[ai][bj][m][n]; }
        }
    }
};
struct EpiMoeUp {
    static constexpr bool PERM = false;
    bf16_t* H;
    __device__ __forceinline__ void operator()(const f32x4 (&acc)[2][2][4][2], const Unit& u, int wr, int wc, int fr, int fq) const {
        const int row0 = u.arow0 + wr * 64 + fr;
#pragma unroll
        for (int ai = 0; ai < 2; ++ai)
#pragma unroll
            for (int m = 0; m < 4; ++m) { bf16_t* rowp = H + (size_t)(row0 + ai * HALF + m * 16) * FF;
#pragma unroll
                for (int bj = 0; bj < 2; ++bj) { const int j = (u.col0 + bj * HALF + wc * 32) / 2 + 4 * fq; const f32x4 a = acc[ai][bj][m][0], b = acc[ai][bj][m][1];
                    float h[4];
#pragma unroll
                    for (int i = 0; i < 4; ++i) h[i] = a[i] * sigmoidf_(a[i]) * b[i];
                    u32x2 o; o[0] = cvt_pk_bf16(h[0], h[1]); o[1] = cvt_pk_bf16(h[2], h[3]);
                    *(u32x2*)(rowp + j) = o; } }
    }
};
}

struct MoeSched {
    const LAS int* pref; const LAS int* cnt; const int* tokl; int nN, G, c, K, rowsB; bool gather;
    __device__ bool next(int i, pg8::Unit& u) const {
        const long L = (long)i * G + c; const int T = __builtin_amdgcn_readfirstlane(pref[NEXP]);
        if (L >= (long)T * nN) return false;
        const int tl = (int)(L / nN), pn = (int)(L % nN);
        int e = 0;
        for (int k = 1; k < NEXP; ++k) e = (pref[k] <= tl) ? k : e;
        e = __builtin_amdgcn_readfirstlane(e);
        u.e = e; u.pbase = __builtin_amdgcn_readfirstlane((tl - pref[e]) * 256); u.cnt = __builtin_amdgcn_readfirstlane(cnt[e]); u.arow0 = tl * 256; u.brow0 = e * rowsB + pn * 256; u.col0 = pn * 256; return true;
    }
    __device__ __forceinline__ unsigned a_off(const pg8::Unit& u, int r, int C) const {
        if (gather) { const int p = u.pbase + r; const int t_ = tokl[(size_t)u.e * MT + min(p, u.cnt - 1)]; const int tok = (p < u.cnt) ? t_ : 0; return (unsigned)(tok * K + C) * 2u; }
        return (unsigned)((u.arow0 + r) * K + C) * 2u;
    }
};

#define WSP(T, off) ((T*)(F.ws + (off)))
__device__ __forceinline__ const float* mod_row(const Frame& F, int layer, int row3) { return (const float*)(F.ws + WS_MOD) + ((size_t)layer * 3 + row3) * MODW; }

__device__ __forceinline__ void expert_prefix(const Frame& F, int layer, LAS int* pref, LAS int* cntl) {
    if (F.wave == 0) {
        const int lane = F.lane_();
        int c = 0; if (lane < NEXP) c = WSP(int, WS_CTL + CTL_CNT)[(size_t)(layer * NEXP + lane) * CNT_STRIDE];
        const int t = (c + 255) >> 8; int sc_ = t;
#pragma unroll
        for (int d = 1; d < NEXP; d <<= 1) { const int o = __shfl_up(sc_, d); if (lane >= d) sc_ += o; }
        if (lane < NEXP) { pref[lane] = sc_ - t; if (cntl) cntl[lane] = c; }
        if (lane == NEXP - 1) pref[NEXP] = sc_;
    }
    __syncthreads();
}

struct CvtJob { const float* src; const float* src2; bf16_t* dst; int Ksrc, Nsrc, ld_src, Kdst, Ndst, koff, grp_rows; size_t grp_stride; int mode; };
struct CvtRegs { f32x4 v[4]; };
__device__ __forceinline__ void cvt_load(const CvtJob& J, int tile, int tid, CvtRegs& R) {
    const int ktiles = J.Kdst / 64, nt = tile / ktiles, kt = tile % ktiles, n0 = nt * 128, k0 = kt * 64;
    const int e = n0 / J.grp_rows, nl0 = n0 % J.grp_rows;
    const int kr = tid >> 3, c8 = tid & 7;
    const int ks = k0 + kr - J.koff;
    const bool kok = (ks >= 0) && (ks < J.Ksrc);
#pragma unroll
    for (int cc = 0; cc < 2; ++cc) {
        const int nl = nl0 + (c8 + cc * 8) * 8;
        const float* sp = J.src + (size_t)e * J.grp_stride; int ncol = nl;
        if (J.mode == 1) { const int g = nl >> 5, w = nl & 31; sp = (w < 16 ? J.src : J.src2) + (size_t)e * J.grp_stride; ncol = g * 16 + (w & 15); }
        if (kok && ncol + 8 <= J.Nsrc) { const float* p = sp + (size_t)ks * J.ld_src + ncol; R.v[cc * 2] = *(const f32x4*)p; R.v[cc * 2 + 1] = *(const f32x4*)(p + 4); }
        else { R.v[cc * 2] = (f32x4){0.f, 0.f, 0.f, 0.f}; R.v[cc * 2 + 1] = (f32x4){0.f, 0.f, 0.f, 0.f}; }
    }
}
__device__ __forceinline__ void cvt_job(const Frame& F, const CvtJob& J, int& base, int nw = 0, int wi = 0) {
    const int ntiles = (J.Ndst / 128) * (J.Kdst / 64), tid = F.tid_();
    LAS float* tl = (LAS float*)F.lds;
    const int G_ = nw > 0 ? nw : F.G, me = nw > 0 ? wi : F.bid;
    if (me < 0) return;
    int t = ((me - base) % G_ + G_) % G_;
    base = (base + ntiles) % G_;
    if (t >= ntiles) return;
    CvtRegs cur, nxt; cvt_load(J, t, tid, cur);
    const int ktiles = J.Kdst / 64;
    for (; t < ntiles; t += G_) {
        const bool hn = (t + G_) < ntiles;
        if (hn) cvt_load(J, t + G_, tid, nxt);
        const int kr = tid >> 3, c8 = tid & 7;
#pragma unroll
        for (int cc = 0; cc < 2; ++cc)
#pragma unroll
            for (int j = 0; j < 8; ++j) tl[kr * 129 + (c8 + cc * 8) * 8 + j] = cur.v[cc * 2 + (j >> 2)][j & 3];
        __syncthreads();
        const int nrow = tid >> 2, kq = tid & 3, nt = t / ktiles, kt = t % ktiles;
        float x[16];
#pragma unroll
        for (int j = 0; j < 16; ++j) x[j] = tl[(kq * 16 + j) * 129 + nrow];
        u32x4 o0, o1;
#pragma unroll
        for (int j = 0; j < 4; ++j) { o0[j] = cvt_pk_bf16(x[2 * j], x[2 * j + 1]); o1[j] = cvt_pk_bf16(x[8 + 2 * j], x[8 + 2 * j + 1]); }
        bf16_t* dp = J.dst + (size_t)(nt * 128 + nrow) * J.Kdst + kt * 64 + kq * 16;
        *(u32x4*)dp = o0; *(u32x4*)(dp + 8) = o1;
        __syncthreads();
        if (hn) cur = nxt;
    }
}
__device__ __forceinline__ void cvt_simple(const Frame& F, const float* src, bf16_t* dst, int Ksrc, int Nsrc, int& base) {
    CvtJob J{src, src, dst, Ksrc, Nsrc, Nsrc, Ksrc, Nsrc, 0, Nsrc, 0, 0}; cvt_job(F, J, base);
}
__device__ __forceinline__ void cvt_moe13(const Frame& F, int layer, bf16_t* w13, int& base, int nw = 0, int wi = 0) {
    const size_t lo = (size_t)layer * NEXP * D * FF;
    CvtJob J1{F.A.in[I_MW1] + lo, F.A.in[I_MW3] + lo, w13, D, FF, FF, D, NEXP * 2 * FF, 0, 2 * FF, (size_t)D * FF, 1}; cvt_job(F, J1, base, nw, wi);
}
__device__ __forceinline__ void cvt_moe2(const Frame& F, int layer, bf16_t* w2t, int& base, int nw = 0, int wi = 0) {
    const size_t lo = (size_t)layer * NEXP * D * FF;
    CvtJob J2{F.A.in[I_MW2] + lo, F.A.in[I_MW2] + lo, w2t, FF, D, D, FF, NEXP * D, 0, D, (size_t)FF * D, 0}; cvt_job(F, J2, base, nw, wi);
}
__device__ __forceinline__ void cvt_moe(const Frame& F, int layer, bf16_t* w13, bf16_t* w2t, int& base) { cvt_moe13(F, layer, w13, base); cvt_moe2(F, layer, w2t, base); }

__device__ __forceinline__ void ph_prologue(const Frame& F) {
    const int tid = F.tid_();
    {
        LAS float* cv = (LAS float*)F.lds;
        LAS float* red = (LAS float*)(F.lds + 32768);
        for (int k = tid; k < D; k += NTHR) {
            const float c0 = F.A.in[I_C][k], c1 = F.A.in[I_C][D + k], c2 = F.A.in[I_CCTX][k];
            cv[k] = c0 * sigmoidf_(c0); cv[D + k] = c1 * sigmoidf_(c1); cv[2 * D + k] = c2 * sigmoidf_(c2);
        }
        __syncthreads();
        for (int item = F.bid; item < 2 * 96; item += F.G) {
            const int l = item / 96, n0 = (item % 96) * 128, c4 = tid & 31, kg = tid >> 5;
            float a[3][4];
#pragma unroll
            for (int r = 0; r < 3; ++r)
#pragma unroll
                for (int j = 0; j < 4; ++j) a[r][j] = 0.f;
            const float* wp = F.A.in[I_ADAW] + (size_t)l * D * MODW + n0 + c4 * 4;
#pragma unroll 1
            for (int kb = kg; kb < D; kb += 16 * 16) {
                f32x4 w[16];
#pragma unroll
                for (int u = 0; u < 16; ++u) w[u] = *(const f32x4*)(wp + (size_t)(kb + 16 * u) * MODW);
                __builtin_amdgcn_sched_barrier(0);
#pragma unroll
                for (int u = 0; u < 16; ++u) { const int k = kb + 16 * u; const float s0 = cv[k], s1 = cv[D + k], s2 = cv[2 * D + k];
#pragma unroll
                    for (int j = 0; j < 4; ++j) { a[0][j] += s0 * w[u][j]; a[1][j] += s1 * w[u][j]; a[2][j] += s2 * w[u][j]; } }
            }
#pragma unroll
            for (int r = 0; r < 3; ++r)
#pragma unroll
                for (int j = 0; j < 4; ++j) red[(kg * 3 + r) * 128 + c4 * 4 + j] = a[r][j];
            __syncthreads();
            if (tid < 384) { const int r = tid >> 7, n = tid & 127; float s = F.A.in[I_ADAB][(size_t)l * MODW + n0 + n];
                for (int g = 0; g < 16; ++g) s += red[(g * 3 + r) * 128 + n];
                WSP(float, WS_MOD)[((size_t)l * 3 + r) * MODW + n0 + n] = s; }
            __syncthreads();
        }
        __syncthreads();
    }
    int base = 0;
    cvt_simple(F, F.A.in[I_WIN], WSP(bf16_t, WT_IN), D, QKVC, base);
    cvt_simple(F, F.A.in[I_WOUT], WSP(bf16_t, WT_OUT), D, D, base);
    cvt_simple(F, F.A.in[I_WR], WSP(bf16_t, WT_R), D, D, base);
    cvt_simple(F, F.A.in[I_WK], WSP(bf16_t, WT_K), D, D, base);
    cvt_simple(F, F.A.in[I_WV], WSP(bf16_t, WT_V), D, D, base);
    cvt_simple(F, F.A.in[I_WO], WSP(bf16_t, WT_O), D, D, base);
    for (int d = 0; d < 2; ++d) {
        { CvtJob J{F.A.in[I_W1] + (size_t)d * D * 96, nullptr, WSP(bf16_t, WT_W1) + (size_t)d * 128 * D, D, 96, 96, D, 128, 0, 128, 0, 0}; cvt_job(F, J, base); }
        { CvtJob J{F.A.in[I_A1] + (size_t)d * D * 96, nullptr, WSP(bf16_t, WT_A1) + (size_t)d * 128 * D, D, 96, 96, D, 128, 0, 128, 0, 0}; cvt_job(F, J, base); }
        { CvtJob J{F.A.in[I_W2] + (size_t)d * 96 * D, nullptr, WSP(bf16_t, WT_W2) + (size_t)d * D * 128, 96, D, D, 128, D, 0, D, 0, 0}; cvt_job(F, J, base); }
        { CvtJob J{F.A.in[I_A2] + (size_t)d * 96 * D, nullptr, WSP(bf16_t, WT_A2) + (size_t)d * D * 128, 96, D, D, 128, D, 0, D, 0, 0}; cvt_job(F, J, base); }
    }
    cvt_simple(F, F.A.in[I_G1], WSP(bf16_t, WT_G1), D, 256, base);
    cvt_simple(F, F.A.in[I_G2], WSP(bf16_t, WT_G2), 256, D, base);
}

struct RowOpts {
    const float* src_l; const float* src_c;
    int nrows;
    bool combine; int comb_layer; const bf16_t* yslot; float* dst_l; float* dst_c;
    bool norm; int layer; int which;
    bf16_t* H;
    bool router;
};
__device__ __forceinline__ void ph_rows(const Frame& F, const RowOpts& O) {
    LAS int* pref = (LAS int*)(F.lds + MISC_OFF + 1024);
    if (O.combine) expert_prefix(F, O.comb_layer, pref, (LAS int*)nullptr);
    const int lane = F.lane_(), stride = F.G * 8;
    LAS float* PA = (LAS float*)F.lds; LAS float* PB = PA + 3 * D; LAS float* PG = PA + 6 * D;
    int t0 = F.tid_(); asm volatile("" : "+v"(t0));
    for (int idx = t0; idx < 3 * D / 4; idx += NTHR) {
        const int m = idx / (D / 4), c = (idx % (D / 4)) * 4;
        if (O.norm) {
            const float* gn = (O.which ? F.A.in[I_NFFN] : F.A.in[I_NMIX]) + (size_t)O.layer * D; const float* mr = mod_row(F, O.layer, m);
            const f32x4 g = *(const f32x4*)(gn + c), sc = *(const f32x4*)(mr + (O.which ? 4 * D : D) + c), sh = *(const f32x4*)(mr + (O.which ? 3 * D : 0) + c);
            f32x4 a;
#pragma unroll
            for (int j = 0; j < 4; ++j) a[j] = g[j] * (1.f + sc[j]);
            *(LAS f32x4*)(PA + m * D + c) = a; *(LAS f32x4*)(PB + m * D + c) = sh;
        }
        if (O.combine) *(LAS f32x4*)(PG + m * D + c) = *(const f32x4*)(mod_row(F, O.comb_layer, m) + 5 * D + c);
    }
    __syncthreads();
    struct RowIn { f32x4 v[8]; int s0, s1; float g0, g1; };
    auto loadrow = [&](int r, RowIn& R) {
        const float* sp = (r >= ML) ? O.src_c + (size_t)(r - ML) * D : O.src_l + (size_t)r * D;
#pragma unroll
        for (int i = 0; i < 8; ++i) R.v[i] = *(const f32x4*)(sp + i * 256 + lane * 4);
        if (O.combine) { R.s0 = WSP(int, WS_TOKSEL)[r * 2]; R.s1 = WSP(int, WS_TOKSEL)[r * 2 + 1]; R.g0 = WSP(float, WS_TOKGATE)[r * 2]; R.g1 = WSP(float, WS_TOKGATE)[r * 2 + 1]; }
    };
    RowIn cur, nxt;
    int r = F.bid * 8 + F.wave;
    if (r < O.nrows) loadrow(r, cur);
    for (; r < O.nrows; r += stride) {
        if (r + stride < O.nrows) loadrow(r + stride, nxt);
        const bool isc = r >= ML;
        const int mrow = isc ? 2 : r / SEQ;
        f32x4 v[8];
#pragma unroll
        for (int i = 0; i < 8; ++i) v[i] = cur.v[i];
        if (O.combine) {
            const int s0 = cur.s0, s1 = cur.s1; const float g0 = cur.g0, g1 = cur.g1;
            const size_t y0 = ((size_t)pref[s0 >> 20] * 256 + (s0 & 0xfffff)) * D, y1 = ((size_t)pref[s1 >> 20] * 256 + (s1 & 0xfffff)) * D;
            const LAS float* gt = PG + mrow * D;
            float* dp = isc ? O.dst_c + (size_t)(r - ML) * D : O.dst_l + (size_t)r * D;
            u32x2 ya[8], yb[8];
#pragma unroll
            for (int i = 0; i < 8; ++i) { ya[i] = *(const u32x2*)(O.yslot + y0 + i * 256 + lane * 4); yb[i] = *(const u32x2*)(O.yslot + y1 + i * 256 + lane * 4); }
#pragma unroll
            for (int i = 0; i < 8; ++i) {
                const int col = i * 256 + lane * 4;
                const u32x2 a = ya[i], b = yb[i];
                const f32x4 g = *(const LAS f32x4*)(gt + col);
                v[i][0] += g[0] * (g0 * bf_lo(a[0]) + g1 * bf_lo(b[0])); v[i][1] += g[1] * (g0 * bf_hi(a[0]) + g1 * bf_hi(b[0]));
                v[i][2] += g[2] * (g0 * bf_lo(a[1]) + g1 * bf_lo(b[1])); v[i][3] += g[3] * (g0 * bf_hi(a[1]) + g1 * bf_hi(b[1]));
                if (TIME_PH >= 0 && !O.norm) { const float tsc = 1.f + sqrtf(*WSP(float, WS_CTL + 20496) * 1e-6f); v[i] *= tsc; }
                *(f32x4*)(dp + col) = v[i];
            }
        }
        if (O.norm) {
            float ss = 0.f;
#pragma unroll
            for (int i = 0; i < 8; ++i) ss += v[i][0] * v[i][0] + v[i][1] * v[i][1] + v[i][2] * v[i][2] + v[i][3] * v[i][3];
            ss = wave_sum(ss);
            const float rstd = rsqrtf(ss * (1.f / D) + 1e-6f);
            const LAS float* pa = PA + mrow * D; const LAS float* pb = PB + mrow * D;
            bf16_t* hp = O.H + (size_t)r * D;
#pragma unroll
            for (int i = 0; i < 8; ++i) {
                const int col = i * 256 + lane * 4;
                const f32x4 ga = *(const LAS f32x4*)(pa + col), sh = *(const LAS f32x4*)(pb + col);
#pragma unroll
                for (int j = 0; j < 4; ++j) v[i][j] = v[i][j] * rstd * ga[j] + sh[j];
                u32x2 o; o[0] = cvt_pk_bf16(v[i][0], v[i][1]); o[1] = cvt_pk_bf16(v[i][2], v[i][3]);
                *(u32x2*)(hp + col) = o;
            }
        }
        cur = nxt;
    }
}

__device__ __forceinline__ void ph_router_fold(const Frame& F) {
    const int tid = F.tid_();
    bf16_t* WFH = WSP(bf16_t, WS_WF); bf16_t* WFL = WFH + (size_t)6 * 48 * D; float* CV = WSP(float, WS_CV);
    for (int idx = F.bid * NTHR + tid; idx < 6 * 48 * (D / 8); idx += F.G * NTHR) {
        const int ln = idx & 63, j3 = (idx >> 6) % 3, s8 = (idx / 192) & 7, wv = (idx / 1536) & 7, lb = idx / 12288, l = lb / 3, b = lb % 3;
        const int n = j3 * 16 + (ln & 15), k8 = wv * 32 + s8 * 4 + (ln >> 4);
        const float* mr = mod_row(F, l, b);
        float v[8];
#pragma unroll
        for (int j = 0; j < 8; ++j) { const int k = k8 * 8 + j;
            const float sc = F.A.in[I_NFFN][(size_t)l * D + k] * (1.f + mr[4 * D + k]);
            const float w = n < 4 ? F.A.in[I_MGRP][((size_t)l * D + k) * 4 + n] : n < 36 ? F.A.in[I_MEXP][((size_t)l * D + k) * NEXP + n - 4] : 0.f;
            v[j] = w * sc; }
        u32x4 hi, lo;
#pragma unroll
        for (int j = 0; j < 4; ++j) { hi[j] = cvt_pk_bf16(v[2 * j], v[2 * j + 1]); lo[j] = cvt_pk_bf16(v[2 * j] - bf_lo(hi[j]), v[2 * j + 1] - bf_hi(hi[j])); }
        *(u32x4*)(WFH + (size_t)idx * 8) = hi; *(u32x4*)(WFL + (size_t)idx * 8) = lo;
    }
    const int lane = F.lane_();
    for (int it = F.bid * 8 + F.wave; it < 2 * 3 * 48; it += F.G * 8) {
        const int n = it % 48, lb = it / 48, l = lb / 3, b = lb % 3;
        const float* sh = mod_row(F, l, b) + 3 * D;
        float a = 0.f;
        if (n < 36) for (int k = lane; k < D; k += 64) { const float w = n < 4 ? F.A.in[I_MGRP][((size_t)l * D + k) * 4 + n] : F.A.in[I_MEXP][((size_t)l * D + k) * NEXP + n - 4]; a += sh[k] * w; }
        a = wave_sum(a);
        if (lane == 0) CV[lb * 48 + n] = a;
    }
}
__device__ __forceinline__ void ph_rows_router(const Frame& F, const float* src_l, const float* src_c, int nrows, int layer, bf16_t* H) {
    const int lane = F.lane_(), wave = F.wave, l15 = lane & 15, q4 = lane >> 4;
    LAS float* lt = (LAS float*)(F.lds + wave * 16640);
    LAS float* pa = (LAS float*)(F.lds + 8 * 16640);
    LAS float* l0 = pa;
    const float* gn = F.A.in[I_NFFN] + (size_t)layer * D;
    f32x4 xv[16];
    auto loadx = [&](int tl, f32x4 (&x)[16]) { const int r0 = tl * 16; const float* sp = (r0 >= ML) ? src_c + (size_t)(r0 - ML) * D : src_l + (size_t)r0 * D;
#pragma unroll
        for (int i = 0; i < 16; ++i) x[i] = *(const f32x4*)(sp + (size_t)i * D + wave * 256 + lane * 4); };
    if (F.bid * 16 < nrows) loadx(F.bid, xv);
    for (int tl = F.bid; tl * 16 < nrows; tl += F.G) {
        const int r0 = tl * 16; const bool isc = r0 >= ML; const int mrow = isc ? 2 : r0 / SEQ;
        const bf16_t* Wh = WSP(bf16_t, WS_WF) + (size_t)(layer * 3 + mrow) * 48 * D; const bf16_t* Wl = Wh + (size_t)6 * 48 * D; const float* cv = WSP(float, WS_CV) + (layer * 3 + mrow) * 48;
        f32x4 acc0 = (f32x4){0.f, 0.f, 0.f, 0.f}, acc1 = acc0, acc2 = acc0; float ssq[16];
#pragma unroll
        for (int i = 0; i < 16; ++i) { ssq[i] = xv[i][0] * xv[i][0] + xv[i][1] * xv[i][1] + xv[i][2] * xv[i][2] + xv[i][3] * xv[i][3]; *(LAS f32x4*)(lt + i * 260 + lane * 4) = xv[i]; }
        LAS float* pw_ = pa + wave * 784;
#pragma unroll
        for (int i = 0; i < 16; ++i) { const float t = wave_sum(ssq[i]); if (lane == i) pw_[768 + i] = t; }
        lds_fence();
        f32x4 pg, psc, psh; float cv0, cv1, cv2;
        {
            const bf16_t* wph = Wh + ((size_t)wave * 1536 + lane) * 8; const bf16_t* wpl = Wl + ((size_t)wave * 1536 + lane) * 8;
            const LAS float* ap = lt + l15 * 260 + q4 * 8;
            bf16x8 hA[2][3], lA[2][3], hB[2][3], lB[2][3];
#define RT_LOAD(kb, H_, L_) do { _Pragma("unroll") for (int s2 = 0; s2 < 2; ++s2) _Pragma("unroll") for (int j = 0; j < 3; ++j) { const size_t o = (size_t)((((kb) * 2 + s2) * 3 + j) * 64) * 8; \
                H_[s2][j] = *(const bf16x8*)(wph + o); L_[s2][j] = *(const bf16x8*)(wpl + o); } } while (0)
#define RT_MMA(kb, H_, L_) do { _Pragma("unroll") for (int s2 = 0; s2 < 2; ++s2) { const f32x4 xa = *(const LAS f32x4*)(ap + ((kb) * 2 + s2) * 32), xb = *(const LAS f32x4*)(ap + ((kb) * 2 + s2) * 32 + 4); \
                u32x4 xh_, xl_; \
                xh_[0] = cvt_pk_bf16(xa[0], xa[1]); xh_[1] = cvt_pk_bf16(xa[2], xa[3]); xh_[2] = cvt_pk_bf16(xb[0], xb[1]); xh_[3] = cvt_pk_bf16(xb[2], xb[3]); \
                xl_[0] = cvt_pk_bf16(xa[0] - bf_lo(xh_[0]), xa[1] - bf_hi(xh_[0])); xl_[1] = cvt_pk_bf16(xa[2] - bf_lo(xh_[1]), xa[3] - bf_hi(xh_[1])); \
                xl_[2] = cvt_pk_bf16(xb[0] - bf_lo(xh_[2]), xb[1] - bf_hi(xh_[2])); xl_[3] = cvt_pk_bf16(xb[2] - bf_lo(xh_[3]), xb[3] - bf_hi(xh_[3])); \
                const bf16x8 ah = *reinterpret_cast<const bf16x8*>(&xh_), al = *reinterpret_cast<const bf16x8*>(&xl_); \
                acc0 = __builtin_amdgcn_mfma_f32_16x16x32_bf16(ah, H_[s2][0], acc0, 0, 0, 0); acc1 = __builtin_amdgcn_mfma_f32_16x16x32_bf16(ah, H_[s2][1], acc1, 0, 0, 0); acc2 = __builtin_amdgcn_mfma_f32_16x16x32_bf16(ah, H_[s2][2], acc2, 0, 0, 0); \
                acc0 = __builtin_amdgcn_mfma_f32_16x16x32_bf16(ah, L_[s2][0], acc0, 0, 0, 0); acc1 = __builtin_amdgcn_mfma_f32_16x16x32_bf16(ah, L_[s2][1], acc1, 0, 0, 0); acc2 = __builtin_amdgcn_mfma_f32_16x16x32_bf16(ah, L_[s2][2], acc2, 0, 0, 0); \
                acc0 = __builtin_amdgcn_mfma_f32_16x16x32_bf16(al, H_[s2][0], acc0, 0, 0, 0); acc1 = __builtin_amdgcn_mfma_f32_16x16x32_bf16(al, H_[s2][1], acc1, 0, 0, 0); acc2 = __builtin_amdgcn_mfma_f32_16x16x32_bf16(al, H_[s2][2], acc2, 0, 0, 0); } } while (0)
            RT_LOAD(0, hA, lA); __builtin_amdgcn_sched_barrier(0);
            RT_LOAD(1, hB, lB); __builtin_amdgcn_sched_barrier(0);
            RT_MMA(0, hA, lA); __builtin_amdgcn_sched_barrier(0);
            RT_LOAD(2, hA, lA); __builtin_amdgcn_sched_barrier(0);
            RT_MMA(1, hB, lB); __builtin_amdgcn_sched_barrier(0);
            RT_LOAD(3, hB, lB); __builtin_amdgcn_sched_barrier(0);
            RT_MMA(2, hA, lA); __builtin_amdgcn_sched_barrier(0);
            { const float* mr = mod_row(F, layer, mrow); const int col = wave * 256 + lane * 4;
              pg = *(const f32x4*)(gn + col); psc = *(const f32x4*)(mr + 4 * D + col); psh = *(const f32x4*)(mr + 3 * D + col); cv0 = cv[l15]; cv1 = cv[16 + l15]; cv2 = cv[32 + l15]; }
            __builtin_amdgcn_sched_barrier(0);
            loadx((tl + F.G) * 16 < nrows ? tl + F.G : tl, xv);
            __builtin_amdgcn_sched_barrier(0);
            RT_MMA(3, hB, lB); __builtin_amdgcn_sched_barrier(0);
#undef RT_LOAD
#undef RT_MMA
        }
#pragma unroll
        for (int j = 0; j < 4; ++j) { pw_[lane * 12 + j] = acc0[j]; pw_[lane * 12 + 4 + j] = acc1[j]; pw_[lane * 12 + 8 + j] = acc2[j]; }
        __syncthreads();
        float sst = 0.f; f32x4 t0 = (f32x4){0.f, 0.f, 0.f, 0.f}, t1 = t0, t2 = t0;
#pragma unroll
        for (int w = 0; w < 8; ++w) { const LAS float* pw = pa + w * 784; sst += pw[768 + l15];
            if (wave == 0) {
#pragma unroll
                for (int j = 0; j < 4; ++j) { t0[j] += pw[lane * 12 + j]; t1[j] += pw[lane * 12 + 4 + j]; t2[j] += pw[lane * 12 + 8 + j]; } } }
        const float rs_own = rsqrtf(sst * (1.f / D) + 1e-6f);
        __syncthreads();
        int ea = 0, eb = 0, pa_ = 0, pb_ = 0; float w1g = 0.f, w2g = 0.f;
        if (wave == 0) {
#pragma unroll
            for (int j = 0; j < 4; ++j) { const int row = 4 * q4 + j; const float rs = __shfl(rs_own, row);
                l0[row * 48 + l15] = rs * t0[j] + cv0; l0[row * 48 + 16 + l15] = rs * t1[j] + cv1; l0[row * 48 + 32 + l15] = rs * t2[j] + cv2; }
            lds_fence();
            if (lane < 16) {
                const LAS float* lg = l0 + lane * 48;
                int gs = 0; float gm = lg[0];
#pragma unroll
                for (int q = 1; q < 4; ++q) if (lg[q] > gm) { gm = lg[q]; gs = q; }
                float den = 0.f;
#pragma unroll
                for (int q = 0; q < 4; ++q) den += __expf(lg[q] - gm);
                const float psel = 1.f / den;
                const LAS float* el = lg + 4 + gs * 8;
                int i1 = 0; float v1 = el[0];
#pragma unroll
                for (int q = 1; q < 8; ++q) if (el[q] > v1) { v1 = el[q]; i1 = q; }
                int i2 = -1; float v2 = -3.0e38f;
#pragma unroll
                for (int q = 0; q < 8; ++q) if (q != i1 && el[q] > v2) { v2 = el[q]; i2 = q; }
                const float e2 = __expf(v2 - v1); w1g = psel / (1.f + e2); w2g = psel * e2 / (1.f + e2);
                int* cnt = WSP(int, WS_CTL + CTL_CNT) + layer * NEXP * CNT_STRIDE;
                ea = gs * 8 + i1; eb = gs * 8 + i2;
                pa_ = atomicAdd(cnt + ea * CNT_STRIDE, 1); pb_ = atomicAdd(cnt + eb * CNT_STRIDE, 1);
            }
        }
        {
            const int col = wave * 256 + lane * 4;
            const f32x4 sh = psh;
            f32x4 m;
#pragma unroll
            for (int j = 0; j < 4; ++j) m[j] = pg[j] * (1.f + psc[j]);
#pragma unroll
            for (int i = 0; i < 16; ++i) { const float rs = __int_as_float(__builtin_amdgcn_readlane(__float_as_int(rs_own), i)); const f32x4 x = *(const LAS f32x4*)(lt + i * 260 + lane * 4);
                u32x2 o; o[0] = cvt_pk_bf16(x[0] * rs * m[0] + sh[0], x[1] * rs * m[1] + sh[1]); o[1] = cvt_pk_bf16(x[2] * rs * m[2] + sh[2], x[3] * rs * m[3] + sh[3]);
                *(u32x2*)(H + (size_t)(r0 + i) * D + col) = o; }
        }
        if (wave == 0 && lane < 16) { const int r = r0 + lane;
            WSP(int, WS_TOKL)[(size_t)ea * MT + pa_] = r; WSP(int, WS_TOKL)[(size_t)eb * MT + pb_] = r;
            WSP(int, WS_TOKSEL)[r * 2] = (ea << 20) | pa_; WSP(int, WS_TOKSEL)[r * 2 + 1] = (eb << 20) | pb_;
            WSP(float, WS_TOKGATE)[r * 2] = w1g; WSP(float, WS_TOKGATE)[r * 2 + 1] = w2g; }
    }
    __syncthreads();
}

__device__ __forceinline__ void ph_qknorm(const Frame& F, bf16_t* QKV) {
    const int lane = F.lane_();
    const int il = lane & 15;
    const float f0 = exp2f(-(float)(2 * il) * (13.287712379549449f / 32.f)), f1 = exp2f(-(float)(2 * il + 1) * (13.287712379549449f / 32.f));
    const int stride = F.G * 8;
    auto loadrow = [&](int r, unsigned (&u)[10]) {
        const bf16_t* row = QKV + (size_t)r * QKVC;
#pragma unroll
        for (int hd = 0; hd < 10; ++hd) { const int col = hd < 2 ? KA0 + hd * 128 : KB0 + (hd - 2) * 128;
            u[hd] = *(const unsigned*)(row + col + 2 * lane); }
    };
    unsigned u[10], un[10];
    const f32x2 gga = *(const f32x2*)(F.A.in[I_AKG] + 2 * lane), ggb = *(const f32x2*)(F.A.in[I_BKG] + 2 * lane);
    int r = F.bid * 8 + F.wave;
    if (r < MT) loadrow(r, u);
    for (; r < MT; r += stride) {
        if (r + stride < MT) loadrow(r + stride, un);
        const bool lat = r < ML; const int t = r % SEQ;
        const float pos = (lane < 32) ? (float)(t / 64) : (float)(t % 64);
        float c0 = 1.f, s0 = 0.f, c1 = 1.f, s1 = 0.f;
        if (lat) { const float r0_ = __builtin_amdgcn_fractf(pos * f0 * 0.15915494309189535f), r1_ = __builtin_amdgcn_fractf(pos * f1 * 0.15915494309189535f);
            s0 = __builtin_amdgcn_sinf(r0_); c0 = __builtin_amdgcn_cosf(r0_); s1 = __builtin_amdgcn_sinf(r1_); c1 = __builtin_amdgcn_cosf(r1_); }
        bf16_t* row = QKV + (size_t)r * QKVC;
        float ss[10];
#pragma unroll
        for (int hd = 0; hd < 10; ++hd) { const float x0 = bf_lo(u[hd]), x1 = bf_hi(u[hd]); ss[hd] = x0 * x0 + x1 * x1; }
#pragma unroll
        for (int hd = 0; hd < 10; ++hd) ss[hd] = wave_sum(ss[hd]);
#pragma unroll
        for (int hd = 0; hd < 10; ++hd) { const int col = hd < 2 ? KA0 + hd * 128 : KB0 + (hd - 2) * 128;
            const f32x2 gg = hd < 2 ? gga : ggb;
            const float rstd = rsqrtf(ss[hd] * (1.f / 128.f) + 1e-6f);
            float x0 = bf_lo(u[hd]) * rstd * gg[0], x1 = bf_hi(u[hd]) * rstd * gg[1];
            if (hd < 2 && lat) {
                const float p0 = __shfl_xor(x0, 16), p1 = __shfl_xor(x1, 16);
                if ((lane & 16) == 0) { x0 = x0 * c0 - p0 * s0; x1 = x1 * c1 - p1 * s1; }
                else { x0 = p0 * s0 + x0 * c0; x1 = p1 * s1 + x1 * c1; }
            }
            *(unsigned*)(row + col + 2 * lane) = cvt_pk_bf16(x0, x1); }
#pragma unroll
        for (int hd = 0; hd < 10; ++hd) u[hd] = un[hd];
    }
}

namespace att {
typedef float f32x16 __attribute__((ext_vector_type(16)));
typedef short s16x4 __attribute__((ext_vector_type(4)));
constexpr int KVBLK = 64;
constexpr float SCALE = 0.08838834764831845f, THR = 8.f;
constexpr int SHM_V = KVBLK * 128 * 2, SHM_K = KVBLK * 128 * 2;
#define KSWZ(row, colB) ((row) * 256 + ((colB) ^ (((row) & 7) << 4)))
#define SBAR() __builtin_amdgcn_sched_barrier(0)
__device__ __forceinline__ int crow(int r, int hi) { return (r & 3) + 8 * (r >> 2) + 4 * hi; }
__device__ __forceinline__ void partialSM(f32x16& p0, f32x16& p1, float& m_reg, float& mn, float& alpha) {
  constexpr float C = SCALE * 1.4426950408889634f;
  float pmax = p0[0];
#pragma unroll
  for (int r = 1; r < 16; ++r) pmax = fmaxf(pmax, p0[r]);
#pragma unroll
  for (int r = 0; r < 16; ++r) pmax = fmaxf(pmax, p1[r]);
  { auto rr = __builtin_amdgcn_permlane32_swap(__float_as_uint(pmax), __float_as_uint(pmax), false, false);
    pmax = fmaxf(__uint_as_float(rr[0]), __uint_as_float(rr[1])); }
  if (__builtin_expect(__all(pmax - m_reg <= THR / SCALE), 1)) { mn = m_reg; alpha = 1.f; }
  else { mn = fmaxf(m_reg, pmax); alpha = __builtin_amdgcn_exp2f((m_reg - mn) * C); m_reg = mn; }
  float mnC = -mn * C;
#pragma unroll
  for (int r = 0; r < 16; ++r) p0[r] = fmaf(p0[r], C, mnC);
#pragma unroll
  for (int r = 0; r < 16; ++r) p1[r] = fmaf(p1[r], C, mnC);
#pragma unroll
  for (int r = 0; r < 16; ++r) p0[r] = __builtin_amdgcn_exp2f(p0[r]);
}
__device__ __forceinline__ void finishSM(f32x16& p0, f32x16& p1, float alpha, float& l_reg, bf16x8& pa0, bf16x8& pa1, bf16x8& pa2, bf16x8& pa3) {
#pragma unroll
  for (int r = 0; r < 16; ++r) p1[r] = __builtin_amdgcn_exp2f(p1[r]);
  float ps = 0;
#pragma unroll
  for (int r = 0; r < 16; ++r) ps += p0[r];
#pragma unroll
  for (int r = 0; r < 16; ++r) ps += p1[r];
  { auto rr = __builtin_amdgcn_permlane32_swap(__float_as_uint(ps), __float_as_uint(ps), false, false);
    ps = __uint_as_float(rr[0]) + __uint_as_float(rr[1]); }
  l_reg = l_reg * alpha + ps;
#define PK4(P, BASE, OUT) do { unsigned a0 = cvt_pk_bf16(P[BASE + 0], P[BASE + 1]), a1 = cvt_pk_bf16(P[BASE + 2], P[BASE + 3]);   \
    unsigned b0 = cvt_pk_bf16(P[BASE + 4], P[BASE + 5]), b1 = cvt_pk_bf16(P[BASE + 6], P[BASE + 7]);                              \
    auto r0 = __builtin_amdgcn_permlane32_swap(a0, b0, false, false); auto r1 = __builtin_amdgcn_permlane32_swap(a1, b1, false, false); \
    u32x4 w = {r0[0], r1[0], r0[1], r1[1]}; OUT = *reinterpret_cast<bf16x8*>(&w); } while (0)
  PK4(p0, 0, pa0); PK4(p0, 8, pa1); PK4(p1, 0, pa2); PK4(p1, 8, pa3);
#undef PK4
}
__device__ __forceinline__ void qkt(f32x16& p0, f32x16& p1, const LAS char* Ks, const bf16x8* qr, int r32, int hi) {
  asm volatile("" : "+v"(r32));
  p0 = f32x16{}; p1 = f32x16{};
#pragma unroll
  for (int d0 = 0; d0 < 8; ++d0) { int cb = (d0 * 16 + hi * 8) * 2;
    bf16x8 b0 = *reinterpret_cast<const LAS bf16x8*>(Ks + KSWZ(r32, cb));
    bf16x8 b1 = *reinterpret_cast<const LAS bf16x8*>(Ks + KSWZ(32 + r32, cb));
    p0 = __builtin_amdgcn_mfma_f32_32x32x16_bf16(b0, qr[d0], p0, 0, 0, 0);
    p1 = __builtin_amdgcn_mfma_f32_32x32x16_bf16(b1, qr[d0], p1, 0, 0, 0); }
}
__device__ __forceinline__ int v_st(int k, int c) { const int kk = (k & ~0xC) | ((k & 4) << 1) | ((k & 8) >> 1); return ((kk >> 3) * 4 + (c >> 5)) * 512 + ((kk & 7) * 32 + (c & 31)) * 2; }
__device__ __forceinline__ int v_rd_base(int lane) { return ((lane & 3) << 3) | (((lane >> 2) & 3) << 6) | (((lane >> 4) & 1) << 5) | (((lane >> 5) & 1) << 8); }
constexpr int v_rd_off(int d0, int ks, int half) { return d0 * 512 + ks * 4096 + half * 2048; }
template <int OFF> __device__ __forceinline__ s16x4 tr_read(int vb) {
  s16x4 r; asm volatile("ds_read_b64_tr_b16 %0, %1 offset:%2" : "=&v"(r) : "v"(vb), "i"(OFF) : "memory"); return r;
}
template <int D0> __device__ __forceinline__ void pv_one(f32x16& od, int vb, bf16x8 pa0, bf16x8 pa1, bf16x8 pa2, bf16x8 pa3) {
  const s16x4 l0 = tr_read<v_rd_off(D0, 0, 0)>(vb), h0 = tr_read<v_rd_off(D0, 0, 1)>(vb), l1 = tr_read<v_rd_off(D0, 1, 0)>(vb), h1 = tr_read<v_rd_off(D0, 1, 1)>(vb);
  const s16x4 l2 = tr_read<v_rd_off(D0, 2, 0)>(vb), h2 = tr_read<v_rd_off(D0, 2, 1)>(vb), l3 = tr_read<v_rd_off(D0, 3, 0)>(vb), h3 = tr_read<v_rd_off(D0, 3, 1)>(vb);
  asm volatile("s_waitcnt lgkmcnt(0)" ::: "memory"); SBAR();
#define PK(L, H) (bf16x8){L[0], L[1], L[2], L[3], H[0], H[1], H[2], H[3]}
  od = __builtin_amdgcn_mfma_f32_32x32x16_bf16(pa0, PK(l0, h0), od, 0, 0, 0);
  od = __builtin_amdgcn_mfma_f32_32x32x16_bf16(pa1, PK(l1, h1), od, 0, 0, 0);
  od = __builtin_amdgcn_mfma_f32_32x32x16_bf16(pa2, PK(l2, h2), od, 0, 0, 0);
  od = __builtin_amdgcn_mfma_f32_32x32x16_bf16(pa3, PK(l3, h3), od, 0, 0, 0);
#undef PK
}
__device__ __forceinline__ void pv_d0(f32x16* o, int vb, bf16x8 pa0, bf16x8 pa1, bf16x8 pa2, bf16x8 pa3) {
  pv_one<0>(o[0], vb, pa0, pa1, pa2, pa3); pv_one<1>(o[1], vb, pa0, pa1, pa2, pa3); pv_one<2>(o[2], vb, pa0, pa1, pa2, pa3); pv_one<3>(o[3], vb, pa0, pa1, pa2, pa3);
}
struct UnitD {
  int nW, NT;
  int wrow0, crow0;
  int qt, wlo;
};
__device__ __forceinline__ void mask_add(f32x16& p0, f32x16& p1, int hi, const LAS float* tp) {
  const LAS float* tq = tp + 4 * hi;
#pragma unroll
  for (int g2 = 0; g2 < 2; ++g2) {
    float a[8], b[8];
#pragma unroll
    for (int q = 0; q < 8; ++q) { const int jc = (q & 3) + 8 * (2 * g2 + (q >> 2)); a[q] = tq[jc]; b[q] = tq[jc + 32]; }
#pragma unroll
    for (int q = 0; q < 8; ++q) { const int r = 8 * g2 + q; p0[r] += a[q]; p1[r] += b[q]; }
    SBAR();
  }
}
__device__ __forceinline__ void mask_add2(f32x16& p0, f32x16& p1, int hi, const LAS float* tpA, const LAS float* tpB) {
  const LAS float* ta = tpA + 4 * hi; const LAS float* tb = tpB + 4 * hi;
#pragma unroll
  for (int g = 0; g < 4; ++g) {
    float a0[4], a1[4], b0[4], b1[4];
#pragma unroll
    for (int q = 0; q < 4; ++q) { const int jc = q + 8 * g; a0[q] = ta[jc]; a1[q] = ta[jc + 32]; b0[q] = tb[jc]; b1[q] = tb[jc + 32]; }
#pragma unroll
    for (int q = 0; q < 4; ++q) { const int r = 4 * g + q; p0[r] += a0[q] + b0[q]; p1[r] += a1[q] + b1[q]; }
    SBAR();
  }
}

__device__ __forceinline__ void attn_unit(const int TYPE, const bf16_t* __restrict__ Qw_, const bf16_t* __restrict__ Kc, const bf16_t* __restrict__ Vc, bf16_t* __restrict__ Ow, const UnitD U,
                                          const int wrr  , const float sink_l2  , LAS char* lds,
                                          const LAS float* qgain  , const bool qrope, const int qt0  ,
                                          int* aq, int& unext  ) {
  const int tid = threadIdx.x, wid = __builtin_amdgcn_readfirstlane(tid >> 6), lane = tid & 63, r32 = lane & 31, hi = lane >> 5;
  LAS char* V_lds = lds; LAS char* K_lds = lds + 2 * SHM_V;
  LAS float* ws = (LAS float*)(lds + 2 * SHM_V + 2 * SHM_K) + wid * 64; LAS float* li_l = ws; LAS float* al_l = ws + 32;
  const LAS float* tbl = (const LAS float*)(lds + 2 * SHM_V + 2 * SHM_K + 2048);
  float m_reg = -1e4f, l_reg = 0; bf16x8 qr[8];
  const bf16_t* Qw = Qw_ + (size_t)r32 * QKVC + hi * 8;
  const int sr = tid >> 4, sc = (tid & 15) * 8;
  struct { bf16x8 vs0, vs1, ks0, ks1; } sr_[1];
#define TROW(j) (((j) < U.nW) ? (U.wrow0 + (j) * 64) : (U.crow0 + (((j) - U.nW) & 3) * 64))
#define SLOAD(i, k0) do { const int _k0 = (k0); sr_[i].vs0 = *reinterpret_cast<const bf16x8*>(&Vc[(size_t)(_k0 + sr) * QKVC + sc]); sr_[i].vs1 = *reinterpret_cast<const bf16x8*>(&Vc[(size_t)(_k0 + 32 + sr) * QKVC + sc]); \
    sr_[i].ks0 = *reinterpret_cast<const bf16x8*>(&Kc[(size_t)(_k0 + sr) * QKVC + sc]); sr_[i].ks1 = *reinterpret_cast<const bf16x8*>(&Kc[(size_t)(_k0 + 32 + sr) * QKVC + sc]); } while (0)
  SLOAD(0, TROW(0)); __builtin_amdgcn_sched_barrier(0);
  {
    u32x4 raw[8]; float ssq = 0.f;
#pragma unroll
    for (int d0 = 0; d0 < 8; ++d0) raw[d0] = *reinterpret_cast<const u32x4*>(Qw + d0 * 16);
    __builtin_amdgcn_sched_barrier(0);
    if (tid == 0) unext = atomicAdd(aq, 1);
    __builtin_amdgcn_sched_barrier(0);
#pragma unroll
    for (int d0 = 0; d0 < 8; ++d0) {
#pragma unroll
      for (int j = 0; j < 4; ++j) { const float a = bf_lo(raw[d0][j]), b = bf_hi(raw[d0][j]); ssq += a * a + b * b; } }
    ssq += __shfl_xor(ssq, 32);
    const float rstd = rsqrtf(ssq * (1.f / 128.f) + 1e-6f);
    const int t = qt0 + r32;
    int hi_l = hi; asm volatile("" : "+v"(hi_l));
#pragma unroll
    for (int hf = 0; hf < 2; ++hf) {
      float q[4][8];
#pragma unroll
      for (int dd = 0; dd < 4; ++dd) { const int d0 = hf * 4 + dd; const f32x4 g0 = *(const LAS f32x4*)(qgain + d0 * 16 + hi_l * 8), g1 = *(const LAS f32x4*)(qgain + d0 * 16 + hi_l * 8 + 4);
#pragma unroll
        for (int j = 0; j < 4; ++j) { q[dd][2 * j] = bf_lo(raw[d0][j]); q[dd][2 * j + 1] = bf_hi(raw[d0][j]); }
#pragma unroll
        for (int j = 0; j < 4; ++j) { q[dd][j] *= rstd * g0[j]; q[dd][4 + j] *= rstd * g1[j]; } }
      if (qrope) { const float pos = hf == 0 ? (float)(t >> 6) : (float)(t & 63);
#pragma unroll
        for (int dd = 0; dd < 2; ++dd)
#pragma unroll
          for (int j = 0; j < 8; ++j) { const int i = dd * 16 + hi_l * 8 + j;
            const float fr = __builtin_amdgcn_fractf(pos * exp2f(-(float)i * (13.287712379549449f / 32.f)) * 0.15915494309189535f);
            const float sn = __builtin_amdgcn_sinf(fr), cs = __builtin_amdgcn_cosf(fr);
            const float x1 = q[dd][j], x2 = q[2 + dd][j];
            q[dd][j] = x1 * cs - x2 * sn; q[2 + dd][j] = x1 * sn + x2 * cs; } }
#pragma unroll
      for (int dd = 0; dd < 4; ++dd) { u32x4 w;
#pragma unroll
        for (int j = 0; j < 4; ++j) w[j] = cvt_pk_bf16(q[dd][2 * j], q[dd][2 * j + 1]);
        qr[hf * 4 + dd] = *reinterpret_cast<bf16x8*>(&w); }
    }
  }
  f32x16 o[4] = {};
  const int vst0 = v_st(sr, sc), vst1 = v_st(32 + sr, sc);
  const int vb0 = (int)(uintptr_t)V_lds + v_rd_base(lane);
  const int iq = (wid & 1) * 32 + r32;
  const int r0w = min(max(wrr - 4, 0), 248);
  const int c0q = min(max(iq - 8, 0), 48);
#define SWRITE(b, i) do { *(LAS bf16x8*)(V_lds + (b) * SHM_V + vst0) = sr_[i].vs0;          \
    *(LAS bf16x8*)(V_lds + (b) * SHM_V + vst1) = sr_[i].vs1; int kc = sc * 2;               \
    *(LAS bf16x8*)(K_lds + (b) * SHM_K + KSWZ(sr, kc)) = sr_[i].ks0;                       \
    *(LAS bf16x8*)(K_lds + (b) * SHM_K + KSWZ(32 + sr, kc)) = sr_[i].ks1; } while (0)
#define RESC(a) do { if (__any((a) < 1.f)) { if (hi == 0) al_l[r32] = (a); asm volatile("s_waitcnt lgkmcnt(0)" ::: "memory"); \
    _Pragma("unroll") for (int d = 0; d < 4; ++d) _Pragma("unroll") for (int r = 0; r < 16; ++r) o[d][r] *= al_l[crow(r, hi)]; } } while (0)
#define MASK(j, P0, P1) do { const int _j = (j); \
    if (TYPE == 0) { if (_j < U.nW) { const int tix = U.wlo + _j; \
        if (tix == U.qt - 2) mask_add(P0, P1, hi, tbl + 17 * 128 + 64 - iq); else if (tix == U.qt + 2) mask_add(P0, P1, hi, tbl + 18 * 128 + 64 - iq); } } \
    else { if (_j < U.nW) { const int dr = U.wlo + _j - r0w; \
        if ((unsigned)dr < 8u) mask_add2(P0, P1, hi, tbl + (U.wlo + _j - wrr + 7) * 128 + 64 - iq, tbl + 16 * 128 + 48 - c0q); \
        else mask_add(P0, P1, hi, tbl + 19 * 128); } } } while (0)
  f32x16 p0, p1; float mn, al = 1.f; bf16x8 pa0, pa1, pa2, pa3; const int NT = U.NT;
  asm volatile("s_waitcnt vmcnt(0)" ::: "memory"); SWRITE(0, 0); SLOAD(0, TROW(1)); __syncthreads();
  for (int j = 0; j < NT; ++j) {
    const int par = j & 1;
    const bool skip = (TYPE == 1) && (j < U.nW) && ((unsigned)(U.wlo + j - r0w) >= 8u);
    if (!skip) qkt(p0, p1, K_lds + par * SHM_K, qr, r32, hi);
    if (j + 1 < NT) { SWRITE(1 - par, 0); }
    if (j + 2 < NT) SLOAD(0, TROW(j + 2));
    if (!skip) {
      MASK(j, p0, p1);
      partialSM(p0, p1, m_reg, mn, al);
      RESC(al);
      finishSM(p0, p1, al, l_reg, pa0, pa1, pa2, pa3); SBAR();
      pv_d0(o, vb0 + par * SHM_V, pa0, pa1, pa2, pa3);
    }
    __syncthreads();
  }
  if (TYPE == 0) l_reg += __builtin_amdgcn_exp2f(sink_l2 - m_reg * (SCALE * 1.4426950408889634f));
  int r32e = r32, hie = hi; asm volatile("" : "+v"(r32e), "+v"(hie));
  if (hie == 0) li_l[r32e] = l_reg; asm volatile("s_waitcnt lgkmcnt(0)" ::: "memory");
  float rli[16];
#pragma unroll
  for (int r = 0; r < 16; ++r) rli[r] = __builtin_amdgcn_rcpf(li_l[crow(r, hie)]);
#pragma unroll
  for (int r = 0; r < 16; ++r) { const int orow = crow(r, hie);
#pragma unroll
    for (int d0 = 0; d0 < 4; ++d0) { const float x = o[d0][r] * rli[r]; Ow[(size_t)orow * D + d0 * 32 + r32e] = (bf16_t)(cvt_pk_bf16(x, x) & 0xffffu); } }
#undef TROW
#undef SLOAD
#undef SWRITE
#undef RESC
#undef MASK
}
}

__device__ __forceinline__ void ph_attn(const Frame& F, const bf16_t* QKV, bf16_t* YC) {
    LAS char* lds = (LAS char*)F.lds;
    LAS float* tbl = (LAS float*)(lds + 2 * att::SHM_V + 2 * att::SHM_K + 2048);
    const int wid = F.wave;
    for (int i = F.tid_(); i < 5 * 128; i += NTHR) { const int row = 15 + (i >> 7), k = i & 127; float v = 0.f;
        if (row == 16) v = ((unsigned)(k - 56 + 8) < 16u) ? 0.f : -1e30f;
        if (row == 17) v = (k - 64 >= 0) ? 0.f : -1e30f;
        if (row == 18) v = (k - 64 <= 0) ? 0.f : -1e30f;
        if (row == 19) v = -1e30f;
        tbl[15 * 128 + i] = v; }
    if (F.tid_() < 256) tbl[20 * 128 + F.tid_()] = F.tid_() < 128 ? F.A.in[I_AQG][F.tid_()] : F.A.in[I_BQG][F.tid_() - 128];
    if (F.tid_() < 16) tbl[22 * 128 + F.tid_()] = F.A.in[I_ASINK][F.tid_()] * 1.4426950408889634f;
    int hprev = -1;
    volatile LAS int* qslot = (volatile LAS int*)(F.lds + MISC_OFF + 768);
    if (F.tid_() == 0) qslot[0] = atomicAdd(WSP(int, WS_CTL + CTL_AQ), 1);
    __syncthreads();
    for (;;) {
        const int u = __builtin_amdgcn_readfirstlane(qslot[0]);
        __syncthreads();
        if (u >= 2080) break;
        int unext = 0;
        att::UnitD U; int type, qrow0, wrr = 0, qoff, koff, voff, ooff, wrow; float sink_l2 = 0.f;
        if (u < 1040) {
            const int b = u / 520, rem = u % 520, h = rem / 65, qg = rem % 65;
            if (h != hprev) {
                int ti = F.tid_(); asm volatile("" : "+v"(ti));
                for (int i = ti; i < 15 * 128; i += NTHR) { const int dr = i >> 7, k = (i & 127) - 49; tbl[i] = ((unsigned)k < 31u) ? F.A.in[I_RPB][(size_t)h * 465 + dr * 31 + k] * (1.f / att::SCALE) : 0.f; }
                hprev = h;
            }
            type = 1;
            U.crow0 = ML + b * CTXL;
            if (qg < 64) { const int R0 = qg * 4; const int klo = min(max(R0 - 4, 0), 248), khi = min(max(R0 - 1, 0), 248) + 7;
                U.nW = khi - klo + 1; U.wrow0 = b * SEQ + klo * 64; U.wlo = klo; U.qt = R0; qrow0 = b * SEQ + R0 * 64; wrr = R0 + (wid >> 1); }
            else { U.nW = 0; U.wrow0 = 0; U.wlo = 0; U.qt = 0; qrow0 = ML + b * CTXL; }
            wrow = wid * 32; qoff = QB0 + h * 128; koff = KB0 + h * 128; voff = VB0 + h * 128; ooff = 1024 + h * 128;
        } else {
            const int v = u - 1040, b = v / 520, rem = v % 520, kvh = rem / 260, qt = rem % 260;
            const int g = wid >> 1, hq = kvh * 4 + g;
            type = 0;
            U.crow0 = ML + b * CTXL;
            if (qt < 256) { const int wlo = max(qt - 2, 0), whi = min(qt + 2, 255); U.nW = whi - wlo + 1; U.wlo = wlo; U.qt = qt; U.wrow0 = b * SEQ + wlo * 64; qrow0 = b * SEQ + qt * 64; }
            else { U.nW = 0; U.wlo = 0; U.qt = 1000; U.wrow0 = 0; qrow0 = ML + b * CTXL + (qt - 256) * 64; }
            sink_l2 = tbl[22 * 128 + hq];
            wrow = (wid & 1) * 32; qoff = QA0 + hq * 128; koff = KA0 + kvh * 128; voff = VA0 + kvh * 128; ooff = hq * 128;
        }
        U.NT = U.nW + 4;
        __syncthreads();
        att::attn_unit(type, QKV + (size_t)(qrow0 + wrow) * QKVC + qoff, QKV + koff, QKV + voff, YC + (size_t)(qrow0 + wrow) * D + ooff, U, wrr, sink_l2, lds,
                       tbl + (20 + type) * 128, (type == 0) && (qrow0 < ML), (qrow0 + wrow) % SEQ, WSP(int, WS_CTL + CTL_AQ), unext);
        if (F.tid_() == 0) qslot[0] = unext;
        __syncthreads();
    }
}

__device__ __forceinline__ void rows_y(const Frame& F, int s0, int s1, const LAS int* pref, const bf16_t* yslot, u32x2 (&ya)[8], u32x2 (&yb)[8]) {
    const int lane = F.lane_();
    const size_t y0 = ((size_t)pref[s0 >> 20] * 256 + (s0 & 0xfffff)) * D, y1 = ((size_t)pref[s1 >> 20] * 256 + (s1 & 0xfffff)) * D;
#pragma unroll
    for (int i = 0; i < 8; ++i) { ya[i] = *(const u32x2*)(yslot + y0 + i * 256 + lane * 4); yb[i] = *(const u32x2*)(yslot + y1 + i * 256 + lane * 4); }
}
template <bool LP>
__device__ __forceinline__ void rows_h(const Frame& F, int r, const f32x4 (&xin)[8], const u32x2 (&ya)[8], const u32x2 (&yb)[8], float g0, float g1, bool writeback, f32x4 (&v)[8], const LAS float* P) {
    const int lane = F.lane_(); const bool isc = r >= ML; const int mrow = isc ? 2 : r / SEQ;
    const float* gt = mod_row(F, 0, mrow) + 5 * D;
    float* dp = isc ? WSP(float, WS_XC) + (size_t)(r - ML) * D : F.out + (size_t)r * D;
    float ss = 0.f;
#pragma unroll
    for (int i = 0; i < 8; ++i) { const int col = i * 256 + lane * 4; const u32x2 a = ya[i], b = yb[i]; const f32x4 g = LP ? *(const LAS f32x4*)(P + 2 * D + col) : *(const f32x4*)(gt + col);
        v[i] = xin[i];
        v[i][0] += g[0] * (g0 * bf_lo(a[0]) + g1 * bf_lo(b[0])); v[i][1] += g[1] * (g0 * bf_hi(a[0]) + g1 * bf_hi(b[0]));
        v[i][2] += g[2] * (g0 * bf_lo(a[1]) + g1 * bf_lo(b[1])); v[i][3] += g[3] * (g0 * bf_hi(a[1]) + g1 * bf_hi(b[1]));
        if (writeback) *(f32x4*)(dp + col) = v[i];
        ss += v[i][0] * v[i][0] + v[i][1] * v[i][1] + v[i][2] * v[i][2] + v[i][3] * v[i][3]; }
    ss = wave_sum(ss);
    const float rstd = rsqrtf(ss * (1.f / D) + 1e-6f);
    const float* gn = F.A.in[I_NMIX] + (size_t)D; const float* mr = mod_row(F, 1, mrow);
#pragma unroll
    for (int i = 0; i < 8; ++i) { const int col = i * 256 + lane * 4;
        if (LP) { const f32x4 ga = *(const LAS f32x4*)(P + col), sh = *(const LAS f32x4*)(P + D + col);
#pragma unroll
            for (int j = 0; j < 4; ++j) v[i][j] = v[i][j] * rstd * ga[j] + sh[j]; }
        else { const f32x4 g = *(const f32x4*)(gn + col), sc = *(const f32x4*)(mr + D + col), sh = *(const f32x4*)(mr + col);
#pragma unroll
            for (int j = 0; j < 4; ++j) v[i][j] = v[i][j] * rstd * (g[j] * (1.f + sc[j])) + sh[j]; } }
}
__device__ __forceinline__ void mix_block(int G, int bid, int& blk0, int& nown) {
    const int nc = max(G / 64, 1), nl = (G - nc) / 2;
    if (bid < 2 * nl) { const int seg = bid >= nl, i = bid - seg * nl, q = SEQ / nl, rm = SEQ % nl; blk0 = seg * SEQ + i * q + min(i, rm); nown = q + (i < rm); }
    else if (bid < 2 * nl + nc) { const int i = bid - 2 * nl, q = 2 * CTXL / nc, rm = (2 * CTXL) % nc; blk0 = ML + i * q + min(i, rm); nown = q + (i < rm); }
    else { blk0 = MT; nown = 0; }
}
struct RowIn2 { f32x4 v[8]; int s0, s1; float g0, g1; };
__device__ __forceinline__ void rows_load(const Frame& F, int r, RowIn2& R) {
    const int lane = F.lane_();
    const float* sp = (r >= ML) ? WSP(float, WS_XC) + (size_t)(r - ML) * D : F.out + (size_t)r * D;
#pragma unroll
    for (int i = 0; i < 8; ++i) R.v[i] = *(const f32x4*)(sp + i * 256 + lane * 4);
    R.s0 = WSP(int, WS_TOKSEL)[r * 2]; R.s1 = WSP(int, WS_TOKSEL)[r * 2 + 1]; R.g0 = WSP(float, WS_TOKGATE)[r * 2]; R.g1 = WSP(float, WS_TOKGATE)[r * 2 + 1];
}
__device__ __forceinline__ void rows_pref(const Frame& F, LAS int* pref) {
    expert_prefix(F, 0, pref, (LAS int*)nullptr);
}
__device__ __forceinline__ void ph_rows_halo(const Frame& F, const bf16_t* yslot) {
    LAS int* pref = (LAS int*)(F.lds + MISC_OFF + 1024); rows_pref(F, pref);
    int blk0, nown; mix_block(F.G, F.bid, blk0, nown); const int lane = F.lane_();
    if (F.wave < 2) {
        const int r = F.wave == 0 ? blk0 - 1 : blk0 + nown;
        if (r >= 0 && r < MT && nown > 0) {
            RowIn2 R; rows_load(F, r, R); u32x2 ya[8], yb[8]; rows_y(F, R.s0, R.s1, pref, yslot, ya, yb); f32x4 v[8]; rows_h<false>(F, r, R.v, ya, yb, R.g0, R.g1, false, v, (const LAS float*)nullptr);
            bf16_t* hp = WSP(bf16_t, WS_HALO) + ((size_t)F.bid * 2 + F.wave) * D;
#pragma unroll
            for (int i = 0; i < 8; ++i) { u32x2 o; o[0] = cvt_pk_bf16(v[i][0], v[i][1]); o[1] = cvt_pk_bf16(v[i][2], v[i][3]); *(u32x2*)(hp + i * 256 + lane * 4) = o; }
        }
    }
}
__device__ __forceinline__ void ph_rows_mix6(const Frame& F, const bf16_t* yslot, bf16_t* Xw, bf16_t* Xa, bf16_t* Xg, bf16_t* Xr, bf16_t* Xk, bf16_t* Xv) {
    const int lane = F.lane_(), wave = F.wave;
    int blk0, nown; mix_block(F.G, F.bid, blk0, nown);
    LAS unsigned char* ring = F.lds;
    LAS float* MU = (LAS float*)(F.lds + 20 * 4096);
    LAS float* P = MU + 6 * D;
    if (nown > 0) {
        const int mrow = blk0 >= ML ? 2 : blk0 / SEQ;
        int t0 = F.tid_(); asm volatile("" : "+v"(t0));
        for (int idx = t0; idx < 6 * D / 4; idx += NTHR) *(LAS f32x4*)(MU + idx * 4) = *(const f32x4*)(F.A.in[I_MU] + idx * 4);
        for (int idx = t0; idx < D / 4; idx += NTHR) { const int c = idx * 4; const float* mr = mod_row(F, 1, mrow);
            const f32x4 g = *(const f32x4*)(F.A.in[I_NMIX] + (size_t)D + c), sc = *(const f32x4*)(mr + D + c);
            f32x4 a;
#pragma unroll
            for (int j = 0; j < 4; ++j) a[j] = g[j] * (1.f + sc[j]);
            *(LAS f32x4*)(P + c) = a; *(LAS f32x4*)(P + D + c) = *(const f32x4*)(mr + c); *(LAS f32x4*)(P + 2 * D + c) = *(const f32x4*)(mod_row(F, 0, mrow) + 5 * D + c); }
    }
    LAS int* pref = (LAS int*)(F.lds + MISC_OFF + 1024); rows_pref(F, pref);
    if (nown <= 0) return;
    const int NIT = (nown + 2 + 7) / 8;
    RowIn2 cur, nxt; u32x2 ya[8], yb[8];
    { const int q = wave; if (q >= 1 && q <= nown) { rows_load(F, blk0 + q - 1, cur); rows_y(F, cur.s0, cur.s1, pref, yslot, ya, yb); } }
    for (int it = 0; it < NIT + 1; ++it) {
        const int q = it * 8 + wave, qn = q + 8;
        if (qn >= 1 && qn <= nown) rows_load(F, blk0 + qn - 1, nxt);
        if (q == 0 || q == nown + 1) {
            const bf16_t* hp = WSP(bf16_t, WS_HALO) + ((size_t)F.bid * 2 + (q ? 1 : 0)) * D;
#pragma unroll
            for (int i = 0; i < 4; ++i) *(LAS u32x4*)(ring + (q % 20) * 4096 + (i * 512 + lane * 8) * 2) = *(const u32x4*)(hp + i * 512 + lane * 8);
        } else if (q >= 1 && q <= nown) {
            f32x4 v[8]; rows_h<true>(F, blk0 + q - 1, cur.v, ya, yb, cur.g0, cur.g1, true, v, P);
#pragma unroll
            for (int i = 0; i < 8; ++i) { u32x2 o; o[0] = cvt_pk_bf16(v[i][0], v[i][1]); o[1] = cvt_pk_bf16(v[i][2], v[i][3]); *(LAS u32x2*)(ring + (q % 20) * 4096 + (i * 256 + lane * 4) * 2) = o; }
        }
        cur = nxt;
        if (qn >= 1 && qn <= nown) rows_y(F, cur.s0, cur.s1, pref, yslot, ya, yb);
        __syncthreads();
        const int qm = it * 8 - 1 + wave;
        if (qm >= 1 && qm <= nown) {
            const int r = blk0 + qm - 1;
            const int sl = (r < ML) ? SEQ : CTXL, t = (r < ML) ? (r % SEQ) : ((r - ML) % CTXL);
            const float fp = (t > 0) ? 0.5f : 0.f, fn = (t < sl - 1) ? 0.5f : 0.f;
            const LAS unsigned char* rc = ring + (qm % 20) * 4096 + lane * 16; const LAS unsigned char* rp = ring + ((qm + 19) % 20) * 4096 + lane * 16; const LAS unsigned char* rn = ring + ((qm + 1) % 20) * 4096 + lane * 16;
#pragma unroll
            for (int i = 0; i < 4; ++i) {
                const int col = i * 512 + lane * 8;
                const u32x4 c = *(const LAS u32x4*)(rc + i * 1024), p = *(const LAS u32x4*)(rp + i * 1024), n = *(const LAS u32x4*)(rn + i * 1024);
                float cv[8], xv[8];
#pragma unroll
                for (int k = 0; k < 4; ++k) { cv[2 * k] = bf_lo(c[k]); cv[2 * k + 1] = bf_hi(c[k]);
                    const float pl = (t > 0) ? bf_lo(p[k]) : 0.f, ph = (t > 0) ? bf_hi(p[k]) : 0.f, nl = (t < sl - 1) ? bf_lo(n[k]) : 0.f, nh = (t < sl - 1) ? bf_hi(n[k]) : 0.f;
                    xv[2 * k] = (fp * pl + fn * nl) - cv[2 * k]; xv[2 * k + 1] = (fp * ph + fn * nh) - cv[2 * k + 1]; }
#pragma unroll
                for (int w = 0; w < 6; ++w) {
                    const int m = w == 0 ? 1 : w == 1 ? 4 : w == 2 ? 5 : w == 3 ? 0 : w == 4 ? 2 : 3;
                    bf16_t* X = w == 0 ? Xw : w == 1 ? Xa : w == 2 ? Xg : w == 3 ? Xr : w == 4 ? Xk : Xv;
                    const LAS float* mu = MU + m * D;
                    const f32x4 ma = *(const LAS f32x4*)(mu + col), mb = *(const LAS f32x4*)(mu + col + 4);
                    u32x4 o;
#pragma unroll
                    for (int k = 0; k < 4; ++k) { const float ml = (k < 2) ? ma[2 * k] : mb[2 * k - 4], mh = (k < 2) ? ma[2 * k + 1] : mb[2 * k - 3];
                        o[k] = cvt_pk_bf16(cv[2 * k] + xv[2 * k] * ml, cv[2 * k + 1] + xv[2 * k + 1] * mh); }
                    *(u32x4*)(X + (size_t)r * D + col) = o;
                }
            }
        }
    }
    __syncthreads();
}

__device__ __forceinline__ int scan_row(int dir, int b, int s) {
    if (s < CTXL) return ML + b * CTXL + (dir ? CTXL - 1 - s : s);
    const int t = s - CTXL; return b * SEQ + (dir ? SEQ - 1 - t : t);
}

namespace cs {
constexpr int CSLOT = 13056, SET = 4 * CSLOT, HP0 = 2 * SET, HPSZ = 10240, TP = 144;
constexpr int O_TA = 0, O_TR = 2304, O_A4 = 4608, O_A2 = 8704, O_A3 = 9728, O_VT = 10752, O_GC = 12800;
constexpr int O_BT = 0, O_KT = 2304;
constexpr int LQ0 = HP0 + 4 * HPSZ, LQSZ = 2048, O_LAB = 0, O_LAK = 1024;
constexpr int FLAG_OFF = MISC_OFF + 512;
typedef short s16x4 __attribute__((ext_vector_type(4)));
__device__ __forceinline__ u32x2 tr_issue(unsigned addr) { u32x2 r; asm volatile("ds_read_b64_tr_b16 %0, %1" : "=&v"(r) : "v"(addr) : "memory"); return r; }
__device__ __forceinline__ void tr_wait() { asm volatile("s_waitcnt lgkmcnt(0)" ::: "memory"); __builtin_amdgcn_sched_barrier(0); }
struct Raw { u32x4 v[5][2]; float rn; };
}
__device__ __forceinline__ void scan_cb(const Frame& F, const bf16_t* Rb, const bf16_t* Kb, const bf16_t* AS0, const bf16_t* AS1, float* CB, int nw, int wi) {
    const int lane = F.lane_(), stride = nw * 8;
    struct In { u32x4 k[4], r[4], a0[4], a1[4]; };
    auto loadrow = [&](int r, In& R) {
#pragma unroll
        for (int i = 0; i < 4; ++i) { const size_t ro = (size_t)r * D + i * 512 + lane * 8;
            R.k[i] = *(const u32x4*)(Kb + ro); R.r[i] = *(const u32x4*)(Rb + ro); R.a0[i] = *(const u32x4*)(AS0 + ro); R.a1[i] = *(const u32x4*)(AS1 + ro); }
    };
    In cur, nxt;
    int r = wi * 8 + F.wave;
    if (r < ML) loadrow(r, cur);
    for (; r < ML; r += stride) {
        if (r + stride < ML) loadrow(r + stride, nxt);
#pragma unroll
        for (int i = 0; i < 4; ++i) {
            const int col = i * 512 + lane * 8;
            const u32x4 kv = cur.k[i], rv = cur.r[i], a0 = cur.a0[i], a1 = cur.a1[i];
            const f32x4 ka0 = *(const f32x4*)(F.A.in[I_KA] + col), ka1 = *(const f32x4*)(F.A.in[I_KA] + col + 4), rk0 = *(const f32x4*)(F.A.in[I_RK] + col), rk1 = *(const f32x4*)(F.A.in[I_RK] + col + 4);
            float c0 = 0.f, c1 = 0.f;
#pragma unroll
            for (int j = 0; j < 8; ++j) { const unsigned kw = kv[j >> 1], rw = rv[j >> 1], aw0 = a0[j >> 1], aw1 = a1[j >> 1];
                const float k = (j & 1) ? bf_hi(kw) : bf_lo(kw), rr = (j & 1) ? bf_hi(rw) : bf_lo(rw), s0 = (j & 1) ? bf_hi(aw0) : bf_lo(aw0), s1 = (j & 1) ? bf_hi(aw1) : bf_lo(aw1);
                const float kac = j < 4 ? ka0[j] : ka1[j - 4], rkc = j < 4 ? rk0[j] : rk1[j - 4];
                const float rk = rr * k * rkc;
                c0 += rk * (1.f + (s0 - 1.f) * kac); c1 += rk * (1.f + (s1 - 1.f) * kac); }
            c0 += dpp_mov<0xB1>(c0); c0 += dpp_mov<0x4E>(c0); c0 += dpp_mov<0x141>(c0);
            c1 += dpp_mov<0xB1>(c1); c1 += dpp_mov<0x4E>(c1); c1 += dpp_mov<0x141>(c1);
            if ((lane & 7) == 0) { const int head = i * 8 + (lane >> 3); CB[(size_t)r * 32 + head] = c0; CB[((size_t)ML + r) * 32 + head] = c1; }
        }
        cur = nxt;
    }
}
__device__ __forceinline__ void ph_kkn(const Frame& F, const bf16_t* Kb, float* RN) {
    const int lane = F.lane_(), stride = F.G * 8;
    u32x4 cur[4], nxt[4];
    f32x4 kk[4][2];
#pragma unroll
    for (int i = 0; i < 4; ++i) { kk[i][0] = *(const f32x4*)(F.A.in[I_KK] + i * 512 + lane * 8); kk[i][1] = *(const f32x4*)(F.A.in[I_KK] + i * 512 + lane * 8 + 4); }
    int r = F.bid * 8 + F.wave;
    if (r < MT) {
#pragma unroll
        for (int i = 0; i < 4; ++i) cur[i] = *(const u32x4*)(Kb + (size_t)r * D + i * 512 + lane * 8); }
    for (; r < MT; r += stride) {
        if (r + stride < MT) {
#pragma unroll
            for (int i = 0; i < 4; ++i) nxt[i] = *(const u32x4*)(Kb + (size_t)(r + stride) * D + i * 512 + lane * 8); }
#pragma unroll
        for (int i = 0; i < 4; ++i) {
            const f32x4 kk0 = kk[i][0], kk1 = kk[i][1];
            float ss = 0.f;
#pragma unroll
            for (int j = 0; j < 4; ++j) { const float a = bf_lo(cur[i][j]) * (j < 2 ? kk0[2 * j] : kk1[2 * j - 4]), b = bf_hi(cur[i][j]) * (j < 2 ? kk0[2 * j + 1] : kk1[2 * j - 3]); ss += a * a + b * b; }
            ss += dpp_mov<0xB1>(ss); ss += dpp_mov<0x4E>(ss); ss += dpp_mov<0x141>(ss);
            if ((lane & 7) == 0) RN[(size_t)r * 32 + i * 8 + (lane >> 3)] = rsqrtf(ss + 1e-12f);
        }
#pragma unroll
        for (int i = 0; i < 4; ++i) cur[i] = nxt[i];
    }
}
__device__ __forceinline__ void ph_scan_chunked(const Frame& F, const bf16_t* Rb, const bf16_t* Kb, const bf16_t* Vb, const float* RN, bf16_t* DEC0, bf16_t* DEC1, const bf16_t* AS0, const bf16_t* AS1) {
    using namespace cs;
    const int lane = F.lane_(), wave = F.wave;
    LAS unsigned char* lds = F.lds;
    constexpr int NCH = (CTXL + SEQ) / 16, NSUP = NCH / 4;
    for (int item = F.bid; item < 128; item += F.G) {
        const int dir = item >> 6, b = (item >> 5) & 1, head = item & 31, hc = head * 64;
        bf16_t* DEC = dir ? DEC1 : DEC0; const bf16_t* AS = dir ? AS1 : AS0;
        if (wave >= 4) {
            const int h = wave - 4, k = lane;
            LAS unsigned char* hp = lds + HP0 + h * HPSZ;
            const float ka = F.A.in[I_KA][hc + k], kkc = F.A.in[I_KK][hc + k];
            Raw raw;
            auto gload = [&](int c) {
#pragma unroll
                for (int i = 0; i < 2; ++i) { const int pc = lane + 64 * i, t = pc >> 3, c8 = (pc & 7) * 8; const size_t o = (size_t)scan_row(dir, b, c * 16 + t) * D + hc + c8;
                    raw.v[0][i] = *(const u32x4*)(DEC + o); raw.v[1][i] = *(const u32x4*)(AS + o); raw.v[2][i] = *(const u32x4*)(Kb + o);
                    raw.v[3][i] = *(const u32x4*)(Rb + o); raw.v[4][i] = *(const u32x4*)(Vb + o); }
                raw.rn = RN[(size_t)scan_row(dir, b, c * 16 + (lane & 15)) * 32 + head];
            };
            auto process = [&](int c, int set, int cnext) {
                LAS unsigned char* sl = lds + set * SET + (c & 3) * CSLOT; LAS unsigned char* lq = lds + LQ0 + (set * 4 + (c & 3)) * LQSZ;
#pragma unroll
                for (int i = 0; i < 2; ++i) { const int pc = lane + 64 * i;
#pragma unroll
                    for (int v5 = 0; v5 < 4; ++v5) *(LAS u32x4*)(hp + v5 * 2048 + pc * 16) = raw.v[v5][i];
                    *(LAS u32x4*)(sl + O_VT + pc * 16) = raw.v[4][i]; }
                const float rn_c = raw.rn;
                lds_fence();
                if (cnext >= 0) gload(cnext);
                const unsigned trb = (unsigned)(uintptr_t)hp + (unsigned)(((lane >> 2) & 3) * 128 + ((lane >> 4) * 16 + (lane & 3) * 4) * 2);
                float e_[16], as_[16], k_[16], kn_[16], r_[16];
                u32x2 X0[4], X1[4], X2[4], X4[4];
#pragma unroll
                for (int j = 0; j < 4; ++j) { X0[j] = tr_issue(trb + 0 * 2048 + j * 512); X1[j] = tr_issue(trb + 1 * 2048 + j * 512); X2[j] = tr_issue(trb + 2 * 2048 + j * 512);
                    X4[j] = tr_issue(trb + 3 * 2048 + j * 512); }
                tr_wait();
#pragma unroll
                for (int j = 0; j < 4; ++j) {
                    const u32x2 x0 = X0[j], x1 = X1[j], x2 = X2[j], x4 = X4[j];
                    e_[4 * j] = bf_lo(x0[0]); e_[4 * j + 1] = bf_hi(x0[0]); e_[4 * j + 2] = bf_lo(x0[1]); e_[4 * j + 3] = bf_hi(x0[1]);
                    as_[4 * j] = bf_lo(x1[0]); as_[4 * j + 1] = bf_hi(x1[0]); as_[4 * j + 2] = bf_lo(x1[1]); as_[4 * j + 3] = bf_hi(x1[1]);
                    k_[4 * j] = bf_lo(x2[0]); k_[4 * j + 1] = bf_hi(x2[0]); k_[4 * j + 2] = bf_lo(x2[1]); k_[4 * j + 3] = bf_hi(x2[1]);
                    r_[4 * j] = bf_lo(x4[0]); r_[4 * j + 1] = bf_hi(x4[0]); r_[4 * j + 2] = bf_lo(x4[1]); r_[4 * j + 3] = bf_hi(x4[1]);
                }
#pragma unroll
                for (int t = 0; t < 16; ++t) kn_[t] = k_[t] * (kkc * __int_as_float(__builtin_amdgcn_readlane(__float_as_int(rn_c), t)));
                float g = 1.f, cs = 0.f, bt[16], kt[16];
#pragma unroll
                for (int t = 0; t < 16; ++t) {
                    const float gp = g; cs += e_[t]; const float m2 = cs * 1.4426950408889634f; g = __builtin_amdgcn_exp2f(-m2); const float ig = __builtin_amdgcn_exp2f(m2);
                    const float bb = kn_[t] * as_[t], kd = k_[t] * (1.f + (as_[t] - 1.f) * ka);
                    bt[t] = bb * ig; kt[t] = kd * ig;
                    const unsigned w0 = cvt_pk_bf16(-kn_[t] * gp, r_[t] * g), w1 = cvt_pk_bf16(bt[t], kt[t]);
                    *(LAS unsigned short*)(sl + O_TA + t * TP + k * 2) = (unsigned short)(w0 & 0xffffu); *(LAS unsigned short*)(sl + O_TR + t * TP + k * 2) = (unsigned short)(w0 >> 16);
                    *(LAS unsigned short*)(hp + O_BT + t * TP + k * 2) = (unsigned short)(w1 & 0xffffu); *(LAS unsigned short*)(hp + O_KT + t * TP + k * 2) = (unsigned short)(w1 >> 16);
                }
#pragma unroll
                for (int q = 0; q < 4; ++q) { u32x4 o; o[0] = cvt_pk_bf16(bt[4 * q] * g, bt[4 * q + 1] * g); o[1] = cvt_pk_bf16(bt[4 * q + 2] * g, bt[4 * q + 3] * g);
                    o[2] = cvt_pk_bf16(kt[4 * q] * g, kt[4 * q + 1] * g); o[3] = cvt_pk_bf16(kt[4 * q + 2] * g, kt[4 * q + 3] * g);
                    *(LAS u32x4*)(sl + O_A4 + k * 64 + q * 16) = o; }
                *(LAS float*)(sl + O_GC + k * 4) = g;
                lds_fence();
                const int i16 = lane & 15, q4 = lane >> 4;
                f32x4 Lab = (f32x4){0.f, 0.f, 0.f, 0.f}, Lak = Lab, Urb = Lab, Urk = Lab;
#pragma unroll
                for (int s2 = 0; s2 < 2; ++s2) {
                    const bf16x8 a_ = *(const LAS bf16x8*)(sl + O_TA + i16 * TP + s2 * 64 + q4 * 16), r2 = *(const LAS bf16x8*)(sl + O_TR + i16 * TP + s2 * 64 + q4 * 16);
                    const bf16x8 b_ = *(const LAS bf16x8*)(hp + O_BT + i16 * TP + s2 * 64 + q4 * 16), k2 = *(const LAS bf16x8*)(hp + O_KT + i16 * TP + s2 * 64 + q4 * 16);
                    Lab = __builtin_amdgcn_mfma_f32_16x16x32_bf16(a_, b_, Lab, 0, 0, 0); Lak = __builtin_amdgcn_mfma_f32_16x16x32_bf16(a_, k2, Lak, 0, 0, 0);
                    Urb = __builtin_amdgcn_mfma_f32_16x16x32_bf16(r2, b_, Urb, 0, 0, 0); Urk = __builtin_amdgcn_mfma_f32_16x16x32_bf16(r2, k2, Urk, 0, 0, 0);
                }
#pragma unroll
                for (int j = 0; j < 4; ++j) { const int t = 4 * q4 + j;
                    const float lab = (i16 < t) ? Lab[j] : 0.f, lak = (i16 < t) ? Lak[j] : 0.f, urb = (i16 <= t) ? Urb[j] : 0.f, urk = (i16 <= t) ? Urk[j] : 0.f;
                    *(LAS float*)(lq + O_LAB + (t * 16 + i16) * 4) = lab; *(LAS float*)(lq + O_LAK + (t * 16 + i16) * 4) = lak;
                    const unsigned w = cvt_pk_bf16(urb, urk);
                    LAS unsigned char* ap = sl + O_A3 + (t * 4 + (i16 >> 2)) * 16 + (i16 & 3) * 2;
                    *(LAS unsigned short*)(ap) = (unsigned short)(w & 0xffffu); *(LAS unsigned short*)(ap + 8) = (unsigned short)(w >> 16); }
            };
            gload(h); process(h, 0, 4 + h);
            __syncthreads();
            for (int s = 0; s < NSUP; ++s) {
                if (s + 1 < NSUP) process(4 * (s + 1) + h, (s + 1) & 1, (s + 2 < NSUP) ? 4 * (s + 2) + h : -1);
                __syncthreads();
            }
        } else {
            const int vb = wave * 16, t16 = lane & 15, q4 = lane >> 4;
            f32x4 St[4];
#pragma unroll
            for (int m = 0; m < 4; ++m) St[m] = (f32x4){0.f, 0.f, 0.f, 0.f};
            volatile LAS int* flag = (volatile LAS int*)(lds + FLAG_OFF);
            if (lane == 0) flag[wave] = 0;
            __syncthreads();
            for (int s = 0; s < NSUP; ++s) {
                {
                    const LAS unsigned char* lq = lds + LQ0 + ((s & 1) * 4 + wave) * LQSZ; LAS unsigned char* sl = lds + (s & 1) * SET + wave * CSLOT;
                    const int cc = lane & 31;
                    float x[16]; f32x4 Lr[16][4];
#pragma unroll
                    for (int t = 0; t < 16; ++t) x[t] = *(const LAS float*)(lq + O_LAK + (t * 16 + (cc & 15)) * 4);
#pragma unroll
                    for (int t = 1; t < 16; ++t)
#pragma unroll
                        for (int i4 = 0; i4 * 4 < t; ++i4) Lr[t][i4] = *(const LAS f32x4*)(lq + O_LAB + (t * 16 + i4 * 4) * 4);
                    asm volatile("s_waitcnt lgkmcnt(0)" ::: "memory"); __builtin_amdgcn_sched_barrier(0);
#pragma unroll
                    for (int t = 0; t < 16; ++t) x[t] = (cc < 16) ? ((cc == t) ? 1.f : 0.f) : x[t];
#pragma unroll
                    for (int i = 0; i < 15; ++i)
#pragma unroll
                        for (int t = i + 1; t < 16; ++t) x[t] += Lr[t][i >> 2][i & 3] * x[i];
                    if (lane < 32) {
#pragma unroll
                        for (int t = 0; t < 16; ++t) *(LAS unsigned short*)(sl + O_A2 + (t * 4 + ((cc & 15) >> 2)) * 16 + (cc & 3) * 2 + ((cc >> 4) * 8)) = (unsigned short)(cvt_pk_bf16(x[t], x[t]) & 0xffffu);
                    }
                    lds_fence();
                    if (lane == 0) flag[wave] = s + 1;
                }
#pragma unroll 1
                for (int jc = 0; jc < 4; ++jc) {
                    const int c = 4 * s + jc;
                    LAS unsigned char* sl = lds + (s & 1) * SET + jc * CSLOT;
                    while (flag[jc] < s + 1) __builtin_amdgcn_s_sleep(1);
                    asm volatile("" ::: "memory");
                    const u32x2 vt = tr_issue((unsigned)(uintptr_t)(sl + O_VT) + (unsigned)((4 * q4 + ((lane >> 2) & 3)) * 128 + (vb + (lane & 3) * 4) * 2));
                    bf16x8 Sb[2];
#pragma unroll
                    for (int s2 = 0; s2 < 2; ++s2) { u32x4 w; w[0] = cvt_pk_bf16(St[2 * s2][0], St[2 * s2][1]); w[1] = cvt_pk_bf16(St[2 * s2][2], St[2 * s2][3]);
                        w[2] = cvt_pk_bf16(St[2 * s2 + 1][0], St[2 * s2 + 1][1]); w[3] = cvt_pk_bf16(St[2 * s2 + 1][2], St[2 * s2 + 1][3]); Sb[s2] = *reinterpret_cast<bf16x8*>(&w); }
                    f32x4 Xa = (f32x4){0.f, 0.f, 0.f, 0.f}, Xr = Xa;
#pragma unroll
                    for (int s2 = 0; s2 < 2; ++s2) {
                        const u32x2 a0 = *(const LAS u32x2*)(sl + O_TA + t16 * TP + s2 * 64 + q4 * 8), a1 = *(const LAS u32x2*)(sl + O_TA + t16 * TP + s2 * 64 + 32 + q4 * 8);
                        const u32x2 r0 = *(const LAS u32x2*)(sl + O_TR + t16 * TP + s2 * 64 + q4 * 8), r1 = *(const LAS u32x2*)(sl + O_TR + t16 * TP + s2 * 64 + 32 + q4 * 8);
                        u32x4 aw = {a0[0], a0[1], a1[0], a1[1]}, rw = {r0[0], r0[1], r1[0], r1[1]};
                        Xa = __builtin_amdgcn_mfma_f32_16x16x32_bf16(*reinterpret_cast<bf16x8*>(&aw), Sb[s2], Xa, 0, 0, 0);
                        Xr = __builtin_amdgcn_mfma_f32_16x16x32_bf16(*reinterpret_cast<bf16x8*>(&rw), Sb[s2], Xr, 0, 0, 0);
                    }
                    tr_wait();
                    u32x4 b2 = {cvt_pk_bf16(Xa[0], Xa[1]), cvt_pk_bf16(Xa[2], Xa[3]), vt[0], vt[1]};
                    const bf16x8 A2 = *(const LAS bf16x8*)(sl + O_A2 + (t16 * 4 + q4) * 16), A3 = *(const LAS bf16x8*)(sl + O_A3 + (t16 * 4 + q4) * 16);
                    const f32x4 P = __builtin_amdgcn_mfma_f32_16x16x32_bf16(A2, *reinterpret_cast<bf16x8*>(&b2), (f32x4){0.f, 0.f, 0.f, 0.f}, 0, 0, 0);
                    u32x4 bp = {cvt_pk_bf16(P[0], P[1]), cvt_pk_bf16(P[2], P[3]), vt[0], vt[1]};
                    const bf16x8 Bpv = *reinterpret_cast<bf16x8*>(&bp);
                    const f32x4 Y = __builtin_amdgcn_mfma_f32_16x16x32_bf16(A3, Bpv, Xr, 0, 0, 0);
#pragma unroll
                    for (int m = 0; m < 4; ++m) { const f32x4 gc = *(const LAS f32x4*)(sl + O_GC + (16 * m + 4 * q4) * 4); const bf16x8 A4 = *(const LAS bf16x8*)(sl + O_A4 + ((16 * m + t16) * 4 + q4) * 16);
                        St[m] = __builtin_amdgcn_mfma_f32_16x16x32_bf16(A4, Bpv, St[m] * gc, 0, 0, 0); }
                    if (c >= CTXL / 16) {
#pragma unroll
                        for (int j = 0; j < 4; ++j) { const int row = scan_row(dir, b, c * 16 + 4 * q4 + j); DEC[(size_t)row * D + hc + vb + t16] = (bf16_t)(cvt_pk_bf16(Y[j], Y[j]) & 0xffffu); }
                    }
                }
                __syncthreads();
            }
        }
        __syncthreads();
    }
}

__device__ __forceinline__ void ph_rwkv_out(const Frame& F, const bf16_t* Y0, const bf16_t* Y1, const bf16_t* Vb, const bf16_t* Gb, const float* CB, bf16_t* Z) {
    const int lane = F.lane_(), stride = F.G * 8;
    struct In { u32x4 a[4], b[4], v[4], g[4]; };
    auto loadrow = [&](int r, In& R) {
#pragma unroll
        for (int i = 0; i < 4; ++i) { const size_t ro = (size_t)r * D + i * 512 + lane * 8;
            R.a[i] = *(const u32x4*)(Y0 + ro); R.b[i] = *(const u32x4*)(Y1 + ro); R.v[i] = *(const u32x4*)(Vb + ro); R.g[i] = *(const u32x4*)(Gb + ro); }
    };
    In cur, nxt;
    int r = F.bid * 8 + F.wave;
    if (r < ML) loadrow(r, cur);
    for (; r < ML; r += stride) {
        if (r + stride < ML) loadrow(r + stride, nxt);
#pragma unroll
        for (int i = 0; i < 4; ++i) {
            const int col = i * 512 + lane * 8, head = i * 8 + (lane >> 3);
            float y[8]; float s = 0.f;
#pragma unroll
            for (int j = 0; j < 4; ++j) { y[2 * j] = bf_lo(cur.a[i][j]) + bf_lo(cur.b[i][j]); y[2 * j + 1] = bf_hi(cur.a[i][j]) + bf_hi(cur.b[i][j]); s += y[2 * j] + y[2 * j + 1]; }
            s += dpp_mov<0xB1>(s); s += dpp_mov<0x4E>(s); s += dpp_mov<0x141>(s);
            const float mu = s * (1.f / 64.f);
            float vs = 0.f;
#pragma unroll
            for (int j = 0; j < 8; ++j) { const float d = y[j] - mu; vs += d * d; }
            vs += dpp_mov<0xB1>(vs); vs += dpp_mov<0x4E>(vs); vs += dpp_mov<0x141>(vs);
            const float rstd = rsqrtf(vs * (1.f / 64.f) + 64e-5f);
            const float cb = CB[(size_t)r * 32 + head] + CB[((size_t)ML + r) * 32 + head];
            const f32x4 lw0 = *(const f32x4*)(F.A.in[I_LNW] + col), lw1 = *(const f32x4*)(F.A.in[I_LNW] + col + 4), lb0 = *(const f32x4*)(F.A.in[I_LNB] + col), lb1 = *(const f32x4*)(F.A.in[I_LNB] + col + 4);
            u32x4 o;
#pragma unroll
            for (int j = 0; j < 4; ++j) { const int c = 2 * j;
                const float w0 = c < 4 ? lw0[c] : lw1[c - 4], w1 = c + 1 < 4 ? lw0[c + 1] : lw1[c - 3], b0 = c < 4 ? lb0[c] : lb1[c - 4], b1 = c + 1 < 4 ? lb0[c + 1] : lb1[c - 3];
                const float z0 = ((y[c] - mu) * rstd * w0 + b0 + cb * bf_lo(cur.v[i][j])) * bf_lo(cur.g[i][j]);
                const float z1 = ((y[c + 1] - mu) * rstd * w1 + b1 + cb * bf_hi(cur.v[i][j])) * bf_hi(cur.g[i][j]);
                o[j] = cvt_pk_bf16(z0, z1); }
            *(u32x4*)(Z + (size_t)r * D + col) = o;
        }
        cur = nxt;
    }
}

__device__ __forceinline__ void moe_prefix(const Frame& F, int layer, LAS int*& pref, LAS int*& cntl) {
    pref = (LAS int*)(F.lds + MISC_OFF + 1024); cntl = pref + 40;
    __syncthreads();
    expert_prefix(F, layer, pref, cntl);
}
__device__ __forceinline__ void ph_moe_up(const Frame& F, int layer, const bf16_t* H, const bf16_t* W13, bf16_t* HID) {
    LAS int* pref; LAS int* cntl; moe_prefix(F, layer, pref, cntl);
    MoeSched S{pref, cntl, WSP(int, WS_TOKL), 4, F.G, F.bid, D, 2 * FF, true};
    pg8::EpiMoeUp E{HID};
    pg8::gemm_phase(F.lds, H, W13, D, S, E);
}
__device__ __forceinline__ void ph_moe_down(const Frame& F, int layer, const bf16_t* HID, const bf16_t* W2T, bf16_t* YS) {
    LAS int* pref; LAS int* cntl; moe_prefix(F, layer, pref, cntl);
    MoeSched S{pref, cntl, WSP(int, WS_TOKL), 8, F.G, F.bid, FF, D, false};
    pg8::EpiStoreBf16<0> E{YS, D, nullptr, 0, 0};
    pg8::gemm_phase(F.lds, HID, W2T, FF, S, E);
}
template <int ACT>
__device__ __forceinline__ void ph_gemm_bf16(const Frame& F, const bf16_t* A, const bf16_t* Bt, int M, int N, int K, bf16_t* O, int ldc, const float* vec, int split_cols, size_t split_stride) {
    pg8::DenseSched S; S.init(M, N, K, F.G, F.bid);
    pg8::EpiStoreBf16<ACT> E{O, ldc, vec, split_cols, split_stride};
    pg8::gemm_phase(F.lds, A, Bt, K, S, E);
}
__device__ __forceinline__ void ph_gemm_multi(const Frame& F, const pg8::MultiSched& S, const bf16_t* Abase, const bf16_t* Bt, int K, const pg8::EpiMultiBf16& E) {
    pg8::gemm_phase(F.lds, Abase, Bt, K, S, E);
}
__device__ __forceinline__ void ph_gemm_res(const Frame& F, const bf16_t* A, const bf16_t* Bt, int M, const float* xin_l, float* out_l, const float* xin_c, float* out_c, const float* gate) {
    pg8::DenseSched S; S.init(M, D, D, F.G, F.bid);
    pg8::EpiRes E{xin_l, out_l, xin_c, out_c, gate};
    pg8::gemm_phase(F.lds, A, Bt, D, S, E);
}

constexpr int LDS_BYTES = 163840;
constexpr int N_PHASES = 20;
__global__ void __launch_bounds__(NTHR, 2) fwd(Args args) {
    extern __shared__ __attribute__((aligned(16))) unsigned char lds_raw[];
    Frame F(args);
    F.out = args.out; F.ws = args.ws; F.lds = (LAS unsigned char*)lds_raw;
    F.wave = __builtin_amdgcn_readfirstlane((int)threadIdx.x >> 6); F.G = gridDim.x; F.bid = blockIdx.x;
    volatile LAS unsigned* misc = (volatile LAS unsigned*)(F.lds + MISC_OFF);
    if (F.tid_() < 4) misc[F.tid_()] = 0u;
    __syncthreads();
    XcdBarrier bar; bar.bar = (unsigned*)(F.ws + WS_CTL); bar.x = 0; bar.st = misc;
    const int lo = args.ph_lo, hi = args.ph_hi;
    if (hi - lo > 1) bar = xcd_barrier_post((unsigned*)(F.ws + WS_CTL), misc);
#ifndef PH_ONLY
#define PH_ONLY -1
#endif
#define IN(k) ((PH_ONLY < 0 || PH_ONLY == (k)) && lo <= (k) && (k) < hi)
#define SEAM(k) do { if (IN(k) && IN((k) + 1)) xcd_barrier(bar); } while (0)
#define S0 WSP(bf16_t, SLOTP(0))
#define S1 WSP(bf16_t, SLOTP(1))
#define S2 WSP(bf16_t, SLOTP(2))
#define S3 WSP(bf16_t, SLOTP(3))
#define S4 WSP(bf16_t, SLOTP(4))
#define S5 WSP(bf16_t, SLOTP(5))
#define S6 WSP(bf16_t, SLOTP(6))
#define S7 WSP(bf16_t, SLOTP(7))
#define S8 WSP(bf16_t, SLOTP(8))
#define XC WSP(float, WS_XC)
#define CB WSP(float, WS_CB)
    const size_t W2OFF = (size_t)NEXP * 2 * FF * D;

#define TSTART(k) do { if (TIME_PH == (k) && blockIdx.x == 0 && threadIdx.x == 0) *WSP(unsigned long long, WS_CTL + 20480) = wall_clock64(); } while (0)
#define TSTOP(k) do { if (TIME_PH == (k) && blockIdx.x == 0 && threadIdx.x == 0) *WSP(float, WS_CTL + 20496) = (float)(wall_clock64() - *WSP(unsigned long long, WS_CTL + 20480)) * 0.01f; } while (0)
    TSTART(0);
    if (IN(0)) ph_prologue(F);
    SEAM(0);
    TSTOP(0);
    TSTART(1);
    if (IN(1)) { { RowOpts O{F.A.in[I_X], F.A.in[I_CTX], MT, false, 0, nullptr, nullptr, nullptr, true, 0, 0, S0, false}; ph_rows(F, O); } ph_router_fold(F); }
    SEAM(1);
    TSTOP(1);
    TSTART(2);
    if (IN(2)) { ph_gemm_bf16<0>(F, S0, WSP(bf16_t, WT_IN), MT, QKVC, D, S1, QKVC, nullptr, 0, 0);
                 const int rem = ((MT / 256) * (QKVC / 256)) % F.G; int base = 0;
                 cvt_moe2(F, 0, S6 + W2OFF, base, F.G - rem, F.bid - rem); }
    SEAM(2);
    TSTOP(2);
    TSTART(3);
    if (IN(3)) ph_qknorm(F, S1);
    SEAM(3);
    TSTOP(3);
    TSTART(4);
    if (IN(4)) ph_attn(F, S1, S4);
    SEAM(4);
    TSTOP(4);
    TSTART(5);
    if (IN(5)) { ph_gemm_res(F, S4, WSP(bf16_t, WT_OUT), MT, F.A.in[I_X], F.out, F.A.in[I_CTX], XC, mod_row(F, 0, 0) + 2 * D);
                 const int rem = ((MT / 256) * (D / 256)) % F.G; int base = 0;
                 cvt_moe13(F, 0, S6, base, F.G - rem, F.bid - rem); }
    SEAM(5);
    TSTOP(5);
    TSTART(6);
    if (IN(6)) ph_rows_router(F, F.out, XC, MT, 0, S0);
    SEAM(6);
    TSTOP(6);
    TSTART(7);
    if (IN(7)) ph_moe_up(F, 0, S0, S6, S5);
    SEAM(7);
    TSTOP(7);
    TSTART(8);
    if (IN(8)) ph_moe_down(F, 0, S5, S6 + W2OFF, S1);
    SEAM(8);
    TSTOP(8);
    TSTART(9);
    if (IN(9)) ph_rows_halo(F, S1);
    SEAM(9);
    TSTOP(9);
    TSTART(10);
    if (IN(10)) ph_rows_mix6(F, S1, S4, S5, S7, S0, S6, S8);
    SEAM(10);
    TSTOP(10);
    TSTART(11);
    if (IN(11)) { { pg8::MultiSched S; S.init(MT, 256, D, 3, F.G, F.bid); S.a0 = (unsigned)SLOTP(4); S.a1 = (unsigned)SLOTP(5); S.a2 = (unsigned)SLOTP(7); S.a3 = 0; S.b0 = 0; S.b1 = 256; S.b2 = 512; S.b3 = 0;
                    pg8::EpiMultiBf16 E{WSP(bf16_t, WS_TW), (size_t)(WS_TA - WS_TW) / 2, 0x210u, 256, 0x201u, F.A.in[I_W0], 0l, 0};
                    ph_gemm_multi(F, S, (const bf16_t*)F.ws, WSP(bf16_t, WT_W1), D, E); }
                  { pg8::MultiSched S; S.init(MT, D, D, 3, F.G, (F.bid + F.G / 2) % F.G);
                    S.a0 = (unsigned)SLOTP(0); S.a1 = (unsigned)SLOTP(6); S.a2 = (unsigned)SLOTP(8); S.a3 = 0; S.b0 = 0; S.b1 = D; S.b2 = 2 * D; S.b3 = 0;
                    pg8::EpiMultiBf16 E{S1, (size_t)SLOT / 2, 0x210u, D, 0u, F.A.in[I_W0], 0l, 0};
                    ph_gemm_multi(F, S, (const bf16_t*)F.ws, WSP(bf16_t, WT_R), D, E); } }
    SEAM(11);
    TSTOP(11);
    TSTART(12);
    if (IN(12)) { pg8::MultiSched S; S.init(MT, D, 256, 4, F.G, F.bid); S.a0 = (unsigned)WS_TW; S.a1 = (unsigned)WS_TW + 256u; S.a2 = (unsigned)WS_TA; S.a3 = (unsigned)WS_TA + 256u;
                  S.b0 = 0; S.b1 = D; S.b2 = (int)((WT_A2 - WT_W2) / 256); S.b3 = (int)((WT_A2 - WT_W2) / 256) + D;
                  pg8::EpiMultiBf16 E{S0, (size_t)SLOT / 2, 0x6540u, D, 0x4433u, F.A.in[I_W0], (long)(F.A.in[I_A0] - F.A.in[I_W0]), D};
                  ph_gemm_multi(F, S, (const bf16_t*)F.ws, WSP(bf16_t, WT_W2), 128, E);
                  ph_kkn(F, S2, WSP(float, WS_RN)); }
    SEAM(12);
    TSTOP(12);
    TSTART(13);
    if (IN(13)) { ph_scan_chunked(F, S1, S2, S3, WSP(float, WS_RN), S0, S4, S5, S6);
                  const int gw = F.G > 128 ? F.G - 128 : F.G, gc = F.G > 128 ? F.bid - 128 : F.bid;
                  if (gc >= 0) {
                      pg8::DenseSched S; S.init(ML, D, 256, gw, gc); pg8::EpiStoreBf16<0> E{S8, D, nullptr, 0, 0};
                      pg8::gemm_phase(F.lds, WSP(bf16_t, WS_TG), WSP(bf16_t, WT_G2), 256, S, E);
                      scan_cb(F, S1, S2, S5, S6, CB, gw, gc);
                      __syncthreads(); int base = 0; cvt_moe13(F, 1, S7, base, gw, gc); } }
    SEAM(13);
    TSTOP(13);
    TSTART(14);
    if (IN(14)) ph_rwkv_out(F, S0, S4, S3, S8, CB, S2);
    SEAM(14);
    TSTOP(14);
    TSTART(15);
    if (IN(15)) ph_gemm_res(F, S2, WSP(bf16_t, WT_O), ML, F.out, F.out, XC, XC, mod_row(F, 1, 0) + 2 * D);
    SEAM(15);
    TSTOP(15);
    TSTART(16);
    if (IN(16)) { ph_rows_router(F, F.out, XC, ML, 1, S0);
                  __syncthreads(); int base = 0; cvt_moe2(F, 1, S5, base); }
    SEAM(16);
    TSTOP(16);
    TSTART(17);
    if (IN(17)) ph_moe_up(F, 1, S0, S7, S4);
    SEAM(17);
    TSTOP(17);
    TSTART(18);
    if (IN(18)) ph_moe_down(F, 1, S4, S5, S1);
    SEAM(18);
    TSTOP(18);
    TSTART(19);
    if (IN(19)) { RowOpts O{F.out, XC, ML, true, 1, S1, F.out, XC, false, 1, 0, nullptr, false}; ph_rows(F, O); }
#undef IN
#undef SEAM
}

extern "C" void kernel_launch(void* const* d_in, const int* in_sizes, int n_in, void* d_out, int out_size, void* d_ws, size_t ws_size, hipStream_t stream) {
    static int grid = 0;
    if (grid == 0) {
        if (n_in != 39 || out_size != ML * D || ws_size < WS_END) { fprintf(stderr, "kernel_launch: unexpected shapes (n_in %d out %d ws %zu need %zu)\n", n_in, out_size, ws_size, (size_t)WS_END); grid = -1; return; }
        int dev = 0, cus = 0;
        if (hipGetDevice(&dev) != hipSuccess || hipDeviceGetAttribute(&cus, hipDeviceAttributeMultiprocessorCount, dev) != hipSuccess) { grid = -1; return; }
        if (hipFuncSetAttribute((const void*)fwd, hipFuncAttributeMaxDynamicSharedMemorySize, LDS_BYTES) != hipSuccess) { fprintf(stderr, "kernel_launch: hipFuncSetAttribute failed\n"); grid = -1; return; }
        int per_cu = 0;
        if (hipOccupancyMaxActiveBlocksPerMultiprocessor(&per_cu, (const void*)fwd, NTHR, LDS_BYTES) != hipSuccess || per_cu < 1) { fprintf(stderr, "kernel_launch: occupancy query says %d\n", per_cu); }
        (void)hipGetLastError();
        grid = cus;
    }
    if (grid < 0) return;
    (void)hipMemsetAsync((char*)d_ws + WS_CTL, 0, CTL_BYTES, stream);
    Args a{};
    for (int i = 0; i < 39; ++i) a.in[i] = (const float*)d_in[i];
    a.out = (float*)d_out; a.ws = (unsigned char*)d_ws;
#if ONE_LAUNCH
    a.ph_lo = 0; a.ph_hi = N_PHASES;
    hipLaunchKernelGGL(fwd, dim3(grid), dim3(NTHR), LDS_BYTES, stream, a);
#else
    for (int p = 0; p < N_PHASES; ++p) { a.ph_lo = p; a.ph_hi = p + 1; const int reps = 1 + (int)((PROBE_MASK >> p) & 1ull); for (int r = 0; r < reps; ++r) hipLaunchKernelGGL(fwd, dim3(grid), dim3(NTHR), LDS_BYTES, stream, a); }
#endif
}
```

```cpp
#include <hip/hip_runtime.h>
#include <stdint.h>
#include <stdio.h>

#ifndef ONE_LAUNCH
#define ONE_LAUNCH 1
#endif
#ifndef PROBE_MASK
#define PROBE_MASK 0ull
#endif
#ifndef TIME_PH
#define TIME_PH -1
#endif

#define LAS __attribute__((address_space(3)))
typedef unsigned short bf16_t;
typedef short bf16x8 __attribute__((ext_vector_type(8)));
typedef float f32x4 __attribute__((ext_vector_type(4)));
typedef float f32x2 __attribute__((ext_vector_type(2)));
typedef unsigned u32x4 __attribute__((ext_vector_type(4)));
typedef unsigned u32x2 __attribute__((ext_vector_type(2)));

constexpr int D = 2048, NB = 2, SEQ = 16384, ML = NB * SEQ, CTXL = 256, MC = NB * CTXL, MT = ML + MC;
constexpr int QKVC = 4608, QA0 = 0, KA0 = 1024, VA0 = 1280, QB0 = 1536, KB0 = 2560, VB0 = 3584;
constexpr int NEXP = 32, FF = 512, MAXSLOT = 2 * MT + NEXP * 256;
constexpr int MODW = 6 * D;
constexpr int NTHR = 512;
constexpr int MISC_OFF = 163840 - 2048;

constexpr size_t MiB = 1ull << 20;
constexpr size_t WS_CTL = 0;
constexpr size_t CTL_BYTES = 64 * 1024;
constexpr size_t CTL_CNT = 32768;
constexpr int CNT_STRIDE = 64;
constexpr size_t CTL_AQ = 24576;
constexpr size_t WS_MOD = 1 * MiB;
constexpr size_t WS_XC = 2 * MiB;
constexpr size_t WS_TOKL = 6 * MiB;
constexpr size_t WS_TOKSEL = 11 * MiB;
constexpr size_t WS_TOKGATE = 11 * MiB + 512 * 1024;
constexpr size_t WS_CB = 12 * MiB;
constexpr size_t WS_WT = 20 * MiB;
constexpr size_t WT_IN = WS_WT, WT_OUT = WS_WT + 18 * MiB, WT_R = WS_WT + 26 * MiB, WT_K = WS_WT + 34 * MiB, WT_V = WS_WT + 42 * MiB, WT_O = WS_WT + 50 * MiB;
constexpr size_t WT_W1 = WS_WT + 58 * MiB, WT_A1 = WS_WT + 59 * MiB, WT_G1 = WS_WT + 60 * MiB, WT_W2 = WS_WT + 61 * MiB, WT_A2 = WS_WT + 63 * MiB, WT_G2 = WS_WT + 65 * MiB;
constexpr size_t WS_TW = 86 * MiB, WS_TA = 103 * MiB, WS_TG = 120 * MiB;
constexpr size_t WS_WF = 137 * MiB;
constexpr size_t WS_CV = WS_WF + (size_t)2 * 3 * 2048 * 48 * 4;
constexpr size_t WS_SLOT0 = 140 * MiB, SLOT = 130 * MiB;
constexpr size_t WS_HALO = WS_SLOT0 + 9 * SLOT;
constexpr size_t WS_RN = WS_HALO + 4 * MiB;
constexpr size_t WS_END = WS_RN + 8 * MiB;
#define SLOTP(k) (WS_SLOT0 + (size_t)(k) * SLOT)

typedef __bf16 bf16x2_t __attribute__((ext_vector_type(2)));
__device__ __forceinline__ unsigned cvt_pk_bf16(float lo, float hi) { f32x2 v = {lo, hi}; bf16x2_t r = __builtin_convertvector(v, bf16x2_t); return *reinterpret_cast<unsigned*>(&r); }
__device__ __forceinline__ float bf_lo(unsigned u) { return __uint_as_float(u << 16); }
__device__ __forceinline__ float bf_hi(unsigned u) { return __uint_as_float(u & 0xffff0000u); }
__device__ __forceinline__ float bf2f(bf16_t v) { return __uint_as_float(((unsigned)v) << 16); }
template <int CTRL> __device__ __forceinline__ float dpp_mov(float v) { return __int_as_float(__builtin_amdgcn_update_dpp(0, __float_as_int(v), CTRL, 0xf, 0xf, true)); }
__device__ __forceinline__ float row_sum16(float v) { v += dpp_mov<0xB1>(v); v += dpp_mov<0x4E>(v); v += dpp_mov<0x141>(v); v += dpp_mov<0x140>(v); return v; }
__device__ __forceinline__ float wave_sum(float v) { v = row_sum16(v);
    const float a = __int_as_float(__builtin_amdgcn_readlane(__float_as_int(v), 0)), b = __int_as_float(__builtin_amdgcn_readlane(__float_as_int(v), 16));
    const float c = __int_as_float(__builtin_amdgcn_readlane(__float_as_int(v), 32)), d = __int_as_float(__builtin_amdgcn_readlane(__float_as_int(v), 48));
    return (a + b) + (c + d); }
__device__ __forceinline__ float wave_max(float v) { for (int o = 32; o; o >>= 1) v = fmaxf(v, __shfl_xor(v, o)); return v; }
__device__ __forceinline__ float sigmoidf_(float x) { return __builtin_amdgcn_rcpf(1.f + __builtin_amdgcn_exp2f(x * -1.4426950408889634f)); }
__device__ __forceinline__ void lds_fence() { asm volatile("s_waitcnt lgkmcnt(0)" ::: "memory"); }

struct Args { const float* in[39]; float* out; unsigned char* ws; int ph_lo, ph_hi; };
struct Frame {
    const Args& A; float* out; unsigned char* ws; LAS unsigned char* lds;
    int wave, G, bid;
    __device__ __forceinline__ Frame(const Args& a) : A(a) {}
    __device__ __forceinline__ int lane_() const { return (int)threadIdx.x & 63; }
    __device__ __forceinline__ int tid_() const { return (int)threadIdx.x; }
};
enum { I_X = 0, I_C, I_CTX, I_CCTX, I_ADAW, I_ADAB, I_NMIX, I_NFFN, I_WIN, I_WOUT, I_AQG, I_AKG, I_ASINK, I_BQG, I_BKG, I_RPB, I_MU, I_WR, I_WK, I_WV, I_WO, I_W0, I_W1, I_W2,
       I_A0, I_A1, I_A2, I_G1, I_G2, I_KK, I_KA, I_RK, I_LNW, I_LNB, I_MGRP, I_MEXP, I_MW1, I_MW3, I_MW2 };

#define XB_TMO      128
#define XB_XCNT(j)  (256  + 64 * (j))
#define XB_XSUB(j)  (1280 + 64 * (j))
#define XB_XGEN(j)  (2304 + 64 * (j))
#define XB_TOP      3328
#define XB_TOPGEN   3392
#define XCD_BAR_WORDS 3456
#define XB_SPIN_CAP (1u << 18)
__device__ __forceinline__ unsigned xb_ld(unsigned* p)              { return __hip_atomic_load(p, __ATOMIC_RELAXED, __HIP_MEMORY_SCOPE_AGENT); }
__device__ __forceinline__ unsigned xb_add(unsigned* p, unsigned v) { return __hip_atomic_fetch_add(p, v, __ATOMIC_RELAXED, __HIP_MEMORY_SCOPE_AGENT); }
__device__ __forceinline__ unsigned xb_xcc_id() { return (unsigned)__builtin_amdgcn_s_getreg((3 << 11) | 20) & 0xFu; }
#define XB_SPIN(cond, bar) do { unsigned _sp = 0; while (cond) { __builtin_amdgcn_s_sleep(1); \
    if ((++_sp & 255u) == 0u) { if (xb_ld(&(bar)[XB_TMO])) break; if (_sp > XB_SPIN_CAP) { atomicAdd(&(bar)[XB_TMO], 1u); break; } } } } while (0)
struct XcdBarrier { unsigned* bar; unsigned x; volatile LAS unsigned* st; };
__device__ __forceinline__ XcdBarrier xcd_barrier_post(unsigned* bar, volatile LAS unsigned* st) {
    XcdBarrier b; b.bar = bar; b.x = xb_xcc_id(); b.st = st;
    if (threadIdx.x == 0) (void)xb_add(&bar[XB_XCNT(b.x)], 1u);
    return b;
}
__device__ __forceinline__ void xcd_barrier_complete(unsigned* bar, unsigned x, unsigned& nloc, unsigned& nx) {
    const unsigned G = gridDim.x * gridDim.y * gridDim.z;
    unsigned sum, cnt, mine, sp = 0u;
    for (;;) {
        sum = 0u; cnt = 0u; mine = 0u;
#pragma unroll
        for (unsigned j = 0; j < 16; ++j) { const unsigned c = xb_ld(&bar[XB_XCNT(j)]); sum += c; cnt += (c > 0u) ? 1u : 0u; mine = (j == x) ? c : mine; }
        if (sum == G) break;
        __builtin_amdgcn_s_sleep(1);
        if ((++sp & 255u) == 0u) { if (xb_ld(&bar[XB_TMO])) break; if (sp > XB_SPIN_CAP) { atomicAdd(&bar[XB_TMO], 1u); break; } }
    }
    nloc = mine > 0u ? mine : 1u; nx = cnt > 0u ? cnt : 1u;
}
__device__ __forceinline__ void xcd_barrier(const XcdBarrier& b) {
    asm volatile("s_waitcnt vmcnt(0)" ::: "memory");
    __syncthreads();
    if (threadIdx.x == 0) {
        unsigned* bar = b.bar;
        __builtin_amdgcn_s_waitcnt(0);
        unsigned nloc = b.st[0], nx = b.st[1];
        if (nloc == 0u) { xcd_barrier_complete(bar, b.x, nloc, nx); b.st[0] = nloc; b.st[1] = nx; }
        const unsigned old = xb_add(&bar[XB_XSUB(b.x)], 1u);
        const unsigned gen = old / nloc;
        if (old + 1u == (gen + 1u) * nloc) {
            __builtin_amdgcn_fence(__ATOMIC_RELEASE, "agent");
            asm volatile("s_waitcnt vmcnt(0)" ::: "memory");
            const unsigned og = xb_add(&bar[XB_TOP], 1u);
            const unsigned tg = og / nx;
            if (og + 1u == (tg + 1u) * nx) xb_add(&bar[XB_TOPGEN], 1u);
            else XB_SPIN(xb_ld(&bar[XB_TOPGEN]) == tg, bar);
            __builtin_amdgcn_fence(__ATOMIC_ACQUIRE, "agent");
            xb_add(&bar[XB_XGEN(b.x)], 1u);
            asm volatile("s_waitcnt vmcnt(0)" ::: "memory");
        } else {
            XB_SPIN(xb_ld(&bar[XB_XGEN(b.x)]) == gen, bar);
            __builtin_amdgcn_fence(__ATOMIC_ACQUIRE, "agent");
            asm volatile("s_waitcnt vmcnt(0)" ::: "memory");
        }
    }
    __syncthreads();
}

namespace pg8 {
constexpr int BM = 256, BK = 64, HALF = 128, HTB = HALF * BK * 2, STAGE_BYTES = 8 * HTB, NXCD = 8, WGM = 8;
__host__ __device__ __forceinline__ int lds_byte(int r, int c) { const int st = (r >> 4) * 2 + (c >> 5), rr = r & 15, cc = c & 31, ob = rr * 64 + cc * 2; return st * 1024 + (ob ^ (((ob >> 9) & 1) << 5)); }
__host__ __device__ __forceinline__ void stage_rc(int b, int& R, int& C) { const int st = b / 1024, sb = b % 1024, swz = sb ^ (((sb >> 9) & 1) << 5); R = (st >> 1) * 16 + swz / 64; C = (st & 1) * 32 + (swz % 64) / 2; }
__host__ __device__ __forceinline__ int perm32(int rho) { const int n = rho >> 4, i = rho & 15; return 8 * (i >> 2) + 4 * n + (i & 3); }

struct Unit { int arow0, brow0, col0, e, pbase, cnt; };

struct DenseSched {
    int nM, nN, nwg, G, c, K;
    __device__ void init(int M, int N, int K_, int G_, int c_) { nM = M / BM; nN = N / BM; nwg = nM * nN; G = G_; c = c_; K = K_; }
    __device__ bool next(int i, Unit& u) const {
        const long L = (long)i * G + c; if (L >= nwg) return false;
        int wgid = (int)L; { const int q = nwg / NXCD, r = nwg % NXCD, xcd = wgid % NXCD, off = wgid / NXCD; wgid = (xcd < r ? xcd * (q + 1) : r * (q + 1) + (xcd - r) * q) + off; }
        const int nig = WGM * nN, gid = wgid / nig, fm = gid * WGM, gsz = (nM - fm) < WGM ? (nM - fm) : WGM;
        const int pm = fm + ((wgid % nig) % gsz), pn = (wgid % nig) / gsz;
        u.arow0 = pm * BM; u.brow0 = pn * BM; u.col0 = pn * BM; u.e = 0; u.pbase = 0; u.cnt = 0; return true;
    }
    __device__ __forceinline__ unsigned a_off(const Unit& u, int r, int C) const { return (unsigned)((u.arow0 + r) * K + C) * 2u; }
};

struct MultiSched {
    int nM, nN, nwg, ng, G, c, lda; unsigned a0, a1, a2, a3; int b0, b1, b2, b3;
    __device__ __forceinline__ void init(int M, int N, int lda_, int ng_, int G_, int c_) { nM = M / BM; nN = N / BM; nwg = nM * nN; ng = ng_; G = G_; c = c_; lda = lda_; }
    __device__ __forceinline__ bool next(int i, Unit& u) const {
        const long L = (long)i * G + c; if (L >= (long)nwg * ng) return false;
        const int w = (int)(L / nwg); int wgid = (int)(L % nwg);
        { const int q = nwg / NXCD, r = nwg % NXCD, xcd = wgid % NXCD, off = wgid / NXCD; wgid = (xcd < r ? xcd * (q + 1) : r * (q + 1) + (xcd - r) * q) + off; }
        const int nig = WGM * nN, gid = wgid / nig, fm = gid * WGM, gsz = (nM - fm) < WGM ? (nM - fm) : WGM;
        const int pm = fm + ((wgid % nig) % gsz), pn = (wgid % nig) / gsz;
        u.arow0 = pm * BM; u.brow0 = (w == 0 ? b0 : w == 1 ? b1 : w == 2 ? b2 : b3) + pn * BM; u.col0 = pn * BM; u.e = w; u.pbase = 0; u.cnt = 0; return true;
    }
    __device__ __forceinline__ unsigned a_off(const Unit& u, int r, int C) const { return (u.e == 0 ? a0 : u.e == 1 ? a1 : u.e == 2 ? a2 : a3) + (unsigned)((u.arow0 + r) * lda + C) * 2u; }
};

template <class Epi, class Sched>
__device__ __forceinline__ void gemm_phase(LAS unsigned char* lds, const bf16_t* A, const bf16_t* Bt, const int K, const Sched& S, const Epi& E) {
    const int tid = threadIdx.x, wid = __builtin_amdgcn_readfirstlane(tid >> 6), lane = tid & 63, wr = wid >> 2, wc = wid & 3, fr = lane & 15, fq = lane >> 4;
    const int nt = K / BK;
    int Rr[2], Cc[2]; unsigned voffB[2];
#pragma unroll
    for (int i = 0; i < 2; ++i) { int R, C; stage_rc(tid * 16 + i * 8192, R, C); const int Rb = Epi::PERM ? ((R & ~31) + perm32(R & 31)) : R;
        Rr[i] = R; Cc[i] = C; voffB[i] = (unsigned)(Rb * K + C) * 2u; }
    const size_t kstep = (size_t)(BK * 2);
    const size_t hstepB = (size_t)HALF * K * 2;
    const unsigned ldsw = (unsigned)wid * 1024u;
    const int aoff = lds_byte(wr * 64 + fr, fq * 8), boff = lds_byte(wc * 32 + fr, fq * 8);
#define PG8_SA(b, h) (((b) * 2 + (h)) * HTB)
#define PG8_SB(b, h) ((4 + (b) * 2 + (h)) * HTB)
#define PG8_STAGE(bufoff, gbase, voff) do { _Pragma("unroll") for (int _i = 0; _i < 2; ++_i) \
        __builtin_amdgcn_global_load_lds((const unsigned*)((const char*)(gbase) + (voff)[_i]), (LAS unsigned*)(lds + (bufoff) + ldsw + _i * 8192), 16, 0, 0); } while (0)
#define PG8_LDA(dst, b, h) do { _Pragma("unroll") for (int m = 0; m < 4; ++m) _Pragma("unroll") for (int k = 0; k < 2; ++k) dst[m][k] = *(const LAS bf16x8*)(lds + PG8_SA(b, h) + aoff + m * 2048 + k * 1024); } while (0)
#define PG8_LDB(dst, b, h) do { _Pragma("unroll") for (int n = 0; n < 2; ++n) _Pragma("unroll") for (int k = 0; k < 2; ++k) dst[n][k] = *(const LAS bf16x8*)(lds + PG8_SB(b, h) + boff + n * 2048 + k * 1024); } while (0)
#define PG8_MMA(ai, bj, At, Bt_) do { __builtin_amdgcn_s_setprio(1); _Pragma("unroll") for (int m = 0; m < 4; ++m) _Pragma("unroll") for (int n = 0; n < 2; ++n) _Pragma("unroll") for (int k = 0; k < 2; ++k) \
        acc[ai][bj][m][n] = __builtin_amdgcn_mfma_f32_16x16x32_bf16(Bt_[n][k], At[m][k], acc[ai][bj][m][n], 0, 0, 0); __builtin_amdgcn_s_setprio(0); } while (0)
#define PG8_WAIT_V(n) asm volatile("s_waitcnt vmcnt(" #n ")" ::: "memory")
#define PG8_WAIT_L(n) asm volatile("s_waitcnt lgkmcnt(" #n ")" ::: "memory")
#define PG8_BAR __builtin_amdgcn_s_barrier()
#define PG8_SCHED __builtin_amdgcn_sched_barrier(0)
    Unit cur, nxt; int ui = 0;
    if (!S.next(0, cur)) return;
    f32x4 acc[2][2][4][2];
#pragma unroll
    for (int a = 0; a < 2; ++a)
#pragma unroll
        for (int b = 0; b < 2; ++b)
#pragma unroll
            for (int m = 0; m < 4; ++m)
#pragma unroll
                for (int n = 0; n < 2; ++n) acc[a][b][m][n] = (f32x4){0.f, 0.f, 0.f, 0.f};
    bf16x8 At[4][2], B0[2][2], B1[2][2];
    unsigned oC0[2], oC1[2], oN0[2], oN1[2];
#pragma unroll
    for (int i = 0; i < 2; ++i) { oC0[i] = S.a_off(cur, Rr[i], Cc[i]); oC1[i] = S.a_off(cur, HALF + Rr[i], Cc[i]); }
    const char* gA = (const char*)A;
    const char* cB = (const char*)Bt + (size_t)cur.brow0 * K * 2;
    PG8_STAGE(PG8_SB(0, 0), cB, voffB); PG8_STAGE(PG8_SA(0, 0), gA, oC0); PG8_STAGE(PG8_SB(0, 1), cB + hstepB, voffB); PG8_STAGE(PG8_SA(0, 1), gA, oC1);
    if (wr == 1) PG8_BAR;
    PG8_WAIT_V(4); PG8_BAR;
    PG8_STAGE(PG8_SB(1, 0), cB + kstep, voffB); PG8_STAGE(PG8_SA(1, 0), gA + kstep, oC0); PG8_STAGE(PG8_SB(1, 1), cB + hstepB + kstep, voffB);
    PG8_WAIT_V(6); PG8_BAR;
    for (;;) {
        const bool has_next = S.next(ui + 1, nxt);
        if (has_next) {
#pragma unroll
            for (int i = 0; i < 2; ++i) { oN0[i] = S.a_off(nxt, Rr[i], Cc[i]); oN1[i] = S.a_off(nxt, HALF + Rr[i], Cc[i]); }
        } else {
#pragma unroll
            for (int i = 0; i < 2; ++i) { oN0[i] = oC0[i]; oN1[i] = oC1[i]; }
        }
        const char* nB = has_next ? (const char*)Bt + (size_t)nxt.brow0 * K * 2 : cB;
        for (int t = 0; t < nt; t += 2) {
            const bool last = (t == nt - 2);
            const char* a1 = gA + (size_t)(t + 1) * kstep;
            const char* a2 = last ? gA : gA + (size_t)(t + 2) * kstep; const char* b2 = last ? nB : cB + (size_t)(t + 2) * kstep;
            const char* a3 = a2 + kstep; const char* b3 = b2 + kstep;
            unsigned o20[2], o21[2];
#pragma unroll
            for (int i = 0; i < 2; ++i) { o20[i] = last ? oN0[i] : oC0[i]; o21[i] = last ? oN1[i] : oC1[i]; }
            PG8_LDB(B0, 0, 0); PG8_SCHED; PG8_LDA(At, 0, 0); PG8_STAGE(PG8_SA(1, 1), a1, oC1);
            PG8_WAIT_L(8); PG8_BAR; PG8_WAIT_L(0); PG8_MMA(0, 0, At, B0); PG8_BAR; PG8_SCHED;
            PG8_LDB(B1, 0, 1); PG8_STAGE(PG8_SB(0, 0), b2, voffB);
            PG8_BAR; PG8_WAIT_L(0); PG8_MMA(0, 1, At, B1); PG8_BAR;
            PG8_LDA(At, 0, 1); PG8_STAGE(PG8_SA(0, 0), a2, o20);
            PG8_BAR; PG8_WAIT_L(0); PG8_MMA(1, 0, At, B0); PG8_BAR; PG8_SCHED;
            PG8_STAGE(PG8_SB(0, 1), b2 + hstepB, voffB);
            PG8_WAIT_V(6); PG8_BAR; PG8_MMA(1, 1, At, B1); PG8_BAR;
            PG8_LDB(B0, 1, 0); PG8_SCHED; PG8_LDA(At, 1, 0); PG8_STAGE(PG8_SA(0, 1), a2, o21);
            PG8_WAIT_L(8); PG8_BAR; PG8_WAIT_L(0); PG8_MMA(0, 0, At, B0); PG8_BAR; PG8_SCHED;
            PG8_LDB(B1, 1, 1); PG8_STAGE(PG8_SB(1, 0), b3, voffB);
            PG8_BAR; PG8_WAIT_L(0); PG8_MMA(0, 1, At, B1); PG8_BAR;
            PG8_LDA(At, 1, 1); PG8_STAGE(PG8_SA(1, 0), a3, o20);
            PG8_BAR; PG8_WAIT_L(0); PG8_MMA(1, 0, At, B0); PG8_BAR; PG8_SCHED;
            PG8_STAGE(PG8_SB(1, 1), b3 + hstepB, voffB);
            PG8_WAIT_V(6); PG8_BAR; PG8_MMA(1, 1, At, B1); PG8_BAR;
        }
        E(acc, cur, wr, wc, fr, fq);
        if (!has_next) break;
#pragma unroll
        for (int a = 0; a < 2; ++a)
#pragma unroll
            for (int b = 0; b < 2; ++b)
#pragma unroll
                for (int m = 0; m < 4; ++m)
#pragma unroll
                    for (int n = 0; n < 2; ++n) acc[a][b][m][n] = (f32x4){0.f, 0.f, 0.f, 0.f};
        cur = nxt; cB = nB; ++ui;
#pragma unroll
        for (int i = 0; i < 2; ++i) { oC0[i] = oN0[i]; oC1[i] = oN1[i]; }
    }
    PG8_WAIT_V(0);
    if (wr == 0) PG8_BAR;
    PG8_BAR;
#undef PG8_SA
#undef PG8_SB
#undef PG8_STAGE
#undef PG8_LDA
#undef PG8_LDB
#undef PG8_MMA
#undef PG8_WAIT_V
#undef PG8_WAIT_L
#undef PG8_BAR
#undef PG8_SCHED
}

template <int ACT> struct EpiStoreBf16 {
    static constexpr bool PERM = true;
    bf16_t* O; int ldc; const float* vec; int split_cols; size_t split_stride;
    __device__ __forceinline__ float act(float v, float b) const {
        if (ACT == 1) return 2.f * sigmoidf_(2.f * v) - 1.f;
        if (ACT == 2) return sigmoidf_(v);
        if (ACT == 3) return 0.60653065971f * sigmoidf_(v + b);
        if (ACT == 4) return sigmoidf_(v + b);
        return v;
    }
    __device__ __forceinline__ void operator()(const f32x4 (&acc)[2][2][4][2], const Unit& u, int wr, int wc, int fr, int fq) const {
        const int row0 = u.arow0 + wr * 64 + fr; int colt = u.col0; bf16_t* base = O;
        if (split_cols) { const int t = colt / split_cols; base += (size_t)t * split_stride; colt -= t * split_cols; }
        const int col0 = colt + wc * 32 + 8 * fq, bcol0 = u.col0 + wc * 32 + 8 * fq;
#pragma unroll
        for (int bj = 0; bj < 2; ++bj) {
            const f32x4 b0 = (ACT >= 3) ? *(const f32x4*)(vec + bcol0 + bj * HALF) : (f32x4){0.f, 0.f, 0.f, 0.f}, b1 = (ACT >= 3) ? *(const f32x4*)(vec + bcol0 + bj * HALF + 4) : (f32x4){0.f, 0.f, 0.f, 0.f};
#pragma unroll
            for (int ai = 0; ai < 2; ++ai)
#pragma unroll
                for (int m = 0; m < 4; ++m) { bf16_t* rowp = base + (size_t)(row0 + ai * HALF + m * 16) * ldc + col0; const f32x4 v0 = acc[ai][bj][m][0], v1 = acc[ai][bj][m][1];
                {
                    u32x4 o; o[0] = cvt_pk_bf16(act(v0[0], b0[0]), act(v0[1], b0[1])); o[1] = cvt_pk_bf16(act(v0[2], b0[2]), act(v0[3], b0[3]));
                    o[2] = cvt_pk_bf16(act(v1[0], b1[0]), act(v1[1], b1[1])); o[3] = cvt_pk_bf16(act(v1[2], b1[2]), act(v1[3], b1[3]));
                    *(u32x4*)(rowp + bj * HALF) = o; } }
        }
    }
};
struct EpiMultiBf16 {
    static constexpr bool PERM = true;
    bf16_t* O; size_t ostride; unsigned omap; int ldc; unsigned acts; const float* V; long vd2; int vd1;
    __device__ __forceinline__ void operator()(const f32x4 (&acc)[2][2][4][2], const Unit& u, int wr, int wc, int fr, int fq) const {
        const int w = u.e; bf16_t* base = O + (size_t)((omap >> (4 * w)) & 15u) * ostride; const float* vec = V + (w >= 2 ? vd2 : 0l) + (w & 1) * vd1;
        const unsigned a = (acts >> (4 * w)) & 15u;
        const bool lin = a == 0u, hasb = a >= 3u;
        const float alpha = a == 1u ? 2.f : a == 3u ? 0.60653065971f : 1.f, beta = a == 1u ? 2.f : 1.f, gamma = a == 1u ? -1.f : 0.f;
        const int row0 = u.arow0 + wr * 64 + fr, col0 = u.col0 + wc * 32 + 8 * fq;
        if (lin) {
#pragma unroll
            for (int bj = 0; bj < 2; ++bj)
#pragma unroll
                for (int ai = 0; ai < 2; ++ai)
#pragma unroll
                    for (int m = 0; m < 4; ++m) { bf16_t* rowp = base + (size_t)(row0 + ai * HALF + m * 16) * ldc + col0; const f32x4 x0 = acc[ai][bj][m][0], x1 = acc[ai][bj][m][1];
                        u32x4 o; o[0] = cvt_pk_bf16(x0[0], x0[1]); o[1] = cvt_pk_bf16(x0[2], x0[3]); o[2] = cvt_pk_bf16(x1[0], x1[1]); o[3] = cvt_pk_bf16(x1[2], x1[3]);
                        *(u32x4*)(rowp + bj * HALF) = o; }
            return;
        }
#pragma unroll
        for (int bj = 0; bj < 2; ++bj) {
            f32x4 b0 = (f32x4){0.f, 0.f, 0.f, 0.f}, b1 = b0;
            if (hasb) { b0 = *(const f32x4*)(vec + col0 + bj * HALF); b1 = *(const f32x4*)(vec + col0 + bj * HALF + 4); }
            const float c1 = -1.4426950408889634f * beta, ia = __builtin_amdgcn_rcpf(alpha);
            b0 *= -1.4426950408889634f; b1 *= -1.4426950408889634f;
#pragma unroll
            for (int ai = 0; ai < 2; ++ai)
#pragma unroll
                for (int m = 0; m < 4; ++m) { bf16_t* rowp = base + (size_t)(row0 + ai * HALF + m * 16) * ldc + col0; const f32x4 x0 = acc[ai][bj][m][0], x1 = acc[ai][bj][m][1];
                    float r[8];
#pragma unroll
                    for (int j = 0; j < 4; ++j) { const float e0 = __builtin_amdgcn_exp2f(fmaf(x0[j], c1, b0[j])), e1 = __builtin_amdgcn_exp2f(fmaf(x1[j], c1, b1[j]));
                        r[j] = __builtin_amdgcn_rcpf(fmaf(e0, ia, ia)) + gamma; r[4 + j] = __builtin_amdgcn_rcpf(fmaf(e1, ia, ia)) + gamma; }
                    u32x4 o; o[0] = cvt_pk_bf16(r[0], r[1]); o[1] = cvt_pk_bf16(r[2], r[3]); o[2] = cvt_pk_bf16(r[4], r[5]); o[3] = cvt_pk_bf16(r[6], r[7]);
                    *(u32x4*)(rowp + bj * HALF) = o; }
        }
    }
};
template <bool INB> struct EpiRes {
    static constexpr bool PERM = true;
    const float* xin_l; const float* xin_c; const bf16_t* xin_b; bf16_t* out; const float* gate;
    __device__ __forceinline__ void operator()(const f32x4 (&acc)[2][2][4][2], const Unit& u, int wr, int wc, int fr, int fq) const {
        const int row0 = u.arow0 + wr * 64 + fr, col0 = u.col0 + wc * 32 + 8 * fq;
        const bool isc = u.arow0 >= ML;
        const int gb = isc ? 2 : (u.arow0 / SEQ);
        const float* gp = gate + (size_t)gb * MODW + col0;
        f32x4 gv[2][2];
#pragma unroll
        for (int bj = 0; bj < 2; ++bj)
#pragma unroll
            for (int n = 0; n < 2; ++n) gv[bj][n] = *(const f32x4*)(gp + bj * HALF + n * 4);
        const float* xi = isc ? xin_c - (size_t)ML * D : xin_l;
#pragma unroll
        for (int ai = 0; ai < 2; ++ai) {
            f32x4 xv[4][2][2]; u32x4 xb[4][2];
#pragma unroll
            for (int m = 0; m < 4; ++m) { const size_t ro = (size_t)(row0 + ai * HALF + m * 16) * D + col0;
#pragma unroll
                for (int bj = 0; bj < 2; ++bj) {
                    if (INB) xb[m][bj] = *(const u32x4*)(xin_b + ro + bj * HALF);
                    else { xv[m][bj][0] = *(const f32x4*)(xi + ro + bj * HALF); xv[m][bj][1] = *(const f32x4*)(xi + ro + bj * HALF + 4); } } }
            __builtin_amdgcn_sched_barrier(0);
#pragma unroll
            for (int m = 0; m < 4; ++m) { const size_t ro = (size_t)(row0 + ai * HALF + m * 16) * D + col0;
#pragma unroll
                for (int bj = 0; bj < 2; ++bj) {
                    f32x4 x0, x1;
                    if (INB) { const u32x4 t = xb[m][bj]; x0 = (f32x4){bf_lo(t[0]), bf_hi(t[0]), bf_lo(t[1]), bf_hi(t[1])}; x1 = (f32x4){bf_lo(t[2]), bf_hi(t[2]), bf_lo(t[3]), bf_hi(t[3])}; }
                    else { x0 = xv[m][bj][0]; x1 = xv[m][bj][1]; }
                    const f32x4 r0 = x0 + gv[bj][0] * acc[ai][bj][m][0], r1 = x1 + gv[bj][1] * acc[ai][bj][m][1];
                    u32x4 o; o[0] = cvt_pk_bf16(r0[0], r0[1]); o[1] = cvt_pk_bf16(r0[2], r0[3]); o[2] = cvt_pk_bf16(r1[0], r1[1]); o[3] = cvt_pk_bf16(r1[2], r1[3]);
                    *(u32x4*)(out + ro + bj * HALF) = o; } }
        }
    }
};
struct EpiMoeUp {
    static constexpr bool PERM = false;
    bf16_t* H;
    __device__ __forceinline__ void operator()(const f32x4 (&acc)[2][2][4][2], const Unit& u, int wr, int wc, int fr, int fq) const {
        const int row0 = u.arow0 + wr * 64 + fr;
#pragma unroll
        for (int ai = 0; ai < 2; ++ai)
#pragma unroll
            for (int m = 0; m < 4; ++m) { bf16_t* rowp = H + (size_t)(row0 + ai * HALF + m * 16) * FF;
#pragma unroll
                for (int bj = 0; bj < 2; ++bj) { const int j = (u.col0 + bj * HALF + wc * 32) / 2 + 4 * fq; const f32x4 a = acc[ai][bj][m][0], b = acc[ai][bj][m][1];
                    float h[4];
#pragma unroll
                    for (int i = 0; i < 4; ++i) h[i] = a[i] * sigmoidf_(a[i]) * b[i];
                    u32x2 o; o[0] = cvt_pk_bf16(h[0], h[1]); o[1] = cvt_pk_bf16(h[2], h[3]);
                    *(u32x2*)(rowp + j) = o; } }
    }
};
}

struct MoeSched {
    const LAS int* pref; const LAS int* cnt; const int* tokl; int nN, G, c, K, rowsB; bool gather;
    __device__ bool next(int i, pg8::Unit& u) const {
        const long L = (long)i * G + c; const int T = __builtin_amdgcn_readfirstlane(pref[NEXP]);
        if (L >= (long)T * nN) return false;
        const int tl = (int)(L / nN), pn = (int)(L % nN);
        int e = 0;
        for (int k = 1; k < NEXP; ++k) e = (pref[k] <= tl) ? k : e;
        e = __builtin_amdgcn_readfirstlane(e);
        u.e = e; u.pbase = __builtin_amdgcn_readfirstlane((tl - pref[e]) * 256); u.cnt = __builtin_amdgcn_readfirstlane(cnt[e]); u.arow0 = tl * 256; u.brow0 = e * rowsB + pn * 256; u.col0 = pn * 256; return true;
    }
    __device__ __forceinline__ unsigned a_off(const pg8::Unit& u, int r, int C) const {
        if (gather) { const int p = u.pbase + r; const int t_ = tokl[(size_t)u.e * MT + min(p, u.cnt - 1)]; const int tok = (p < u.cnt) ? t_ : 0; return (unsigned)(tok * K + C) * 2u; }
        return (unsigned)((u.arow0 + r) * K + C) * 2u;
    }
};

#define WSP(T, off) ((T*)(F.ws + (off)))
__device__ __forceinline__ const float* mod_row(const Frame& F, int layer, int row3) { return (const float*)(F.ws + WS_MOD) + ((size_t)layer * 3 + row3) * MODW; }

__device__ __forceinline__ void expert_prefix(const Frame& F, int layer, LAS int* pref, LAS int* cntl) {
    if (F.wave == 0) {
        const int lane = F.lane_();
        int c = 0; if (lane < NEXP) c = WSP(int, WS_CTL + CTL_CNT)[(size_t)(layer * NEXP + lane) * CNT_STRIDE];
        const int t = (c + 255) >> 8; int sc_ = t;
#pragma unroll
        for (int d = 1; d < NEXP; d <<= 1) { const int o = __shfl_up(sc_, d); if (lane >= d) sc_ += o; }
        if (lane < NEXP) { pref[lane] = sc_ - t; if (cntl) cntl[lane] = c; }
        if (lane == NEXP - 1) pref[NEXP] = sc_;
    }
    __syncthreads();
}

struct CvtJob { const float* src; const float* src2; bf16_t* dst; int Ksrc, Nsrc, ld_src, Kdst, Ndst, koff, grp_rows; size_t grp_stride; int mode; };
struct CvtRegs { f32x4 v[4]; };
__device__ __forceinline__ void cvt_load(const CvtJob& J, int tile, int tid, CvtRegs& R) {
    const int ktiles = J.Kdst / 64, nt = tile / ktiles, kt = tile % ktiles, n0 = nt * 128, k0 = kt * 64;
    const int e = n0 / J.grp_rows, nl0 = n0 % J.grp_rows;
    const int kr = tid >> 3, c8 = tid & 7;
    const int ks = k0 + kr - J.koff;
    const bool kok = (ks >= 0) && (ks < J.Ksrc);
#pragma unroll
    for (int cc = 0; cc < 2; ++cc) {
        const int nl = nl0 + (c8 + cc * 8) * 8;
        const float* sp = J.src + (size_t)e * J.grp_stride; int ncol = nl;
        if (J.mode == 1) { const int g = nl >> 5, w = nl & 31; sp = (w < 16 ? J.src : J.src2) + (size_t)e * J.grp_stride; ncol = g * 16 + (w & 15); }
        if (kok && ncol + 8 <= J.Nsrc) { const float* p = sp + (size_t)ks * J.ld_src + ncol; R.v[cc * 2] = *(const f32x4*)p; R.v[cc * 2 + 1] = *(const f32x4*)(p + 4); }
        else { R.v[cc * 2] = (f32x4){0.f, 0.f, 0.f, 0.f}; R.v[cc * 2 + 1] = (f32x4){0.f, 0.f, 0.f, 0.f}; }
    }
}
__device__ __forceinline__ void cvt_job(const Frame& F, const CvtJob& J, int& base, int nw = 0, int wi = 0) {
    const int ntiles = (J.Ndst / 128) * (J.Kdst / 64), tid = F.tid_();
    LAS float* tl = (LAS float*)F.lds;
    const int G_ = nw > 0 ? nw : F.G, me = nw > 0 ? wi : F.bid;
    if (me < 0) return;
    int t = ((me - base) % G_ + G_) % G_;
    base = (base + ntiles) % G_;
    if (t >= ntiles) return;
    CvtRegs cur, nxt; cvt_load(J, t, tid, cur);
    const int ktiles = J.Kdst / 64;
    for (; t < ntiles; t += G_) {
        const bool hn = (t + G_) < ntiles;
        if (hn) cvt_load(J, t + G_, tid, nxt);
        const int kr = tid >> 3, c8 = tid & 7;
#pragma unroll
        for (int cc = 0; cc < 2; ++cc)
#pragma unroll
            for (int j = 0; j < 8; ++j) tl[kr * 129 + (c8 + cc * 8) * 8 + j] = cur.v[cc * 2 + (j >> 2)][j & 3];
        __syncthreads();
        const int nrow = tid >> 2, kq = tid & 3, nt = t / ktiles, kt = t % ktiles;
        float x[16];
#pragma unroll
        for (int j = 0; j < 16; ++j) x[j] = tl[(kq * 16 + j) * 129 + nrow];
        u32x4 o0, o1;
#pragma unroll
        for (int j = 0; j < 4; ++j) { o0[j] = cvt_pk_bf16(x[2 * j], x[2 * j + 1]); o1[j] = cvt_pk_bf16(x[8 + 2 * j], x[8 + 2 * j + 1]); }
        bf16_t* dp = J.dst + (size_t)(nt * 128 + nrow) * J.Kdst + kt * 64 + kq * 16;
        *(u32x4*)dp = o0; *(u32x4*)(dp + 8) = o1;
        __syncthreads();
        if (hn) cur = nxt;
    }
}
__device__ __forceinline__ void cvt_simple(const Frame& F, const float* src, bf16_t* dst, int Ksrc, int Nsrc, int& base) {
    CvtJob J{src, src, dst, Ksrc, Nsrc, Nsrc, Ksrc, Nsrc, 0, Nsrc, 0, 0}; cvt_job(F, J, base);
}
__device__ __forceinline__ void cvt_moe13(const Frame& F, int layer, bf16_t* w13, int& base, int nw = 0, int wi = 0) {
    const size_t lo = (size_t)layer * NEXP * D * FF;
    CvtJob J1{F.A.in[I_MW1] + lo, F.A.in[I_MW3] + lo, w13, D, FF, FF, D, NEXP * 2 * FF, 0, 2 * FF, (size_t)D * FF, 1}; cvt_job(F, J1, base, nw, wi);
}
__device__ __forceinline__ void cvt_moe2(const Frame& F, int layer, bf16_t* w2t, int& base, int nw = 0, int wi = 0) {
    const size_t lo = (size_t)layer * NEXP * D * FF;
    CvtJob J2{F.A.in[I_MW2] + lo, F.A.in[I_MW2] + lo, w2t, FF, D, D, FF, NEXP * D, 0, D, (size_t)FF * D, 0}; cvt_job(F, J2, base, nw, wi);
}
__device__ __forceinline__ void cvt_moe(const Frame& F, int layer, bf16_t* w13, bf16_t* w2t, int& base) { cvt_moe13(F, layer, w13, base); cvt_moe2(F, layer, w2t, base); }

__device__ __forceinline__ void ph_prologue(const Frame& F) {
    const int tid = F.tid_();
    {
        LAS float* cv = (LAS float*)F.lds;
        LAS float* red = (LAS float*)(F.lds + 32768);
        for (int k = tid; k < D; k += NTHR) {
            const float c0 = F.A.in[I_C][k], c1 = F.A.in[I_C][D + k], c2 = F.A.in[I_CCTX][k];
            cv[k] = c0 * sigmoidf_(c0); cv[D + k] = c1 * sigmoidf_(c1); cv[2 * D + k] = c2 * sigmoidf_(c2);
        }
        __syncthreads();
        for (int item = F.bid; item < 2 * 96; item += F.G) {
            const int l = item / 96, n0 = (item % 96) * 128, c4 = tid & 31, kg = tid >> 5;
            float a[3][4];
#pragma unroll
            for (int r = 0; r < 3; ++r)
#pragma unroll
                for (int j = 0; j < 4; ++j) a[r][j] = 0.f;
            const float* wp = F.A.in[I_ADAW] + (size_t)l * D * MODW + n0 + c4 * 4;
#pragma unroll 1
            for (int kb = kg; kb < D; kb += 16 * 16) {
                f32x4 w[16];
#pragma unroll
                for (int u = 0; u < 16; ++u) w[u] = *(const f32x4*)(wp + (size_t)(kb + 16 * u) * MODW);
                __builtin_amdgcn_sched_barrier(0);
#pragma unroll
                for (int u = 0; u < 16; ++u) { const int k = kb + 16 * u; const float s0 = cv[k], s1 = cv[D + k], s2 = cv[2 * D + k];
#pragma unroll
                    for (int j = 0; j < 4; ++j) { a[0][j] += s0 * w[u][j]; a[1][j] += s1 * w[u][j]; a[2][j] += s2 * w[u][j]; } }
            }
#pragma unroll
            for (int r = 0; r < 3; ++r)
#pragma unroll
                for (int j = 0; j < 4; ++j) red[(kg * 3 + r) * 128 + c4 * 4 + j] = a[r][j];
            __syncthreads();
            if (tid < 384) { const int r = tid >> 7, n = tid & 127; float s = F.A.in[I_ADAB][(size_t)l * MODW + n0 + n];
                for (int g = 0; g < 16; ++g) s += red[(g * 3 + r) * 128 + n];
                WSP(float, WS_MOD)[((size_t)l * 3 + r) * MODW + n0 + n] = s; }
            __syncthreads();
        }
        __syncthreads();
    }
    int base = 0;
    cvt_simple(F, F.A.in[I_WIN], WSP(bf16_t, WT_IN), D, QKVC, base);
    cvt_simple(F, F.A.in[I_WOUT], WSP(bf16_t, WT_OUT), D, D, base);
    cvt_simple(F, F.A.in[I_WR], WSP(bf16_t, WT_R), D, D, base);
    cvt_simple(F, F.A.in[I_WK], WSP(bf16_t, WT_K), D, D, base);
    cvt_simple(F, F.A.in[I_WV], WSP(bf16_t, WT_V), D, D, base);
    cvt_simple(F, F.A.in[I_WO], WSP(bf16_t, WT_O), D, D, base);
    for (int d = 0; d < 2; ++d) {
        { CvtJob J{F.A.in[I_W1] + (size_t)d * D * 96, nullptr, WSP(bf16_t, WT_W1) + (size_t)d * 128 * D, D, 96, 96, D, 128, 0, 128, 0, 0}; cvt_job(F, J, base); }
        { CvtJob J{F.A.in[I_A1] + (size_t)d * D * 96, nullptr, WSP(bf16_t, WT_A1) + (size_t)d * 128 * D, D, 96, 96, D, 128, 0, 128, 0, 0}; cvt_job(F, J, base); }
        { CvtJob J{F.A.in[I_W2] + (size_t)d * 96 * D, nullptr, WSP(bf16_t, WT_W2) + (size_t)d * D * 128, 96, D, D, 128, D, 0, D, 0, 0}; cvt_job(F, J, base); }
        { CvtJob J{F.A.in[I_A2] + (size_t)d * 96 * D, nullptr, WSP(bf16_t, WT_A2) + (size_t)d * D * 128, 96, D, D, 128, D, 0, D, 0, 0}; cvt_job(F, J, base); }
    }
    cvt_simple(F, F.A.in[I_G1], WSP(bf16_t, WT_G1), D, 256, base);
    cvt_simple(F, F.A.in[I_G2], WSP(bf16_t, WT_G2), 256, D, base);
}

struct RowOpts {
    const float* src_l; const float* src_c;
    int nrows;
    bool combine; int comb_layer; const bf16_t* yslot; float* dst_l; float* dst_c;
    bool norm; int layer; int which;
    bf16_t* H;
    bool router;
    const bf16_t* src_b;
};
__device__ __forceinline__ void ph_rows(const Frame& F, const RowOpts& O) {
    LAS int* pref = (LAS int*)(F.lds + MISC_OFF + 1024);
    if (O.combine) expert_prefix(F, O.comb_layer, pref, (LAS int*)nullptr);
    const int lane = F.lane_(), stride = F.G * 8;
    LAS float* PA = (LAS float*)F.lds; LAS float* PB = PA + 3 * D; LAS float* PG = PA + 6 * D;
    int t0 = F.tid_(); asm volatile("" : "+v"(t0));
    for (int idx = t0; idx < 3 * D / 4; idx += NTHR) {
        const int m = idx / (D / 4), c = (idx % (D / 4)) * 4;
        if (O.norm) {
            const float* gn = (O.which ? F.A.in[I_NFFN] : F.A.in[I_NMIX]) + (size_t)O.layer * D; const float* mr = mod_row(F, O.layer, m);
            const f32x4 g = *(const f32x4*)(gn + c), sc = *(const f32x4*)(mr + (O.which ? 4 * D : D) + c), sh = *(const f32x4*)(mr + (O.which ? 3 * D : 0) + c);
            f32x4 a;
#pragma unroll
            for (int j = 0; j < 4; ++j) a[j] = g[j] * (1.f + sc[j]);
            *(LAS f32x4*)(PA + m * D + c) = a; *(LAS f32x4*)(PB + m * D + c) = sh;
        }
        if (O.combine) *(LAS f32x4*)(PG + m * D + c) = *(const f32x4*)(mod_row(F, O.comb_layer, m) + 5 * D + c);
    }
    __syncthreads();
    struct RowIn { f32x4 v[8]; u32x2 b[8]; int s0, s1; float g0, g1; };
    auto loadrow = [&](int r, RowIn& R) {
        if (O.src_b) {
#pragma unroll
            for (int i = 0; i < 8; ++i) R.b[i] = *(const u32x2*)(O.src_b + (size_t)r * D + i * 256 + lane * 4);
        } else {
            const float* sp = (r >= ML) ? O.src_c + (size_t)(r - ML) * D : O.src_l + (size_t)r * D;
#pragma unroll
            for (int i = 0; i < 8; ++i) R.v[i] = *(const f32x4*)(sp + i * 256 + lane * 4);
        }
        if (O.combine) { R.s0 = WSP(int, WS_TOKSEL)[r * 2]; R.s1 = WSP(int, WS_TOKSEL)[r * 2 + 1]; R.g0 = WSP(float, WS_TOKGATE)[r * 2]; R.g1 = WSP(float, WS_TOKGATE)[r * 2 + 1]; }
    };
    RowIn cur, nxt;
    int r = F.bid * 8 + F.wave;
    if (r < O.nrows) loadrow(r, cur);
    for (; r < O.nrows; r += stride) {
        if (r + stride < O.nrows) loadrow(r + stride, nxt);
        const bool isc = r >= ML;
        const int mrow = isc ? 2 : r / SEQ;
        f32x4 v[8];
#pragma unroll
        for (int i = 0; i < 8; ++i) v[i] = O.src_b ? (f32x4){bf_lo(cur.b[i][0]), bf_hi(cur.b[i][0]), bf_lo(cur.b[i][1]), bf_hi(cur.b[i][1])} : cur.v[i];
        if (O.combine) {
            const int s0 = cur.s0, s1 = cur.s1; const float g0 = cur.g0, g1 = cur.g1;
            const size_t y0 = ((size_t)pref[s0 >> 20] * 256 + (s0 & 0xfffff)) * D, y1 = ((size_t)pref[s1 >> 20] * 256 + (s1 & 0xfffff)) * D;
            const LAS float* gt = PG + mrow * D;
            float* dp = isc ? O.dst_c + (size_t)(r - ML) * D : O.dst_l + (size_t)r * D;
            u32x2 ya[8], yb[8];
#pragma unroll
            for (int i = 0; i < 8; ++i) { ya[i] = *(const u32x2*)(O.yslot + y0 + i * 256 + lane * 4); yb[i] = *(const u32x2*)(O.yslot + y1 + i * 256 + lane * 4); }
#pragma unroll
            for (int i = 0; i < 8; ++i) {
                const int col = i * 256 + lane * 4;
                const u32x2 a = ya[i], b = yb[i];
                const f32x4 g = *(const LAS f32x4*)(gt + col);
                v[i][0] += g[0] * (g0 * bf_lo(a[0]) + g1 * bf_lo(b[0])); v[i][1] += g[1] * (g0 * bf_hi(a[0]) + g1 * bf_hi(b[0]));
                v[i][2] += g[2] * (g0 * bf_lo(a[1]) + g1 * bf_lo(b[1])); v[i][3] += g[3] * (g0 * bf_hi(a[1]) + g1 * bf_hi(b[1]));
                if (TIME_PH >= 0 && !O.norm) { const float tsc = 1.f + sqrtf(*WSP(float, WS_CTL + 20496) * 1e-6f); v[i] *= tsc; }
                *(f32x4*)(dp + col) = v[i];
            }
        }
        if (O.norm) {
            float ss = 0.f;
#pragma unroll
            for (int i = 0; i < 8; ++i) ss += v[i][0] * v[i][0] + v[i][1] * v[i][1] + v[i][2] * v[i][2] + v[i][3] * v[i][3];
            ss = wave_sum(ss);
            const float rstd = rsqrtf(ss * (1.f / D) + 1e-6f);
            const LAS float* pa = PA + mrow * D; const LAS float* pb = PB + mrow * D;
            bf16_t* hp = O.H + (size_t)r * D;
#pragma unroll
            for (int i = 0; i < 8; ++i) {
                const int col = i * 256 + lane * 4;
                const f32x4 ga = *(const LAS f32x4*)(pa + col), sh = *(const LAS f32x4*)(pb + col);
#pragma unroll
                for (int j = 0; j < 4; ++j) v[i][j] = v[i][j] * rstd * ga[j] + sh[j];
                u32x2 o; o[0] = cvt_pk_bf16(v[i][0], v[i][1]); o[1] = cvt_pk_bf16(v[i][2], v[i][3]);
                *(u32x2*)(hp + col) = o;
            }
        }
        cur = nxt;
    }
}

__device__ __forceinline__ void ph_router_fold(const Frame& F) {
    const int tid = F.tid_();
    bf16_t* WFH = WSP(bf16_t, WS_WF); bf16_t* WFL = WFH + (size_t)6 * 48 * D; float* CV = WSP(float, WS_CV);
    for (int idx = F.bid * NTHR + tid; idx < 6 * 48 * (D / 8); idx += F.G * NTHR) {
        const int ln = idx & 63, j3 = (idx >> 6) % 3, s8 = (idx / 192) & 7, wv = (idx / 1536) & 7, lb = idx / 12288, l = lb / 3, b = lb % 3;
        const int n = j3 * 16 + (ln & 15), k8 = wv * 32 + s8 * 4 + (ln >> 4);
        const float* mr = mod_row(F, l, b);
        float v[8];
#pragma unroll
        for (int j = 0; j < 8; ++j) { const int k = k8 * 8 + j;
            const float sc = F.A.in[I_NFFN][(size_t)l * D + k] * (1.f + mr[4 * D + k]);
            const float w = n < 4 ? F.A.in[I_MGRP][((size_t)l * D + k) * 4 + n] : n < 36 ? F.A.in[I_MEXP][((size_t)l * D + k) * NEXP + n - 4] : 0.f;
            v[j] = w * sc; }
        u32x4 hi, lo;
#pragma unroll
        for (int j = 0; j < 4; ++j) { hi[j] = cvt_pk_bf16(v[2 * j], v[2 * j + 1]); lo[j] = cvt_pk_bf16(v[2 * j] - bf_lo(hi[j]), v[2 * j + 1] - bf_hi(hi[j])); }
        *(u32x4*)(WFH + (size_t)idx * 8) = hi; *(u32x4*)(WFL + (size_t)idx * 8) = lo;
    }
    const int lane = F.lane_();
    for (int it = F.bid * 8 + F.wave; it < 2 * 3 * 48; it += F.G * 8) {
        const int n = it % 48, lb = it / 48, l = lb / 3, b = lb % 3;
        const float* sh = mod_row(F, l, b) + 3 * D;
        float a = 0.f;
        if (n < 36) for (int k = lane; k < D; k += 64) { const float w = n < 4 ? F.A.in[I_MGRP][((size_t)l * D + k) * 4 + n] : F.A.in[I_MEXP][((size_t)l * D + k) * NEXP + n - 4]; a += sh[k] * w; }
        a = wave_sum(a);
        if (lane == 0) CV[lb * 48 + n] = a;
    }
}
__device__ __forceinline__ void ph_rows_router(const Frame& F, const bf16_t* src, int nrows, int layer, bf16_t* H) {
    const int lane = F.lane_(), wave = F.wave, l15 = lane & 15, q4 = lane >> 4;
    LAS float* lt = (LAS float*)(F.lds + wave * 16640);
    LAS float* pa = (LAS float*)(F.lds + 8 * 16640);
    LAS float* l0 = pa;
    const float* gn = F.A.in[I_NFFN] + (size_t)layer * D;
    u32x2 xv[16];
    auto loadx = [&](int tl, u32x2 (&x)[16]) { const bf16_t* sp = src + (size_t)tl * 16 * D + wave * 256 + lane * 4;
#pragma unroll
        for (int i = 0; i < 16; ++i) x[i] = *(const u32x2*)(sp + (size_t)i * D); };
    if (F.bid * 16 < nrows) loadx(F.bid, xv);
    for (int tl = F.bid; tl * 16 < nrows; tl += F.G) {
        const int r0 = tl * 16; const bool isc = r0 >= ML; const int mrow = isc ? 2 : r0 / SEQ;
        const bf16_t* Wh = WSP(bf16_t, WS_WF) + (size_t)(layer * 3 + mrow) * 48 * D; const bf16_t* Wl = Wh + (size_t)6 * 48 * D; const float* cv = WSP(float, WS_CV) + (layer * 3 + mrow) * 48;
        f32x4 acc0 = (f32x4){0.f, 0.f, 0.f, 0.f}, acc1 = acc0, acc2 = acc0; float ssq[16];
#pragma unroll
        for (int i = 0; i < 16; ++i) { const f32x4 xf = (f32x4){bf_lo(xv[i][0]), bf_hi(xv[i][0]), bf_lo(xv[i][1]), bf_hi(xv[i][1])};
            ssq[i] = xf[0] * xf[0] + xf[1] * xf[1] + xf[2] * xf[2] + xf[3] * xf[3]; *(LAS f32x4*)(lt + i * 260 + lane * 4) = xf; }
        LAS float* pw_ = pa + wave * 784;
#pragma unroll
        for (int i = 0; i < 16; ++i) { const float t = wave_sum(ssq[i]); if (lane == i) pw_[768 + i] = t; }
        lds_fence();
        f32x4 pg, psc, psh; float cv0, cv1, cv2;
        {
            const bf16_t* wph = Wh + ((size_t)wave * 1536 + lane) * 8; const bf16_t* wpl = Wl + ((size_t)wave * 1536 + lane) * 8;
            const LAS float* ap = lt + l15 * 260 + q4 * 8;
            bf16x8 hA[2][3], lA[2][3], hB[2][3], lB[2][3];
#define RT_LOAD(kb, H_, L_) do { _Pragma("unroll") for (int s2 = 0; s2 < 2; ++s2) _Pragma("unroll") for (int j = 0; j < 3; ++j) { const size_t o = (size_t)((((kb) * 2 + s2) * 3 + j) * 64) * 8; \
                H_[s2][j] = *(const bf16x8*)(wph + o); L_[s2][j] = *(const bf16x8*)(wpl + o); } } while (0)
#define RT_MMA(kb, H_, L_) do { _Pragma("unroll") for (int s2 = 0; s2 < 2; ++s2) { const f32x4 xa = *(const LAS f32x4*)(ap + ((kb) * 2 + s2) * 32), xb = *(const LAS f32x4*)(ap + ((kb) * 2 + s2) * 32 + 4); \
                u32x4 xh_, xl_; \
                xh_[0] = cvt_pk_bf16(xa[0], xa[1]); xh_[1] = cvt_pk_bf16(xa[2], xa[3]); xh_[2] = cvt_pk_bf16(xb[0], xb[1]); xh_[3] = cvt_pk_bf16(xb[2], xb[3]); \
                xl_[0] = cvt_pk_bf16(xa[0] - bf_lo(xh_[0]), xa[1] - bf_hi(xh_[0])); xl_[1] = cvt_pk_bf16(xa[2] - bf_lo(xh_[1]), xa[3] - bf_hi(xh_[1])); \
                xl_[2] = cvt_pk_bf16(xb[0] - bf_lo(xh_[2]), xb[1] - bf_hi(xh_[2])); xl_[3] = cvt_pk_bf16(xb[2] - bf_lo(xh_[3]), xb[3] - bf_hi(xh_[3])); \
                const bf16x8 ah = *reinterpret_cast<const bf16x8*>(&xh_), al = *reinterpret_cast<const bf16x8*>(&xl_); \
                acc0 = __builtin_amdgcn_mfma_f32_16x16x32_bf16(ah, H_[s2][0], acc0, 0, 0, 0); acc1 = __builtin_amdgcn_mfma_f32_16x16x32_bf16(ah, H_[s2][1], acc1, 0, 0, 0); acc2 = __builtin_amdgcn_mfma_f32_16x16x32_bf16(ah, H_[s2][2], acc2, 0, 0, 0); \
                acc0 = __builtin_amdgcn_mfma_f32_16x16x32_bf16(ah, L_[s2][0], acc0, 0, 0, 0); acc1 = __builtin_amdgcn_mfma_f32_16x16x32_bf16(ah, L_[s2][1], acc1, 0, 0, 0); acc2 = __builtin_amdgcn_mfma_f32_16x16x32_bf16(ah, L_[s2][2], acc2, 0, 0, 0); \
                acc0 = __builtin_amdgcn_mfma_f32_16x16x32_bf16(al, H_[s2][0], acc0, 0, 0, 0); acc1 = __builtin_amdgcn_mfma_f32_16x16x32_bf16(al, H_[s2][1], acc1, 0, 0, 0); acc2 = __builtin_amdgcn_mfma_f32_16x16x32_bf16(al, H_[s2][2], acc2, 0, 0, 0); } } while (0)
            RT_LOAD(0, hA, lA); __builtin_amdgcn_sched_barrier(0);
            RT_LOAD(1, hB, lB); __builtin_amdgcn_sched_barrier(0);
            RT_MMA(0, hA, lA); __builtin_amdgcn_sched_barrier(0);
            RT_LOAD(2, hA, lA); __builtin_amdgcn_sched_barrier(0);
            RT_MMA(1, hB, lB); __builtin_amdgcn_sched_barrier(0);
            RT_LOAD(3, hB, lB); __builtin_amdgcn_sched_barrier(0);
            RT_MMA(2, hA, lA); __builtin_amdgcn_sched_barrier(0);
            { const float* mr = mod_row(F, layer, mrow); const int col = wave * 256 + lane * 4;
              pg = *(const f32x4*)(gn + col); psc = *(const f32x4*)(mr + 4 * D + col); psh = *(const f32x4*)(mr + 3 * D + col); cv0 = cv[l15]; cv1 = cv[16 + l15]; cv2 = cv[32 + l15]; }
            __builtin_amdgcn_sched_barrier(0);
            loadx((tl + F.G) * 16 < nrows ? tl + F.G : tl, xv);
            __builtin_amdgcn_sched_barrier(0);
            RT_MMA(3, hB, lB); __builtin_amdgcn_sched_barrier(0);
#undef RT_LOAD
#undef RT_MMA
        }
#pragma unroll
        for (int j = 0; j < 4; ++j) { pw_[lane * 12 + j] = acc0[j]; pw_[lane * 12 + 4 + j] = acc1[j]; pw_[lane * 12 + 8 + j] = acc2[j]; }
        __syncthreads();
        float sst = 0.f; f32x4 t0 = (f32x4){0.f, 0.f, 0.f, 0.f}, t1 = t0, t2 = t0;
#pragma unroll
        for (int w = 0; w < 8; ++w) { const LAS float* pw = pa + w * 784; sst += pw[768 + l15];
            if (wave == 0) {
#pragma unroll
                for (int j = 0; j < 4; ++j) { t0[j] += pw[lane * 12 + j]; t1[j] += pw[lane * 12 + 4 + j]; t2[j] += pw[lane * 12 + 8 + j]; } } }
        const float rs_own = rsqrtf(sst * (1.f / D) + 1e-6f);
        __syncthreads();
        int ea = 0, eb = 0, pa_ = 0, pb_ = 0; float w1g = 0.f, w2g = 0.f;
        if (wave == 0) {
#pragma unroll
            for (int j = 0; j < 4; ++j) { const int row = 4 * q4 + j; const float rs = __shfl(rs_own, row);
                l0[row * 48 + l15] = rs * t0[j] + cv0; l0[row * 48 + 16 + l15] = rs * t1[j] + cv1; l0[row * 48 + 32 + l15] = rs * t2[j] + cv2; }
            lds_fence();
            if (lane < 16) {
                const LAS float* lg = l0 + lane * 48;
                int gs = 0; float gm = lg[0];
#pragma unroll
                for (int q = 1; q < 4; ++q) if (lg[q] > gm) { gm = lg[q]; gs = q; }
                float den = 0.f;
#pragma unroll
                for (int q = 0; q < 4; ++q) den += __expf(lg[q] - gm);
                const float psel = __builtin_amdgcn_rcpf(den);
                const LAS float* el = lg + 4 + gs * 8;
                int i1 = 0; float v1 = el[0];
#pragma unroll
                for (int q = 1; q < 8; ++q) if (el[q] > v1) { v1 = el[q]; i1 = q; }
                int i2 = -1; float v2 = -3.0e38f;
#pragma unroll
                for (int q = 0; q < 8; ++q) if (q != i1 && el[q] > v2) { v2 = el[q]; i2 = q; }
                const float e2 = __expf(v2 - v1), r12 = psel * __builtin_amdgcn_rcpf(1.f + e2); w1g = r12; w2g = r12 * e2;
                int* cnt = WSP(int, WS_CTL + CTL_CNT) + layer * NEXP * CNT_STRIDE;
                ea = gs * 8 + i1; eb = gs * 8 + i2;
                pa_ = atomicAdd(cnt + ea * CNT_STRIDE, 1); pb_ = atomicAdd(cnt + eb * CNT_STRIDE, 1);
            }
        }
        {
            const int col = wave * 256 + lane * 4;
            const f32x4 sh = psh;
            f32x4 m;
#pragma unroll
            for (int j = 0; j < 4; ++j) m[j] = pg[j] * (1.f + psc[j]);
#pragma unroll
            for (int i = 0; i < 16; ++i) { const float rs = __int_as_float(__builtin_amdgcn_readlane(__float_as_int(rs_own), i)); const f32x4 x = *(const LAS f32x4*)(lt + i * 260 + lane * 4);
                u32x2 o; o[0] = cvt_pk_bf16(x[0] * rs * m[0] + sh[0], x[1] * rs * m[1] + sh[1]); o[1] = cvt_pk_bf16(x[2] * rs * m[2] + sh[2], x[3] * rs * m[3] + sh[3]);
                *(u32x2*)(H + (size_t)(r0 + i) * D + col) = o; }
        }
        if (wave == 0 && lane < 16) { const int r = r0 + lane;
            WSP(int, WS_TOKL)[(size_t)ea * MT + pa_] = r; WSP(int, WS_TOKL)[(size_t)eb * MT + pb_] = r;
            WSP(int, WS_TOKSEL)[r * 2] = (ea << 20) | pa_; WSP(int, WS_TOKSEL)[r * 2 + 1] = (eb << 20) | pb_;
            WSP(float, WS_TOKGATE)[r * 2] = w1g; WSP(float, WS_TOKGATE)[r * 2 + 1] = w2g; }
    }
    __syncthreads();
}

__device__ __forceinline__ void ph_qknorm(const Frame& F, bf16_t* QKV) {
    const int lane = F.lane_();
    const int il = lane & 15;
    const float f0 = exp2f(-(float)(2 * il) * (13.287712379549449f / 32.f)), f1 = exp2f(-(float)(2 * il + 1) * (13.287712379549449f / 32.f));
    const int stride = F.G * 8;
    auto loadrow = [&](int r, unsigned (&u)[10]) {
        const bf16_t* row = QKV + (size_t)r * QKVC;
#pragma unroll
        for (int hd = 0; hd < 10; ++hd) { const int col = hd < 2 ? KA0 + hd * 128 : KB0 + (hd - 2) * 128;
            u[hd] = *(const unsigned*)(row + col + 2 * lane); }
    };
    unsigned u[10], un[10];
    const f32x2 gga = *(const f32x2*)(F.A.in[I_AKG] + 2 * lane), ggb = *(const f32x2*)(F.A.in[I_BKG] + 2 * lane);
    int r = F.bid * 8 + F.wave;
    if (r < MT) loadrow(r, u);
    for (; r < MT; r += stride) {
        if (r + stride < MT) loadrow(r + stride, un);
        const bool lat = r < ML; const int t = r % SEQ;
        const float pos = (lane < 32) ? (float)(t / 64) : (float)(t % 64);
        float c0 = 1.f, s0 = 0.f, c1 = 1.f, s1 = 0.f;
        if (lat) { const float r0_ = __builtin_amdgcn_fractf(pos * f0 * 0.15915494309189535f), r1_ = __builtin_amdgcn_fractf(pos * f1 * 0.15915494309189535f);
            s0 = __builtin_amdgcn_sinf(r0_); c0 = __builtin_amdgcn_cosf(r0_); s1 = __builtin_amdgcn_sinf(r1_); c1 = __builtin_amdgcn_cosf(r1_); }
        bf16_t* row = QKV + (size_t)r * QKVC;
        float ss[10];
#pragma unroll
        for (int hd = 0; hd < 10; ++hd) { const float x0 = bf_lo(u[hd]), x1 = bf_hi(u[hd]); ss[hd] = x0 * x0 + x1 * x1; }
#pragma unroll
        for (int hd = 0; hd < 10; ++hd) ss[hd] = wave_sum(ss[hd]);
#pragma unroll
        for (int hd = 0; hd < 10; ++hd) { const int col = hd < 2 ? KA0 + hd * 128 : KB0 + (hd - 2) * 128;
            const f32x2 gg = hd < 2 ? gga : ggb;
            const float rstd = rsqrtf(ss[hd] * (1.f / 128.f) + 1e-6f);
            float x0 = bf_lo(u[hd]) * rstd * gg[0], x1 = bf_hi(u[hd]) * rstd * gg[1];
            if (hd < 2 && lat) {
                const float p0 = __shfl_xor(x0, 16), p1 = __shfl_xor(x1, 16);
                if ((lane & 16) == 0) { x0 = x0 * c0 - p0 * s0; x1 = x1 * c1 - p1 * s1; }
                else { x0 = p0 * s0 + x0 * c0; x1 = p1 * s1 + x1 * c1; }
            }
            *(unsigned*)(row + col + 2 * lane) = cvt_pk_bf16(x0, x1); }
#pragma unroll
        for (int hd = 0; hd < 10; ++hd) u[hd] = un[hd];
    }
}

namespace att {
typedef float f32x16 __attribute__((ext_vector_type(16)));
typedef short s16x4 __attribute__((ext_vector_type(4)));
constexpr int KVBLK = 64;
constexpr float SCALE = 0.08838834764831845f, THR = 8.f;
constexpr int SHM_V = KVBLK * 128 * 2, SHM_K = KVBLK * 128 * 2;
#define KSWZ(row, colB) ((row) * 256 + ((colB) ^ (((row) & 7) << 4)))
#define SBAR() __builtin_amdgcn_sched_barrier(0)
__device__ __forceinline__ int crow(int r, int hi) { return (r & 3) + 8 * (r >> 2) + 4 * hi; }
__device__ __forceinline__ void partialSM(f32x16& p0, f32x16& p1, float& m_reg, float& mn, float& alpha) {
  constexpr float C = SCALE * 1.4426950408889634f;
  float pmax = p0[0];
#pragma unroll
  for (int r = 1; r < 16; ++r) pmax = fmaxf(pmax, p0[r]);
#pragma unroll
  for (int r = 0; r < 16; ++r) pmax = fmaxf(pmax, p1[r]);
  { auto rr = __builtin_amdgcn_permlane32_swap(__float_as_uint(pmax), __float_as_uint(pmax), false, false);
    pmax = fmaxf(__uint_as_float(rr[0]), __uint_as_float(rr[1])); }
  if (__builtin_expect(__all(pmax - m_reg <= THR / SCALE), 1)) { mn = m_reg; alpha = 1.f; }
  else { mn = fmaxf(m_reg, pmax); alpha = __builtin_amdgcn_exp2f((m_reg - mn) * C); m_reg = mn; }
  float mnC = -mn * C;
#pragma unroll
  for (int r = 0; r < 16; ++r) p0[r] = fmaf(p0[r], C, mnC);
#pragma unroll
  for (int r = 0; r < 16; ++r) p1[r] = fmaf(p1[r], C, mnC);
#pragma unroll
  for (int r = 0; r < 16; ++r) p0[r] = __builtin_amdgcn_exp2f(p0[r]);
}
__device__ __forceinline__ void finishSM(f32x16& p0, f32x16& p1, float alpha, float& l_reg, bf16x8& pa0, bf16x8& pa1, bf16x8& pa2, bf16x8& pa3) {
#pragma unroll
  for (int r = 0; r < 16; ++r) p1[r] = __builtin_amdgcn_exp2f(p1[r]);
  float ps = 0;
#pragma unroll
  for (int r = 0; r < 16; ++r) ps += p0[r];
#pragma unroll
  for (int r = 0; r < 16; ++r) ps += p1[r];
  { auto rr = __builtin_amdgcn_permlane32_swap(__float_as_uint(ps), __float_as_uint(ps), false, false);
    ps = __uint_as_float(rr[0]) + __uint_as_float(rr[1]); }
  l_reg = l_reg * alpha + ps;
#define PK4(P, BASE, OUT) do { unsigned a0 = cvt_pk_bf16(P[BASE + 0], P[BASE + 1]), a1 = cvt_pk_bf16(P[BASE + 2], P[BASE + 3]);   \
    unsigned b0 = cvt_pk_bf16(P[BASE + 4], P[BASE + 5]), b1 = cvt_pk_bf16(P[BASE + 6], P[BASE + 7]);                              \
    auto r0 = __builtin_amdgcn_permlane32_swap(a0, b0, false, false); auto r1 = __builtin_amdgcn_permlane32_swap(a1, b1, false, false); \
    u32x4 w = {r0[0], r1[0], r0[1], r1[1]}; OUT = *reinterpret_cast<bf16x8*>(&w); } while (0)
  PK4(p0, 0, pa0); PK4(p0, 8, pa1); PK4(p1, 0, pa2); PK4(p1, 8, pa3);
#undef PK4
}
__device__ __forceinline__ void qkt(f32x16& p0, f32x16& p1, const LAS char* Ks, const bf16x8* qr, int r32, int hi) {
  asm volatile("" : "+v"(r32));
  p0 = f32x16{}; p1 = f32x16{};
#pragma unroll
  for (int d0 = 0; d0 < 8; ++d0) { int cb = (d0 * 16 + hi * 8) * 2;
    bf16x8 b0 = *reinterpret_cast<const LAS bf16x8*>(Ks + KSWZ(r32, cb));
    bf16x8 b1 = *reinterpret_cast<const LAS bf16x8*>(Ks + KSWZ(32 + r32, cb));
    p0 = __builtin_amdgcn_mfma_f32_32x32x16_bf16(b0, qr[d0], p0, 0, 0, 0);
    p1 = __builtin_amdgcn_mfma_f32_32x32x16_bf16(b1, qr[d0], p1, 0, 0, 0); }
}
__device__ __forceinline__ int v_st(int k, int c) { const int kk = (k & ~0xC) | ((k & 4) << 1) | ((k & 8) >> 1); return ((kk >> 3) * 4 + (c >> 5)) * 512 + ((kk & 7) * 32 + (c & 31)) * 2; }
__device__ __forceinline__ int v_rd_base(int lane) { return ((lane & 3) << 3) | (((lane >> 2) & 3) << 6) | (((lane >> 4) & 1) << 5) | (((lane >> 5) & 1) << 8); }
constexpr int v_rd_off(int d0, int ks, int half) { return d0 * 512 + ks * 4096 + half * 2048; }
template <int OFF> __device__ __forceinline__ s16x4 tr_read(int vb) {
  s16x4 r; asm volatile("ds_read_b64_tr_b16 %0, %1 offset:%2" : "=&v"(r) : "v"(vb), "i"(OFF) : "memory"); return r;
}
template <int D0> __device__ __forceinline__ void pv_one(f32x16& od, int vb, bf16x8 pa0, bf16x8 pa1, bf16x8 pa2, bf16x8 pa3) {
  const s16x4 l0 = tr_read<v_rd_off(D0, 0, 0)>(vb), h0 = tr_read<v_rd_off(D0, 0, 1)>(vb), l1 = tr_read<v_rd_off(D0, 1, 0)>(vb), h1 = tr_read<v_rd_off(D0, 1, 1)>(vb);
  const s16x4 l2 = tr_read<v_rd_off(D0, 2, 0)>(vb), h2 = tr_read<v_rd_off(D0, 2, 1)>(vb), l3 = tr_read<v_rd_off(D0, 3, 0)>(vb), h3 = tr_read<v_rd_off(D0, 3, 1)>(vb);
  asm volatile("s_waitcnt lgkmcnt(0)" ::: "memory"); SBAR();
#define PK(L, H) (bf16x8){L[0], L[1], L[2], L[3], H[0], H[1], H[2], H[3]}
  od = __builtin_amdgcn_mfma_f32_32x32x16_bf16(pa0, PK(l0, h0), od, 0, 0, 0);
  od = __builtin_amdgcn_mfma_f32_32x32x16_bf16(pa1, PK(l1, h1), od, 0, 0, 0);
  od = __builtin_amdgcn_mfma_f32_32x32x16_bf16(pa2, PK(l2, h2), od, 0, 0, 0);
  od = __builtin_amdgcn_mfma_f32_32x32x16_bf16(pa3, PK(l3, h3), od, 0, 0, 0);
#undef PK
}
__device__ __forceinline__ void pv_d0(f32x16* o, int vb, bf16x8 pa0, bf16x8 pa1, bf16x8 pa2, bf16x8 pa3) {
  pv_one<0>(o[0], vb, pa0, pa1, pa2, pa3); pv_one<1>(o[1], vb, pa0, pa1, pa2, pa3); pv_one<2>(o[2], vb, pa0, pa1, pa2, pa3); pv_one<3>(o[3], vb, pa0, pa1, pa2, pa3);
}
struct UnitD {
  int nW, NT;
  int wrow0, crow0;
  int qt, wlo;
};
__device__ __forceinline__ void mask_add(f32x16& p0, f32x16& p1, int hi, const LAS float* tp) {
  const LAS float* tq = tp + 4 * hi;
#pragma unroll
  for (int g2 = 0; g2 < 2; ++g2) {
    float a[8], b[8];
#pragma unroll
    for (int q = 0; q < 8; ++q) { const int jc = (q & 3) + 8 * (2 * g2 + (q >> 2)); a[q] = tq[jc]; b[q] = tq[jc + 32]; }
#pragma unroll
    for (int q = 0; q < 8; ++q) { const int r = 8 * g2 + q; p0[r] += a[q]; p1[r] += b[q]; }
    SBAR();
  }
}
__device__ __forceinline__ void mask_add2(f32x16& p0, f32x16& p1, int hi, const LAS float* tpA, const LAS float* tpB) {
  const LAS float* ta = tpA + 4 * hi; const LAS float* tb = tpB + 4 * hi;
#pragma unroll
  for (int g = 0; g < 4; ++g) {
    float a0[4], a1[4], b0[4], b1[4];
#pragma unroll
    for (int q = 0; q < 4; ++q) { const int jc = q + 8 * g; a0[q] = ta[jc]; a1[q] = ta[jc + 32]; b0[q] = tb[jc]; b1[q] = tb[jc + 32]; }
#pragma unroll
    for (int q = 0; q < 4; ++q) { const int r = 4 * g + q; p0[r] += a0[q] + b0[q]; p1[r] += a1[q] + b1[q]; }
    SBAR();
  }
}

__device__ __forceinline__ void attn_unit(const int TYPE, const bf16_t* __restrict__ Qw_, const bf16_t* __restrict__ Kc, const bf16_t* __restrict__ Vc, bf16_t* __restrict__ Ow, const UnitD U,
                                          const int wrr  , const float sink_l2  , LAS char* lds,
                                          const LAS float* qgain  , const bool qrope, const int qt0  ,
                                          int* aq, int& unext  ) {
  const int tid = threadIdx.x, wid = __builtin_amdgcn_readfirstlane(tid >> 6), lane = tid & 63, r32 = lane & 31, hi = lane >> 5;
  LAS char* V_lds = lds; LAS char* K_lds = lds + 2 * SHM_V;
  LAS float* ws = (LAS float*)(lds + 2 * SHM_V + 2 * SHM_K) + wid * 64; LAS float* li_l = ws; LAS float* al_l = ws + 32;
  const LAS float* tbl = (const LAS float*)(lds + 2 * SHM_V + 2 * SHM_K + 2048);
  float m_reg = -1e4f, l_reg = 0; bf16x8 qr[8];
  const bf16_t* Qw = Qw_ + (size_t)r32 * QKVC + hi * 8;
  const int sr = tid >> 4, sc = (tid & 15) * 8;
  struct { bf16x8 vs0, vs1, ks0, ks1; } sr_[1];
#define TROW(j) (((j) < U.nW) ? (U.wrow0 + (j) * 64) : (U.crow0 + (((j) - U.nW) & 3) * 64))
#define SLOAD(i, k0) do { const int _k0 = (k0); sr_[i].vs0 = *reinterpret_cast<const bf16x8*>(&Vc[(size_t)(_k0 + sr) * QKVC + sc]); sr_[i].vs1 = *reinterpret_cast<const bf16x8*>(&Vc[(size_t)(_k0 + 32 + sr) * QKVC + sc]); \
    sr_[i].ks0 = *reinterpret_cast<const bf16x8*>(&Kc[(size_t)(_k0 + sr) * QKVC + sc]); sr_[i].ks1 = *reinterpret_cast<const bf16x8*>(&Kc[(size_t)(_k0 + 32 + sr) * QKVC + sc]); } while (0)
  SLOAD(0, TROW(0)); __builtin_amdgcn_sched_barrier(0);
  {
    u32x4 raw[8]; float ssq = 0.f;
#pragma unroll
    for (int d0 = 0; d0 < 8; ++d0) raw[d0] = *reinterpret_cast<const u32x4*>(Qw + d0 * 16);
    __builtin_amdgcn_sched_barrier(0);
    if (tid == 0) unext = atomicAdd(aq, 1);
    __builtin_amdgcn_sched_barrier(0);
#pragma unroll
    for (int d0 = 0; d0 < 8; ++d0) {
#pragma unroll
      for (int j = 0; j < 4; ++j) { const float a = bf_lo(raw[d0][j]), b = bf_hi(raw[d0][j]); ssq += a * a + b * b; } }
    ssq += __shfl_xor(ssq, 32);
    const float rstd = rsqrtf(ssq * (1.f / 128.f) + 1e-6f);
    const int t = qt0 + r32;
    int hi_l = hi; asm volatile("" : "+v"(hi_l));
#pragma unroll
    for (int hf = 0; hf < 2; ++hf) {
      float q[4][8];
#pragma unroll
      for (int dd = 0; dd < 4; ++dd) { const int d0 = hf * 4 + dd; const f32x4 g0 = *(const LAS f32x4*)(qgain + d0 * 16 + hi_l * 8), g1 = *(const LAS f32x4*)(qgain + d0 * 16 + hi_l * 8 + 4);
#pragma unroll
        for (int j = 0; j < 4; ++j) { q[dd][2 * j] = bf_lo(raw[d0][j]); q[dd][2 * j + 1] = bf_hi(raw[d0][j]); }
#pragma unroll
        for (int j = 0; j < 4; ++j) { q[dd][j] *= rstd * g0[j]; q[dd][4 + j] *= rstd * g1[j]; } }
      if (qrope) { const float pos = hf == 0 ? (float)(t >> 6) : (float)(t & 63);
#pragma unroll
        for (int dd = 0; dd < 2; ++dd)
#pragma unroll
          for (int j = 0; j < 8; ++j) { const int i = dd * 16 + hi_l * 8 + j;
            const float fr = __builtin_amdgcn_fractf(pos * exp2f(-(float)i * (13.287712379549449f / 32.f)) * 0.15915494309189535f);
            const float sn = __builtin_amdgcn_sinf(fr), cs = __builtin_amdgcn_cosf(fr);
            const float x1 = q[dd][j], x2 = q[2 + dd][j];
            q[dd][j] = x1 * cs - x2 * sn; q[2 + dd][j] = x1 * sn + x2 * cs; } }
#pragma unroll
      for (int dd = 0; dd < 4; ++dd) { u32x4 w;
#pragma unroll
        for (int j = 0; j < 4; ++j) w[j] = cvt_pk_bf16(q[dd][2 * j], q[dd][2 * j + 1]);
        qr[hf * 4 + dd] = *reinterpret_cast<bf16x8*>(&w); }
    }
  }
  f32x16 o[4] = {};
  const int vst0 = v_st(sr, sc), vst1 = v_st(32 + sr, sc);
  const int vb0 = (int)(uintptr_t)V_lds + v_rd_base(lane);
  const int iq = (wid & 1) * 32 + r32;
  const int r0w = min(max(wrr - 4, 0), 248);
  const int c0q = min(max(iq - 8, 0), 48);
#define SWRITE(b, i) do { *(LAS bf16x8*)(V_lds + (b) * SHM_V + vst0) = sr_[i].vs0;          \
    *(LAS bf16x8*)(V_lds + (b) * SHM_V + vst1) = sr_[i].vs1; int kc = sc * 2;               \
    *(LAS bf16x8*)(K_lds + (b) * SHM_K + KSWZ(sr, kc)) = sr_[i].ks0;                       \
    *(LAS bf16x8*)(K_lds + (b) * SHM_K + KSWZ(32 + sr, kc)) = sr_[i].ks1; } while (0)
#define RESC(a) do { if (__any((a) < 1.f)) { if (hi == 0) al_l[r32] = (a); asm volatile("s_waitcnt lgkmcnt(0)" ::: "memory"); \
    _Pragma("unroll") for (int d = 0; d < 4; ++d) _Pragma("unroll") for (int r = 0; r < 16; ++r) o[d][r] *= al_l[crow(r, hi)]; } } while (0)
#define MASK(j, P0, P1) do { const int _j = (j); \
    if (TYPE == 0) { if (_j < U.nW) { const int tix = U.wlo + _j; \
        if (tix == U.qt - 2) mask_add(P0, P1, hi, tbl + 17 * 128 + 64 - iq); else if (tix == U.qt + 2) mask_add(P0, P1, hi, tbl + 18 * 128 + 64 - iq); } } \
    else { if (_j < U.nW) { const int dr = U.wlo + _j - r0w; \
        if ((unsigned)dr < 8u) mask_add2(P0, P1, hi, tbl + (U.wlo + _j - wrr + 7) * 128 + 64 - iq, tbl + 16 * 128 + 48 - c0q); \
        else mask_add(P0, P1, hi, tbl + 19 * 128); } } } while (0)
  f32x16 p0, p1; float mn, al = 1.f; bf16x8 pa0, pa1, pa2, pa3; const int NT = U.NT;
  asm volatile("s_waitcnt vmcnt(0)" ::: "memory"); SWRITE(0, 0); SLOAD(0, TROW(1)); __syncthreads();
  for (int j = 0; j < NT; ++j) {
    const int par = j & 1;
    const bool skip = (TYPE == 1) && (j < U.nW) && ((unsigned)(U.wlo + j - r0w) >= 8u);
    if (!skip) qkt(p0, p1, K_lds + par * SHM_K, qr, r32, hi);
    if (j + 1 < NT) { SWRITE(1 - par, 0); }
    if (j + 2 < NT) SLOAD(0, TROW(j + 2));
    if (!skip) {
      MASK(j, p0, p1);
      partialSM(p0, p1, m_reg, mn, al);
      RESC(al);
      finishSM(p0, p1, al, l_reg, pa0, pa1, pa2, pa3); SBAR();
      pv_d0(o, vb0 + par * SHM_V, pa0, pa1, pa2, pa3);
    }
    __syncthreads();
  }
  if (TYPE == 0) l_reg += __builtin_amdgcn_exp2f(sink_l2 - m_reg * (SCALE * 1.4426950408889634f));
  int r32e = r32, hie = hi; asm volatile("" : "+v"(r32e), "+v"(hie));
  if (hie == 0) li_l[r32e] = l_reg; asm volatile("s_waitcnt lgkmcnt(0)" ::: "memory");
  float rli[16];
#pragma unroll
  for (int r = 0; r < 16; ++r) rli[r] = __builtin_amdgcn_rcpf(li_l[crow(r, hie)]);
#pragma unroll
  for (int r = 0; r < 16; ++r) { const int orow = crow(r, hie);
#pragma unroll
    for (int d0 = 0; d0 < 4; ++d0) { const float x = o[d0][r] * rli[r]; Ow[(size_t)orow * D + d0 * 32 + r32e] = (bf16_t)(cvt_pk_bf16(x, x) & 0xffffu); } }
#undef TROW
#undef SLOAD
#undef SWRITE
#undef RESC
#undef MASK
}
}

__device__ __forceinline__ void ph_attn(const Frame& F, const bf16_t* QKV, bf16_t* YC) {
    LAS char* lds = (LAS char*)F.lds;
    LAS float* tbl = (LAS float*)(lds + 2 * att::SHM_V + 2 * att::SHM_K + 2048);
    const int wid = F.wave;
    for (int i = F.tid_(); i < 5 * 128; i += NTHR) { const int row = 15 + (i >> 7), k = i & 127; float v = 0.f;
        if (row == 16) v = ((unsigned)(k - 56 + 8) < 16u) ? 0.f : -1e30f;
        if (row == 17) v = (k - 64 >= 0) ? 0.f : -1e30f;
        if (row == 18) v = (k - 64 <= 0) ? 0.f : -1e30f;
        if (row == 19) v = -1e30f;
        tbl[15 * 128 + i] = v; }
    if (F.tid_() < 256) tbl[20 * 128 + F.tid_()] = F.tid_() < 128 ? F.A.in[I_AQG][F.tid_()] : F.A.in[I_BQG][F.tid_() - 128];
    if (F.tid_() < 16) tbl[22 * 128 + F.tid_()] = F.A.in[I_ASINK][F.tid_()] * 1.4426950408889634f;
    int hprev = -1;
    volatile LAS int* qslot = (volatile LAS int*)(F.lds + MISC_OFF + 768);
    if (F.tid_() == 0) qslot[0] = atomicAdd(WSP(int, WS_CTL + CTL_AQ), 1);
    __syncthreads();
    for (;;) {
        const int u = __builtin_amdgcn_readfirstlane(qslot[0]);
        __syncthreads();
        if (u >= 2080) break;
        int unext = 0;
        att::UnitD U; int type, qrow0, wrr = 0, qoff, koff, voff, ooff, wrow; float sink_l2 = 0.f;
        if (u < 1040) {
            const int b = u / 520, rem = u % 520, h = rem / 65, qg = rem % 65;
            if (h != hprev) {
                int ti = F.tid_(); asm volatile("" : "+v"(ti));
                for (int i = ti; i < 15 * 128; i += NTHR) { const int dr = i >> 7, k = (i & 127) - 49; tbl[i] = ((unsigned)k < 31u) ? F.A.in[I_RPB][(size_t)h * 465 + dr * 31 + k] * (1.f / att::SCALE) : 0.f; }
                hprev = h;
            }
            type = 1;
            U.crow0 = ML + b * CTXL;
            if (qg < 64) { const int R0 = qg * 4; const int klo = min(max(R0 - 4, 0), 248), khi = min(max(R0 - 1, 0), 248) + 7;
                U.nW = khi - klo + 1; U.wrow0 = b * SEQ + klo * 64; U.wlo = klo; U.qt = R0; qrow0 = b * SEQ + R0 * 64; wrr = R0 + (wid >> 1); }
            else { U.nW = 0; U.wrow0 = 0; U.wlo = 0; U.qt = 0; qrow0 = ML + b * CTXL; }
            wrow = wid * 32; qoff = QB0 + h * 128; koff = KB0 + h * 128; voff = VB0 + h * 128; ooff = 1024 + h * 128;
        } else {
            const int v = u - 1040, b = v / 520, rem = v % 520, kvh = rem / 260, qt = rem % 260;
            const int g = wid >> 1, hq = kvh * 4 + g;
            type = 0;
            U.crow0 = ML + b * CTXL;
            if (qt < 256) { const int wlo = max(qt - 2, 0), whi = min(qt + 2, 255); U.nW = whi - wlo + 1; U.wlo = wlo; U.qt = qt; U.wrow0 = b * SEQ + wlo * 64; qrow0 = b * SEQ + qt * 64; }
            else { U.nW = 0; U.wlo = 0; U.qt = 1000; U.wrow0 = 0; qrow0 = ML + b * CTXL + (qt - 256) * 64; }
            sink_l2 = tbl[22 * 128 + hq];
            wrow = (wid & 1) * 32; qoff = QA0 + hq * 128; koff = KA0 + kvh * 128; voff = VA0 + kvh * 128; ooff = hq * 128;
        }
        U.NT = U.nW + 4;
        __syncthreads();
        att::attn_unit(type, QKV + (size_t)(qrow0 + wrow) * QKVC + qoff, QKV + koff, QKV + voff, YC + (size_t)(qrow0 + wrow) * D + ooff, U, wrr, sink_l2, lds,
                       tbl + (20 + type) * 128, (type == 0) && (qrow0 < ML), (qrow0 + wrow) % SEQ, WSP(int, WS_CTL + CTL_AQ), unext);
        if (F.tid_() == 0) qslot[0] = unext;
        __syncthreads();
    }
}

__device__ __forceinline__ void rows_y(const Frame& F, int s0, int s1, const LAS int* pref, const bf16_t* yslot, u32x2 (&ya)[8], u32x2 (&yb)[8]) {
    const int lane = F.lane_();
    const size_t y0 = ((size_t)pref[s0 >> 20] * 256 + (s0 & 0xfffff)) * D, y1 = ((size_t)pref[s1 >> 20] * 256 + (s1 & 0xfffff)) * D;
#pragma unroll
    for (int i = 0; i < 8; ++i) { ya[i] = *(const u32x2*)(yslot + y0 + i * 256 + lane * 4); yb[i] = *(const u32x2*)(yslot + y1 + i * 256 + lane * 4); }
}
template <bool LP>
__device__ __forceinline__ void rows_h(const Frame& F, int r, const u32x2 (&xin)[8], const u32x2 (&ya)[8], const u32x2 (&yb)[8], float g0, float g1, bool writeback, f32x4 (&v)[8], const LAS float* P) {
    const int lane = F.lane_(); const bool isc = r >= ML; const int mrow = isc ? 2 : r / SEQ;
    const float* gt = mod_row(F, 0, mrow) + 5 * D;
    bf16_t* dp = (bf16_t*)F.out + (size_t)r * D;
    float ss = 0.f;
#pragma unroll
    for (int i = 0; i < 8; ++i) { const int col = i * 256 + lane * 4; const u32x2 a = ya[i], b = yb[i]; const f32x4 g = LP ? *(const LAS f32x4*)(P + 2 * D + col) : *(const f32x4*)(gt + col);
        v[i] = (f32x4){bf_lo(xin[i][0]), bf_hi(xin[i][0]), bf_lo(xin[i][1]), bf_hi(xin[i][1])};
        v[i][0] += g[0] * (g0 * bf_lo(a[0]) + g1 * bf_lo(b[0])); v[i][1] += g[1] * (g0 * bf_hi(a[0]) + g1 * bf_hi(b[0]));
        v[i][2] += g[2] * (g0 * bf_lo(a[1]) + g1 * bf_lo(b[1])); v[i][3] += g[3] * (g0 * bf_hi(a[1]) + g1 * bf_hi(b[1]));
        if (writeback) { u32x2 o; o[0] = cvt_pk_bf16(v[i][0], v[i][1]); o[1] = cvt_pk_bf16(v[i][2], v[i][3]); *(u32x2*)(dp + col) = o; }
        ss += v[i][0] * v[i][0] + v[i][1] * v[i][1] + v[i][2] * v[i][2] + v[i][3] * v[i][3]; }
    ss = wave_sum(ss);
    const float rstd = rsqrtf(ss * (1.f / D) + 1e-6f);
    const float* gn = F.A.in[I_NMIX] + (size_t)D; const float* mr = mod_row(F, 1, mrow);
#pragma unroll
    for (int i = 0; i < 8; ++i) { const int col = i * 256 + lane * 4;
        if (LP) { const f32x4 ga = *(const LAS f32x4*)(P + col), sh = *(const LAS f32x4*)(P + D + col);
#pragma unroll
            for (int j = 0; j < 4; ++j) v[i][j] = v[i][j] * rstd * ga[j] + sh[j]; }
        else { const f32x4 g = *(const f32x4*)(gn + col), sc = *(const f32x4*)(mr + D + col), sh = *(const f32x4*)(mr + col);
#pragma unroll
            for (int j = 0; j < 4; ++j) v[i][j] = v[i][j] * rstd * (g[j] * (1.f + sc[j])) + sh[j]; } }
}
__device__ __forceinline__ void mix_block(int G, int bid, int& blk0, int& nown) {
    const int nc = max(G / 64, 1), nl = (G - nc) / 2;
    if (bid < 2 * nl) { const int seg = bid >= nl, i = bid - seg * nl, q = SEQ / nl, rm = SEQ % nl; blk0 = seg * SEQ + i * q + min(i, rm); nown = q + (i < rm); }
    else if (bid < 2 * nl + nc) { const int i = bid - 2 * nl, q = 2 * CTXL / nc, rm = (2 * CTXL) % nc; blk0 = ML + i * q + min(i, rm); nown = q + (i < rm); }
    else { blk0 = MT; nown = 0; }
}
struct RowIn2 { u32x2 v[8]; int s0, s1; float g0, g1; };
__device__ __forceinline__ void rows_load(const Frame& F, int r, RowIn2& R) {
    const int lane = F.lane_();
    const bf16_t* sp = (const bf16_t*)F.out + (size_t)r * D;
#pragma unroll
    for (int i = 0; i < 8; ++i) R.v[i] = *(const u32x2*)(sp + i * 256 + lane * 4);
    R.s0 = WSP(int, WS_TOKSEL)[r * 2]; R.s1 = WSP(int, WS_TOKSEL)[r * 2 + 1]; R.g0 = WSP(float, WS_TOKGATE)[r * 2]; R.g1 = WSP(float, WS_TOKGATE)[r * 2 + 1];
}
__device__ __forceinline__ void rows_pref(const Frame& F, LAS int* pref) {
    expert_prefix(F, 0, pref, (LAS int*)nullptr);
}
__device__ __forceinline__ void ph_rows_halo(const Frame& F, const bf16_t* yslot) {
    LAS int* pref = (LAS int*)(F.lds + MISC_OFF + 1024); rows_pref(F, pref);
    int blk0, nown; mix_block(F.G, F.bid, blk0, nown); const int lane = F.lane_();
    if (F.wave < 2) {
        const int r = F.wave == 0 ? blk0 - 1 : blk0 + nown;
        if (r >= 0 && r < MT && nown > 0) {
            RowIn2 R; rows_load(F, r, R); u32x2 ya[8], yb[8]; rows_y(F, R.s0, R.s1, pref, yslot, ya, yb); f32x4 v[8]; rows_h<false>(F, r, R.v, ya, yb, R.g0, R.g1, false, v, (const LAS float*)nullptr);
            bf16_t* hp = WSP(bf16_t, WS_HALO) + ((size_t)F.bid * 2 + F.wave) * D;
#pragma unroll
            for (int i = 0; i < 8; ++i) { u32x2 o; o[0] = cvt_pk_bf16(v[i][0], v[i][1]); o[1] = cvt_pk_bf16(v[i][2], v[i][3]); *(u32x2*)(hp + i * 256 + lane * 4) = o; }
        }
    }
}
__device__ __forceinline__ void ph_rows_mix6(const Frame& F, const bf16_t* yslot, bf16_t* Xw, bf16_t* Xa, bf16_t* Xg, bf16_t* Xr, bf16_t* Xk, bf16_t* Xv) {
    const int lane = F.lane_(), wave = F.wave;
    int blk0, nown; mix_block(F.G, F.bid, blk0, nown);
    LAS unsigned char* ring = F.lds;
    LAS float* MU = (LAS float*)(F.lds + 20 * 4096);
    LAS float* P = MU + 6 * D;
    if (nown > 0) {
        const int mrow = blk0 >= ML ? 2 : blk0 / SEQ;
        int t0 = F.tid_(); asm volatile("" : "+v"(t0));
        for (int idx = t0; idx < 6 * D / 4; idx += NTHR) *(LAS f32x4*)(MU + idx * 4) = *(const f32x4*)(F.A.in[I_MU] + idx * 4);
        for (int idx = t0; idx < D / 4; idx += NTHR) { const int c = idx * 4; const float* mr = mod_row(F, 1, mrow);
            const f32x4 g = *(const f32x4*)(F.A.in[I_NMIX] + (size_t)D + c), sc = *(const f32x4*)(mr + D + c);
            f32x4 a;
#pragma unroll
            for (int j = 0; j < 4; ++j) a[j] = g[j] * (1.f + sc[j]);
            *(LAS f32x4*)(P + c) = a; *(LAS f32x4*)(P + D + c) = *(const f32x4*)(mr + c); *(LAS f32x4*)(P + 2 * D + c) = *(const f32x4*)(mod_row(F, 0, mrow) + 5 * D + c); }
    }
    LAS int* pref = (LAS int*)(F.lds + MISC_OFF + 1024); rows_pref(F, pref);
    if (nown <= 0) return;
    const int NIT = (nown + 2 + 7) / 8;
    RowIn2 cur, nxt; u32x2 ya[8], yb[8];
    { const int q = wave; if (q >= 1 && q <= nown) { rows_load(F, blk0 + q - 1, cur); rows_y(F, cur.s0, cur.s1, pref, yslot, ya, yb); } }
    for (int it = 0; it < NIT + 1; ++it) {
        const int q = it * 8 + wave, qn = q + 8;
        if (qn >= 1 && qn <= nown) rows_load(F, blk0 + qn - 1, nxt);
        if (q == 0 || q == nown + 1) {
            const bf16_t* hp = WSP(bf16_t, WS_HALO) + ((size_t)F.bid * 2 + (q ? 1 : 0)) * D;
#pragma unroll
            for (int i = 0; i < 4; ++i) *(LAS u32x4*)(ring + (q % 20) * 4096 + (i * 512 + lane * 8) * 2) = *(const u32x4*)(hp + i * 512 + lane * 8);
        } else if (q >= 1 && q <= nown) {
            f32x4 v[8]; rows_h<true>(F, blk0 + q - 1, cur.v, ya, yb, cur.g0, cur.g1, true, v, P);
#pragma unroll
            for (int i = 0; i < 8; ++i) { u32x2 o; o[0] = cvt_pk_bf16(v[i][0], v[i][1]); o[1] = cvt_pk_bf16(v[i][2], v[i][3]); *(LAS u32x2*)(ring + (q % 20) * 4096 + (i * 256 + lane * 4) * 2) = o; }
        }
        cur = nxt;
        if (qn >= 1 && qn <= nown) rows_y(F, cur.s0, cur.s1, pref, yslot, ya, yb);
        __syncthreads();
        const int qm = it * 8 - 1 + wave;
        if (qm >= 1 && qm <= nown) {
            const int r = blk0 + qm - 1;
            const int sl = (r < ML) ? SEQ : CTXL, t = (r < ML) ? (r % SEQ) : ((r - ML) % CTXL);
            const float fp = (t > 0) ? 0.5f : 0.f, fn = (t < sl - 1) ? 0.5f : 0.f;
            const LAS unsigned char* rc = ring + (qm % 20) * 4096 + lane * 16; const LAS unsigned char* rp = ring + ((qm + 19) % 20) * 4096 + lane * 16; const LAS unsigned char* rn = ring + ((qm + 1) % 20) * 4096 + lane * 16;
#pragma unroll
            for (int i = 0; i < 4; ++i) {
                const int col = i * 512 + lane * 8;
                const u32x4 c = *(const LAS u32x4*)(rc + i * 1024), p = *(const LAS u32x4*)(rp + i * 1024), n = *(const LAS u32x4*)(rn + i * 1024);
                float cv[8], xv[8];
#pragma unroll
                for (int k = 0; k < 4; ++k) { cv[2 * k] = bf_lo(c[k]); cv[2 * k + 1] = bf_hi(c[k]);
                    const float pl = (t > 0) ? bf_lo(p[k]) : 0.f, ph = (t > 0) ? bf_hi(p[k]) : 0.f, nl = (t < sl - 1) ? bf_lo(n[k]) : 0.f, nh = (t < sl - 1) ? bf_hi(n[k]) : 0.f;
                    xv[2 * k] = (fp * pl + fn * nl) - cv[2 * k]; xv[2 * k + 1] = (fp * ph + fn * nh) - cv[2 * k + 1]; }
#pragma unroll
                for (int w = 0; w < 6; ++w) {
                    const int m = w == 0 ? 1 : w == 1 ? 4 : w == 2 ? 5 : w == 3 ? 0 : w == 4 ? 2 : 3;
                    bf16_t* X = w == 0 ? Xw : w == 1 ? Xa : w == 2 ? Xg : w == 3 ? Xr : w == 4 ? Xk : Xv;
                    const LAS float* mu = MU + m * D;
                    const f32x4 ma = *(const LAS f32x4*)(mu + col), mb = *(const LAS f32x4*)(mu + col + 4);
                    u32x4 o;
#pragma unroll
                    for (int k = 0; k < 4; ++k) { const float ml = (k < 2) ? ma[2 * k] : mb[2 * k - 4], mh = (k < 2) ? ma[2 * k + 1] : mb[2 * k - 3];
                        o[k] = cvt_pk_bf16(cv[2 * k] + xv[2 * k] * ml, cv[2 * k + 1] + xv[2 * k + 1] * mh); }
                    *(u32x4*)(X + (size_t)r * D + col) = o;
                }
            }
        }
    }
    __syncthreads();
}

__device__ __forceinline__ int scan_row(int dir, int b, int s) {
    if (s < CTXL) return ML + b * CTXL + (dir ? CTXL - 1 - s : s);
    const int t = s - CTXL; return b * SEQ + (dir ? SEQ - 1 - t : t);
}

namespace cs {
constexpr int CSLOT = 13056, SET = 4 * CSLOT, HP0 = 2 * SET, HPSZ = 10240, TP = 144;
constexpr int O_TA = 0, O_TR = 2304, O_A4 = 4608, O_A2 = 8704, O_A3 = 9728, O_VT = 10752, O_GC = 12800;
constexpr int O_BT = 0, O_KT = 2304;
constexpr int LQ0 = HP0 + 4 * HPSZ, LQSZ = 2048, O_LAB = 0, O_LAK = 1024;
constexpr int FLAG_OFF = MISC_OFF + 512;
typedef short s16x4 __attribute__((ext_vector_type(4)));
__device__ __forceinline__ u32x2 tr_issue(unsigned addr) { u32x2 r; asm volatile("ds_read_b64_tr_b16 %0, %1" : "=&v"(r) : "v"(addr) : "memory"); return r; }
__device__ __forceinline__ void tr_wait() { asm volatile("s_waitcnt lgkmcnt(0)" ::: "memory"); __builtin_amdgcn_sched_barrier(0); }
struct Raw { u32x4 v[5][2]; float rn; };
}
__device__ __forceinline__ void scan_cb(const Frame& F, const bf16_t* Rb, const bf16_t* Kb, const bf16_t* AS0, const bf16_t* AS1, float* CB, int nw, int wi) {
    const int lane = F.lane_(), stride = nw * 8;
    struct In { u32x4 k[4], r[4], a0[4], a1[4]; };
    auto loadrow = [&](int r, In& R) {
#pragma unroll
        for (int i = 0; i < 4; ++i) { const size_t ro = (size_t)r * D + i * 512 + lane * 8;
            R.k[i] = *(const u32x4*)(Kb + ro); R.r[i] = *(const u32x4*)(Rb + ro); R.a0[i] = *(const u32x4*)(AS0 + ro); R.a1[i] = *(const u32x4*)(AS1 + ro); }
    };
    In cur, nxt;
    int r = wi * 8 + F.wave;
    if (r < ML) loadrow(r, cur);
    for (; r < ML; r += stride) {
        if (r + stride < ML) loadrow(r + stride, nxt);
#pragma unroll
        for (int i = 0; i < 4; ++i) {
            const int col = i * 512 + lane * 8;
            const u32x4 kv = cur.k[i], rv = cur.r[i], a0 = cur.a0[i], a1 = cur.a1[i];
            const f32x4 ka0 = *(const f32x4*)(F.A.in[I_KA] + col), ka1 = *(const f32x4*)(F.A.in[I_KA] + col + 4), rk0 = *(const f32x4*)(F.A.in[I_RK] + col), rk1 = *(const f32x4*)(F.A.in[I_RK] + col + 4);
            float c0 = 0.f, c1 = 0.f;
#pragma unroll
            for (int j = 0; j < 8; ++j) { const unsigned kw = kv[j >> 1], rw = rv[j >> 1], aw0 = a0[j >> 1], aw1 = a1[j >> 1];
                const float k = (j & 1) ? bf_hi(kw) : bf_lo(kw), rr = (j & 1) ? bf_hi(rw) : bf_lo(rw), s0 = (j & 1) ? bf_hi(aw0) : bf_lo(aw0), s1 = (j & 1) ? bf_hi(aw1) : bf_lo(aw1);
                const float kac = j < 4 ? ka0[j] : ka1[j - 4], rkc = j < 4 ? rk0[j] : rk1[j - 4];
                const float rk = rr * k * rkc;
                c0 += rk * (1.f + (s0 - 1.f) * kac); c1 += rk * (1.f + (s1 - 1.f) * kac); }
            c0 += dpp_mov<0xB1>(c0); c0 += dpp_mov<0x4E>(c0); c0 += dpp_mov<0x141>(c0);
            c1 += dpp_mov<0xB1>(c1); c1 += dpp_mov<0x4E>(c1); c1 += dpp_mov<0x141>(c1);
            if ((lane & 7) == 0) { const int head = i * 8 + (lane >> 3); CB[(size_t)r * 32 + head] = c0; CB[((size_t)ML + r) * 32 + head] = c1; }
        }
        cur = nxt;
    }
}
__device__ __forceinline__ void ph_kkn(const Frame& F, const bf16_t* Kb, float* RN) {
    const int lane = F.lane_(), stride = F.G * 8;
    u32x4 cur[4], nxt[4];
    f32x4 kk[4][2];
#pragma unroll
    for (int i = 0; i < 4; ++i) { kk[i][0] = *(const f32x4*)(F.A.in[I_KK] + i * 512 + lane * 8); kk[i][1] = *(const f32x4*)(F.A.in[I_KK] + i * 512 + lane * 8 + 4); }
    int r = F.bid * 8 + F.wave;
    if (r < MT) {
#pragma unroll
        for (int i = 0; i < 4; ++i) cur[i] = *(const u32x4*)(Kb + (size_t)r * D + i * 512 + lane * 8); }
    for (; r < MT; r += stride) {
        if (r + stride < MT) {
#pragma unroll
            for (int i = 0; i < 4; ++i) nxt[i] = *(const u32x4*)(Kb + (size_t)(r + stride) * D + i * 512 + lane * 8); }
#pragma unroll
        for (int i = 0; i < 4; ++i) {
            const f32x4 kk0 = kk[i][0], kk1 = kk[i][1];
            float ss = 0.f;
#pragma unroll
            for (int j = 0; j < 4; ++j) { const float a = bf_lo(cur[i][j]) * (j < 2 ? kk0[2 * j] : kk1[2 * j - 4]), b = bf_hi(cur[i][j]) * (j < 2 ? kk0[2 * j + 1] : kk1[2 * j - 3]); ss += a * a + b * b; }
            ss += dpp_mov<0xB1>(ss); ss += dpp_mov<0x4E>(ss); ss += dpp_mov<0x141>(ss);
            if ((lane & 7) == 0) RN[(size_t)r * 32 + i * 8 + (lane >> 3)] = rsqrtf(ss + 1e-12f);
        }
#pragma unroll
        for (int i = 0; i < 4; ++i) cur[i] = nxt[i];
    }
}
__device__ __forceinline__ void ph_scan_chunked(const Frame& F, const bf16_t* Rb, const bf16_t* Kb, const bf16_t* Vb, const float* RN, bf16_t* DEC0, bf16_t* DEC1, const bf16_t* AS0, const bf16_t* AS1) {
    using namespace cs;
    const int lane = F.lane_(), wave = F.wave;
    LAS unsigned char* lds = F.lds;
    constexpr int NCH = (CTXL + SEQ) / 16, NSUP = NCH / 4;
    for (int item = F.bid; item < 128; item += F.G) {
        const int dir = item >> 6, b = (item >> 5) & 1, head = item & 31, hc = head * 64;
        bf16_t* DEC = dir ? DEC1 : DEC0; const bf16_t* AS = dir ? AS1 : AS0;
        if (wave >= 4) {
            const int h = wave - 4, k = lane;
            LAS unsigned char* hp = lds + HP0 + h * HPSZ;
            const float ka = F.A.in[I_KA][hc + k], kkc = F.A.in[I_KK][hc + k];
            Raw raw;
            auto gload = [&](int c) {
#pragma unroll
                for (int i = 0; i < 2; ++i) { const int pc = lane + 64 * i, t = pc >> 3, c8 = (pc & 7) * 8; const size_t o = (size_t)scan_row(dir, b, c * 16 + t) * D + hc + c8;
                    raw.v[0][i] = *(const u32x4*)(DEC + o); raw.v[1][i] = *(const u32x4*)(AS + o); raw.v[2][i] = *(const u32x4*)(Kb + o);
                    raw.v[3][i] = *(const u32x4*)(Rb + o); raw.v[4][i] = *(const u32x4*)(Vb + o); }
                raw.rn = RN[(size_t)scan_row(dir, b, c * 16 + (lane & 15)) * 32 + head];
            };
            auto process = [&](int c, int set, int cnext) {
                LAS unsigned char* sl = lds + set * SET + (c & 3) * CSLOT; LAS unsigned char* lq = lds + LQ0 + (set * 4 + (c & 3)) * LQSZ;
#pragma unroll
                for (int i = 0; i < 2; ++i) { const int pc = lane + 64 * i;
#pragma unroll
                    for (int v5 = 0; v5 < 4; ++v5) *(LAS u32x4*)(hp + v5 * 2048 + pc * 16) = raw.v[v5][i];
                    *(LAS u32x4*)(sl + O_VT + pc * 16) = raw.v[4][i]; }
                const float rn_c = raw.rn;
                lds_fence();
                if (cnext >= 0) gload(cnext);
                const unsigned trb = (unsigned)(uintptr_t)hp + (unsigned)(((lane >> 2) & 3) * 128 + ((lane >> 4) * 16 + (lane & 3) * 4) * 2);
                float e_[16], as_[16], k_[16], kn_[16], r_[16];
                u32x2 X0[4], X1[4], X2[4], X4[4];
#pragma unroll
                for (int j = 0; j < 4; ++j) { X0[j] = tr_issue(trb + 0 * 2048 + j * 512); X1[j] = tr_issue(trb + 1 * 2048 + j * 512); X2[j] = tr_issue(trb + 2 * 2048 + j * 512);
                    X4[j] = tr_issue(trb + 3 * 2048 + j * 512); }
                tr_wait();
#pragma unroll
                for (int j = 0; j < 4; ++j) {
                    const u32x2 x0 = X0[j], x1 = X1[j], x2 = X2[j], x4 = X4[j];
                    e_[4 * j] = bf_lo(x0[0]); e_[4 * j + 1] = bf_hi(x0[0]); e_[4 * j + 2] = bf_lo(x0[1]); e_[4 * j + 3] = bf_hi(x0[1]);
                    as_[4 * j] = bf_lo(x1[0]); as_[4 * j + 1] = bf_hi(x1[0]); as_[4 * j + 2] = bf_lo(x1[1]); as_[4 * j + 3] = bf_hi(x1[1]);
                    k_[4 * j] = bf_lo(x2[0]); k_[4 * j + 1] = bf_hi(x2[0]); k_[4 * j + 2] = bf_lo(x2[1]); k_[4 * j + 3] = bf_hi(x2[1]);
                    r_[4 * j] = bf_lo(x4[0]); r_[4 * j + 1] = bf_hi(x4[0]); r_[4 * j + 2] = bf_lo(x4[1]); r_[4 * j + 3] = bf_hi(x4[1]);
                }
#pragma unroll
                for (int t = 0; t < 16; ++t) kn_[t] = k_[t] * (kkc * __int_as_float(__builtin_amdgcn_readlane(__float_as_int(rn_c), t)));
                float g = 1.f, cs = 0.f, bt[16], kt[16];
#pragma unroll
                for (int t = 0; t < 16; ++t) {
                    const float gp = g; cs += e_[t]; const float m2 = cs * 1.4426950408889634f; g = __builtin_amdgcn_exp2f(-m2); const float ig = __builtin_amdgcn_exp2f(m2);
                    const float bb = kn_[t] * as_[t], kd = k_[t] * (1.f + (as_[t] - 1.f) * ka);
                    bt[t] = bb * ig; kt[t] = kd * ig;
                    const unsigned w0 = cvt_pk_bf16(-kn_[t] * gp, r_[t] * g), w1 = cvt_pk_bf16(bt[t], kt[t]);
                    *(LAS unsigned short*)(sl + O_TA + t * TP + k * 2) = (unsigned short)(w0 & 0xffffu); *(LAS unsigned short*)(sl + O_TR + t * TP + k * 2) = (unsigned short)(w0 >> 16);
                    *(LAS unsigned short*)(hp + O_BT + t * TP + k * 2) = (unsigned short)(w1 & 0xffffu); *(LAS unsigned short*)(hp + O_KT + t * TP + k * 2) = (unsigned short)(w1 >> 16);
                }
#pragma unroll
                for (int q = 0; q < 4; ++q) { u32x4 o; o[0] = cvt_pk_bf16(bt[4 * q] * g, bt[4 * q + 1] * g); o[1] = cvt_pk_bf16(bt[4 * q + 2] * g, bt[4 * q + 3] * g);
                    o[2] = cvt_pk_bf16(kt[4 * q] * g, kt[4 * q + 1] * g); o[3] = cvt_pk_bf16(kt[4 * q + 2] * g, kt[4 * q + 3] * g);
                    *(LAS u32x4*)(sl + O_A4 + k * 64 + q * 16) = o; }
                *(LAS float*)(sl + O_GC + k * 4) = g;
                lds_fence();
                const int i16 = lane & 15, q4 = lane >> 4;
                f32x4 Lab = (f32x4){0.f, 0.f, 0.f, 0.f}, Lak = Lab, Urb = Lab, Urk = Lab;
#pragma unroll
                for (int s2 = 0; s2 < 2; ++s2) {
                    const bf16x8 a_ = *(const LAS bf16x8*)(sl + O_TA + i16 * TP + s2 * 64 + q4 * 16), r2 = *(const LAS bf16x8*)(sl + O_TR + i16 * TP + s2 * 64 + q4 * 16);
                    const bf16x8 b_ = *(const LAS bf16x8*)(hp + O_BT + i16 * TP + s2 * 64 + q4 * 16), k2 = *(const LAS bf16x8*)(hp + O_KT + i16 * TP + s2 * 64 + q4 * 16);
                    Lab = __builtin_amdgcn_mfma_f32_16x16x32_bf16(a_, b_, Lab, 0, 0, 0); Lak = __builtin_amdgcn_mfma_f32_16x16x32_bf16(a_, k2, Lak, 0, 0, 0);
                    Urb = __builtin_amdgcn_mfma_f32_16x16x32_bf16(r2, b_, Urb, 0, 0, 0); Urk = __builtin_amdgcn_mfma_f32_16x16x32_bf16(r2, k2, Urk, 0, 0, 0);
                }
#pragma unroll
                for (int j = 0; j < 4; ++j) { const int t = 4 * q4 + j;
                    const float lab = (i16 < t) ? Lab[j] : 0.f, lak = (i16 < t) ? Lak[j] : 0.f, urb = (i16 <= t) ? Urb[j] : 0.f, urk = (i16 <= t) ? Urk[j] : 0.f;
                    *(LAS float*)(lq + O_LAB + (t * 16 + i16) * 4) = lab; *(LAS float*)(lq + O_LAK + (t * 16 + i16) * 4) = lak;
                    const unsigned w = cvt_pk_bf16(urb, urk);
                    LAS unsigned char* ap = sl + O_A3 + (t * 4 + (i16 >> 2)) * 16 + (i16 & 3) * 2;
                    *(LAS unsigned short*)(ap) = (unsigned short)(w & 0xffffu); *(LAS unsigned short*)(ap + 8) = (unsigned short)(w >> 16); }
            };
            gload(h); process(h, 0, 4 + h);
            __syncthreads();
            for (int s = 0; s < NSUP; ++s) {
                if (s + 1 < NSUP) process(4 * (s + 1) + h, (s + 1) & 1, (s + 2 < NSUP) ? 4 * (s + 2) + h : -1);
                __syncthreads();
            }
        } else {
            const int vb = wave * 16, t16 = lane & 15, q4 = lane >> 4;
            f32x4 St[4];
#pragma unroll
            for (int m = 0; m < 4; ++m) St[m] = (f32x4){0.f, 0.f, 0.f, 0.f};
            volatile LAS int* flag = (volatile LAS int*)(lds + FLAG_OFF);
            if (lane == 0) flag[wave] = 0;
            __syncthreads();
            for (int s = 0; s < NSUP; ++s) {
                {
                    const LAS unsigned char* lq = lds + LQ0 + ((s & 1) * 4 + wave) * LQSZ; LAS unsigned char* sl = lds + (s & 1) * SET + wave * CSLOT;
                    const int cc = lane & 31;
                    float x[16]; f32x4 Lr[16][4];
#pragma unroll
                    for (int t = 0; t < 16; ++t) x[t] = *(const LAS float*)(lq + O_LAK + (t * 16 + (cc & 15)) * 4);
#pragma unroll
                    for (int t = 1; t < 16; ++t)
#pragma unroll
                        for (int i4 = 0; i4 * 4 < t; ++i4) Lr[t][i4] = *(const LAS f32x4*)(lq + O_LAB + (t * 16 + i4 * 4) * 4);
                    asm volatile("s_waitcnt lgkmcnt(0)" ::: "memory"); __builtin_amdgcn_sched_barrier(0);
#pragma unroll
                    for (int t = 0; t < 16; ++t) x[t] = (cc < 16) ? ((cc == t) ? 1.f : 0.f) : x[t];
#pragma unroll
                    for (int i = 0; i < 15; ++i)
#pragma unroll
                        for (int t = i + 1; t < 16; ++t) x[t] += Lr[t][i >> 2][i & 3] * x[i];
                    if (lane < 32) {
#pragma unroll
                        for (int t = 0; t < 16; ++t) *(LAS unsigned short*)(sl + O_A2 + (t * 4 + ((cc & 15) >> 2)) * 16 + (cc & 3) * 2 + ((cc >> 4) * 8)) = (unsigned short)(cvt_pk_bf16(x[t], x[t]) & 0xffffu);
                    }
                    lds_fence();
                    if (lane == 0) flag[wave] = s + 1;
                }
#pragma unroll 1
                for (int jc = 0; jc < 4; ++jc) {
                    const int c = 4 * s + jc;
                    LAS unsigned char* sl = lds + (s & 1) * SET + jc * CSLOT;
                    while (flag[jc] < s + 1) __builtin_amdgcn_s_sleep(1);
                    asm volatile("" ::: "memory");
                    const u32x2 vt = tr_issue((unsigned)(uintptr_t)(sl + O_VT) + (unsigned)((4 * q4 + ((lane >> 2) & 3)) * 128 + (vb + (lane & 3) * 4) * 2));
                    bf16x8 Sb[2];
#pragma unroll
                    for (int s2 = 0; s2 < 2; ++s2) { u32x4 w; w[0] = cvt_pk_bf16(St[2 * s2][0], St[2 * s2][1]); w[1] = cvt_pk_bf16(St[2 * s2][2], St[2 * s2][3]);
                        w[2] = cvt_pk_bf16(St[2 * s2 + 1][0], St[2 * s2 + 1][1]); w[3] = cvt_pk_bf16(St[2 * s2 + 1][2], St[2 * s2 + 1][3]); Sb[s2] = *reinterpret_cast<bf16x8*>(&w); }
                    f32x4 Xa = (f32x4){0.f, 0.f, 0.f, 0.f}, Xr = Xa;
#pragma unroll
                    for (int s2 = 0; s2 < 2; ++s2) {
                        const u32x2 a0 = *(const LAS u32x2*)(sl + O_TA + t16 * TP + s2 * 64 + q4 * 8), a1 = *(const LAS u32x2*)(sl + O_TA + t16 * TP + s2 * 64 + 32 + q4 * 8);
                        const u32x2 r0 = *(const LAS u32x2*)(sl + O_TR + t16 * TP + s2 * 64 + q4 * 8), r1 = *(const LAS u32x2*)(sl + O_TR + t16 * TP + s2 * 64 + 32 + q4 * 8);
                        u32x4 aw = {a0[0], a0[1], a1[0], a1[1]}, rw = {r0[0], r0[1], r1[0], r1[1]};
                        Xa = __builtin_amdgcn_mfma_f32_16x16x32_bf16(*reinterpret_cast<bf16x8*>(&aw), Sb[s2], Xa, 0, 0, 0);
                        Xr = __builtin_amdgcn_mfma_f32_16x16x32_bf16(*reinterpret_cast<bf16x8*>(&rw), Sb[s2], Xr, 0, 0, 0);
                    }
                    tr_wait();
                    u32x4 b2 = {cvt_pk_bf16(Xa[0], Xa[1]), cvt_pk_bf16(Xa[2], Xa[3]), vt[0], vt[1]};
                    const bf16x8 A2 = *(const LAS bf16x8*)(sl + O_A2 + (t16 * 4 + q4) * 16), A3 = *(const LAS bf16x8*)(sl + O_A3 + (t16 * 4 + q4) * 16);
                    const f32x4 P = __builtin_amdgcn_mfma_f32_16x16x32_bf16(A2, *reinterpret_cast<bf16x8*>(&b2), (f32x4){0.f, 0.f, 0.f, 0.f}, 0, 0, 0);
                    u32x4 bp = {cvt_pk_bf16(P[0], P[1]), cvt_pk_bf16(P[2], P[3]), vt[0], vt[1]};
                    const bf16x8 Bpv = *reinterpret_cast<bf16x8*>(&bp);
                    const f32x4 Y = __builtin_amdgcn_mfma_f32_16x16x32_bf16(A3, Bpv, Xr, 0, 0, 0);
#pragma unroll
                    for (int m = 0; m < 4; ++m) { const f32x4 gc = *(const LAS f32x4*)(sl + O_GC + (16 * m + 4 * q4) * 4); const bf16x8 A4 = *(const LAS bf16x8*)(sl + O_A4 + ((16 * m + t16) * 4 + q4) * 16);
                        St[m] = __builtin_amdgcn_mfma_f32_16x16x32_bf16(A4, Bpv, St[m] * gc, 0, 0, 0); }
                    if (c >= CTXL / 16) {
#pragma unroll
                        for (int j = 0; j < 4; ++j) { const int row = scan_row(dir, b, c * 16 + 4 * q4 + j); DEC[(size_t)row * D + hc + vb + t16] = (bf16_t)(cvt_pk_bf16(Y[j], Y[j]) & 0xffffu); }
                    }
                }
                __syncthreads();
            }
        }
        __syncthreads();
    }
}

__device__ __forceinline__ void ph_rwkv_out(const Frame& F, const bf16_t* Y0, const bf16_t* Y1, const bf16_t* Vb, const bf16_t* Gb, const float* CB, bf16_t* Z) {
    const int lane = F.lane_(), stride = F.G * 8;
    struct In { u32x4 a[4], b[4], v[4], g[4]; };
    auto loadrow = [&](int r, In& R) {
#pragma unroll
        for (int i = 0; i < 4; ++i) { const size_t ro = (size_t)r * D + i * 512 + lane * 8;
            R.a[i] = *(const u32x4*)(Y0 + ro); R.b[i] = *(const u32x4*)(Y1 + ro); R.v[i] = *(const u32x4*)(Vb + ro); R.g[i] = *(const u32x4*)(Gb + ro); }
    };
    In cur, nxt;
    int r = F.bid * 8 + F.wave;
    if (r < ML) loadrow(r, cur);
    for (; r < ML; r += stride) {
        if (r + stride < ML) loadrow(r + stride, nxt);
#pragma unroll
        for (int i = 0; i < 4; ++i) {
            const int col = i * 512 + lane * 8, head = i * 8 + (lane >> 3);
            float y[8]; float s = 0.f;
#pragma unroll
            for (int j = 0; j < 4; ++j) { y[2 * j] = bf_lo(cur.a[i][j]) + bf_lo(cur.b[i][j]); y[2 * j + 1] = bf_hi(cur.a[i][j]) + bf_hi(cur.b[i][j]); s += y[2 * j] + y[2 * j + 1]; }
            s += dpp_mov<0xB1>(s); s += dpp_mov<0x4E>(s); s += dpp_mov<0x141>(s);
            const float mu = s * (1.f / 64.f);
            float vs = 0.f;
#pragma unroll
            for (int j = 0; j < 8; ++j) { const float d = y[j] - mu; vs += d * d; }
            vs += dpp_mov<0xB1>(vs); vs += dpp_mov<0x4E>(vs); vs += dpp_mov<0x141>(vs);
            const float rstd = rsqrtf(vs * (1.f / 64.f) + 64e-5f);
            const float cb = CB[(size_t)r * 32 + head] + CB[((size_t)ML + r) * 32 + head];
            const f32x4 lw0 = *(const f32x4*)(F.A.in[I_LNW] + col), lw1 = *(const f32x4*)(F.A.in[I_LNW] + col + 4), lb0 = *(const f32x4*)(F.A.in[I_LNB] + col), lb1 = *(const f32x4*)(F.A.in[I_LNB] + col + 4);
            u32x4 o;
#pragma unroll
            for (int j = 0; j < 4; ++j) { const int c = 2 * j;
                const float w0 = c < 4 ? lw0[c] : lw1[c - 4], w1 = c + 1 < 4 ? lw0[c + 1] : lw1[c - 3], b0 = c < 4 ? lb0[c] : lb1[c - 4], b1 = c + 1 < 4 ? lb0[c + 1] : lb1[c - 3];
                const float z0 = ((y[c] - mu) * rstd * w0 + b0 + cb * bf_lo(cur.v[i][j])) * bf_lo(cur.g[i][j]);
                const float z1 = ((y[c + 1] - mu) * rstd * w1 + b1 + cb * bf_hi(cur.v[i][j])) * bf_hi(cur.g[i][j]);
                o[j] = cvt_pk_bf16(z0, z1); }
            *(u32x4*)(Z + (size_t)r * D + col) = o;
        }
        cur = nxt;
    }
}

__device__ __forceinline__ void moe_prefix(const Frame& F, int layer, LAS int*& pref, LAS int*& cntl) {
    pref = (LAS int*)(F.lds + MISC_OFF + 1024); cntl = pref + 40;
    __syncthreads();
    expert_prefix(F, layer, pref, cntl);
}
__device__ __forceinline__ void ph_moe_up(const Frame& F, int layer, const bf16_t* H, const bf16_t* W13, bf16_t* HID) {
    LAS int* pref; LAS int* cntl; moe_prefix(F, layer, pref, cntl);
    MoeSched S{pref, cntl, WSP(int, WS_TOKL), 4, F.G, F.bid, D, 2 * FF, true};
    pg8::EpiMoeUp E{HID};
    pg8::gemm_phase(F.lds, H, W13, D, S, E);
}
__device__ __forceinline__ void ph_moe_down(const Frame& F, int layer, const bf16_t* HID, const bf16_t* W2T, bf16_t* YS) {
    LAS int* pref; LAS int* cntl; moe_prefix(F, layer, pref, cntl);
    MoeSched S{pref, cntl, WSP(int, WS_TOKL), 8, F.G, F.bid, FF, D, false};
    pg8::EpiStoreBf16<0> E{YS, D, nullptr, 0, 0};
    pg8::gemm_phase(F.lds, HID, W2T, FF, S, E);
}
template <int ACT>
__device__ __forceinline__ void ph_gemm_bf16(const Frame& F, const bf16_t* A, const bf16_t* Bt, int M, int N, int K, bf16_t* O, int ldc, const float* vec, int split_cols, size_t split_stride) {
    pg8::DenseSched S; S.init(M, N, K, F.G, F.bid);
    pg8::EpiStoreBf16<ACT> E{O, ldc, vec, split_cols, split_stride};
    pg8::gemm_phase(F.lds, A, Bt, K, S, E);
}
__device__ __forceinline__ void ph_gemm_multi(const Frame& F, const pg8::MultiSched& S, const bf16_t* Abase, const bf16_t* Bt, int K, const pg8::EpiMultiBf16& E) {
    pg8::gemm_phase(F.lds, Abase, Bt, K, S, E);
}
template <bool INB>
__device__ __forceinline__ void ph_gemm_res(const Frame& F, const bf16_t* A, const bf16_t* Bt, int M, const float* xin_l, const float* xin_c, const bf16_t* xin_b, bf16_t* out, const float* gate) {
    pg8::DenseSched S; S.init(M, D, D, F.G, F.bid);
    pg8::EpiRes<INB> E{xin_l, xin_c, xin_b, out, gate};
    pg8::gemm_phase(F.lds, A, Bt, D, S, E);
}

constexpr int LDS_BYTES = 163840;
constexpr int N_PHASES = 20;
__global__ void __launch_bounds__(NTHR, 2) fwd(Args args) {
    extern __shared__ __attribute__((aligned(16))) unsigned char lds_raw[];
    Frame F(args);
    F.out = args.out; F.ws = args.ws; F.lds = (LAS unsigned char*)lds_raw;
    F.wave = __builtin_amdgcn_readfirstlane((int)threadIdx.x >> 6); F.G = gridDim.x; F.bid = blockIdx.x;
    volatile LAS unsigned* misc = (volatile LAS unsigned*)(F.lds + MISC_OFF);
    if (F.tid_() < 4) misc[F.tid_()] = 0u;
    __syncthreads();
    XcdBarrier bar; bar.bar = (unsigned*)(F.ws + WS_CTL); bar.x = 0; bar.st = misc;
    const int lo = args.ph_lo, hi = args.ph_hi;
    if (hi - lo > 1) bar = xcd_barrier_post((unsigned*)(F.ws + WS_CTL), misc);
#ifndef PH_ONLY
#define PH_ONLY -1
#endif
#define IN(k) ((PH_ONLY < 0 || PH_ONLY == (k)) && lo <= (k) && (k) < hi)
#define SEAM(k) do { if (IN(k) && IN((k) + 1)) xcd_barrier(bar); } while (0)
#define S0 WSP(bf16_t, SLOTP(0))
#define S1 WSP(bf16_t, SLOTP(1))
#define S2 WSP(bf16_t, SLOTP(2))
#define S3 WSP(bf16_t, SLOTP(3))
#define S4 WSP(bf16_t, SLOTP(4))
#define S5 WSP(bf16_t, SLOTP(5))
#define S6 WSP(bf16_t, SLOTP(6))
#define S7 WSP(bf16_t, SLOTP(7))
#define S8 WSP(bf16_t, SLOTP(8))
#define XS ((bf16_t*)F.out)
#define CB WSP(float, WS_CB)
    const size_t W2OFF = (size_t)NEXP * 2 * FF * D;

#define TSTART(k) do { if (TIME_PH == (k) && blockIdx.x == 0 && threadIdx.x == 0) *WSP(unsigned long long, WS_CTL + 20480) = wall_clock64(); } while (0)
#define TSTOP(k) do { if (TIME_PH == (k) && blockIdx.x == 0 && threadIdx.x == 0) *WSP(float, WS_CTL + 20496) = (float)(wall_clock64() - *WSP(unsigned long long, WS_CTL + 20480)) * 0.01f; } while (0)
    TSTART(0);
    if (IN(0)) ph_prologue(F);
    SEAM(0);
    TSTOP(0);
    TSTART(1);
    if (IN(1)) { { RowOpts O{F.A.in[I_X], F.A.in[I_CTX], MT, false, 0, nullptr, nullptr, nullptr, true, 0, 0, S0, false}; ph_rows(F, O); } ph_router_fold(F); }
    SEAM(1);
    TSTOP(1);
    TSTART(2);
    if (IN(2)) { ph_gemm_bf16<0>(F, S0, WSP(bf16_t, WT_IN), MT, QKVC, D, S1, QKVC, nullptr, 0, 0);
                 const int rem = ((MT / 256) * (QKVC / 256)) % F.G; int base = 0;
                 cvt_moe2(F, 0, S6 + W2OFF, base, F.G - rem, F.bid - rem); }
    SEAM(2);
    TSTOP(2);
    TSTART(3);
    if (IN(3)) ph_qknorm(F, S1);
    SEAM(3);
    TSTOP(3);
    TSTART(4);
    if (IN(4)) ph_attn(F, S1, S4);
    SEAM(4);
    TSTOP(4);
    TSTART(5);
    if (IN(5)) { ph_gemm_res<false>(F, S4, WSP(bf16_t, WT_OUT), MT, F.A.in[I_X], F.A.in[I_CTX], nullptr, XS, mod_row(F, 0, 0) + 2 * D);
                 const int rem = ((MT / 256) * (D / 256)) % F.G; int base = 0;
                 cvt_moe13(F, 0, S6, base, F.G - rem, F.bid - rem); }
    SEAM(5);
    TSTOP(5);
    TSTART(6);
    if (IN(6)) ph_rows_router(F, XS, MT, 0, S0);
    SEAM(6);
    TSTOP(6);
    TSTART(7);
    if (IN(7)) ph_moe_up(F, 0, S0, S6, S5);
    SEAM(7);
    TSTOP(7);
    TSTART(8);
    if (IN(8)) ph_moe_down(F, 0, S5, S6 + W2OFF, S1);
    SEAM(8);
    TSTOP(8);
    TSTART(9);
    if (IN(9)) ph_rows_halo(F, S1);
    SEAM(9);
    TSTOP(9);
    TSTART(10);
    if (IN(10)) ph_rows_mix6(F, S1, S4, S5, S7, S0, S6, S8);
    SEAM(10);
    TSTOP(10);
    TSTART(11);
    if (IN(11)) { { pg8::MultiSched S; S.init(MT, 256, D, 3, F.G, F.bid); S.a0 = (unsigned)SLOTP(4); S.a1 = (unsigned)SLOTP(5); S.a2 = (unsigned)SLOTP(7); S.a3 = 0; S.b0 = 0; S.b1 = 256; S.b2 = 512; S.b3 = 0;
                    pg8::EpiMultiBf16 E{WSP(bf16_t, WS_TW), (size_t)(WS_TA - WS_TW) / 2, 0x210u, 256, 0x201u, F.A.in[I_W0], 0l, 0};
                    ph_gemm_multi(F, S, (const bf16_t*)F.ws, WSP(bf16_t, WT_W1), D, E); }
                  { pg8::MultiSched S; S.init(MT, D, D, 3, F.G, (F.bid + F.G / 2) % F.G);
                    S.a0 = (unsigned)SLOTP(0); S.a1 = (unsigned)SLOTP(6); S.a2 = (unsigned)SLOTP(8); S.a3 = 0; S.b0 = 0; S.b1 = D; S.b2 = 2 * D; S.b3 = 0;
                    pg8::EpiMultiBf16 E{S1, (size_t)SLOT / 2, 0x210u, D, 0u, F.A.in[I_W0], 0l, 0};
                    ph_gemm_multi(F, S, (const bf16_t*)F.ws, WSP(bf16_t, WT_R), D, E); } }
    SEAM(11);
    TSTOP(11);
    TSTART(12);
    if (IN(12)) { pg8::MultiSched S; S.init(MT, D, 256, 4, F.G, F.bid); S.a0 = (unsigned)WS_TW; S.a1 = (unsigned)WS_TW + 256u; S.a2 = (unsigned)WS_TA; S.a3 = (unsigned)WS_TA + 256u;
                  S.b0 = 0; S.b1 = D; S.b2 = (int)((WT_A2 - WT_W2) / 256); S.b3 = (int)((WT_A2 - WT_W2) / 256) + D;
                  pg8::EpiMultiBf16 E{S0, (size_t)SLOT / 2, 0x6540u, D, 0x4433u, F.A.in[I_W0], (long)(F.A.in[I_A0] - F.A.in[I_W0]), D};
#pragma unroll 1
                  for (int pass = 0; pass < 2; ++pass) {
                      if (((F.bid >> 3) & 1) == pass) ph_gemm_multi(F, S, (const bf16_t*)F.ws, WSP(bf16_t, WT_W2), 128, E);
                      else ph_kkn(F, S2, WSP(float, WS_RN));
                      __syncthreads();
                  } }
    SEAM(12);
    TSTOP(12);
    TSTART(13);
    if (IN(13)) { ph_scan_chunked(F, S1, S2, S3, WSP(float, WS_RN), S0, S4, S5, S6);
                  const int gw = F.G > 128 ? F.G - 128 : F.G, gc = F.G > 128 ? F.bid - 128 : F.bid;
                  if (gc >= 0) {
                      pg8::DenseSched S; S.init(ML, D, 256, gw, gc); pg8::EpiStoreBf16<0> E{S8, D, nullptr, 0, 0};
                      pg8::gemm_phase(F.lds, WSP(bf16_t, WS_TG), WSP(bf16_t, WT_G2), 256, S, E);
                      scan_cb(F, S1, S2, S5, S6, CB, gw, gc);
                      __syncthreads(); int base = 0; cvt_moe13(F, 1, S7, base, gw, gc); } }
    SEAM(13);
    TSTOP(13);
    TSTART(14);
    if (IN(14)) ph_rwkv_out(F, S0, S4, S3, S8, CB, S2);
    SEAM(14);
    TSTOP(14);
    TSTART(15);
    if (IN(15)) ph_gemm_res<true>(F, S2, WSP(bf16_t, WT_O), ML, nullptr, nullptr, XS, S8, mod_row(F, 1, 0) + 2 * D);
    SEAM(15);
    TSTOP(15);
    TSTART(16);
    if (IN(16)) {
#pragma unroll 1
        for (int pass = 0; pass < 2; ++pass) {
            if (((F.bid >> 3) & 1) == pass) ph_rows_router(F, S8, ML, 1, S0);
            else { int base = 0; cvt_moe2(F, 1, S5, base); }
            __syncthreads();
        } }
    SEAM(16);
    TSTOP(16);
    TSTART(17);
    if (IN(17)) ph_moe_up(F, 1, S0, S7, S4);
    SEAM(17);
    TSTOP(17);
    TSTART(18);
    if (IN(18)) ph_moe_down(F, 1, S4, S5, S1);
    SEAM(18);
    TSTOP(18);
    TSTART(19);
    if (IN(19)) { RowOpts O{nullptr, nullptr, ML, true, 1, S1, F.out, nullptr, false, 1, 0, nullptr, false, S8}; ph_rows(F, O); }
#undef IN
#undef SEAM
}

extern "C" void kernel_launch(void* const* d_in, const int* in_sizes, int n_in, void* d_out, int out_size, void* d_ws, size_t ws_size, hipStream_t stream) {
    static int grid = 0;
    if (grid == 0) {
        if (n_in != 39 || out_size != ML * D || ws_size < WS_END) { fprintf(stderr, "kernel_launch: unexpected shapes (n_in %d out %d ws %zu need %zu)\n", n_in, out_size, ws_size, (size_t)WS_END); grid = -1; return; }
        int dev = 0, cus = 0;
        if (hipGetDevice(&dev) != hipSuccess || hipDeviceGetAttribute(&cus, hipDeviceAttributeMultiprocessorCount, dev) != hipSuccess) { grid = -1; return; }
        if (hipFuncSetAttribute((const void*)fwd, hipFuncAttributeMaxDynamicSharedMemorySize, LDS_BYTES) != hipSuccess) { fprintf(stderr, "kernel_launch: hipFuncSetAttribute failed\n"); grid = -1; return; }
        int per_cu = 0;
        if (hipOccupancyMaxActiveBlocksPerMultiprocessor(&per_cu, (const void*)fwd, NTHR, LDS_BYTES) != hipSuccess || per_cu < 1) { fprintf(stderr, "kernel_launch: occupancy query says %d\n", per_cu); }
        (void)hipGetLastError();
        grid = cus;
    }
    if (grid < 0) return;
    (void)hipMemsetAsync((char*)d_ws + WS_CTL, 0, CTL_BYTES, stream);
    Args a{};
    for (int i = 0; i < 39; ++i) a.in[i] = (const float*)d_in[i];
    a.out = (float*)d_out; a.ws = (unsigned char*)d_ws;
#if ONE_LAUNCH
    a.ph_lo = 0; a.ph_hi = N_PHASES;
    hipLaunchKernelGGL(fwd, dim3(grid), dim3(NTHR), LDS_BYTES, stream, a);
#else
    for (int p = 0; p < N_PHASES; ++p) { a.ph_lo = p; a.ph_hi = p + 1; const int reps = 1 + (int)((PROBE_MASK >> p) & 1ull); for (int r = 0; r < reps; ++r) hipLaunchKernelGGL(fwd, dim3(grid), dim3(NTHR), LDS_BYTES, stream, a); }
#endif
}
```
